# Optimizing an MI355X kernel written in HIP

```python
import jax
import jax.numpy as jnp
from jax import lax
import numpy as np

D_MODEL = 1024
BATCH = 8
SEQ = 8192
DEPTH = 1

ATT_HEADS = 4
ATT_HEAD_DIM = 128
ATT_WIDTH = ATT_HEADS * ATT_HEAD_DIM
IDX_HEADS = 8
IDX_DIM = 64
TOPK_MAX = 256
Q_BLOCK = 128
GLA_HEADS = 4
GLA_DK = 64
GLA_DV = 128
GLA_WIDTH = GLA_HEADS * GLA_DV
GLA_GATE_RANK = 16
GLA_TAU = 16.0
GLA_CHUNK = 64
D_MIX = ATT_WIDTH + GLA_WIDTH
D_FF = ((8 * D_MODEL + 2) // 3 + 255) // 256 * 256
N_MOD = 6
NORM_EPS = 1e-6
IN_SPLITS = (ATT_WIDTH, ATT_WIDTH, ATT_WIDTH,
             IDX_HEADS * IDX_DIM, IDX_DIM, IDX_HEADS,
             GLA_HEADS * GLA_DK, GLA_HEADS * GLA_DK,
             GLA_WIDTH, GLA_WIDTH, GLA_GATE_RANK)
D_IN = sum(IN_SPLITS)

kernel_name = 'hymba_dsa_gla_adaln_block'


def _rms_norm(x, g):
    xf = x.astype(jnp.float32)
    y = xf * lax.rsqrt(jnp.mean(xf * xf, axis=-1, keepdims=True) + NORM_EPS)
    return (y * g.astype(jnp.float32)).astype(x.dtype)


def _modulate(h, shift, scale):
    return h * (1 + scale[:, None, :]) + shift[:, None, :]


def _split_cols(p, sizes):
    offs = []
    acc = 0
    for s in sizes[:-1]:
        acc += s
        offs.append(acc)
    return jnp.split(p, offs, axis=-1)


def dsa_attention(q, k, v, q_idx, k_idx, w_idx):
    B, L, H, Dh = q.shape
    n_sel = min(TOPK_MAX, L // 4)
    n_blocks = L // Q_BLOCK
    att_scale = Dh ** -0.5
    idx_scale = (IDX_HEADS ** -0.5) * (IDX_DIM ** -0.5)
    key_pos = jnp.arange(L)
    k_idx_f = k_idx.astype(jnp.float32)

    def block(i):
        start = i * Q_BLOCK
        qb = lax.dynamic_slice_in_dim(q, start, Q_BLOCK, axis=1)
        qib = lax.dynamic_slice_in_dim(q_idx, start, Q_BLOCK, axis=1)
        wb = lax.dynamic_slice_in_dim(w_idx, start, Q_BLOCK, axis=1)
        q_pos = start + jnp.arange(Q_BLOCK)
        causal = key_pos[None, :] <= q_pos[:, None]
        s_idx = jnp.einsum('bthd,bsd->bths', qib.astype(jnp.float32), k_idx_f)
        score = jnp.einsum('bths,bth->bts', jax.nn.relu(s_idx),
                           wb.astype(jnp.float32) * idx_scale)
        score = jnp.where(causal[None], score, -jnp.inf)
        _, sel = lax.top_k(score, n_sel)
        valid = sel <= q_pos[None, :, None]
        kg = jax.vmap(lambda kk, ii: kk[ii])(k, sel)
        vg = jax.vmap(lambda vv, ii: vv[ii])(v, sel)
        logits = jnp.einsum('bthd,btjhd->bthj', qb, kg).astype(jnp.float32) * att_scale
        logits = jnp.where(valid[:, :, None, :], logits, -jnp.inf)
        p = jax.nn.softmax(logits, axis=-1).astype(v.dtype)
        return jnp.einsum('bthj,btjhd->bthd', p, vg)

    out = lax.map(block, jnp.arange(n_blocks))
    return out.transpose(1, 0, 2, 3, 4).reshape(B, L, H * Dh)


def gla_chunked(q, k, v, log_a):
    B, L, H, DK = q.shape
    DV = v.shape[-1]
    C = GLA_CHUNK
    NC = L // C

    def to_chunks(t):
        return t.astype(jnp.float32).reshape(B, NC, C, H, t.shape[-1]).transpose(1, 0, 3, 2, 4)

    qc_all = to_chunks(q) * (DK ** -0.5)
    kc_all, vc_all, gc_all = to_chunks(k), to_chunks(v), to_chunks(log_a)
    tril = jnp.tril(jnp.ones((C, C), dtype=bool))

    def step(S, inp):
        qc, kc, vc, gc = inp
        b = jnp.cumsum(gc, axis=2)
        diff = b[:, :, :, None, :] - b[:, :, None, :, :]
        decay = jnp.exp(jnp.where(tril[None, None, :, :, None], diff, -jnp.inf))
        A = jnp.einsum('bhid,bhjd,bhijd->bhij', qc, kc, decay)
        o = (jnp.einsum('bhij,bhjv->bhiv', A, vc)
             + jnp.einsum('bhid,bhdv->bhiv', qc * jnp.exp(b), S))
        b_last = b[:, :, -1:, :]
        S = (jnp.exp(b_last)[:, :, 0, :, None] * S
             + jnp.einsum('bhjd,bhjv->bhdv', kc * jnp.exp(b_last - b), vc))
        return S, o

    S0 = jnp.zeros((B, H, DK, DV), jnp.float32)
    _, o = lax.scan(step, S0, (qc_all, kc_all, vc_all, gc_all))
    return o.transpose(1, 0, 3, 2, 4).reshape(B, L, H, DV).astype(v.dtype)


def setup_inputs(seed: int = 0) -> dict:
    key = jax.random.key(seed)
    ks = jax.random.split(key, 16)

    def nrm(k, shape, scale):
        return jax.random.normal(k, shape, jnp.float32) * scale

    return {
        'x': nrm(ks[0], (BATCH, SEQ, D_MODEL), 1.0),
        'c': nrm(ks[1], (BATCH, D_MODEL), 1.0),
        'w_mod': nrm(ks[2], (DEPTH, D_MODEL, N_MOD * D_MODEL), D_MODEL ** -0.5),
        'b_mod': nrm(ks[3], (DEPTH, N_MOD * D_MODEL), 0.02),
        'norm1_g': 1.0 + nrm(ks[4], (DEPTH, D_MODEL), 0.02),
        'w_in': nrm(ks[5], (DEPTH, D_MODEL, D_IN), D_MODEL ** -0.5),
        'w_gate2': nrm(ks[6], (DEPTH, GLA_GATE_RANK, GLA_HEADS * GLA_DK), GLA_GATE_RANK ** -0.5),
        'b_gate2': nrm(ks[7], (DEPTH, GLA_HEADS * GLA_DK), 0.02),
        'att_out_g': 1.0 + nrm(ks[8], (DEPTH, ATT_WIDTH), 0.02),
        'gla_out_g': 1.0 + nrm(ks[9], (DEPTH, GLA_DV), 0.02),
        'w_out': nrm(ks[10], (DEPTH, D_MIX, D_MODEL), D_MIX ** -0.5),
        'norm2_g': 1.0 + nrm(ks[11], (DEPTH, D_MODEL), 0.02),
        'w_gate_up': nrm(ks[12], (DEPTH, D_MODEL, 2 * D_FF), D_MODEL ** -0.5),
        'w_down': nrm(ks[13], (DEPTH, D_FF, D_MODEL), D_FF ** -0.5),
        'final_g': 1.0 + nrm(ks[14], (D_MODEL,), 0.02),
    }


def reference(x, c, w_mod, b_mod, norm1_g, w_in, w_gate2, b_gate2, att_out_g,
              gla_out_g, w_out, norm2_g, w_gate_up, w_down, final_g):
    B, L, _ = x.shape
    for l in range(DEPTH):
        mod = jax.nn.silu(c) @ w_mod[l] + b_mod[l]
        sh1, sc1, g1, sh2, sc2, g2 = jnp.split(mod, N_MOD, axis=-1)

        h = _modulate(_rms_norm(x, norm1_g[l]), sh1, sc1)
        proj = h @ w_in[l]
        (q, k, v, q_idx, k_idx, w_idx,
         gq, gk, gv, go, g_lr) = _split_cols(proj, IN_SPLITS)

        att = dsa_attention(q.reshape(B, L, ATT_HEADS, ATT_HEAD_DIM),
                            k.reshape(B, L, ATT_HEADS, ATT_HEAD_DIM),
                            v.reshape(B, L, ATT_HEADS, ATT_HEAD_DIM),
                            q_idx.reshape(B, L, IDX_HEADS, IDX_DIM), k_idx, w_idx)
        att = _rms_norm(att, att_out_g[l])

        log_a = jax.nn.log_sigmoid((g_lr @ w_gate2[l] + b_gate2[l]).astype(jnp.float32)) / GLA_TAU
        gla = gla_chunked(gq.reshape(B, L, GLA_HEADS, GLA_DK),
                          gk.reshape(B, L, GLA_HEADS, GLA_DK),
                          gv.reshape(B, L, GLA_HEADS, GLA_DV),
                          log_a.reshape(B, L, GLA_HEADS, GLA_DK))
        gla = _rms_norm(gla, gla_out_g[l]).reshape(B, L, GLA_WIDTH) * jax.nn.silu(go)

        mix = jnp.concatenate([att, gla], axis=-1) @ w_out[l]
        x = x + g1[:, None, :] * mix

        h2 = _modulate(_rms_norm(x, norm2_g[l]), sh2, sc2)
        gate, up = jnp.split(h2 @ w_gate_up[l], 2, axis=-1)
        x = x + g2[:, None, :] * ((jax.nn.silu(gate) * up) @ w_down[l])
    return _rms_norm(x, final_g)
```

```cpp
#include <hip/hip_runtime.h>
#include <cstdio>
#include <cstdint>
#include <cmath>
namespace nv {
constexpr int D = 1024, NB = 8, L = 8192, DIN = 3672, DFF = 2816;
constexpr int OQ = 0, OK_ = 512, OV = 1024, OQI = 1536, OKI = 2048, OWI = 2112, OGQ = 2120, OGK = 2376, OGV = 2632, OGO = 3144, OGLR = 3656;
constexpr float EPS = 1e-6f;

__device__ __forceinline__ float silu(float v) { return v / (1.f + expf(-v)); }

__global__ void k_mod(const float* __restrict__ c, const float* __restrict__ w_mod, const float* __restrict__ b_mod, float* __restrict__ mod) {
    const int j = blockIdx.x * 256 + threadIdx.x, b = blockIdx.y;
    float acc = 0.f;
    for (int k = 0; k < D; ++k) acc += silu(c[b * D + k]) * w_mod[(size_t)k * (6 * D) + j];
    mod[b * 6 * D + j] = acc + b_mod[j];
}

__device__ __forceinline__ float block_sum256(float v, float* red) {
#pragma unroll
    for (int o = 32; o >= 1; o >>= 1) v += __shfl_xor(v, o);
    __syncthreads();
    if ((threadIdx.x & 63) == 0) red[threadIdx.x >> 6] = v;
    __syncthreads();
    return red[0] + red[1] + red[2] + red[3];
}
__device__ __forceinline__ float block_max256(float v, float* red) {
#pragma unroll
    for (int o = 32; o >= 1; o >>= 1) v = fmaxf(v, __shfl_xor(v, o));
    __syncthreads();
    if ((threadIdx.x & 63) == 0) red[threadIdx.x >> 6] = v;
    __syncthreads();
    return fmaxf(fmaxf(red[0], red[1]), fmaxf(red[2], red[3]));
}

__global__ void k_norm_mod(const float* x, const float* __restrict__ g, const float* __restrict__ shift, const float* __restrict__ scale, float* out) {
    __shared__ float red[8];
    const size_t row = blockIdx.x;
    const float4 v = ((const float4*)(x + row * D))[threadIdx.x];
    const float ss = block_sum256(v.x * v.x + v.y * v.y + v.z * v.z + v.w * v.w, red);
    const float r = rsqrtf(ss * (1.f / D) + EPS);
    const float4 gv = ((const float4*)g)[threadIdx.x];
    float4 o; o.x = v.x * r * gv.x; o.y = v.y * r * gv.y; o.z = v.z * r * gv.z; o.w = v.w * r * gv.w;
    if (scale) { const float4 sc = ((const float4*)scale)[threadIdx.x], sh = ((const float4*)shift)[threadIdx.x];
        o.x = o.x * (1.f + sc.x) + sh.x; o.y = o.y * (1.f + sc.y) + sh.y; o.z = o.z * (1.f + sc.z) + sh.z; o.w = o.w * (1.f + sc.w) + sh.w; }
    ((float4*)(out + row * D))[threadIdx.x] = o;
}

struct EpiStore { float* C; int ldc; int pad; __device__ __forceinline__ void operator()(int m, int n, float v) const { C[(size_t)m * ldc + n] = v; } };
struct EpiResGate { const float* base; const float* gate; float* out; int ldc; int pad; __device__ __forceinline__ void operator()(int m, int n, float v) const { out[(size_t)m * ldc + n] = base[(size_t)m * ldc + n] + gate[n] * v; } };

template <class Epi>
__global__ void __launch_bounds__(256) k_sgemm(const float* __restrict__ A, int lda, const float* __restrict__ Bm, int ldb, int M, int N, int K, Epi epi) {
    __shared__ float As[16][68];
    __shared__ float Bs[16][68];
    const int tx = threadIdx.x & 15, ty = threadIdx.x >> 4;
    const int m0 = blockIdx.y * 64, n0 = blockIdx.x * 64;
    float acc[4][4];
#pragma unroll
    for (int i = 0; i < 4; ++i)
#pragma unroll
        for (int j = 0; j < 4; ++j) acc[i][j] = 0.f;
    for (int k0 = 0; k0 < K; k0 += 16) {
        { const int r = threadIdx.x >> 2, cq = (threadIdx.x & 3) * 4; const float4 v = *(const float4*)(A + (size_t)(m0 + r) * lda + k0 + cq);
          As[cq][r] = v.x; As[cq + 1][r] = v.y; As[cq + 2][r] = v.z; As[cq + 3][r] = v.w; }
        { const int r = threadIdx.x >> 4, cq = (threadIdx.x & 15) * 4; const int n = n0 + cq; float4 v = make_float4(0.f, 0.f, 0.f, 0.f);
          if (n < N) v = *(const float4*)(Bm + (size_t)(k0 + r) * ldb + n);
          Bs[r][cq] = v.x; Bs[r][cq + 1] = v.y; Bs[r][cq + 2] = v.z; Bs[r][cq + 3] = v.w; }
        __syncthreads();
#pragma unroll
        for (int kk = 0; kk < 16; ++kk) {
            float a[4], b[4];
#pragma unroll
            for (int i = 0; i < 4; ++i) { a[i] = As[kk][ty * 4 + i]; b[i] = Bs[kk][tx * 4 + i]; }
#pragma unroll
            for (int i = 0; i < 4; ++i)
#pragma unroll
                for (int j = 0; j < 4; ++j) acc[i][j] += a[i] * b[j];
        }
        __syncthreads();
    }
#pragma unroll
    for (int i = 0; i < 4; ++i)
#pragma unroll
        for (int j = 0; j < 4; ++j) { const int m = m0 + ty * 4 + i, n = n0 + tx * 4 + j; if (n < N) epi(m, n, acc[i][j]); }
}

__device__ __forceinline__ unsigned fkey(float f) { f = f + 0.0f; const unsigned u = __float_as_uint(f); return (u & 0x80000000u) ? ~u : (u | 0x80000000u); }

__global__ void __launch_bounds__(256) k_dsa(const float* __restrict__ proj, const float* __restrict__ att_g, float* __restrict__ catbuf) {
    __shared__ float sc[8192];
    __shared__ float qi[512];
    __shared__ float qa[512];
    __shared__ float wi[8];
    __shared__ int hist[256];
    __shared__ int sel[256];
    __shared__ float pl[256];
    __shared__ float orow[512];
    __shared__ float opart[2][128];
    __shared__ int cnts[256];
    __shared__ int misc[4];
    __shared__ float red[8];
    const int t = blockIdx.x, tid = threadIdx.x;
    const float* prow = proj + (size_t)t * DIN;
    for (int i = tid; i < 512; i += 256) { qi[i] = prow[OQI + i]; qa[i] = prow[OQ + i]; }
    if (tid < 8) wi[tid] = prow[OWI + tid] * (0.35355339059327373f * 0.125f);
    if (tid == 0) { misc[0] = 0; }
    __syncthreads();
    const int n = t + 1;
    for (int s = tid; s < n; s += 256) {
        const float* kr = proj + (size_t)s * DIN + OKI;
        float kv[64];
#pragma unroll
        for (int d = 0; d < 64; d += 4) { const float4 v = *(const float4*)(kr + d); kv[d] = v.x; kv[d + 1] = v.y; kv[d + 2] = v.z; kv[d + 3] = v.w; }
        float tot = 0.f;
#pragma unroll
        for (int h = 0; h < 8; ++h) { float dsum = 0.f;
#pragma unroll
            for (int d = 0; d < 64; ++d) dsum += qi[h * 64 + d] * kv[d];
            tot += wi[h] * fmaxf(dsum, 0.f); }
        sc[s] = tot;
    }
    __syncthreads();
    int nsel;
    if (n <= 256) { if (tid < n) sel[tid] = tid; nsel = n; __syncthreads(); }
    else {
        unsigned prefix = 0u, mask = 0u; int kk = 256;
        for (int pass = 0; pass < 4; ++pass) {
            const int shift = 24 - 8 * pass;
            hist[tid] = 0;
            __syncthreads();
            for (int s = tid; s < n; s += 256) { const unsigned key = fkey(sc[s]); if ((key & mask) == prefix) atomicAdd(&hist[(key >> shift) & 255u], 1); }
            __syncthreads();
            if (tid == 0) { int cum = 0, digit = 0; for (int b = 255; b >= 0; --b) { const int hb = hist[b]; if (cum + hb >= kk) { digit = b; break; } cum += hb; } misc[1] = digit; misc[2] = kk - cum; }
            __syncthreads();
            prefix |= ((unsigned)misc[1]) << shift; mask |= 255u << shift; kk = misc[2];
            __syncthreads();
        }
        const int c0 = tid * 32;
        int ceq = 0;
        for (int s = c0; s < c0 + 32 && s < n; ++s) if (fkey(sc[s]) == prefix) ++ceq;
        cnts[tid] = ceq;
        __syncthreads();
        if (tid == 0) { int run = 0; for (int i = 0; i < 256; ++i) { const int cc = cnts[i]; cnts[i] = run; run += cc; } }
        __syncthreads();
        int rank = cnts[tid];
        for (int s = c0; s < c0 + 32 && s < n; ++s) { const unsigned key = fkey(sc[s]); bool take = key > prefix; if (key == prefix) { take = rank < kk; ++rank; }
            if (take) { const int p = atomicAdd(&misc[0], 1); if (p < 256) sel[p] = s; } }
        __syncthreads();
        nsel = misc[0] < 256 ? misc[0] : 256;
    }
    for (int h = 0; h < 4; ++h) {
        float lg = -INFINITY;
        if (tid < nsel) { const float* kr = proj + (size_t)sel[tid] * DIN + OK_ + h * 128; float dsum = 0.f;
            for (int d = 0; d < 128; d += 4) { const float4 v = *(const float4*)(kr + d); dsum += qa[h * 128 + d] * v.x + qa[h * 128 + d + 1] * v.y + qa[h * 128 + d + 2] * v.z + qa[h * 128 + d + 3] * v.w; }
            lg = dsum * 0.08838834764831845f; }
        const float mx = block_max256(lg, red);
        const float e = (tid < nsel) ? expf(lg - mx) : 0.f;
        const float sm = block_sum256(e, red);
        pl[tid] = e / sm;
        __syncthreads();
        { const int d = tid & 127, half = tid >> 7; float o = 0.f;
          for (int j = half; j < nsel; j += 2) o += pl[j] * proj[(size_t)sel[j] * DIN + OV + h * 128 + d];
          opart[half][d] = o; }
        __syncthreads();
        if (tid < 128) orow[h * 128 + tid] = opart[0][tid] + opart[1][tid];
        __syncthreads();
    }
    const float a0 = orow[tid], a1 = orow[tid + 256];
    const float ss = block_sum256(a0 * a0 + a1 * a1, red);
    const float r = rsqrtf(ss * (1.f / 512.f) + EPS);
    catbuf[(size_t)t * D + tid] = a0 * r * att_g[tid];
    catbuf[(size_t)t * D + tid + 256] = a1 * r * att_g[tid + 256];
}

__global__ void __launch_bounds__(256) k_gla(const float* __restrict__ proj, const float* __restrict__ w_gate2, const float* __restrict__ b_gate2, const float* __restrict__ gla_g, float* __restrict__ catbuf) {
    constexpr int TT = 8;
    __shared__ float sq[TT][64], sk[TT][64], sa[TT][64], sv[TT][128], so[TT][2][128], wg[16][64], bg[64], glr[TT][16];
    const int h = blockIdx.x, tid = threadIdx.x, dv = tid & 127, half = tid >> 7;
    for (int i = tid; i < 16 * 64; i += 256) wg[i >> 6][i & 63] = w_gate2[(i >> 6) * 256 + h * 64 + (i & 63)];
    if (tid < 64) bg[tid] = b_gate2[h * 64 + tid];
    float S[32];
#pragma unroll
    for (int i = 0; i < 32; ++i) S[i] = 0.f;
    __syncthreads();
    for (int t0 = 0; t0 < L; t0 += TT) {
        if (tid < TT * 16) glr[tid >> 4][tid & 15] = proj[(size_t)(t0 + (tid >> 4)) * DIN + OGLR + (tid & 15)];
        for (int i = tid; i < TT * 64; i += 256) { const int tt = i >> 6, dk = i & 63; const float* pr = proj + (size_t)(t0 + tt) * DIN;
            sq[tt][dk] = pr[OGQ + h * 64 + dk] * 0.125f; sk[tt][dk] = pr[OGK + h * 64 + dk]; }
        for (int i = tid; i < TT * 128; i += 256) { const int tt = i >> 7, d = i & 127; sv[tt][d] = proj[(size_t)(t0 + tt) * DIN + OGV + h * 128 + d]; }
        __syncthreads();
        for (int i = tid; i < TT * 64; i += 256) { const int tt = i >> 6, dk = i & 63; float z = bg[dk];
#pragma unroll
            for (int r = 0; r < 16; ++r) z += glr[tt][r] * wg[r][dk];
            const float ls = fminf(z, 0.f) - log1pf(expf(-fabsf(z)));
            sa[tt][dk] = expf(ls * (1.f / 16.f)); }
        __syncthreads();
#pragma unroll
        for (int tt = 0; tt < TT; ++tt) { const float vv = sv[tt][dv]; float o = 0.f;
#pragma unroll
            for (int i = 0; i < 32; ++i) { const int dk = half * 32 + i; S[i] = sa[tt][dk] * S[i] + sk[tt][dk] * vv; o += sq[tt][dk] * S[i]; }
            so[tt][half][dv] = o; }
        __syncthreads();
        { const int tt = tid >> 5, l32 = tid & 31; float ov[4]; float ss = 0.f;
#pragma unroll
          for (int j = 0; j < 4; ++j) { const int d = l32 + 32 * j; ov[j] = so[tt][0][d] + so[tt][1][d]; ss += ov[j] * ov[j]; }
#pragma unroll
          for (int o = 16; o >= 1; o >>= 1) ss += __shfl_xor(ss, o);
          const float r = rsqrtf(ss * (1.f / 128.f) + EPS);
#pragma unroll
          for (int j = 0; j < 4; ++j) { const int d = l32 + 32 * j; const float go = proj[(size_t)(t0 + tt) * DIN + OGO + h * 128 + d];
              catbuf[(size_t)(t0 + tt) * D + 512 + h * 128 + d] = ov[j] * r * gla_g[d] * silu(go); } }
        __syncthreads();
    }
}

__global__ void k_swiglu(const float* __restrict__ gu, float* __restrict__ act, size_t rows) {
    const size_t i = (size_t)blockIdx.x * 256 + threadIdx.x; if (i >= rows * DFF) return;
    const size_t r = i / DFF, j = i % DFF;
    act[i] = silu(gu[r * (2 * DFF) + j]) * gu[r * (2 * DFF) + DFF + j];
}

static void forward(void* const* d_in, float* out, unsigned char* ws, hipStream_t st, int nbatch = NB) {
    const float* x = (const float*)d_in[0]; const float* c = (const float*)d_in[1]; const float* w_mod = (const float*)d_in[2]; const float* b_mod = (const float*)d_in[3];
    const float* norm1_g = (const float*)d_in[4]; const float* w_in = (const float*)d_in[5]; const float* w_gate2 = (const float*)d_in[6]; const float* b_gate2 = (const float*)d_in[7];
    const float* att_g = (const float*)d_in[8]; const float* gla_g = (const float*)d_in[9]; const float* w_out = (const float*)d_in[10]; const float* norm2_g = (const float*)d_in[11];
    const float* w_gu = (const float*)d_in[12]; const float* w_down = (const float*)d_in[13]; const float* final_g = (const float*)d_in[14];
    const size_t MB = 1u << 20;
    float* mod = (float*)(ws); float* h = (float*)(ws + 1 * MB); float* proj = (float*)(ws + 40 * MB); float* cat = (float*)(ws + 168 * MB);
    float* x1 = (float*)(ws + 200 * MB); float* h2 = (float*)(ws + 232 * MB); float* gu = (float*)(ws + 264 * MB); float* act = (float*)(ws + 456 * MB);
    hipLaunchKernelGGL(k_mod, dim3(6 * D / 256, NB), dim3(256), 0, st, c, w_mod, b_mod, mod);
    for (int b = 0; b < nbatch; ++b) {
        const float* xb = x + (size_t)b * L * D; float* ob = out + (size_t)b * L * D; const float* mb = mod + b * 6 * D;
        hipLaunchKernelGGL(k_norm_mod, dim3(L), dim3(256), 0, st, xb, norm1_g, mb, mb + D, h);
        hipLaunchKernelGGL(k_sgemm<EpiStore>, dim3((DIN + 63) / 64, L / 64), dim3(256), 0, st, (const float*)h, D, w_in, DIN, L, DIN, D, EpiStore{proj, DIN, 0});
        hipLaunchKernelGGL(k_dsa, dim3(L), dim3(256), 0, st, (const float*)proj, att_g, cat);
        hipLaunchKernelGGL(k_gla, dim3(4), dim3(256), 0, st, (const float*)proj, w_gate2, b_gate2, gla_g, cat);
        hipLaunchKernelGGL(k_sgemm<EpiResGate>, dim3(D / 64, L / 64), dim3(256), 0, st, (const float*)cat, D, w_out, D, L, D, D, EpiResGate{xb, mb + 2 * D, x1, D, 0});
        hipLaunchKernelGGL(k_norm_mod, dim3(L), dim3(256), 0, st, (const float*)x1, norm2_g, mb + 3 * D, mb + 4 * D, h2);
        hipLaunchKernelGGL(k_sgemm<EpiStore>, dim3(2 * DFF / 64, L / 64), dim3(256), 0, st, (const float*)h2, D, w_gu, 2 * DFF, L, 2 * DFF, D, EpiStore{gu, 2 * DFF, 0});
        hipLaunchKernelGGL(k_swiglu, dim3((unsigned)(((size_t)L * DFF + 255) / 256)), dim3(256), 0, st, (const float*)gu, act, (size_t)L);
        hipLaunchKernelGGL(k_sgemm<EpiResGate>, dim3(D / 64, L / 64), dim3(256), 0, st, (const float*)act, DFF, w_down, D, L, D, DFF, EpiResGate{(const float*)x1, mb + 5 * D, ob, D, 0});
        hipLaunchKernelGGL(k_norm_mod, dim3(L), dim3(256), 0, st, (const float*)ob, final_g, (const float*)nullptr, (const float*)nullptr, ob);
    }
}
}

extern "C" void kernel_launch(void* const* d_in, const int* in_sizes, int n_in, void* d_out, int out_size, void* d_ws, size_t ws_size, hipStream_t stream) {
    nv::forward(d_in, (float*)d_out, (unsigned char*)d_ws, stream);
}
```

```cpp
#include <hip/hip_runtime.h>
#include <hip/hip_cooperative_groups.h>
#include <cstdio>
#include <cstdint>
#include <cmath>
namespace pg8 {
#define PG8_LAS __attribute__((address_space(3)))
typedef unsigned short bf16_t;
typedef _Float16 bf16x8 __attribute__((ext_vector_type(8)));
typedef float f32x4 __attribute__((ext_vector_type(4)));
typedef unsigned u32x4 __attribute__((ext_vector_type(4)));
constexpr int BM = 256, BK = 64, HALF = 128, HTB = HALF * BK * 2  , STAGE_BYTES = 8 * HTB, NXCD = 8, WGM = 8;

__host__ __device__ __forceinline__ int lds_byte(int r, int c) { const int st = (r >> 4) * 2 + (c >> 5), rr = r & 15, cc = c & 31, ob = rr * 64 + cc * 2; return st * 1024 + (ob ^ (((ob >> 9) & 1) << 5)); }
__host__ __device__ __forceinline__ void stage_rc(int b, int& R, int& C) { const int st = b / 1024, sb = b % 1024, swz = sb ^ (((sb >> 9) & 1) << 5); R = (st >> 1) * 16 + swz / 64; C = (st & 1) * 32 + (swz % 64) / 2; }
__host__ __device__ __forceinline__ int perm32(int rho) { const int n = rho >> 4, i = rho & 15; return 8 * (i >> 2) + 4 * n + (i & 3); }

struct Unit { int pm, pn; };
struct Gemm { const bf16_t* A; const bf16_t* Bt; int M, N, K; };

struct StaticOrder {
    int nM, nN, nwg, G, c, wgm;
    __host__ __device__ void init(int M, int N, int G_, int c_, int wgm_ = WGM) { nM = M / BM; nN = N / BM; nwg = nM * nN; G = G_; c = c_; wgm = wgm_; }
    __host__ __device__ bool next(int i, Unit& u) const {
        const long L = (long)i * G + c; if (L >= nwg) return false;
        int wgid = (int)L; { const int q = nwg / NXCD, r = nwg % NXCD, xcd = wgid % NXCD, off = wgid / NXCD; wgid = (xcd < r ? xcd * (q + 1) : r * (q + 1) + (xcd - r) * q) + off; }
        const int nig = wgm * nN, gid = wgid / nig, fm = gid * wgm, gsz = (nM - fm) < wgm ? (nM - fm) : wgm;
        u.pm = fm + ((wgid % nig) % gsz); u.pn = (wgid % nig) / gsz; return true;
    }
    __device__ __forceinline__ void a_ready(const Unit&) const {}
    __device__ __forceinline__ void done(const Unit&) const {}
};
template <class Epi, class Sched>
__device__ __forceinline__ void gemm_phase(PG8_LAS unsigned char* lds, const Gemm g, const Sched& S, const Epi& E) {
    const int tid = threadIdx.x, wid = __builtin_amdgcn_readfirstlane(tid >> 6), lane = tid & 63, wr = wid >> 2, wc = wid & 3, fr = lane & 15, fq = lane >> 4;
    const int K = g.K, nt = K / BK;
    unsigned voffA[2], voffB[2];
#pragma unroll
    for (int i = 0; i < 2; ++i) { int R, C; stage_rc(tid * 16 + i * 8192, R, C); const int Rb = Epi::PERM ? ((R & ~31) + perm32(R & 31)) : R;
        voffA[i] = (unsigned)(R * K + C) * 2u; voffB[i] = (unsigned)(Rb * K + C) * 2u; }
    const size_t kstep = (size_t)(BK * 2);
    const size_t hstep = (size_t)HALF * K * 2;
    const size_t tstep = 2 * hstep;
    const unsigned ldsw = (unsigned)wid * 1024u;
    const int aoff = lds_byte(wr * 64 + fr, fq * 8), boff = lds_byte(wc * 32 + fr, fq * 8);
#define PG8_SA(b, h) (((b) * 2 + (h)) * HTB)
#define PG8_SB(b, h) ((4 + (b) * 2 + (h)) * HTB)
#define PG8_STAGE(bufoff, gbase, voff) do { _Pragma("unroll") for (int _i = 0; _i < 2; ++_i) \
        __builtin_amdgcn_global_load_lds((const unsigned*)((const char*)(gbase) + (voff)[_i]), (PG8_LAS unsigned*)(lds + (bufoff) + ldsw + _i * 8192), 16, 0, 0); } while (0)
#define PG8_LDA(dst, b, h) do { _Pragma("unroll") for (int m = 0; m < 4; ++m) _Pragma("unroll") for (int k = 0; k < 2; ++k) dst[m][k] = *(const PG8_LAS bf16x8*)(lds + PG8_SA(b, h) + aoff + m * 2048 + k * 1024); } while (0)
#define PG8_LDB(dst, b, h) do { _Pragma("unroll") for (int n = 0; n < 2; ++n) _Pragma("unroll") for (int k = 0; k < 2; ++k) dst[n][k] = *(const PG8_LAS bf16x8*)(lds + PG8_SB(b, h) + boff + n * 2048 + k * 1024); } while (0)
#define PG8_MMA(ai, bj, At, Bt) do { __builtin_amdgcn_s_setprio(1); _Pragma("unroll") for (int m = 0; m < 4; ++m) _Pragma("unroll") for (int n = 0; n < 2; ++n) _Pragma("unroll") for (int k = 0; k < 2; ++k) \
        acc[ai][bj][m][n] = __builtin_amdgcn_mfma_f32_16x16x32_f16(Bt[n][k], At[m][k], acc[ai][bj][m][n], 0, 0, 0); __builtin_amdgcn_s_setprio(0); } while (0)
#define PG8_WAIT_V(n) asm volatile("s_waitcnt vmcnt(" #n ")" ::: "memory")
#define PG8_WAIT_L(n) asm volatile("s_waitcnt lgkmcnt(" #n ")" ::: "memory")
#define PG8_BAR __builtin_amdgcn_s_barrier()
#define PG8_SCHED __builtin_amdgcn_sched_barrier(0)
    Unit cur, nxt; int ui = 0;
    if (!S.next(0, cur)) return;
    f32x4 acc[2][2][4][2];
#pragma unroll
    for (int a = 0; a < 2; ++a)
#pragma unroll
        for (int b = 0; b < 2; ++b)
#pragma unroll
            for (int m = 0; m < 4; ++m)
#pragma unroll
                for (int n = 0; n < 2; ++n) acc[a][b][m][n] = (f32x4){0.f, 0.f, 0.f, 0.f};
    bf16x8 At[4][2], B0[2][2], B1[2][2];
    const char* cA = (const char*)g.A + (size_t)cur.pm * tstep; const char* cB = (const char*)g.Bt + (size_t)cur.pn * tstep;
    S.a_ready(cur);
    PG8_STAGE(PG8_SB(0, 0), cB, voffB); PG8_STAGE(PG8_SA(0, 0), cA, voffA); PG8_STAGE(PG8_SB(0, 1), cB + hstep, voffB); PG8_STAGE(PG8_SA(0, 1), cA + hstep, voffA);
    if (wr == 1) PG8_BAR;
    PG8_WAIT_V(4); PG8_BAR;
    PG8_STAGE(PG8_SB(1, 0), cB + kstep, voffB); PG8_STAGE(PG8_SA(1, 0), cA + kstep, voffA); PG8_STAGE(PG8_SB(1, 1), cB + hstep + kstep, voffB);
    PG8_WAIT_V(6); PG8_BAR;
    for (;;) {
        const bool has_next = S.next(ui + 1, nxt);
        const char* nA = has_next ? (const char*)g.A + (size_t)nxt.pm * tstep : cA; const char* nB = has_next ? (const char*)g.Bt + (size_t)nxt.pn * tstep : cB;
        for (int t = 0; t < nt; t += 2) {
            const bool last = (t == nt - 2);
            const char* a1 = cA + (size_t)(t + 1) * kstep;
            const char* a2 = last ? nA : cA + (size_t)(t + 2) * kstep; const char* b2 = last ? nB : cB + (size_t)(t + 2) * kstep;
            const char* a3 = a2 + kstep; const char* b3 = b2 + kstep;
            if (last && has_next) S.a_ready(nxt);
            PG8_LDB(B0, 0, 0); PG8_SCHED; PG8_LDA(At, 0, 0); PG8_STAGE(PG8_SA(1, 1), a1 + hstep, voffA);
            PG8_WAIT_L(8); PG8_BAR; PG8_WAIT_L(0); PG8_MMA(0, 0, At, B0); PG8_BAR; PG8_SCHED;
            PG8_LDB(B1, 0, 1); PG8_STAGE(PG8_SB(0, 0), b2, voffB);
            PG8_BAR; PG8_WAIT_L(0); PG8_MMA(0, 1, At, B1); PG8_BAR;
            PG8_LDA(At, 0, 1); PG8_STAGE(PG8_SA(0, 0), a2, voffA);
            PG8_BAR; PG8_WAIT_L(0); PG8_MMA(1, 0, At, B0); PG8_BAR; PG8_SCHED;
            PG8_STAGE(PG8_SB(0, 1), b2 + hstep, voffB);
            PG8_WAIT_V(6); PG8_BAR; PG8_MMA(1, 1, At, B1); PG8_BAR;
            PG8_LDB(B0, 1, 0); PG8_SCHED; PG8_LDA(At, 1, 0); PG8_STAGE(PG8_SA(0, 1), a2 + hstep, voffA);
            PG8_WAIT_L(8); PG8_BAR; PG8_WAIT_L(0); PG8_MMA(0, 0, At, B0); PG8_BAR; PG8_SCHED;
            PG8_LDB(B1, 1, 1); PG8_STAGE(PG8_SB(1, 0), b3, voffB);
            PG8_BAR; PG8_WAIT_L(0); PG8_MMA(0, 1, At, B1); PG8_BAR;
            PG8_LDA(At, 1, 1); PG8_STAGE(PG8_SA(1, 0), a3, voffA);
            PG8_BAR; PG8_WAIT_L(0); PG8_MMA(1, 0, At, B0); PG8_BAR; PG8_SCHED;
            PG8_STAGE(PG8_SB(1, 1), b3 + hstep, voffB);
            PG8_WAIT_V(6); PG8_BAR; PG8_MMA(1, 1, At, B1); PG8_BAR;
        }
        if constexpr (!Epi::AFTER_DRAIN) { E(acc, cur, wr, wc, fr, fq); S.done(cur); }
        if (!has_next) break;
#pragma unroll
        for (int a = 0; a < 2; ++a)
#pragma unroll
            for (int b = 0; b < 2; ++b)
#pragma unroll
                for (int m = 0; m < 4; ++m)
#pragma unroll
                    for (int n = 0; n < 2; ++n) acc[a][b][m][n] = (f32x4){0.f, 0.f, 0.f, 0.f};
        cur = nxt; cA = nA; cB = nB; ++ui;
    }
    PG8_WAIT_V(0);
    if (wr == 0) PG8_BAR;
    PG8_BAR;
    if constexpr (Epi::AFTER_DRAIN) { E.fused(acc, cur, wr, wc, fr, fq, lds, wid, lane); S.done(cur); }
#undef PG8_SA
#undef PG8_SB
#undef PG8_STAGE
#undef PG8_LDA
#undef PG8_LDB
#undef PG8_MMA
#undef PG8_WAIT_V
#undef PG8_WAIT_L
#undef PG8_BAR
#undef PG8_SCHED
}
}
namespace mk {
#define LAS __attribute__((address_space(3)))
using pg8::f32x4; using pg8::u32x4; using pg8::Unit;
typedef float f32x2 __attribute__((ext_vector_type(2)));
typedef float f32x16 __attribute__((ext_vector_type(16)));
typedef _Float16 h2v __attribute__((ext_vector_type(2)));
typedef _Float16 f16x8 __attribute__((ext_vector_type(8)));
typedef _Float16 f16x4 __attribute__((ext_vector_type(4)));
typedef short bf16x8 __attribute__((ext_vector_type(8)));
typedef unsigned u32x2 __attribute__((ext_vector_type(2)));
typedef unsigned short u16;

constexpr int NWAVES = 8, NT = 512;
constexpr int D = 1024, NB = 8, L = 8192, T = NB * L, DIN = 3672, DFF = 2816;
constexpr int PJ = 3584;
constexpr int CQ = 0, CK = 512, CV = 1024, CQI = 1536, CGQ = 2048, CGK = 2304, CGV = 2560, CGO = 3072;
constexpr float EPS = 1e-6f;
constexpr float IDX_SCALE = 0.35355339059327373f * 0.125f;
constexpr size_t MiB = 1u << 20;
constexpr size_t WS_CTL = 0, WS_MOD = 1 * MiB, WS_WIN = 2 * MiB, WS_WOUT = 10 * MiB, WS_WGU = 12 * MiB, WS_WDN = 23 * MiB;
constexpr size_t WS_SS1 = 29 * MiB, WS_SS2 = 33 * MiB, WS_KIDX = 37 * MiB, WS_WIDX = 45 * MiB, WS_GLR = 47 * MiB, WS_THR = 51 * MiB;
constexpr size_t WS_H = 64 * MiB, WS_CAT = 192 * MiB, WS_PROJ = 320 * MiB, WS_ACT = 320 * MiB, WS_GLAS = 768 * MiB, WS_VT = 896 * MiB, WS_KF = 960 * MiB, WS_END = 1024 * MiB;
constexpr int LDS_BYTES = 163840;

struct Params {
    const float *x, *c, *w_mod, *b_mod, *norm1_g, *w_in, *w_gate2, *b_gate2, *att_g, *gla_g, *w_out, *norm2_g, *w_gu, *w_down, *final_g;
    float* out; unsigned char* ws; int ph_lo, ph_hi;
};

__device__ __forceinline__ unsigned pkh(float a, float b) { const h2v h = __builtin_convertvector((f32x2){a, b}, h2v); return __builtin_bit_cast(unsigned, h); }
__device__ __forceinline__ float silu_f(float v) { return v * __builtin_amdgcn_rcpf(1.f + __expf(-v)); }
__device__ __forceinline__ float wave_sum(float v) {
#pragma unroll
    for (int o = 1; o < 64; o <<= 1) v += __shfl_xor(v, o);
    return v;
}
__device__ __forceinline__ float rows_sum(float s) {
    { const unsigned u = __builtin_bit_cast(unsigned, s); const auto r = __builtin_amdgcn_permlane16_swap(u, u, false, false); const unsigned a = r[0], b = r[1]; s = __builtin_bit_cast(float, a) + __builtin_bit_cast(float, b); }
    { const unsigned u = __builtin_bit_cast(unsigned, s); const auto r = __builtin_amdgcn_permlane32_swap(u, u, false, false); const unsigned a = r[0], b = r[1]; s = __builtin_bit_cast(float, a) + __builtin_bit_cast(float, b); }
    return s;
}
#define LDS_WAIT() asm volatile("s_waitcnt lgkmcnt(0)" ::: "memory")

struct MapIn { __device__ __forceinline__ int operator()(int n) const {
    if (n < 2048) return n; if (n < 3584) return n + 72; if (n < 3648) return 2048 + (n - 3584); if (n < 3656) return 2112 + (n - 3648); if (n < 3672) return n; return -1; } };
struct MapGU { __device__ __forceinline__ int operator()(int n) const { const int pn = n >> 8, r = n & 255; return r < 128 ? 128 * pn + r : DFF + 128 * pn + (r - 128); } };
struct MapId { __device__ __forceinline__ int operator()(int n) const { return n; } };

template <class Map>
__device__ __forceinline__ void transpose_item(const float* __restrict__ W, int K, int Nsrc, u16* __restrict__ WT, int nblk, LAS float* scr, int item, int lane, Map map) {
    const int kb = item / nblk, nb = item % nblk, k0 = 64 * kb, n0 = 32 * nb;
    const int sc = map(n0 + (lane & 31));
#pragma unroll 8
    for (int i = 0; i < 32; ++i) { const int kk = 2 * i + (lane >> 5); scr[kk * 33 + (lane & 31)] = sc >= 0 ? W[(size_t)(k0 + kk) * Nsrc + sc] : 0.f; }
    LDS_WAIT(); asm volatile("" ::: "memory");
    const int c = lane & 7;
#pragma unroll
    for (int j = 0; j < 4; ++j) { const int n = (lane >> 3) + 8 * j; const LAS float* s = scr + (8 * c) * 33 + n;
        u32x4 o; o.x = pkh(s[0 * 33], s[1 * 33]); o.y = pkh(s[2 * 33], s[3 * 33]); o.z = pkh(s[4 * 33], s[5 * 33]); o.w = pkh(s[6 * 33], s[7 * 33]);
        *(u32x4*)(WT + (size_t)(n0 + n) * K + k0 + 8 * c) = o; }
    LDS_WAIT(); asm volatile("" ::: "memory");
}

__device__ __forceinline__ void phase_p0a(const Params& p, LAS unsigned char* lds, int wave, int lane) {
    LAS float* sct = (LAS float*)(lds + 98304);
    for (int i = threadIdx.x; i < NB * D; i += NT) { const float cv = p.c[i]; sct[i] = cv / (1.f + expf(-cv)); }
    __syncthreads();
    const int gw = blockIdx.x * NWAVES + wave, NGW = gridDim.x * NWAVES;
    float* mod = (float*)(p.ws + WS_MOD);
    for (int it = gw; it < 6 * D / 16; it += NGW) {
        const int j = it * 16 + (lane & 15), kq = lane >> 4;
        float acc[NB];
#pragma unroll
        for (int b = 0; b < NB; ++b) acc[b] = 0.f;
#pragma unroll 4
        for (int k4 = 0; k4 < D / 4; ++k4) { const int k = 4 * k4 + kq; const float w = p.w_mod[(size_t)k * (6 * D) + j];
#pragma unroll
            for (int b = 0; b < NB; ++b) acc[b] += sct[b * D + k] * w; }
#pragma unroll
        for (int b = 0; b < NB; ++b) acc[b] = rows_sum(acc[b]);
        if (lane < 16) { const float bm = p.b_mod[j];
#pragma unroll
            for (int b = 0; b < NB; ++b) mod[b * 6 * D + j] = acc[b] + bm; }
    }
    LAS float* scr = (LAS float*)(lds + wave * 8704);
    constexpr int I_IN = (D / 64) * (3840 / 32), I_OUT = (D / 64) * (D / 32), I_GU = (D / 64) * (2 * DFF / 32), I_DN = (DFF / 64) * (D / 32);
    constexpr int NITEMS = I_IN + I_OUT + I_GU + I_DN;
    for (int it = gw; it < NITEMS; it += NGW) {
        int r = it;
        if (r < I_IN) { transpose_item(p.w_in, D, DIN, (u16*)(p.ws + WS_WIN), 3840 / 32, scr, r, lane, MapIn()); continue; } r -= I_IN;
        if (r < I_OUT) { transpose_item(p.w_out, D, D, (u16*)(p.ws + WS_WOUT), D / 32, scr, r, lane, MapId()); continue; } r -= I_OUT;
        if (r < I_GU) { transpose_item(p.w_gu, D, 2 * DFF, (u16*)(p.ws + WS_WGU), 2 * DFF / 32, scr, r, lane, MapGU()); continue; } r -= I_GU;
        transpose_item(p.w_down, DFF, D, (u16*)(p.ws + WS_WDN), D / 32, scr, r, lane, MapId());
    }
}

template <int MODE>
__device__ __forceinline__ void row_phase(const void* xin, const float* __restrict__ g, const float* __restrict__ mod, int sh_off, int sc_off, const float* __restrict__ ss, void* outp, int wave, int lane) {
    const int gw = blockIdx.x * NWAVES + wave, NGW = gridDim.x * NWAVES;
    f32x4 gv[4];
#pragma unroll
    for (int j = 0; j < 4; ++j) gv[j] = ((const f32x4*)g)[lane + 64 * j];
    auto load = [&](f32x4 (&v)[4], int m) __attribute__((always_inline)) {
        if (MODE == 0) { const f32x4* xr = (const f32x4*)((const float*)xin + (size_t)m * D) + lane;
#pragma unroll
            for (int j = 0; j < 4; ++j) v[j] = __builtin_nontemporal_load(xr + 64 * j); }
        else { const u32x2* xr = (const u32x2*)((const u16*)xin + (size_t)m * D) + lane;
#pragma unroll
            for (int j = 0; j < 4; ++j) { const u32x2 w = xr[64 * j]; const unsigned wx = w.x, wy = w.y; const h2v a = __builtin_bit_cast(h2v, wx), b = __builtin_bit_cast(h2v, wy); v[j] = (f32x4){(float)a[0], (float)a[1], (float)b[0], (float)b[1]}; } }
    };
    auto finish = [&](f32x4 (&v)[4], int m) __attribute__((always_inline)) {
        float tot;
        if (MODE == 0) { float s = 0.f;
#pragma unroll
            for (int j = 0; j < 4; ++j) s += (v[j].x * v[j].x + v[j].y * v[j].y) + (v[j].z * v[j].z + v[j].w * v[j].w);
            tot = wave_sum(s); }
        else { const f32x4* sp = (const f32x4*)(ss + (size_t)m * 16); const f32x4 a = sp[0], b = sp[1], c = sp[2], d = sp[3];
            tot = ((a.x + a.y) + (a.z + a.w)) + ((b.x + b.y) + (b.z + b.w)) + ((c.x + c.y) + (c.z + c.w)) + ((d.x + d.y) + (d.z + d.w)); }
        const float rstd = rsqrtf(tot * (1.f / D) + EPS);
        if (MODE == 2) { f32x4* o = (f32x4*)((float*)outp + (size_t)m * D) + lane;
#pragma unroll
            for (int j = 0; j < 4; ++j) __builtin_nontemporal_store(v[j] * rstd * gv[j], o + 64 * j); }
        else { const float* mb = mod + (m >> 13) * (6 * D);
            u32x2* o = (u32x2*)((u16*)outp + (size_t)m * D) + lane;
#pragma unroll
            for (int j = 0; j < 4; ++j) { const f32x4 sc = ((const f32x4*)(mb + sc_off))[lane + 64 * j], sh = ((const f32x4*)(mb + sh_off))[lane + 64 * j];
                const f32x4 r = v[j] * rstd * gv[j] * (sc + 1.f) + sh; u32x2 w; w.x = pkh(r.x, r.y); w.y = pkh(r.z, r.w); o[64 * j] = w; } }
    };
    for (int m = gw; m < T; m += 2 * NGW) {
        f32x4 va[4], vb[4];
        load(va, m); const bool two = m + NGW < T; if (two) load(vb, m + NGW);
        finish(va, m); if (two) finish(vb, m + NGW);
    }
}

struct EpiProj {
    static constexpr bool PERM = true, AFTER_DRAIN = false;
    u16* P; u16* kidx; float* widx; float* glr; u16* kf;
    __device__ __forceinline__ void operator()(const f32x4 (&acc)[2][2][4][2], const Unit& u, int wr, int wc, int fr, int fq) const {
        const int row0 = u.pm * 256 + wr * 64 + fr;
        if (u.pn < 14) {
            const int col0 = u.pn * 256 + wc * 32 + 8 * fq;
#pragma unroll
            for (int ai = 0; ai < 2; ++ai)
#pragma unroll
                for (int m = 0; m < 4; ++m) { u16* rowp = P + (size_t)(row0 + ai * 128 + m * 16) * PJ + col0;
#pragma unroll
                    for (int bj = 0; bj < 2; ++bj) { const f32x4 v0 = acc[ai][bj][m][0], v1 = acc[ai][bj][m][1];
                        u32x4 w; w.x = pkh(v0[0], v0[1]); w.y = pkh(v0[2], v0[3]); w.z = pkh(v1[0], v1[1]); w.w = pkh(v1[2], v1[3]);
                        if (u.pn == 2 || u.pn == 3) {
                            const int row = row0 + ai * 128 + m * 16, hd = 2 * (u.pn - 2) + bj, bb = row >> 13, kt = (row & 8191) >> 5;
                            __builtin_nontemporal_store(w, (u32x4*)(kf + ((((size_t)(bb * 4 + hd) * 256 + kt) * 8 + 2 * wc + (fq >> 1)) * 64 + (fq & 1) * 32 + (row & 31)) * 8)); }
                        else __builtin_nontemporal_store(w, (u32x4*)(rowp + bj * 128)); } }
        } else {
#pragma unroll
            for (int ai = 0; ai < 2; ++ai)
#pragma unroll
                for (int m = 0; m < 4; ++m) { const size_t row = (size_t)(row0 + ai * 128 + m * 16); const f32x4 v0 = acc[ai][0][m][0], v1 = acc[ai][0][m][1];
                    if (wc < 2) { u32x4 w; w.x = pkh(v0[0], v0[1]); w.y = pkh(v0[2], v0[3]); w.z = pkh(v1[0], v1[1]); w.w = pkh(v1[2], v1[3]);
                        *(u32x4*)(kidx + (((row >> 5) * 4 + 2 * wc + (fq >> 1)) * 64 + (fq & 1) * 32 + (row & 31)) * 8) = w; }
                    else if (wc == 2) {
                        if (fq == 0) { *(f32x4*)(widx + row * 8) = v0 * IDX_SCALE; *(f32x4*)(widx + row * 8 + 4) = v1 * IDX_SCALE; }
                        else if (fq < 3) { *(f32x4*)(glr + row * 16 + (fq - 1) * 8) = v0; *(f32x4*)(glr + row * 16 + (fq - 1) * 8 + 4) = v1; } } }
        }
    }
};
template <bool BASE_HALF>
struct EpiRes {
    static constexpr bool PERM = false, AFTER_DRAIN = false;
    const void* base; u16* out; const float* mod; float* ss; int gate_off; int pad;
    __device__ __forceinline__ void operator()(const f32x4 (&acc)[2][2][4][2], const Unit& u, int wr, int wc, int fr, int fq) const {
        const int row0 = u.pm * 256 + wr * 64 + fr, col0 = u.pn * 256 + wc * 32 + 4 * fq;
        const float* g = mod + (u.pm >> 5) * (6 * D) + gate_off;
        f32x4 gv[2][2];
#pragma unroll
        for (int bj = 0; bj < 2; ++bj)
#pragma unroll
            for (int n = 0; n < 2; ++n) gv[bj][n] = *(const f32x4*)(g + col0 + bj * 128 + n * 16);
#pragma unroll
        for (int ai = 0; ai < 2; ++ai)
#pragma unroll
            for (int m = 0; m < 4; ++m) { const size_t row = (size_t)(row0 + ai * 128 + m * 16); float s = 0.f;
#pragma unroll
                for (int bj = 0; bj < 2; ++bj)
#pragma unroll
                    for (int n = 0; n < 2; ++n) { const size_t off = row * D + col0 + bj * 128 + n * 16; f32x4 bs;
                        if (BASE_HALF) { const u32x2 wi = *(const u32x2*)((const u16*)base + off); const unsigned wx = wi.x, wy = wi.y;        const h2v a = __builtin_bit_cast(h2v, wx), b = __builtin_bit_cast(h2v, wy); bs = (f32x4){(float)a[0], (float)a[1], (float)b[0], (float)b[1]}; }
                        else bs = __builtin_nontemporal_load((const f32x4*)((const float*)base + off));
                        const f32x4 o = bs + gv[bj][n] * acc[ai][bj][m][n]; u32x2 w; w.x = pkh(o[0], o[1]); w.y = pkh(o[2], o[3]); *(u32x2*)(out + off) = w;
                        s += (o[0] * o[0] + o[1] * o[1]) + (o[2] * o[2] + o[3] * o[3]); }
                s = rows_sum(s);
                if (fq == 0) ss[row * 16 + u.pn * 4 + wc] = s; }
    }
};
struct EpiSwiGLU {
    static constexpr bool PERM = true, AFTER_DRAIN = false;
    u16* act;
    __device__ __forceinline__ void operator()(const f32x4 (&acc)[2][2][4][2], const Unit& u, int wr, int wc, int fr, int fq) const {
        const int row0 = u.pm * 256 + wr * 64 + fr, col0 = u.pn * 128 + wc * 32 + 8 * fq;
#pragma unroll
        for (int ai = 0; ai < 2; ++ai)
#pragma unroll
            for (int m = 0; m < 4; ++m) { const f32x4 g0 = acc[ai][0][m][0], g1 = acc[ai][0][m][1], u0 = acc[ai][1][m][0], u1 = acc[ai][1][m][1];
                float a[8];
#pragma unroll
                for (int j = 0; j < 4; ++j) { a[j] = silu_f(g0[j]) * u0[j]; a[4 + j] = silu_f(g1[j]) * u1[j]; }
                u32x4 w; w.x = pkh(a[0], a[1]); w.y = pkh(a[2], a[3]); w.z = pkh(a[4], a[5]); w.w = pkh(a[6], a[7]);
                __builtin_nontemporal_store(w, (u32x4*)(act + (size_t)(row0 + ai * 128 + m * 16) * DFF + col0)); }
    }
};
}
#define MK_HAVE_MIX 1
namespace mk {
constexpr size_t WS_GDEC = 52 * MiB;
constexpr size_t WS_SELM = WS_H + 64 * MiB;
constexpr size_t WS_X16 = WS_GLAS;
constexpr size_t WS_S16 = WS_H;
constexpr int NCH = L / 64;

__device__ __forceinline__ unsigned f2bf(float f) { unsigned u = __builtin_bit_cast(unsigned, f); return (u + 0x7fffu + ((u >> 16) & 1u)) >> 16; }
__device__ __forceinline__ unsigned pkbf(float lo, float hi) { return f2bf(lo) | (f2bf(hi) << 16); }
__device__ __forceinline__ float h2f(u16 h) { return (float)__builtin_bit_cast(_Float16, h); }
__device__ __forceinline__ float hlo(unsigned w) { return h2f((u16)(w & 0xffffu)); }
__device__ __forceinline__ float hhi(unsigned w) { return h2f((u16)(w >> 16)); }
__device__ __forceinline__ int kperm16(int o) { return 8 * ((o >> 2) & 1) + 4 * (o >> 3) + (o & 3); }

__device__ __forceinline__ void vt_item(const Params& p, LAS unsigned char* scr  , int item, int lane) {
    const int tb = item & 255, h = (item >> 8) & 3, b = item >> 10, t0 = tb * 32;
    const u16* src = (const u16*)(p.ws + WS_PROJ) + (size_t)(b * L + t0) * PJ + CV + h * 128;
#pragma unroll
    for (int i = 0; i < 8; ++i) { const int r = 4 * i + (lane >> 4), ch = lane & 15; const u32x4 v = *(const u32x4*)(src + (size_t)r * PJ + ch * 8);
        LAS unsigned* d = (LAS unsigned*)(scr + r * 264 + ch * 16); d[0] = v.x; d[1] = v.y; d[2] = v.z; d[3] = v.w; }
    LDS_WAIT(); asm volatile("" ::: "memory");
    u16* dst = (u16*)(p.ws + WS_VT) + ((size_t)(b * 4 + h) * 256 + tb) * 4096;
#pragma unroll
    for (int i = 0; i < 8; ++i) { const int c = i * 64 + lane, dv = c & 127, tg = c >> 7;
        unsigned w[4];
#pragma unroll
        for (int jp = 0; jp < 4; ++jp) { const int j = 2 * jp, tok = 16 * (tg >> 1) + 8 * (j >> 2) + 4 * (tg & 1) + (j & 3);
            const unsigned lo = *(LAS u16*)(scr + tok * 264 + dv * 2), hi = *(LAS u16*)(scr + (tok + 1) * 264 + dv * 2); w[jp] = lo | (hi << 16); }
        u32x4 o; o.x = w[0]; o.y = w[1]; o.z = w[2]; o.w = w[3];
        *(u32x4*)(dst + ((((dv >> 5) * 2 + (tg >> 1)) * 2 + (tg & 1)) * 32 + (dv & 31)) * 8) = o; }
    LDS_WAIT(); asm volatile("" ::: "memory");
}

constexpr int GL_SEG = 106496;
constexpr int GL_GLR = 0, GL_WG = 4096, GL_BG = 8192, GL_BC = 8448, GL_QD = 25088, GL_KD = 34304, GL_QP = 43520, GL_VT = 52736, GL_SSQ = 71168, GL_OST = 72192, GL_END = 105984;
constexpr int GST = 72;
__device__ __forceinline__ void gla_bcum(const Params& p, LAS unsigned char* lds, int b, int h, int c) {
    const int tid = threadIdx.x;
    LAS float* glr = (LAS float*)(lds + GL_GLR); LAS float* wg = (LAS float*)(lds + GL_WG); LAS float* bg = (LAS float*)(lds + GL_BG); LAS float* bc = (LAS float*)(lds + GL_BC);
    const float* gsrc = (const float*)(p.ws + WS_GLR) + (size_t)(b * L + c * 64) * 16;
    for (int i = tid; i < 1024; i += NT) { glr[i] = gsrc[i]; wg[i] = p.w_gate2[(i >> 6) * 256 + h * 64 + (i & 63)]; }
    if (tid < 64) bg[tid] = p.b_gate2[h * 64 + tid];
    __syncthreads();
    { const int dk = tid & 63; float wr[16];
#pragma unroll
      for (int r = 0; r < 16; ++r) wr[r] = wg[r * 64 + dk];
      const float bias = bg[dk];
#pragma unroll
      for (int i = 0; i < 8; ++i) { const int t = (tid >> 6) + 8 * i; float z = bias;
#pragma unroll
          for (int r4 = 0; r4 < 4; ++r4) { const f32x4 gq = *(const LAS f32x4*)(glr + t * 16 + 4 * r4); z += gq[0] * wr[4 * r4] + gq[1] * wr[4 * r4 + 1] + gq[2] * wr[4 * r4 + 2] + gq[3] * wr[4 * r4 + 3]; }
          bc[t * 65 + dk] = (fminf(z, 0.f) - __logf(1.f + __expf(-fabsf(z)))) * (1.f / 16.f); } }
    __syncthreads();
    { const int dk = tid & 63, sg = tid >> 6; LAS float* segt = (LAS float*)(lds + GL_SEG);
      float v[8], run = 0.f;
#pragma unroll
      for (int i = 0; i < 8; ++i) { run += bc[(sg * 8 + i) * 65 + dk]; v[i] = run; }
      segt[sg * 64 + dk] = run;
      __syncthreads();
      float off = 0.f;
#pragma unroll
      for (int j = 0; j < 7; ++j) off += (j < sg) ? segt[j * 64 + dk] : 0.f;
#pragma unroll
      for (int i = 0; i < 8; ++i) bc[(sg * 8 + i) * 65 + dk] = v[i] + off; }
    __syncthreads();
}

__device__ __forceinline__ void gla1_item(const Params& p, LAS unsigned char* lds, int item, int wave, int lane) {
    const int tid = threadIdx.x, c = item & (NCH - 1), h = (item >> 7) & 3, b = item >> 9;
    const u16* prow = (const u16*)(p.ws + WS_PROJ) + (size_t)(b * L + c * 64) * PJ;
    unsigned kw0[4], kw1[4], vw0[8], vw1[8];
#pragma unroll
    for (int i = 0; i < 4; ++i) { const int idx = tid + NT * i, dk = idx & 63, t = 2 * (idx >> 6);
        kw0[i] = prow[(size_t)t * PJ + CGK + h * 64 + dk]; kw1[i] = prow[(size_t)(t + 1) * PJ + CGK + h * 64 + dk]; }
#pragma unroll
    for (int i = 0; i < 8; ++i) { const int idx = tid + NT * i, dv = idx & 127, t = 2 * (idx >> 7);
        vw0[i] = prow[(size_t)t * PJ + CGV + h * 128 + dv]; vw1[i] = prow[(size_t)(t + 1) * PJ + CGV + h * 128 + dv]; }
    gla_bcum(p, lds, b, h, c);
    LAS float* bc = (LAS float*)(lds + GL_BC); LAS u16* KT = (LAS u16*)(lds + GL_KD); LAS u16* VTl = (LAS u16*)(lds + GL_VT);
#pragma unroll
    for (int i = 0; i < 4; ++i) { const int idx = tid + NT * i, dk = idx & 63, t = 2 * (idx >> 6); const float bl = bc[63 * 65 + dk];
        const float k0 = h2f((u16)kw0[i]) * __expf(bl - bc[t * 65 + dk]), k1 = h2f((u16)kw1[i]) * __expf(bl - bc[(t + 1) * 65 + dk]);
        *(LAS unsigned*)(KT + dk * GST + t) = pkh(k0, k1); }
#pragma unroll
    for (int i = 0; i < 8; ++i) { const int idx = tid + NT * i, dv = idx & 127, t = 2 * (idx >> 7);
        *(LAS unsigned*)(VTl + dv * GST + t) = vw0[i] | (vw1[i] << 16); }
    if (tid < 64) ((float*)(p.ws + WS_GDEC))[(size_t)item * 64 + tid] = __expf(bc[63 * 65 + tid]);
#pragma unroll
    for (int i = 0; i < 8; ++i) { const int idx = tid + NT * i, t = idx >> 6, dk = idx & 63;
        ((float*)((u16*)(p.ws + WS_PROJ) + (size_t)(b * L + c * 64 + t) * PJ + CK + h * 128))[dk] = bc[t * 65 + dk]; }
    __syncthreads();
    const int mbv = wave >> 1, nbk = wave & 1, hh = lane >> 5, l31 = lane & 31;
    f32x16 acc;
#pragma unroll
    for (int i = 0; i < 16; ++i) acc[i] = 0.f;
#pragma unroll
    for (int s = 0; s < 4; ++s) { const f16x8 a = *(const LAS f16x8*)(VTl + (mbv * 32 + l31) * GST + 16 * s + 8 * hh), bb = *(const LAS f16x8*)(KT + (nbk * 32 + l31) * GST + 16 * s + 8 * hh);
        acc = __builtin_amdgcn_mfma_f32_32x32x16_f16(a, bb, acc, 0, 0, 0); }
    float* dst = (float*)(p.ws + WS_GLAS) + (size_t)item * 8192;
#pragma unroll
    for (int i = 0; i < 16; ++i) { const int dv = mbv * 32 + (i & 3) + 8 * (i >> 2) + 4 * hh; dst[dv * 64 + nbk * 32 + l31] = acc[i]; }
    __syncthreads();
}

__device__ __forceinline__ void phase_p4(const Params& p, LAS unsigned char* lds, int wave, int lane) {
    const float* dS = (const float*)(p.ws + WS_GLAS); const float* dec = (const float*)(p.ws + WS_GDEC); unsigned* S16 = (unsigned*)(p.ws + WS_S16);
    for (int ch = blockIdx.x * NT + threadIdx.x; ch < 32 * 4096; ch += gridDim.x * NT) {
        const int bh = ch >> 12, e2 = ch & 4095, dk = (e2 * 2) & 63;
        f32x2 run = {0.f, 0.f};
#pragma unroll 16
        for (int c = 0; c < NCH; ++c) { const size_t item = (size_t)bh * NCH + c;
            const f32x2 d = *(const f32x2*)(dS + item * 8192 + e2 * 2), a = *(const f32x2*)(dec + item * 64 + dk);
            S16[item * 4096 + e2] = pkh(run.x, run.y);
            run = a * run + d; }
    }
}

struct G3Ops { unsigned qw[4], kw[4], vw0[8], vw1[8]; u32x4 g0, g1; f16x8 sfr[4]; float bw[8]; };
#define GL_SYNC() do { asm volatile("s_waitcnt lgkmcnt(0)" ::: "memory"); __builtin_amdgcn_s_barrier(); asm volatile("" ::: "memory"); } while (0)
__device__ __forceinline__ void gla3_load(const Params& p, G3Ops& o, int item, int wave, int lane) {
    const int tid = threadIdx.x, c = item & (NCH - 1), h = (item >> 7) & 3, b = item >> 9;
    const int mb = wave >> 1, hh = lane >> 5, l31 = lane & 31;
    const u16* prow = (const u16*)(p.ws + WS_PROJ) + (size_t)(b * L + c * 64) * PJ;
#pragma unroll
    for (int i = 0; i < 4; ++i) { const int idx = tid + NT * i, dk = 2 * (idx & 31), t = idx >> 5;
        o.qw[i] = *(const unsigned*)(prow + (size_t)t * PJ + CGQ + h * 64 + dk); o.kw[i] = *(const unsigned*)(prow + (size_t)t * PJ + CGK + h * 64 + dk); }
#pragma unroll
    for (int i = 0; i < 8; ++i) { const int idx = tid + NT * i, dv = idx & 127, t = 2 * (idx >> 7);
        o.vw0[i] = prow[(size_t)t * PJ + CGV + h * 128 + dv]; o.vw1[i] = prow[(size_t)(t + 1) * PJ + CGV + h * 128 + dv]; }
    const u16* gorow = prow + (size_t)(tid >> 3) * PJ + CGO + h * 128 + (tid & 7) * 16;
    o.g0 = *(const u32x4*)gorow; o.g1 = *(const u32x4*)(gorow + 8);
    { const u16* srow = (const u16*)(p.ws + WS_S16) + (size_t)item * 8192 + (size_t)(mb * 32 + l31) * 64;
#pragma unroll
      for (int s = 0; s < 4; ++s) o.sfr[s] = *(const f16x8*)(srow + 16 * s + 8 * hh); }
#pragma unroll
    for (int i = 0; i < 8; ++i) { const int idx = tid + NT * i, t = idx >> 6, dk = idx & 63; o.bw[i] = ((const float*)(prow + (size_t)t * PJ + CK + h * 128))[dk]; }
}
__device__ __forceinline__ void gla3_item(const Params& p, LAS unsigned char* lds, const G3Ops& ops, int item, int wave, int lane) {
    const int tid = threadIdx.x, c = item & (NCH - 1), h = (item >> 7) & 3, b = item >> 9;
    const int mb = wave >> 1, nb = wave & 1, hh = lane >> 5, l31 = lane & 31;
    const unsigned (&qw)[4] = ops.qw; const unsigned (&kw)[4] = ops.kw; const unsigned (&vw0)[8] = ops.vw0; const unsigned (&vw1)[8] = ops.vw1; const u32x4 g0 = ops.g0, g1 = ops.g1; const f16x8 (&sfr)[4] = ops.sfr;
    LAS float* bc = (LAS float*)(lds + GL_BC);
#pragma unroll
    for (int i = 0; i < 8; ++i) { const int idx = tid + NT * i, t = idx >> 6, dk = idx & 63; bc[t * 65 + dk] = ops.bw[i]; }
    GL_SYNC();
    LAS u16* QD = (LAS u16*)(lds + GL_QD); LAS u16* KD = (LAS u16*)(lds + GL_KD); LAS u16* QP = (LAS u16*)(lds + GL_QP); LAS u16* VTl = (LAS u16*)(lds + GL_VT);
    LAS float* ssq = (LAS float*)(lds + GL_SSQ); LAS float* ost = (LAS float*)(lds + GL_OST);
#pragma unroll
    for (int i = 0; i < 4; ++i) { const int idx = tid + NT * i, dk = 2 * (idx & 31), t = idx >> 5;
        const float b0 = bc[t * 65 + dk], b1 = bc[t * 65 + dk + 1], r0 = bc[31 * 65 + dk], r1 = bc[31 * 65 + dk + 1];
        const float q0 = hlo(qw[i]) * 0.125f, q1 = hhi(qw[i]) * 0.125f;
        *(LAS unsigned*)(QD + t * GST + dk) = pkbf(q0 * __expf(b0 - r0), q1 * __expf(b1 - r1));
        *(LAS unsigned*)(KD + t * GST + dk) = pkbf(hlo(kw[i]) * __expf(r0 - b0), hhi(kw[i]) * __expf(r1 - b1));
        *(LAS unsigned*)(QP + t * GST + dk) = pkh(q0 * __expf(b0), q1 * __expf(b1)); }
#pragma unroll
    for (int i = 0; i < 8; ++i) { const int idx = tid + NT * i, dv = idx & 127, t = 2 * (idx >> 7);
        *(LAS unsigned*)(VTl + dv * GST + (t & ~15) + kperm16(t & 15)) = vw0[i] | (vw1[i] << 16); }
    GL_SYNC();
    f16x8 pf[4];
#pragma unroll
    for (int jb = 0; jb < 2; ++jb) {
        if (jb > nb) {
#pragma unroll
            for (int e = 0; e < 8; ++e) { pf[2 * jb][e] = (_Float16)0.f; pf[2 * jb + 1][e] = (_Float16)0.f; }
            continue; }
        f32x16 x;
#pragma unroll
        for (int i = 0; i < 16; ++i) x[i] = 0.f;
#pragma unroll
        for (int s = 0; s < 4; ++s) { const bf16x8 a = *(const LAS bf16x8*)(KD + (jb * 32 + l31) * GST + 16 * s + 8 * hh), bb = *(const LAS bf16x8*)(QD + (nb * 32 + l31) * GST + 16 * s + 8 * hh);
            x = __builtin_amdgcn_mfma_f32_32x32x16_bf16(a, bb, x, 0, 0, 0); }
#pragma unroll
        for (int i = 0; i < 16; ++i) { const int rowi = (i & 3) + 8 * (i >> 2) + 4 * hh; const bool keep = (jb < nb) || (rowi <= l31); const float v = keep ? x[i] : 0.f;
            pf[2 * jb + (i >> 3)][i & 7] = (_Float16)v; }
    }
    f32x16 o;
#pragma unroll
    for (int i = 0; i < 16; ++i) o[i] = 0.f;
#pragma unroll
    for (int kk = 0; kk < 4; ++kk) { if ((kk >> 1) > nb) continue;
        const f16x8 a = *(const LAS f16x8*)(VTl + (mb * 32 + l31) * GST + 16 * kk + 8 * hh);
        o = __builtin_amdgcn_mfma_f32_32x32x16_f16(a, pf[kk], o, 0, 0, 0); }
#pragma unroll
    for (int s = 0; s < 4; ++s) { const f16x8 bb = *(const LAS f16x8*)(QP + (nb * 32 + l31) * GST + 16 * s + 8 * hh);
        o = __builtin_amdgcn_mfma_f32_32x32x16_f16(sfr[s], bb, o, 0, 0, 0); }
    float part = 0.f;
#pragma unroll
    for (int i = 0; i < 16; ++i) { part += o[i] * o[i]; ost[(nb * 32 + l31) * 132 + mb * 32 + (i & 3) + 8 * (i >> 2) + 4 * hh] = o[i]; }
    part += __shfl_xor(part, 32);
    if (lane < 32) ssq[mb * 64 + nb * 32 + lane] = part;
    GL_SYNC();
    { const int t = tid >> 3, dv0 = (tid & 7) * 16;
      const float rstd = rsqrtf((ssq[t] + ssq[64 + t] + ssq[128 + t] + ssq[192 + t]) * (1.f / 128.f) + EPS);
      const unsigned gw[8] = {g0.x, g0.y, g0.z, g0.w, g1.x, g1.y, g1.z, g1.w};
      unsigned ow[8];
#pragma unroll
      for (int e = 0; e < 8; ++e) { const int dv = dv0 + 2 * e;
          const float a0 = ost[t * 132 + dv] * rstd * p.gla_g[dv] * silu_f(hlo(gw[e])), a1 = ost[t * 132 + dv + 1] * rstd * p.gla_g[dv + 1] * silu_f(hhi(gw[e]));
          ow[e] = pkh(a0, a1); }
      u16* crow = (u16*)(p.ws + WS_CAT) + (size_t)(b * L + c * 64 + t) * D + 512 + h * 128 + dv0;
      u32x4 o0, o1; o0.x = ow[0]; o0.y = ow[1]; o0.z = ow[2]; o0.w = ow[3]; o1.x = ow[4]; o1.y = ow[5]; o1.z = ow[6]; o1.w = ow[7];
      *(u32x4*)crow = o0; *(u32x4*)(crow + 8) = o1; }
    GL_SYNC();
}
}
namespace mk {
__device__ __forceinline__ int idx_row_slot(int r) { return 2 * ((r >> 2) & 1) + (r >> 4); }
__device__ __forceinline__ int idx_row_head(int r) { return (r & 3) + 4 * ((r >> 3) & 1); }
__device__ __forceinline__ float relu_f(float x) { const int i = __builtin_bit_cast(int, x); return __builtin_bit_cast(float, i > 0 ? i : 0); }
template <int BASE> __device__ __forceinline__ float idx_score(const f32x16& acc, const f32x4 wa, const f32x4 wb) {
    float s = wa[0] * relu_f(acc[BASE + 0]);
    s = __builtin_fmaf(wa[1], relu_f(acc[BASE + 1]), s);
    s = __builtin_fmaf(wa[2], relu_f(acc[BASE + 2]), s); s = __builtin_fmaf(wa[3], relu_f(acc[BASE + 3]), s);
    s = __builtin_fmaf(wb[0], relu_f(acc[BASE + 4]), s); s = __builtin_fmaf(wb[1], relu_f(acc[BASE + 5]), s);
    s = __builtin_fmaf(wb[2], relu_f(acc[BASE + 6]), s); s = __builtin_fmaf(wb[3], relu_f(acc[BASE + 7]), s);
    return s;
}
__device__ __forceinline__ unsigned fkey(float f) { f = f + 0.0f; const unsigned u = __builtin_bit_cast(unsigned, f); return u ^ ((unsigned)((int)u >> 31) | 0x80000000u); }
__device__ __forceinline__ int opq(int v) { asm volatile("" : "+v"(v)); return v; }
__device__ __forceinline__ unsigned lds_add(LAS unsigned* p, unsigned v) { return __hip_atomic_fetch_add(p, v, __ATOMIC_RELAXED, __HIP_MEMORY_SCOPE_WORKGROUP); }
__device__ __forceinline__ unsigned wave_prefix_incl(unsigned v) {
#define MK_DPPADD(ctrl, rm) v += (unsigned)__builtin_amdgcn_update_dpp(0, (int)v, ctrl, rm, 0xf, false)
    MK_DPPADD(0x111, 0xf); MK_DPPADD(0x112, 0xf); MK_DPPADD(0x114, 0xf); MK_DPPADD(0x118, 0xf); MK_DPPADD(0x142, 0xa); MK_DPPADD(0x143, 0xc);
#undef MK_DPPADD
    return v;
}
__device__ __forceinline__ unsigned wave_suffix_sum(unsigned x, int lane) {
    const unsigned pre = wave_prefix_incl(x), tot = (unsigned)__builtin_amdgcn_readlane((int)pre, 63);
    return tot - pre + x;
}

template <int NP, int NC>
__device__ __forceinline__ void wave_select(const LAS unsigned* const (&cq)[NC], const unsigned (&sc)[NC][4], const unsigned (&kk0)[NC], LAS unsigned* const (&hq)[NC], int lane, const int (&rp0)[NC], const unsigned (&pre)[NC], unsigned (&out)[NC]) {
    unsigned prefix[NC], mask[NC], kk[NC];
#pragma unroll
    for (int c = 0; c < NC; ++c) { prefix[c] = pre[c]; mask[c] = rp0[c] ? (0xffffffffu << (32 - 8 * rp0[c])) : 0u; kk[c] = kk0[c]; }
    int rpmin = NP;
#pragma unroll
    for (int c = 0; c < NC; ++c) rpmin = rp0[c] < rpmin ? rp0[c] : rpmin;
    for (int rp = rpmin; rp < NP; ++rp) { const int shift = 24 - 8 * rp;
#pragma unroll
        for (int c = 0; c < NC; ++c) { u32x4 z = {0u, 0u, 0u, 0u}; *(LAS u32x4*)(hq[c] + 4 * lane) = z; }
#pragma unroll
        for (int sl = 0; sl < 4; ++sl)
#pragma unroll
            for (int i = 0; i < 4; ++i)
#pragma unroll
                for (int c = 0; c < NC; ++c) { const unsigned idx = lane + 64 * i; if (rp >= rp0[c] && idx < sc[c][sl]) { const unsigned key = fkey(__builtin_bit_cast(float, cq[c][256 * sl + idx])); if ((key & mask[c]) == prefix[c]) lds_add(hq[c] + ((key >> shift) & 255u), 1u); } }
        LDS_WAIT();
        u32x4 cw[NC]; unsigned cs[NC], incl[NC];
#pragma unroll
        for (int c = 0; c < NC; ++c) { cw[c] = *(LAS u32x4*)(hq[c] + 4 * lane); cs[c] = cw[c].x + cw[c].y + cw[c].z + cw[c].w; incl[c] = cs[c]; }
#pragma unroll
        for (int c = 0; c < NC; ++c) incl[c] = wave_suffix_sum(cs[c], lane);
#pragma unroll
        for (int c = 0; c < NC; ++c) { const unsigned above = incl[c] - cs[c]; const bool found = above < kk[c] && kk[c] <= incl[c];
            unsigned dig = 0u, kk2 = 0u;
            if (found) { unsigned cum = above; const unsigned cv[4] = {cw[c].x, cw[c].y, cw[c].z, cw[c].w};
#pragma unroll
                for (int i = 3; i >= 0; --i) { if (kk2 == 0u) { if (cum + cv[i] >= kk[c]) { dig = (unsigned)(4 * lane + i); kk2 = kk[c] - cum; } else cum += cv[i]; } } }
            const unsigned long long bal = __ballot(found); const int src = bal ? (int)__builtin_ctzll(bal) : 0;
            dig = (unsigned)__builtin_amdgcn_readlane((int)dig, src); kk2 = (unsigned)__builtin_amdgcn_readlane((int)kk2, src);
            if (rp >= rp0[c]) { prefix[c] |= dig << shift; mask[c] |= 255u << shift; kk[c] = kk2 ? kk2 : 1u; } }
    }
#pragma unroll
    for (int c = 0; c < NC; ++c) out[c] = prefix[c];
}

constexpr int TH_HIST = 0, TH_CAND = 65536, TH_ST = 131072, TH_A = 133120;
constexpr int ST_LO = 0, ST_RMAX = 16, ST_SH = 32, ST_NEED = 48, ST_MODE = 64, ST_CCNT = 80, ST_HI = 96, ST_ABOVE = 112, ST_WL = 128, ST_SAMP = 256, ST_SCNT = 272, ST_THR = 336, ST_DIRTY = 352;
__device__ __forceinline__ void thr_loadB(f16x8 (&Bf)[4], const u16* KI, int kt) {
#pragma unroll
    for (int s = 0; s < 4; ++s) Bf[s] = *(const f16x8*)(KI + (size_t)(kt * 4 + s) * 512);
}
__device__ __forceinline__ void thr_scores(const f32x16& acc, const LAS float* wl, int mb, int hh, unsigned& k0, unsigned& k1) {
    const LAS float* w0 = wl + (4 * mb + 2 * hh) * 8;
    const f32x4 a0 = *(const LAS f32x4*)(w0), b0 = *(const LAS f32x4*)(w0 + 4), a1 = *(const LAS f32x4*)(w0 + 8), b1 = *(const LAS f32x4*)(w0 + 12);
    k0 = fkey(idx_score<0>(acc, a0, b0)); k1 = fkey(idx_score<8>(acc, a1, b1));
}
constexpr int TH_MASK = 0, TH_CIDX = 16384, TH_SCR = 49152;
__device__ __forceinline__ float key2f(unsigned k) { return __builtin_bit_cast(float, (k & 0x80000000u) ? (k ^ 0x80000000u) : ~k); }
template <int KIND>
__device__ __forceinline__ void thr_sweep(LAS unsigned char* lds, const f16x8 (&A)[2][4], const u16* KI, int t0, int ntiles, int wave, int lane) {
    LAS unsigned* hist = (LAS unsigned*)(lds + TH_HIST); LAS unsigned* cand = (LAS unsigned*)(lds + TH_CAND); LAS unsigned* st = (LAS unsigned*)(lds + TH_ST);
    LAS unsigned* maskb = (LAS unsigned*)(lds + TH_MASK); LAS u16* cidx = (LAS u16*)(lds + TH_CIDX);
    const int hh = lane >> 5, l31 = lane & 31, mbp = wave & 1, ph = wave >> 1;
    unsigned lo[2][2], rmax[2][2], sh[2][2], ccn[2][2]; float lof[2][2], upf[2][2];
#pragma unroll
    for (int mbl = 0; mbl < 2; ++mbl)
#pragma unroll
        for (int jj = 0; jj < 2; ++jj) { const int ql = 8 * mbp + 4 * mbl + 2 * hh + jj; const unsigned lk = st[ST_LO + ql], rm = st[ST_RMAX + ql], uk = lk + rm;
            lo[mbl][jj] = lk; rmax[mbl][jj] = rm; sh[mbl][jj] = st[ST_SH + ql]; ccn[mbl][jj] = 0u;
            lof[mbl][jj] = lk <= 0x007fffffu ? -__builtin_inff() : key2f(lk); upf[mbl][jj] = uk >= 0xff800000u ? (lk == 0xffffffffu ? -__builtin_inff() : __builtin_inff()) : key2f(uk); }
    f16x8 B0[4], B1[4];
    const unsigned cbase4 = (unsigned)(__UINTPTR_TYPE__)(lds + TH_CAND) + ((8 * mbp + 2 * hh) * 1024 + ph * 256) * 4, cbase2 = (unsigned)(__UINTPTR_TYPE__)(lds + TH_CIDX) + ((8 * mbp + 2 * hh) * 1024 + ph * 256) * 2;
    float lofv[2][2] = {{lof[0][0], lof[0][1]}, {lof[1][0], lof[1][1]}};
    float lofc[2][2];
#pragma unroll
    for (int mbl = 0; mbl < 2; ++mbl)
#pragma unroll
        for (int jj = 0; jj < 2; ++jj) lofc[mbl][jj] = ((ntiles - 1) * 32 + l31 <= t0 + 8 * mbp + 4 * mbl + 2 * hh + jj) ? lof[mbl][jj] : __builtin_inff();
    const LAS float* wlb = (const LAS float*)(st + ST_WL) + (8 * mbp + 2 * hh) * 8;
    asm volatile("" : "+v"(wlb));
    f32x4 wreg[2][2][2];
    if (KIND == 1) {
#pragma unroll
        for (int mbl = 0; mbl < 2; ++mbl)
#pragma unroll
            for (int jj = 0; jj < 2; ++jj) { wreg[mbl][jj][0] = *(const LAS f32x4*)(wlb + (4 * mbl + jj) * 8); wreg[mbl][jj][1] = *(const LAS f32x4*)(wlb + (4 * mbl + jj) * 8 + 4); } }
    auto tile = [&](const f16x8 (&BX)[4], int kt, const bool chk) __attribute__((always_inline)) {
        const int skey = kt * 32 + l31;
        f32x16 acc[2];
#pragma unroll
        for (int mbl = 0; mbl < 2; ++mbl) {
#pragma unroll
            for (int i = 0; i < 16; ++i) acc[mbl][i] = 0.f;
#pragma unroll
            for (int s = 0; s < 4; ++s) acc[mbl] = __builtin_amdgcn_mfma_f32_32x32x16_f16(A[mbl][s], BX[s], acc[mbl], 0, 0, 0); }
#pragma unroll
        for (int mbl = 0; mbl < 2; ++mbl)
#pragma unroll
            for (int jj = 0; jj < 2; ++jj) { const int ql = 8 * mbp + 4 * mbl + 2 * hh + jj;
                const f32x4 wa = KIND == 1 ? wreg[mbl][jj][0] : *(const LAS f32x4*)(wlb + (4 * mbl + jj) * 8), wb = KIND == 1 ? wreg[mbl][jj][1] : *(const LAS f32x4*)(wlb + (4 * mbl + jj) * 8 + 4);
                const float sc = jj == 0 ? idx_score<0>(acc[mbl], wa, wb) : idx_score<8>(acc[mbl], wa, wb);
                if (KIND == 0) { const bool caus = !chk || skey <= t0 + ql;
                    const unsigned key = fkey(sc), d = key - lo[mbl][jj]; if (caus && d <= rmax[mbl][jj]) { const unsigned bin = d >> sh[mbl][jj]; lds_add(hist + ql * 1024 + (bin >> 1), 1u << (16 * (bin & 1u))); } }
                else {
                    const unsigned long long bal = __ballot(sc >= lofv[mbl][jj]);
                    const unsigned blo = (unsigned)bal, bhi = (unsigned)(bal >> 32), nlo = (unsigned)__builtin_popcount(blo), nhi = (unsigned)__builtin_popcount(bhi);
                    const unsigned cpk = ccn[mbl][jj] - (nlo << 16);
                    const int base = __builtin_amdgcn_sbfe((int)cpk, 16 * hh, 16);
                    unsigned pos = __builtin_amdgcn_mbcnt_hi(bhi, __builtin_amdgcn_mbcnt_lo(blo, (unsigned)base)); pos = pos < 255u ? pos : 255u;
                    { const unsigned a4 = cbase4 + (4 * mbl + jj) * 4096 + pos * 4, a2 = cbase2 + (4 * mbl + jj) * 2048 + pos * 2; unsigned long long sv;
                      asm volatile("s_and_saveexec_b64 %0, %1\n\tds_write_b32 %2, %3\n\tds_write_b16 %4, %5\n\ts_mov_b64 exec, %0" : "=&s"(sv) : "s"(bal), "v"(a4), "v"(sc), "v"(a2), "v"(skey) : "memory"); }
                    ccn[mbl][jj] += nlo + (nhi << 16); } }
    };
    int kt = ph; const int last = ntiles - 1;
    if (KIND == 0) {
        for (; kt < ntiles; kt += 4) { thr_loadB(B0, KI, kt); tile(B0, kt, true); }
        return; }
    thr_loadB(B0, KI, kt);
#define TH_LASTTHR() do { if (kt == last) { asm volatile("" ::: "memory");   _Pragma("unroll") for (int a = 0; a < 2; ++a) { _Pragma("unroll") for (int c = 0; c < 2; ++c) lofv[a][c] = lofc[a][c]; } } } while (0)
    for (;;) {
        thr_loadB(B1, KI, kt + 4 < last ? kt + 4 : last); TH_LASTTHR(); tile(B0, kt, kt == last); kt += 4; if (kt >= ntiles) break;
        thr_loadB(B0, KI, kt + 4 < last ? kt + 4 : last); TH_LASTTHR(); tile(B1, kt, kt == last); kt += 4; if (kt >= ntiles) break;
    }
#undef TH_LASTTHR
    if (KIND == 1) {
#pragma unroll
        for (int mbl = 0; mbl < 2; ++mbl)
#pragma unroll
            for (int jj = 0; jj < 2; ++jj) {
                if (l31 == 0) st[ST_SCNT + (8 * mbp + 4 * mbl + 2 * hh + jj) * 4 + ph] = (ccn[mbl][jj] >> (16 * hh)) & 0xffffu; } }
}
__device__ __forceinline__ void thr_write_masks(const Params& p, LAS unsigned char* lds, int b, int t0, int ntw) {
    const int tidw = opq(threadIdx.x);
    const LAS unsigned* maskb = (const LAS unsigned*)(lds + TH_MASK); const int q = tidw & 15;
    unsigned* dst = (unsigned*)(p.ws + WS_SELM) + ((size_t)(b * 128 + (t0 >> 6)) * 256) * 64 + (t0 & 63) + q;
    for (int kt = tidw >> 4; kt < ntw; kt += 32) dst[(size_t)kt * 64] = maskb[q * 256 + kt];
}
struct ThrOps { f16x8 A[2][4]; float wl; };
__device__ __forceinline__ void thr_load(const Params& p, ThrOps& o, int b, int qb, int wave) {
    const int tid = opq(threadIdx.x), lane = tid & 63, hh = lane >> 5, l31 = lane & 31, t0 = qb * 16, mbp = wave & 1;
    const u16* P16 = (const u16*)(p.ws + WS_PROJ); const int slot = idx_row_slot(l31), head = idx_row_head(l31);
#pragma unroll
    for (int mbl = 0; mbl < 2; ++mbl) { const u16* qr = P16 + (size_t)(b * L + t0 + 8 * mbp + 4 * mbl + slot) * PJ + CQI + head * 64 + 8 * hh;
#pragma unroll
        for (int s = 0; s < 4; ++s) o.A[mbl][s] = *(const f16x8*)(qr + 16 * s); }
    o.wl = ((const float*)(p.ws + WS_WIDX))[(size_t)(b * L + t0) * 8 + (tid & 127)];
}
#define TH_SYNC() do { asm volatile("s_waitcnt lgkmcnt(0)" ::: "memory"); __builtin_amdgcn_s_barrier(); asm volatile("" ::: "memory"); } while (0)
__device__ __forceinline__ void thr_item(const Params& p, LAS unsigned char* lds, const ThrOps& ops, int b, int qb, int wave, int lane) {
    int tid = opq(threadIdx.x); lane = tid & 63; int hh = lane >> 5, l31 = lane & 31; const int t0 = qb * 16;
#define TH_FRESH() do { tid = opq(tid); lane = tid & 63; hh = lane >> 5; l31 = lane & 31; } while (0)
    LAS unsigned* hist = (LAS unsigned*)(lds + TH_HIST); LAS unsigned* cand = (LAS unsigned*)(lds + TH_CAND); LAS unsigned* st = (LAS unsigned*)(lds + TH_ST);
    LAS unsigned* maskb = (LAS unsigned*)(lds + TH_MASK);
    const int ntw = 2 * (qb >> 2) + 2;
    if (tid < 16) { const int n = t0 + tid + 1;
        if (n <= 256) { st[ST_MODE + tid] = 2u; st[ST_THR + tid] = 0u; }
        else { st[ST_MODE + tid] = 0u; st[ST_LO + tid] = 0u; st[ST_RMAX + tid] = 0xffffffffu; st[ST_SH + tid] = 21u; st[ST_NEED + tid] = 256u; }
        st[ST_SAMP + tid] = 0u; }
    if (tid == 0) st[ST_DIRTY] = 0u;
    if (tid < 128) ((LAS float*)(st + ST_WL))[tid] = ops.wl;
    TH_SYNC();
    if (t0 + 16 <= 256) {
        for (int i = tid; i < 16 * 256; i += NT) { const int q = i >> 8, kt = i & 255, d = t0 + q - kt * 32; maskb[i] = d < 0 ? 0u : (d >= 31 ? 0xffffffffu : (2u << d) - 1u); }
        TH_SYNC(); thr_write_masks(p, lds, b, t0, ntw); TH_SYNC(); return; }
    const u16* P16 = (const u16*)(p.ws + WS_PROJ); const u16* KI = (const u16*)(p.ws + WS_KIDX) + (size_t)b * L * 64 + lane * 8;
    const int mbp = wave & 1, ph = wave >> 1;
    const f16x8 (&A)[2][4] = ops.A;
    const int ntiles = (t0 + 15) / 32 + 1;
    const int sd = ntiles >= 128 ? 16 : (ntiles >= 64 ? 8 : (ntiles >= 32 ? 4 : (ntiles >= 16 ? 2 : 1))), soff = sd == 16 ? 7 : (sd == 8 ? 3 : (sd == 4 ? 2 : 0)), mg = sd == 16 ? 17 : (sd == 8 ? 22 : (sd == 4 ? 30 : 35));
    const int ms = ntiles / sd;
    {
        { const LAS float* wlb = (const LAS float*)(st + ST_WL) + (8 * mbp + 2 * hh) * 8; asm volatile("" : "+v"(wlb));
          f16x8 Bs0[4], Bs1[4];
          auto stile = [&](const f16x8 (&Bs)[4], int j) __attribute__((always_inline)) { const int kt = sd * j + soff;
            f32x16 acc[2];
#pragma unroll
            for (int mbl = 0; mbl < 2; ++mbl) {
#pragma unroll
                for (int i = 0; i < 16; ++i) acc[mbl][i] = 0.f;
#pragma unroll
                for (int s = 0; s < 4; ++s) acc[mbl] = __builtin_amdgcn_mfma_f32_32x32x16_f16(A[mbl][s], Bs[s], acc[mbl], 0, 0, 0); }
#pragma unroll
            for (int mbl = 0; mbl < 2; ++mbl)
#pragma unroll
                for (int jj = 0; jj < 2; ++jj) { const int ql = 8 * mbp + 4 * mbl + 2 * hh + jj;
                    const f32x4 wa = *(const LAS f32x4*)(wlb + (4 * mbl + jj) * 8), wb = *(const LAS f32x4*)(wlb + (4 * mbl + jj) * 8 + 4);
                    const float sc = jj == 0 ? idx_score<0>(acc[mbl], wa, wb) : idx_score<8>(acc[mbl], wa, wb);
                    const bool caus = kt * 32 + l31 <= t0 + ql;
                    cand[ql * 1024 + j * 32 + l31] = caus ? __builtin_bit_cast(unsigned, sc) : 0xff800000u; }
          };
          if (ph < ms) { int j = ph; const int jl = ms - 1;
            thr_loadB(Bs0, KI, sd * j + soff);
            for (;;) {
                thr_loadB(Bs1, KI, sd * (j + 4 < jl ? j + 4 : jl) + soff); stile(Bs0, j); j += 4; if (j >= ms) break;
                thr_loadB(Bs0, KI, sd * (j + 4 < jl ? j + 4 : jl) + soff); stile(Bs1, j); j += 4; if (j >= ms) break;
            } } }
        TH_FRESH();
        if (sd == 1) { u32x4 z = {0u, 0u, 0u, 0u};
#pragma unroll
            for (int i = 0; i < 2; ++i) *(LAS u32x4*)(lds + TH_MASK + (tid + NT * i) * 16) = z; }
        TH_SYNC();
        const unsigned m = (unsigned)(ms * 32); const int qa = 2 * wave, qb2 = 2 * wave + 1;
        const unsigned s0 = m < 256u ? m : 256u, s1 = m < 256u ? 0u : (m < 512u ? m - 256u : 256u), s2 = m < 512u ? 0u : (m < 768u ? m - 512u : 256u), s3 = m < 768u ? 0u : m - 768u;
        if (sd == 1) {
            const LAS unsigned* const cq[2] = {cand + qa * 1024, cand + qb2 * 1024}; const unsigned sc[2][4] = {{s0, s1, s2, s3}, {s0, s1, s2, s3}}; const unsigned kk[2] = {256u, 256u};
            LAS unsigned* const hq[2] = {(LAS unsigned*)(lds + TH_SCR) + qa * 256, (LAS unsigned*)(lds + TH_SCR) + qb2 * 256}; const int rp0[2] = {0, 0}; const unsigned pre[2] = {0u, 0u}; unsigned res[2];
            wave_select<4, 2>(cq, sc, kk, hq, lane, rp0, pre, res);
#pragma unroll
            for (int c = 0; c < 2; ++c) { const int q = 2 * wave + c;
                for (int k2 = 0; 2 * k2 < ntiles; ++k2) { const int ki = k2 * 64 + lane; const bool sel = ki < (int)m && ki <= t0 + q && fkey(__builtin_bit_cast(float, cand[q * 1024 + ki])) >= res[c];
                    const unsigned long long bal = __ballot(sel); if (lane == 0) { maskb[q * 256 + 2 * k2] = (unsigned)bal; maskb[q * 256 + 2 * k2 + 1] = (unsigned)(bal >> 32); } }
                if (lane == 0) { st[ST_THR + q] = res[c]; st[ST_MODE + q] = 2u; } }
        } else {
          const float ra = 256.f * (float)m / (float)(t0 + qa + 1), rb = 256.f * (float)m / (float)(t0 + qb2 + 1);
          const int rloa = (int)ra + mg + 1, rlob = (int)rb + mg + 1;
          const LAS unsigned* const cq[2] = {cand + qa * 1024, cand + qb2 * 1024};
          const unsigned sc[2][4] = {{s0, s1, s2, s3}, {s0, s1, s2, s3}};
          const unsigned kk[2] = {(unsigned)(rloa <= (int)m ? rloa : (int)m), (unsigned)(rlob <= (int)m ? rlob : (int)m)};
          LAS unsigned* const hq[2] = {hist + (wave * 2 + 0) * 256, hist + (wave * 2 + 1) * 256};
          const int rp0[2] = {0, 0}; const unsigned pre[2] = {0u, 0u}; unsigned res[2];
          wave_select<2, 2>(cq, sc, kk, hq, lane, rp0, pre, res);
          if (lane == 0) {
              const unsigned loka = rloa <= (int)m ? res[0] : 0u, lokb = rlob <= (int)m ? res[1] : 0u;
              st[ST_MODE + qa] = 1u; st[ST_SAMP + qa] = 1u; st[ST_LO + qa] = loka; st[ST_RMAX + qa] = 0xffffffffu - loka;
              st[ST_MODE + qb2] = 1u; st[ST_SAMP + qb2] = 1u; st[ST_LO + qb2] = lokb; st[ST_RMAX + qb2] = 0xffffffffu - lokb; } }
        TH_SYNC();
    }
    bool clean = true, finalpass = false;
    for (int pass = 0; pass < 10 && sd != 1; ++pass) {
        TH_FRESH();
        { u32x4 z = {0u, 0u, 0u, 0u};
#pragma unroll
          for (int i = 0; i < 8; ++i) *(LAS u32x4*)(lds + TH_HIST + (tid + NT * i) * 16) = z;
          if (tid < 16) { st[ST_CCNT + tid] = 0u;
              if (finalpass) { const unsigned tk = st[ST_THR + tid]; st[ST_LO + tid] = tk; st[ST_RMAX + tid] = 0xffffffffu - tk; st[ST_MODE + tid] = 3u; } } }
        TH_SYNC();
        int kind; { const LAS u32x4* mv = (const LAS u32x4*)(st + ST_MODE); const u32x4 m0 = mv[0], m1 = mv[1], m2 = mv[2], m3 = mv[3];
            const unsigned w[16] = {m0.x, m0.y, m0.z, m0.w, m1.x, m1.y, m1.z, m1.w, m2.x, m2.y, m2.z, m2.w, m3.x, m3.y, m3.z, m3.w}; unsigned anyh = 0u;
#pragma unroll
            for (int q = 0; q < 16; ++q) anyh |= (w[q] == 0u) ? 1u : 0u;
            kind = __builtin_amdgcn_readfirstlane((int)anyh) ? 0 : 1; }
        const bool mpass = clean && pass == 0 && kind == 1;
        if (!mpass) clean = false;
        if (kind == 0) thr_sweep<0>(lds, A, KI, t0, ntiles, wave, lane); else thr_sweep<1>(lds, A, KI, t0, ntiles, wave, lane);
        TH_FRESH();
        TH_SYNC();
        if (finalpass) {
            for (int c = 0; c < 2; ++c) { const int q = 2 * wave + c; const LAS u16* ci = (const LAS u16*)(lds + TH_CIDX) + q * 1024;
#pragma unroll
                for (int sl = 0; sl < 4; ++sl) { const unsigned n = st[ST_SCNT + q * 4 + sl] < 256u ? st[ST_SCNT + q * 4 + sl] : 256u;
                    for (unsigned idx = lane; idx < n; idx += 64) { const unsigned ki = ci[256 * sl + idx];
                        __hip_atomic_fetch_or(maskb + q * 256 + (ki >> 5), 1u << (ki & 31u), __ATOMIC_RELAXED, __HIP_MEMORY_SCOPE_WORKGROUP); } } }
            break; }
        if (kind == 0) {
            for (int qq = 0; qq < 2; ++qq) { const int q = 2 * wave + qq;
                if (st[ST_MODE + q] != 0u) continue;
                const unsigned need = st[ST_NEED + q], shq = st[ST_SH + q], loq = st[ST_LO + q];
                LAS unsigned* hq = hist + q * 1024 + 16 * lane; unsigned c = 0u;
#pragma unroll
                for (int i = 0; i < 16; ++i) { const unsigned w = hq[i]; c += (w & 0xffffu) + (w >> 16); }
                const unsigned incl = wave_suffix_sum(c, lane), above = incl - c;
                if (above < need && need <= incl) {
                    unsigned cum = above, bsel = 0u, bcnt = 0u;
                    for (int i = 31; i >= 0; --i) { const unsigned w = hq[i >> 1], cnt = (i & 1) ? (w >> 16) : (w & 0xffffu); if (cum + cnt >= need) { bsel = (unsigned)(32 * lane + i); bcnt = cnt; break; } cum += cnt; }
                    const unsigned need2 = need - cum, newlo = loq + (bsel << shq);
                    if (bcnt == need2 || shq == 0u) { st[ST_THR + q] = newlo; st[ST_MODE + q] = 2u; st[ST_LO + q] = 0xffffffffu; st[ST_RMAX + q] = 0u; }
                    else { st[ST_LO + q] = newlo; st[ST_RMAX + q] = (1u << shq) - 1u; st[ST_NEED + q] = need2;
                        st[ST_SH + q] = shq > 11u ? shq - 11u : 0u; }
                } }
        } else {
            const LAS unsigned* cq[2]; unsigned sc[2][4], kk[2], pre[2], res[2]; LAS unsigned* hq[2]; int rp0[2]; bool act[2], good[2];
#pragma unroll
            for (int c = 0; c < 2; ++c) { const int q = 2 * wave + c; act[c] = st[ST_MODE + q] == 1u;
#pragma unroll
                for (int sl = 0; sl < 4; ++sl) sc[c][sl] = st[ST_SCNT + q * 4 + sl];
                const unsigned cnt = sc[c][0] + sc[c][1] + sc[c][2] + sc[c][3]; kk[c] = st[ST_NEED + q]; good[c] = sc[c][0] <= 256u && sc[c][1] <= 256u && sc[c][2] <= 256u && sc[c][3] <= 256u;
                good[c] = good[c] && kk[c] <= cnt;
                const unsigned loq = st[ST_LO + q], hiq = loq + st[ST_RMAX + q]; rp0[c] = (loq >> 24) != (hiq >> 24) ? 0 : ((loq >> 16) != (hiq >> 16) ? 1 : 2);
                pre[c] = rp0[c] == 0 ? 0u : (rp0[c] == 1 ? (loq & 0xff000000u) : (loq & 0xffff0000u));
                cq[c] = cand + q * 1024; hq[c] = (LAS unsigned*)(lds + TH_SCR) + q * 256;
                if (!(act[c] && good[c])) { sc[c][0] = 0u; sc[c][1] = 0u; sc[c][2] = 0u; sc[c][3] = 0u; kk[c] = 1u; rp0[c] = 4; } }
            wave_select<4, 2>(cq, sc, kk, hq, lane, rp0, pre, res);
#pragma unroll
            for (int c = 0; c < 2; ++c) { const int q = 2 * wave + c;
                if (!act[c]) continue;
                if (good[c]) { const unsigned key = res[c];
                    if (mpass) {
                        const LAS u16* ci = (const LAS u16*)(lds + TH_CIDX) + q * 1024;
#pragma unroll
                        for (int sl = 0; sl < 4; ++sl)
#pragma unroll
                            for (int i = 0; i < 4; ++i) { const unsigned idx = lane + 64 * i; if (idx < sc[c][sl] && fkey(__builtin_bit_cast(float, cand[q * 1024 + 256 * sl + idx])) >= key) { const unsigned ki = ci[256 * sl + idx];
                                __hip_atomic_fetch_or(maskb + q * 256 + (ki >> 5), 1u << (ki & 31u), __ATOMIC_RELAXED, __HIP_MEMORY_SCOPE_WORKGROUP); } } }
                    if (lane == 0) { st[ST_THR + q] = key; st[ST_MODE + q] = 2u; st[ST_LO + q] = 0xffffffffu; st[ST_RMAX + q] = 0u; } }
                else if (lane == 0) { st[ST_DIRTY] = 1u; st[ST_MODE + q] = 0u; st[ST_SAMP + q] = 0u; st[ST_LO + q] = 0u; st[ST_RMAX + q] = 0xffffffffu; st[ST_SH + q] = 21u; st[ST_NEED + q] = 256u; }
            }
        }
        TH_SYNC();
        bool alldone; { const LAS u32x4* mv = (const LAS u32x4*)(st + ST_MODE); const u32x4 m0 = mv[0], m1 = mv[1], m2 = mv[2], m3 = mv[3];
            const unsigned w[16] = {m0.x, m0.y, m0.z, m0.w, m1.x, m1.y, m1.z, m1.w, m2.x, m2.y, m2.z, m2.w, m3.x, m3.y, m3.z, m3.w}; unsigned nd = 0u;
#pragma unroll
            for (int q = 0; q < 16; ++q) nd |= (w[q] != 2u) ? 1u : 0u;
            alldone = __builtin_amdgcn_readfirstlane((int)nd) == 0; }
        if (alldone) { if (clean && st[ST_DIRTY] == 0u) break; finalpass = true; }
    }
    TH_SYNC();
    thr_write_masks(p, lds, b, t0, ntw);
    TH_SYNC();
#undef TH_FRESH
}
}
namespace mk {
constexpr int AT_MASKR = 0, AT_SSQ = 2560, AT_KVB = 16384, AT_OST = 16384;
#define AT_DMA(gp, lp) __builtin_amdgcn_global_load_lds((const unsigned*)(gp), (LAS unsigned*)(lp), 16, 0, 0)
#define AT_DMAO(gp, lp, off) __builtin_amdgcn_global_load_lds((const unsigned*)(gp), (LAS unsigned*)(lp), 16, off, 0)
#define AT_DMA4(gp, lp) __builtin_amdgcn_global_load_lds((const unsigned*)(gp), (LAS unsigned*)(lp), 4, 0, 0)
__device__ __forceinline__ void att_item(const Params& p, LAS unsigned char* lds, int b, int qblk, int wave, int lane) {
    const int q0 = qblk * 128, g = wave >> 1, h2 = wave & 1, hh = lane >> 5, l31 = lane & 31;
    LAS unsigned* maskr = (LAS unsigned*)(lds + AT_MASKR); LAS float* ssq = (LAS float*)(lds + AT_SSQ);
    const u16* P16 = (const u16*)(p.ws + WS_PROJ);
    const unsigned* SM = (const unsigned*)(p.ws + WS_SELM) + (size_t)(b * 128 + 2 * qblk + (wave & 1)) * 256 * 64 + lane;
    const int ntiles = 4 * qblk + 4, glast = q0 + 32 * g + 31;
    const float csc = 0.08838834764831845f * 1.4426950408889634f;
    LAS unsigned char* ostw = lds + AT_OST + wave * 8704;
    u16* cbase = (u16*)(p.ws + WS_CAT) + (size_t)(b * L + q0 + 32 * g) * D;
    for (int sp = 0; sp < 2; ++sp) {
        const int h = 2 * sp + h2;
        const unsigned char* KF = (const unsigned char*)(p.ws + WS_KF) + (size_t)(b * 4 + 2 * sp + (wave & 1)) * 256 * 8192 + (size_t)(2 * (wave >> 1)) * 1024 + lane * 16;
        const unsigned char* VF = (const unsigned char*)(p.ws + WS_VT) + (size_t)(b * 4 + 2 * sp + (wave & 1)) * 256 * 8192 + (size_t)(2 * (wave >> 1)) * 1024 + lane * 16;
        const int dofs = (wave & 1) * 8192 + 2 * (wave >> 1) * 1024;
        if (wave < 2) { AT_DMA4(SM, lds + AT_MASKR + wave * 256); AT_DMA4(SM + 64, lds + AT_MASKR + 512 + wave * 256); }
#pragma unroll
        for (int i = 0; i < 2; ++i) { AT_DMA(KF + i * 1024, lds + AT_KVB + dofs + i * 1024); AT_DMA(VF + i * 1024, lds + AT_KVB + 16384 + dofs + i * 1024); }
        f16x8 Qf[8];
        { const u16* qa = P16 + (size_t)(b * L + q0 + 32 * g + l31) * PJ + CQ + h * 128 + 8 * hh;
#pragma unroll
          for (int s = 0; s < 8; ++s) Qf[s] = *(const f16x8*)(qa + 16 * s); }
#pragma unroll
        for (int s = 0; s < 8; ++s) Qf[s] = Qf[s] * (_Float16)csc;
        f32x16 O[4];
#pragma unroll
        for (int d = 0; d < 4; ++d)
#pragma unroll
            for (int i = 0; i < 16; ++i) O[d][i] = 0.f;
        const unsigned char* kfp = KF; const unsigned char* vfp = VF; const unsigned* smp = SM + 64;
        float mrun = 0.f, lsum = 0.f;
        f32x16 negm;
#pragma unroll
        for (int i = 0; i < 16; ++i) negm[i] = 0.f;
        for (int kt = 0; kt < ntiles; ++kt) {
            asm volatile("s_waitcnt vmcnt(0)" ::: "memory");
            __syncthreads();
            const bool act = kt * 32 <= glast;
            const LAS f16x8* kb = (const LAS f16x8*)(lds + AT_KVB + (kt & 1) * 32768 + h2 * 8192) + lane;
            f16x8 kf[8];
            if (act) {
#pragma unroll
                for (int s = 0; s < 8; ++s) kf[s] = kb[s * 64]; }
            kfp += 8192; vfp += 8192; smp += 64;
            asm volatile("" : "+v"(kfp), "+v"(vfp), "+v"(smp));
            if (kt + 1 < ntiles) { const int bo = AT_KVB + ((kt + 1) & 1) * 32768 + dofs;
                AT_DMAO(kfp, lds + bo, 0); AT_DMAO(kfp, lds + bo, 1024); AT_DMAO(vfp, lds + bo + 16384, 0); AT_DMAO(vfp, lds + bo + 16384, 1024); }
            if (kt + 2 < ntiles && wave < 2) AT_DMA4(smp, lds + AT_MASKR + ((kt + 2) & 3) * 512 + wave * 256);
            if (act) {
                f32x16 S = negm;
#pragma unroll
                for (int s = 0; s < 8; ++s) S = __builtin_amdgcn_mfma_f32_32x32x16_f16(kf[s], Qf[s], S, 0, 0, 0);

                const unsigned bits = maskr[(kt & 3) * 128 + 32 * g + l31] >> (4 * hh);
                f16x8 vf[8];
                const unsigned av = (unsigned)(__UINTPTR_TYPE__)(lds + AT_KVB + (kt & 1) * 32768 + 16384 + h2 * 8192) + lane * 16;
#define AT_RD(dst, off, dep) asm volatile("ds_read_b128 %0, %1 offset:" #off : "=v"(dst) : "v"(av), "v"(dep))
                AT_RD(vf[0], 0, bits); AT_RD(vf[2], 2048, bits); AT_RD(vf[4], 4096, bits); AT_RD(vf[6], 6144, bits);
                int mxi = 0;
#pragma unroll
                for (int i = 0; i < 16; ++i) { const unsigned mk = (unsigned)__builtin_amdgcn_sbfe((int)bits, (i & 3) + 8 * (i >> 2), 1); const float si = S[i];
                    S[i] = __builtin_bit_cast(float, (__builtin_bit_cast(unsigned, si) & mk) | (0xff61b1e6u & ~mk)); }
#pragma unroll
                for (int i = 0; i < 16; i += 2) { const float a = S[i], c = S[i + 1]; const int ai = __builtin_bit_cast(int, a), ci = __builtin_bit_cast(int, c); const int t = mxi > ai ? mxi : ai; mxi = t > ci ? t : ci; }
                { const auto r = __builtin_amdgcn_permlane32_swap((unsigned)mxi, (unsigned)mxi, false, false); const int r0 = (int)r[0], r1 = (int)r[1]; mxi = r0 > r1 ? r0 : r1; }
                const float mx = __builtin_bit_cast(float, mxi);
                if (__ballot(mx > 8.f)) { const float dlt = mx > 8.f ? mx : 0.f, alpha = __builtin_amdgcn_exp2f(-dlt);
                    mrun += dlt; lsum *= alpha;
#pragma unroll
                    for (int d = 0; d < 4; ++d)
#pragma unroll
                        for (int i = 0; i < 16; ++i) O[d][i] *= alpha;
#pragma unroll
                    for (int i = 0; i < 16; ++i) { S[i] -= dlt; negm[i] = -mrun; } }
                float ps = 0.f; f16x8 pf[2];
#pragma unroll
                for (int i = 0; i < 16; ++i) { const float pe = __builtin_amdgcn_exp2f(S[i]); ps += pe; pf[i >> 3][i & 7] = (_Float16)pe; }
                lsum += ps;
                asm volatile("s_waitcnt lgkmcnt(0)" : "+v"(vf[0]), "+v"(vf[2]), "+v"(vf[4]), "+v"(vf[6]));
                AT_RD(vf[1], 1024, vf[0]); AT_RD(vf[3], 3072, vf[0]); AT_RD(vf[5], 5120, vf[0]); AT_RD(vf[7], 7168, vf[0]);
#undef AT_RD
#pragma unroll
                for (int d = 0; d < 4; ++d) O[d] = __builtin_amdgcn_mfma_f32_32x32x16_f16(vf[d * 2], pf[0], O[d], 0, 0, 0);
                asm volatile("s_waitcnt lgkmcnt(0)" : "+v"(vf[1]), "+v"(vf[3]), "+v"(vf[5]), "+v"(vf[7]));
#pragma unroll
                for (int d = 0; d < 4; ++d) O[d] = __builtin_amdgcn_mfma_f32_32x32x16_f16(vf[d * 2 + 1], pf[1], O[d], 0, 0, 0);
            }
        }
        int lane2 = lane; asm volatile("" : "+v"(lane2)); const int l31b = lane2 & 31, hhb = lane2 >> 5;
        const float ltot = lsum + __shfl_xor(lsum, 32), inv = 1.f / ltot;
        float part = 0.f;
#pragma unroll
        for (int d = 0; d < 4; ++d)
#pragma unroll
            for (int i = 0; i < 16; ++i) { O[d][i] *= inv; part += O[d][i] * O[d][i]; }
        part += __shfl_xor(part, 32);
        if (lane2 < 32) ssq[h * 128 + 32 * g + lane2] = part;
        __syncthreads();
        const int qi = 32 * g + l31b;
        const float rstd = sp == 0 ? 1.f : rsqrtf((ssq[qi] + ssq[128 + qi] + ssq[256 + qi] + ssq[384 + qi]) * (1.f / 512.f) + EPS);
#pragma unroll
        for (int d = 0; d < 4; ++d)
#pragma unroll
            for (int ip = 0; ip < 8; ++ip) { const int i = 2 * ip, dv = d * 32 + (i & 3) + 8 * (i >> 2) + 4 * hhb;
                const float g0 = sp == 0 ? 1.f : p.att_g[h * 128 + dv], g1 = sp == 0 ? 1.f : p.att_g[h * 128 + dv + 1];
                *(LAS unsigned*)(ostw + l31b * 272 + dv * 2) = pkh(O[d][i] * rstd * g0, O[d][i + 1] * rstd * g1); }
        LDS_WAIT(); asm volatile("" ::: "memory");
#pragma unroll
        for (int i = 0; i < 8; ++i) { const int idx = i * 64 + lane2, row = idx >> 4, ch = idx & 15;
            const u32x4 v = *(const LAS u32x4*)(ostw + row * 272 + ch * 16); *(u32x4*)(cbase + (size_t)row * D + h * 128 + ch * 8) = v; }
        if (sp == 0) __syncthreads();
    }
    {
            int lane2 = lane; asm volatile("" : "+v"(lane2));
            asm volatile("s_waitcnt vmcnt(0)" ::: "memory");
#pragma unroll
            for (int i = 0; i < 8; ++i) { const int idx = i * 64 + lane2, row = idx >> 4, ch = idx & 15;
                u16* ptr = cbase + (size_t)row * D + h2 * 128 + ch * 8; const u32x4 v = *(const u32x4*)ptr; const int qr = 32 * g + row;
                const float rs = rsqrtf((ssq[qr] + ssq[128 + qr] + ssq[256 + qr] + ssq[384 + qr]) * (1.f / 512.f) + EPS);
                const unsigned wv[4] = {v.x, v.y, v.z, v.w}; unsigned ov[4];
#pragma unroll
                for (int e = 0; e < 4; ++e) { const int dv = ch * 8 + 2 * e; ov[e] = pkh(hlo(wv[e]) * rs * p.att_g[h2 * 128 + dv], hhi(wv[e]) * rs * p.att_g[h2 * 128 + dv + 1]); }
                u32x4 o; o.x = ov[0]; o.y = ov[1]; o.z = ov[2]; o.w = ov[3]; *(u32x4*)ptr = o; } }
    __syncthreads();
}

__device__ __forceinline__ void phase_p3(const Params& p, LAS unsigned char* lds, int wave, int lane) {
    const int G = gridDim.x, bx = blockIdx.x;
    { LAS unsigned char* scr = lds + wave * 8704; const int gw = bx * NWAVES + wave, NGW = G * NWAVES;
      for (int it = gw; it < NB * 4 * (L / 32); it += NGW) vt_item(p, scr, it, lane); }
    __syncthreads();
    for (int it = bx; it < NB * 4 * NCH; it += G) gla1_item(p, lds, it, wave, lane);
    {
    if (G == 256) { const int bt = bx & 7, j = bx >> 3;
        ThrOps cur; thr_load(p, cur, bt, j, wave);
        for (int r = 0; r < 16; ++r) { const int qb = (r & 1) ? 511 - (32 * (r >> 1) + j) : 32 * (r >> 1) + j; const int rn = r < 15 ? r + 1 : r, qbn = (rn & 1) ? 511 - (32 * (rn >> 1) + j) : 32 * (rn >> 1) + j;
            ThrOps nxt; thr_load(p, nxt, bt, qbn, wave);
            thr_item(p, lds, cur, bt, qb, wave, lane); cur = nxt; } }
    else { for (int it = bx; it < NB * 512; it += G) { ThrOps cur; thr_load(p, cur, it >> 9, it & 511, wave); thr_item(p, lds, cur, it >> 9, it & 511, wave, lane); } } }
}
__device__ __forceinline__ void phase_p5(const Params& p, LAS unsigned char* lds, int wave, int lane) {
    const int G = gridDim.x, bx = blockIdx.x;
    if (G == 256) { const int bt = bx & 7, j = bx >> 3;
        for (int r = 0; r < 2; ++r) att_item(p, lds, bt, r == 0 ? 63 - j : j, wave, lane); }
    else { for (int it = bx; it < NB * 64; it += G) att_item(p, lds, it >> 6, it & 63, wave, lane); }
    { const int N = NB * 4 * NCH; G3Ops cur; if (bx < N) gla3_load(p, cur, bx, wave, lane);
      for (int it = bx; it < N; it += G) { G3Ops nxt; gla3_load(p, nxt, it + G < N ? it + G : it, wave, lane);
          gla3_item(p, lds, cur, it, wave, lane); cur = nxt; }
      __syncthreads(); }
}
}
namespace mk {
#define XB_TMO      128
#define XB_XCNT(j)  (256  + 64 * (j))
#define XB_XSUB(j)  (1280 + 64 * (j))
#define XB_XGEN(j)  (2304 + 64 * (j))
#define XB_TOP      3328
#define XB_TOPGEN   3392
#define XCD_BAR_WORDS 3456
#define XB_SPIN_CAP (1u << 18)

__device__ __forceinline__ unsigned xb_ld(unsigned* p)              { return __hip_atomic_load(p, __ATOMIC_RELAXED, __HIP_MEMORY_SCOPE_AGENT); }
__device__ __forceinline__ unsigned xb_add(unsigned* p, unsigned v) { return __hip_atomic_fetch_add(p, v, __ATOMIC_RELAXED, __HIP_MEMORY_SCOPE_AGENT); }
__device__ __forceinline__ unsigned xb_xcc_id() { return (unsigned)__builtin_amdgcn_s_getreg((3 << 11) | 20) & 0xFu; }
#define XB_SPIN(cond, bar) do { unsigned _sp = 0; while (cond) { __builtin_amdgcn_s_sleep(1); \
    if ((++_sp & 255u) == 0u) { if (xb_ld(&(bar)[XB_TMO])) break; if (_sp > XB_SPIN_CAP) { atomicAdd(&(bar)[XB_TMO], 1u); break; } } } } while (0)

struct XcdBarrier {
    unsigned* bar; unsigned x;
    volatile LAS unsigned* st;
};

__device__ __forceinline__ XcdBarrier xcd_barrier_post(unsigned* bar, volatile LAS unsigned* st) {
    XcdBarrier b; b.bar = bar; b.x = xb_xcc_id(); b.st = st;
    if (threadIdx.x == 0) (void)xb_add(&bar[XB_XCNT(b.x)], 1u);
    return b;
}
__device__ __forceinline__ void xcd_barrier_complete(unsigned* bar, unsigned x, unsigned& nloc, unsigned& nx) {
    const unsigned G = gridDim.x * gridDim.y * gridDim.z;
    unsigned sum, cnt, mine, sp = 0u;
    for (;;) {
        sum = 0u; cnt = 0u; mine = 0u;
#pragma unroll
        for (unsigned j = 0; j < 16; ++j) { const unsigned c = xb_ld(&bar[XB_XCNT(j)]); sum += c; cnt += (c > 0u) ? 1u : 0u; mine = (j == x) ? c : mine; }
        if (sum == G) break;
        __builtin_amdgcn_s_sleep(1);
        if ((++sp & 255u) == 0u) { if (xb_ld(&bar[XB_TMO])) break; if (sp > XB_SPIN_CAP) { atomicAdd(&bar[XB_TMO], 1u); break; } }
    }
    nloc = mine > 0u ? mine : 1u; nx = cnt > 0u ? cnt : 1u;
}

__device__ __forceinline__ void xcd_barrier(const XcdBarrier& b) {
    asm volatile("s_waitcnt vmcnt(0)" ::: "memory");
    __syncthreads();
    if (threadIdx.x == 0) {
        unsigned* bar = b.bar;
        __builtin_amdgcn_s_waitcnt(0);
        unsigned nloc = b.st[0], nx = b.st[1];
        if (nloc == 0u) { xcd_barrier_complete(bar, b.x, nloc, nx); b.st[0] = nloc; b.st[1] = nx; }
        const unsigned old = xb_add(&bar[XB_XSUB(b.x)], 1u);
        const unsigned gen = old / nloc;
        if (old + 1u == (gen + 1u) * nloc) {
            __builtin_amdgcn_fence(__ATOMIC_RELEASE, "agent");
            asm volatile("s_waitcnt vmcnt(0)" ::: "memory");
            const unsigned og = xb_add(&bar[XB_TOP], 1u);
            const unsigned tg = og / nx;
            if (og + 1u == (tg + 1u) * nx) xb_add(&bar[XB_TOPGEN], 1u);
            else XB_SPIN(xb_ld(&bar[XB_TOPGEN]) == tg, bar);
            __builtin_amdgcn_fence(__ATOMIC_ACQUIRE, "agent");
            xb_add(&bar[XB_XGEN(b.x)], 1u);
            asm volatile("s_waitcnt vmcnt(0)" ::: "memory");
        } else {
            XB_SPIN(xb_ld(&bar[XB_XGEN(b.x)]) == gen, bar);
            __builtin_amdgcn_fence(__ATOMIC_ACQUIRE, "agent");
            asm volatile("s_waitcnt vmcnt(0)" ::: "memory");
        }
    }
    __syncthreads();
}

}
namespace mk {
namespace cg = cooperative_groups;
constexpr int NPHASE = 11;
__global__ void __launch_bounds__(NT, 2) mk_fwd(Params p) {
    extern __shared__ __attribute__((aligned(16))) unsigned char lds_raw[];
    LAS unsigned char* lds = (LAS unsigned char*)lds_raw;
    cg::grid_group grid = cg::this_grid();
    const int tid = threadIdx.x, lane = tid & 63, wave = __builtin_amdgcn_readfirstlane(tid >> 6);
    unsigned char* ws = p.ws;
    float* mod = (float*)(ws + WS_MOD);
    volatile LAS unsigned* xst = (volatile LAS unsigned*)(lds + LDS_BYTES - 64);
    if (tid == 0) { xst[0] = 0u; xst[1] = 0u; }
    __syncthreads();
    const XcdBarrier xbar = xcd_barrier_post((unsigned*)(ws + WS_CTL), xst);
#define IN(k) (p.ph_lo <= (k) && (k) < p.ph_hi)
#define SEAM(k) do { if (IN(k) && IN((k) + 1)) { if ((k) == 0) grid.sync(); else xcd_barrier(xbar); } } while (0)
    if (IN(0)) { phase_p0a(p, lds, wave, lane); __syncthreads(); }
    SEAM(0);
    if (IN(1)) row_phase<0>(p.x, p.norm1_g, mod, 0, D, nullptr, ws + WS_H, wave, lane);
    SEAM(1);
    if (IN(2)) {
        pg8::Gemm g{(const pg8::bf16_t*)(ws + WS_H), (const pg8::bf16_t*)(ws + WS_WIN), T, 3840, D}; pg8::StaticOrder S; S.init(T, 3840, gridDim.x, blockIdx.x);
        EpiProj E{(u16*)(ws + WS_PROJ), (u16*)(ws + WS_KIDX), (float*)(ws + WS_WIDX), (float*)(ws + WS_GLR), (u16*)(ws + WS_KF)};
        pg8::gemm_phase<EpiProj, pg8::StaticOrder>(lds, g, S, E);
    }
    SEAM(2);
    if (IN(3)) phase_p3(p, lds, wave, lane);
    SEAM(3);
    if (IN(4)) phase_p4(p, lds, wave, lane);
    SEAM(4);
    if (IN(5)) phase_p5(p, lds, wave, lane);
    SEAM(5);
    if (IN(6)) {
        pg8::Gemm g{(const pg8::bf16_t*)(ws + WS_CAT), (const pg8::bf16_t*)(ws + WS_WOUT), T, D, D}; pg8::StaticOrder S; S.init(T, D, gridDim.x, blockIdx.x);
        EpiRes<false> E{p.x, (u16*)(ws + WS_X16), mod, (float*)(ws + WS_SS1), 2 * D, 0};
        pg8::gemm_phase<EpiRes<false>, pg8::StaticOrder>(lds, g, S, E);
    }
    SEAM(6);
    if (IN(7)) row_phase<1>(ws + WS_X16, p.norm2_g, mod, 3 * D, 4 * D, (const float*)(ws + WS_SS1), ws + WS_H, wave, lane);
    SEAM(7);
    if (IN(8)) {
        pg8::Gemm g{(const pg8::bf16_t*)(ws + WS_H), (const pg8::bf16_t*)(ws + WS_WGU), T, 2 * DFF, D}; pg8::StaticOrder S; S.init(T, 2 * DFF, gridDim.x, blockIdx.x);
        EpiSwiGLU E{(u16*)(ws + WS_ACT)};
        pg8::gemm_phase<EpiSwiGLU, pg8::StaticOrder>(lds, g, S, E);
    }
    SEAM(8);
    if (IN(9)) {
        pg8::Gemm g{(const pg8::bf16_t*)(ws + WS_ACT), (const pg8::bf16_t*)(ws + WS_WDN), T, D, DFF}; pg8::StaticOrder S; S.init(T, D, gridDim.x, blockIdx.x);
        EpiRes<true> E{ws + WS_X16, (u16*)(ws + WS_X16), mod, (float*)(ws + WS_SS2), 5 * D, 0};
        pg8::gemm_phase<EpiRes<true>, pg8::StaticOrder>(lds, g, S, E);
    }
    SEAM(9);
    if (IN(10)) row_phase<2>(ws + WS_X16, p.final_g, nullptr, 0, 0, (const float*)(ws + WS_SS2), p.out, wave, lane);
#undef IN
#undef SEAM
}

static int g_grid = 0;
static Params make_params(void* const* d_in, void* d_out, void* d_ws) {
    Params p{};
    p.x = (const float*)d_in[0]; p.c = (const float*)d_in[1]; p.w_mod = (const float*)d_in[2]; p.b_mod = (const float*)d_in[3]; p.norm1_g = (const float*)d_in[4];
    p.w_in = (const float*)d_in[5]; p.w_gate2 = (const float*)d_in[6]; p.b_gate2 = (const float*)d_in[7]; p.att_g = (const float*)d_in[8]; p.gla_g = (const float*)d_in[9];
    p.w_out = (const float*)d_in[10]; p.norm2_g = (const float*)d_in[11]; p.w_gu = (const float*)d_in[12]; p.w_down = (const float*)d_in[13]; p.final_g = (const float*)d_in[14];
    p.out = (float*)d_out; p.ws = (unsigned char*)d_ws; p.ph_lo = 0; p.ph_hi = NPHASE;
    return p;
}
static bool init_grid(size_t ws_size) {
    if (g_grid) return g_grid > 0;
    int dev = 0, cus = 0, per_cu = 0;
    if (hipGetDevice(&dev) != hipSuccess || hipDeviceGetAttribute(&cus, hipDeviceAttributeMultiprocessorCount, dev) != hipSuccess) { g_grid = -1; return false; }
    if (hipFuncSetAttribute((const void*)mk_fwd, hipFuncAttributeMaxDynamicSharedMemorySize, LDS_BYTES) != hipSuccess) { fprintf(stderr, "hipFuncSetAttribute failed\n"); g_grid = -1; return false; }
    if (hipOccupancyMaxActiveBlocksPerMultiprocessor(&per_cu, (const void*)mk_fwd, NT, LDS_BYTES) != hipSuccess || per_cu < 1) { fprintf(stderr, "occupancy query: %d blocks/CU\n", per_cu); g_grid = -1; return false; }
    if (ws_size < WS_END) { fprintf(stderr, "workspace too small: %zu < %zu\n", ws_size, (size_t)WS_END); g_grid = -1; return false; }
    g_grid = cus;
    fprintf(stderr, "mk: grid %d, per_cu %d, ws %zu\n", g_grid, per_cu, ws_size);
    return true;
}
static void launch(Params p, int lo, int hi, hipStream_t stream) {
    p.ph_lo = lo; p.ph_hi = hi;
    if (hipMemsetAsync(p.ws + WS_CTL, 0, 16384, stream) != hipSuccess) { fprintf(stderr, "hipMemsetAsync of the barrier words failed\n"); return; }
    void* args[] = {&p};
    const hipError_t e = hipLaunchCooperativeKernel((const void*)mk_fwd, dim3(g_grid), dim3(NT), args, LDS_BYTES, stream);
    if (e != hipSuccess) fprintf(stderr, "cooperative launch failed: %s (grid %d)\n", hipGetErrorString(e), g_grid);
}
}

extern "C" void kernel_launch(void* const* d_in, const int* in_sizes, int n_in, void* d_out, int out_size, void* d_ws, size_t ws_size, hipStream_t stream) {
    using namespace mk;
    if (n_in != 15 || out_size != T * D) { fprintf(stderr, "kernel_launch: unexpected problem shape\n"); return; }
    if (!init_grid(ws_size)) return;
    Params p = make_params(d_in, d_out, d_ws);
    launch(p, 0, NPHASE, stream);
}
```

```cpp
#include <hip/hip_runtime.h>
#include <hip/hip_cooperative_groups.h>
#include <cstdio>
#include <cstdint>
#include <cmath>
namespace pg8 {
#define PG8_LAS __attribute__((address_space(3)))
typedef unsigned short bf16_t;
typedef _Float16 bf16x8 __attribute__((ext_vector_type(8)));
typedef float f32x4 __attribute__((ext_vector_type(4)));
typedef unsigned u32x4 __attribute__((ext_vector_type(4)));
constexpr int BM = 256, BK = 64, HALF = 128, HTB = HALF * BK * 2  , STAGE_BYTES = 8 * HTB, NXCD = 8, WGM = 8;

__host__ __device__ __forceinline__ int lds_byte(int r, int c) { const int st = (r >> 4) * 2 + (c >> 5), rr = r & 15, cc = c & 31, ob = rr * 64 + cc * 2; return st * 1024 + (ob ^ (((ob >> 9) & 1) << 5)); }
__host__ __device__ __forceinline__ void stage_rc(int b, int& R, int& C) { const int st = b / 1024, sb = b % 1024, swz = sb ^ (((sb >> 9) & 1) << 5); R = (st >> 1) * 16 + swz / 64; C = (st & 1) * 32 + (swz % 64) / 2; }
__host__ __device__ __forceinline__ int perm32(int rho) { const int n = rho >> 4, i = rho & 15; return 8 * (i >> 2) + 4 * n + (i & 3); }

struct Unit { int pm, pn; };
struct Gemm { const bf16_t* A; const bf16_t* Bt; int M, N, K; };

struct StaticOrder {
    int nM, nN, nwg, G, c, wgm;
    __host__ __device__ void init(int M, int N, int G_, int c_, int wgm_ = WGM) { nM = M / BM; nN = N / BM; nwg = nM * nN; G = G_; c = c_; wgm = wgm_; }
    __host__ __device__ bool next(int i, Unit& u) const {
        const long L = (long)i * G + c; if (L >= nwg) return false;
        int wgid = (int)L; { const int q = nwg / NXCD, r = nwg % NXCD, xcd = wgid % NXCD, off = wgid / NXCD; wgid = (xcd < r ? xcd * (q + 1) : r * (q + 1) + (xcd - r) * q) + off; }
        const int nig = wgm * nN, gid = wgid / nig, fm = gid * wgm, gsz = (nM - fm) < wgm ? (nM - fm) : wgm;
        u.pm = fm + ((wgid % nig) % gsz); u.pn = (wgid % nig) / gsz; return true;
    }
    __device__ __forceinline__ void a_ready(const Unit&) const {}
    __device__ __forceinline__ void done(const Unit&) const {}
};
template <class Epi, class Sched>
__device__ __forceinline__ void gemm_phase(PG8_LAS unsigned char* lds, const Gemm g, const Sched& S, const Epi& E) {
    const int tid = threadIdx.x, wid = __builtin_amdgcn_readfirstlane(tid >> 6), lane = tid & 63, wr = wid >> 2, wc = wid & 3, fr = lane & 15, fq = lane >> 4;
    const int K = g.K, nt = K / BK;
    unsigned voffA[2], voffB[2];
#pragma unroll
    for (int i = 0; i < 2; ++i) { int R, C; stage_rc(tid * 16 + i * 8192, R, C); const int Rb = Epi::PERM ? ((R & ~31) + perm32(R & 31)) : R;
        voffA[i] = (unsigned)(R * K + C) * 2u; voffB[i] = (unsigned)(Rb * K + C) * 2u; }
    const size_t kstep = (size_t)(BK * 2);
    const size_t hstep = (size_t)HALF * K * 2;
    const size_t tstep = 2 * hstep;
    const unsigned ldsw = (unsigned)wid * 1024u;
    const int aoff = lds_byte(wr * 64 + fr, fq * 8), boff = lds_byte(wc * 32 + fr, fq * 8);
#define PG8_SA(b, h) (((b) * 2 + (h)) * HTB)
#define PG8_SB(b, h) ((4 + (b) * 2 + (h)) * HTB)
#define PG8_STAGE(bufoff, gbase, voff) do { _Pragma("unroll") for (int _i = 0; _i < 2; ++_i) \
        __builtin_amdgcn_global_load_lds((const unsigned*)((const char*)(gbase) + (voff)[_i]), (PG8_LAS unsigned*)(lds + (bufoff) + ldsw + _i * 8192), 16, 0, 0); } while (0)
#define PG8_LDA(dst, b, h) do { _Pragma("unroll") for (int m = 0; m < 4; ++m) _Pragma("unroll") for (int k = 0; k < 2; ++k) dst[m][k] = *(const PG8_LAS bf16x8*)(lds + PG8_SA(b, h) + aoff + m * 2048 + k * 1024); } while (0)
#define PG8_LDB(dst, b, h) do { _Pragma("unroll") for (int n = 0; n < 2; ++n) _Pragma("unroll") for (int k = 0; k < 2; ++k) dst[n][k] = *(const PG8_LAS bf16x8*)(lds + PG8_SB(b, h) + boff + n * 2048 + k * 1024); } while (0)
#define PG8_MMA(ai, bj, At, Bt) do { __builtin_amdgcn_s_setprio(1); _Pragma("unroll") for (int m = 0; m < 4; ++m) _Pragma("unroll") for (int n = 0; n < 2; ++n) _Pragma("unroll") for (int k = 0; k < 2; ++k) \
        acc[ai][bj][m][n] = __builtin_amdgcn_mfma_f32_16x16x32_f16(Bt[n][k], At[m][k], acc[ai][bj][m][n], 0, 0, 0); __builtin_amdgcn_s_setprio(0); } while (0)
#define PG8_WAIT_V(n) asm volatile("s_waitcnt vmcnt(" #n ")" ::: "memory")
#define PG8_WAIT_L(n) asm volatile("s_waitcnt lgkmcnt(" #n ")" ::: "memory")
#define PG8_BAR __builtin_amdgcn_s_barrier()
#define PG8_SCHED __builtin_amdgcn_sched_barrier(0)
    Unit cur, nxt; int ui = 0;
    if (!S.next(0, cur)) return;
    f32x4 acc[2][2][4][2];
#pragma unroll
    for (int a = 0; a < 2; ++a)
#pragma unroll
        for (int b = 0; b < 2; ++b)
#pragma unroll
            for (int m = 0; m < 4; ++m)
#pragma unroll
                for (int n = 0; n < 2; ++n) acc[a][b][m][n] = (f32x4){0.f, 0.f, 0.f, 0.f};
    bf16x8 At[4][2], B0[2][2], B1[2][2];
    const char* cA = (const char*)g.A + (size_t)cur.pm * tstep; const char* cB = (const char*)g.Bt + (size_t)cur.pn * tstep;
    S.a_ready(cur);
    PG8_STAGE(PG8_SB(0, 0), cB, voffB); PG8_STAGE(PG8_SA(0, 0), cA, voffA); PG8_STAGE(PG8_SB(0, 1), cB + hstep, voffB); PG8_STAGE(PG8_SA(0, 1), cA + hstep, voffA);
    if (wr == 1) PG8_BAR;
    PG8_WAIT_V(4); PG8_BAR;
    PG8_STAGE(PG8_SB(1, 0), cB + kstep, voffB); PG8_STAGE(PG8_SA(1, 0), cA + kstep, voffA); PG8_STAGE(PG8_SB(1, 1), cB + hstep + kstep, voffB);
    PG8_WAIT_V(6); PG8_BAR;
    for (;;) {
        const bool has_next = S.next(ui + 1, nxt);
        const char* nA = has_next ? (const char*)g.A + (size_t)nxt.pm * tstep : cA; const char* nB = has_next ? (const char*)g.Bt + (size_t)nxt.pn * tstep : cB;
        for (int t = 0; t < nt; t += 2) {
            const bool last = (t == nt - 2);
            const char* a1 = cA + (size_t)(t + 1) * kstep;
            const char* a2 = last ? nA : cA + (size_t)(t + 2) * kstep; const char* b2 = last ? nB : cB + (size_t)(t + 2) * kstep;
            const char* a3 = a2 + kstep; const char* b3 = b2 + kstep;
            if (last && has_next) S.a_ready(nxt);
            PG8_LDB(B0, 0, 0); PG8_SCHED; PG8_LDA(At, 0, 0); PG8_STAGE(PG8_SA(1, 1), a1 + hstep, voffA);
            PG8_WAIT_L(8); PG8_BAR; PG8_WAIT_L(0); PG8_MMA(0, 0, At, B0); PG8_BAR; PG8_SCHED;
            PG8_LDB(B1, 0, 1); PG8_STAGE(PG8_SB(0, 0), b2, voffB);
            PG8_BAR; PG8_WAIT_L(0); PG8_MMA(0, 1, At, B1); PG8_BAR;
            PG8_LDA(At, 0, 1); PG8_STAGE(PG8_SA(0, 0), a2, voffA);
            PG8_BAR; PG8_WAIT_L(0); PG8_MMA(1, 0, At, B0); PG8_BAR; PG8_SCHED;
            PG8_STAGE(PG8_SB(0, 1), b2 + hstep, voffB);
            PG8_WAIT_V(6); PG8_BAR; PG8_MMA(1, 1, At, B1); PG8_BAR;
            PG8_LDB(B0, 1, 0); PG8_SCHED; PG8_LDA(At, 1, 0); PG8_STAGE(PG8_SA(0, 1), a2 + hstep, voffA);
            PG8_WAIT_L(8); PG8_BAR; PG8_WAIT_L(0); PG8_MMA(0, 0, At, B0); PG8_BAR; PG8_SCHED;
            PG8_LDB(B1, 1, 1); PG8_STAGE(PG8_SB(1, 0), b3, voffB);
            PG8_BAR; PG8_WAIT_L(0); PG8_MMA(0, 1, At, B1); PG8_BAR;
            PG8_LDA(At, 1, 1); PG8_STAGE(PG8_SA(1, 0), a3, voffA);
            PG8_BAR; PG8_WAIT_L(0); PG8_MMA(1, 0, At, B0); PG8_BAR; PG8_SCHED;
            PG8_STAGE(PG8_SB(1, 1), b3 + hstep, voffB);
            PG8_WAIT_V(6); PG8_BAR; PG8_MMA(1, 1, At, B1); PG8_BAR;
        }
        if constexpr (!Epi::AFTER_DRAIN) { E(acc, cur, wr, wc, fr, fq); S.done(cur); }
        if (!has_next) break;
#pragma unroll
        for (int a = 0; a < 2; ++a)
#pragma unroll
            for (int b = 0; b < 2; ++b)
#pragma unroll
                for (int m = 0; m < 4; ++m)
#pragma unroll
                    for (int n = 0; n < 2; ++n) acc[a][b][m][n] = (f32x4){0.f, 0.f, 0.f, 0.f};
        cur = nxt; cA = nA; cB = nB; ++ui;
    }
    PG8_WAIT_V(0);
    if (wr == 0) PG8_BAR;
    PG8_BAR;
    if constexpr (Epi::AFTER_DRAIN) { E.fused(acc, cur, wr, wc, fr, fq, lds, wid, lane); S.done(cur); }
#undef PG8_SA
#undef PG8_SB
#undef PG8_STAGE
#undef PG8_LDA
#undef PG8_LDB
#undef PG8_MMA
#undef PG8_WAIT_V
#undef PG8_WAIT_L
#undef PG8_BAR
#undef PG8_SCHED
}
}
namespace mk {
#define LAS __attribute__((address_space(3)))
using pg8::f32x4; using pg8::u32x4; using pg8::Unit;
typedef float f32x2 __attribute__((ext_vector_type(2)));
typedef float f32x16 __attribute__((ext_vector_type(16)));
typedef _Float16 h2v __attribute__((ext_vector_type(2)));
typedef _Float16 f16x8 __attribute__((ext_vector_type(8)));
typedef _Float16 f16x4 __attribute__((ext_vector_type(4)));
typedef short bf16x8 __attribute__((ext_vector_type(8)));
typedef unsigned u32x2 __attribute__((ext_vector_type(2)));
typedef unsigned short u16;

constexpr int NWAVES = 8, NT = 512;
constexpr int D = 1024, NB = 8, L = 8192, T = NB * L, DIN = 3672, DFF = 2816;
constexpr int PJ = 3584;
constexpr int CQ = 0, CK = 512, CV = 1024, CQI = 1536, CGQ = 2048, CGK = 2304, CGV = 2560, CGO = 3072;
constexpr float EPS = 1e-6f;
constexpr float IDX_SCALE = 0.35355339059327373f * 0.125f;
constexpr size_t MiB = 1u << 20;
constexpr size_t WS_CTL = 0, WS_MOD = 1 * MiB, WS_WIN = 2 * MiB, WS_WOUT = 10 * MiB, WS_WGU = 12 * MiB, WS_WDN = 23 * MiB;
constexpr size_t WS_SS1 = 29 * MiB, WS_SS2 = 33 * MiB, WS_KIDX = 37 * MiB, WS_WIDX = 45 * MiB, WS_GLR = 47 * MiB, WS_THR = 51 * MiB;
constexpr size_t WS_H = 64 * MiB, WS_CAT = 192 * MiB, WS_PROJ = 320 * MiB, WS_ACT = 320 * MiB, WS_GLAS = 768 * MiB, WS_VT = 896 * MiB, WS_KF = 960 * MiB, WS_END = 1024 * MiB;
constexpr int LDS_BYTES = 163840;

struct Params {
    const float *x, *c, *w_mod, *b_mod, *norm1_g, *w_in, *w_gate2, *b_gate2, *att_g, *gla_g, *w_out, *norm2_g, *w_gu, *w_down, *final_g;
    float* out; unsigned char* ws; int ph_lo, ph_hi;
};

__device__ __forceinline__ unsigned pkh(float a, float b) { const h2v h = __builtin_convertvector((f32x2){a, b}, h2v); return __builtin_bit_cast(unsigned, h); }
__device__ __forceinline__ float silu_f(float v) { return v * __builtin_amdgcn_rcpf(1.f + __expf(-v)); }
__device__ __forceinline__ float wave_sum(float v) {
#pragma unroll
    for (int o = 1; o < 64; o <<= 1) v += __shfl_xor(v, o);
    return v;
}
__device__ __forceinline__ float rows_sum(float s) {
    { const unsigned u = __builtin_bit_cast(unsigned, s); const auto r = __builtin_amdgcn_permlane16_swap(u, u, false, false); const unsigned a = r[0], b = r[1]; s = __builtin_bit_cast(float, a) + __builtin_bit_cast(float, b); }
    { const unsigned u = __builtin_bit_cast(unsigned, s); const auto r = __builtin_amdgcn_permlane32_swap(u, u, false, false); const unsigned a = r[0], b = r[1]; s = __builtin_bit_cast(float, a) + __builtin_bit_cast(float, b); }
    return s;
}
#define LDS_WAIT() asm volatile("s_waitcnt lgkmcnt(0)" ::: "memory")

struct MapIn { __device__ __forceinline__ int operator()(int n) const {
    if (n < 2048) return n; if (n < 3584) return n + 72; if (n < 3648) return 2048 + (n - 3584); if (n < 3656) return 2112 + (n - 3648); if (n < 3672) return n; return -1; } };
struct MapGU { __device__ __forceinline__ int operator()(int n) const { const int pn = n >> 8, r = n & 255; return r < 128 ? 128 * pn + r : DFF + 128 * pn + (r - 128); } };
struct MapId { __device__ __forceinline__ int operator()(int n) const { return n; } };

template <class Map>
__device__ __forceinline__ void transpose_item(const float* __restrict__ W, int K, int Nsrc, u16* __restrict__ WT, int nblk, LAS float* scr, int item, int lane, Map map) {
    const int kb = item / nblk, nb = item % nblk, k0 = 64 * kb, n0 = 32 * nb;
    const int sc = map(n0 + (lane & 31));
#pragma unroll 8
    for (int i = 0; i < 32; ++i) { const int kk = 2 * i + (lane >> 5); scr[kk * 33 + (lane & 31)] = sc >= 0 ? W[(size_t)(k0 + kk) * Nsrc + sc] : 0.f; }
    LDS_WAIT(); asm volatile("" ::: "memory");
    const int c = lane & 7;
#pragma unroll
    for (int j = 0; j < 4; ++j) { const int n = (lane >> 3) + 8 * j; const LAS float* s = scr + (8 * c) * 33 + n;
        u32x4 o; o.x = pkh(s[0 * 33], s[1 * 33]); o.y = pkh(s[2 * 33], s[3 * 33]); o.z = pkh(s[4 * 33], s[5 * 33]); o.w = pkh(s[6 * 33], s[7 * 33]);
        *(u32x4*)(WT + (size_t)(n0 + n) * K + k0 + 8 * c) = o; }
    LDS_WAIT(); asm volatile("" ::: "memory");
}

__device__ __forceinline__ void phase_p0a(const Params& p, LAS unsigned char* lds, int wave, int lane) {
    LAS float* sct = (LAS float*)(lds + 98304);
    for (int i = threadIdx.x; i < NB * D; i += NT) { const float cv = p.c[i]; sct[i] = cv / (1.f + expf(-cv)); }
    __syncthreads();
    const int gw = blockIdx.x * NWAVES + wave, NGW = gridDim.x * NWAVES;
    float* mod = (float*)(p.ws + WS_MOD);
    for (int it = gw; it < 6 * D / 16; it += NGW) {
        const int j = it * 16 + (lane & 15), kq = lane >> 4;
        float acc[NB];
#pragma unroll
        for (int b = 0; b < NB; ++b) acc[b] = 0.f;
#pragma unroll 4
        for (int k4 = 0; k4 < D / 4; ++k4) { const int k = 4 * k4 + kq; const float w = p.w_mod[(size_t)k * (6 * D) + j];
#pragma unroll
            for (int b = 0; b < NB; ++b) acc[b] += sct[b * D + k] * w; }
#pragma unroll
        for (int b = 0; b < NB; ++b) acc[b] = rows_sum(acc[b]);
        if (lane < 16) { const float bm = p.b_mod[j];
#pragma unroll
            for (int b = 0; b < NB; ++b) mod[b * 6 * D + j] = acc[b] + bm; }
    }
    LAS float* scr = (LAS float*)(lds + wave * 8704);
    constexpr int I_IN = (D / 64) * (3840 / 32), I_OUT = (D / 64) * (D / 32), I_GU = (D / 64) * (2 * DFF / 32), I_DN = (DFF / 64) * (D / 32);
    constexpr int NITEMS = I_IN + I_OUT + I_GU + I_DN;
    for (int it = gw; it < NITEMS; it += NGW) {
        int r = it;
        if (r < I_IN) { transpose_item(p.w_in, D, DIN, (u16*)(p.ws + WS_WIN), 3840 / 32, scr, r, lane, MapIn()); continue; } r -= I_IN;
        if (r < I_OUT) { transpose_item(p.w_out, D, D, (u16*)(p.ws + WS_WOUT), D / 32, scr, r, lane, MapId()); continue; } r -= I_OUT;
        if (r < I_GU) { transpose_item(p.w_gu, D, 2 * DFF, (u16*)(p.ws + WS_WGU), 2 * DFF / 32, scr, r, lane, MapGU()); continue; } r -= I_GU;
        transpose_item(p.w_down, DFF, D, (u16*)(p.ws + WS_WDN), D / 32, scr, r, lane, MapId());
    }
}

template <int MODE>
__device__ __forceinline__ void row_phase(const void* xin, const float* __restrict__ g, const float* __restrict__ mod, int sh_off, int sc_off, const float* __restrict__ ss, void* outp, int wave, int lane) {
    const int gw = blockIdx.x * NWAVES + wave, NGW = gridDim.x * NWAVES;
    f32x4 gv[4];
#pragma unroll
    for (int j = 0; j < 4; ++j) gv[j] = ((const f32x4*)g)[lane + 64 * j];
    auto load = [&](f32x4 (&v)[4], int m) __attribute__((always_inline)) {
        if (MODE == 0) { const f32x4* xr = (const f32x4*)((const float*)xin + (size_t)m * D) + lane;
#pragma unroll
            for (int j = 0; j < 4; ++j) v[j] = __builtin_nontemporal_load(xr + 64 * j); }
        else { const u32x2* xr = (const u32x2*)((const u16*)xin + (size_t)m * D) + lane;
#pragma unroll
            for (int j = 0; j < 4; ++j) { const u32x2 w = xr[64 * j]; const unsigned wx = w.x, wy = w.y; const h2v a = __builtin_bit_cast(h2v, wx), b = __builtin_bit_cast(h2v, wy); v[j] = (f32x4){(float)a[0], (float)a[1], (float)b[0], (float)b[1]}; } }
    };
    auto finish = [&](f32x4 (&v)[4], int m) __attribute__((always_inline)) {
        float tot;
        if (MODE == 0) { float s = 0.f;
#pragma unroll
            for (int j = 0; j < 4; ++j) s += (v[j].x * v[j].x + v[j].y * v[j].y) + (v[j].z * v[j].z + v[j].w * v[j].w);
            tot = wave_sum(s); }
        else { const f32x4* sp = (const f32x4*)(ss + (size_t)m * 16); const f32x4 a = sp[0], b = sp[1], c = sp[2], d = sp[3];
            tot = ((a.x + a.y) + (a.z + a.w)) + ((b.x + b.y) + (b.z + b.w)) + ((c.x + c.y) + (c.z + c.w)) + ((d.x + d.y) + (d.z + d.w)); }
        const float rstd = rsqrtf(tot * (1.f / D) + EPS);
        if (MODE == 2) { f32x4* o = (f32x4*)((float*)outp + (size_t)m * D) + lane;
#pragma unroll
            for (int j = 0; j < 4; ++j) __builtin_nontemporal_store(v[j] * rstd * gv[j], o + 64 * j); }
        else { const float* mb = mod + (m >> 13) * (6 * D);
            u32x2* o = (u32x2*)((u16*)outp + (size_t)m * D) + lane;
#pragma unroll
            for (int j = 0; j < 4; ++j) { const f32x4 sc = ((const f32x4*)(mb + sc_off))[lane + 64 * j], sh = ((const f32x4*)(mb + sh_off))[lane + 64 * j];
                const f32x4 r = v[j] * rstd * gv[j] * (sc + 1.f) + sh; u32x2 w; w.x = pkh(r.x, r.y); w.y = pkh(r.z, r.w); o[64 * j] = w; } }
    };
    for (int m = gw; m < T; m += 2 * NGW) {
        f32x4 va[4], vb[4];
        load(va, m); const bool two = m + NGW < T; if (two) load(vb, m + NGW);
        finish(va, m); if (two) finish(vb, m + NGW);
    }
}

struct EpiProj {
    static constexpr bool PERM = true, AFTER_DRAIN = false;
    u16* P; u16* kidx; float* widx; float* glr; u16* kf;
    __device__ __forceinline__ void operator()(const f32x4 (&acc)[2][2][4][2], const Unit& u, int wr, int wc, int fr, int fq) const {
        const int row0 = u.pm * 256 + wr * 64 + fr;
        if (u.pn < 14) {
            const int col0 = u.pn * 256 + wc * 32 + 8 * fq;
#pragma unroll
            for (int ai = 0; ai < 2; ++ai)
#pragma unroll
                for (int m = 0; m < 4; ++m) { u16* rowp = P + (size_t)(row0 + ai * 128 + m * 16) * PJ + col0;
#pragma unroll
                    for (int bj = 0; bj < 2; ++bj) { const f32x4 v0 = acc[ai][bj][m][0], v1 = acc[ai][bj][m][1];
                        u32x4 w; w.x = pkh(v0[0], v0[1]); w.y = pkh(v0[2], v0[3]); w.z = pkh(v1[0], v1[1]); w.w = pkh(v1[2], v1[3]);
                        if (u.pn == 2 || u.pn == 3) {
                            const int row = row0 + ai * 128 + m * 16, hd = 2 * (u.pn - 2) + bj, bb = row >> 13, kt = (row & 8191) >> 5;
                            __builtin_nontemporal_store(w, (u32x4*)(kf + ((((size_t)(bb * 4 + hd) * 256 + kt) * 8 + 2 * wc + (fq >> 1)) * 64 + (fq & 1) * 32 + (row & 31)) * 8)); }
                        else __builtin_nontemporal_store(w, (u32x4*)(rowp + bj * 128)); } }
        } else {
#pragma unroll
            for (int ai = 0; ai < 2; ++ai)
#pragma unroll
                for (int m = 0; m < 4; ++m) { const size_t row = (size_t)(row0 + ai * 128 + m * 16); const f32x4 v0 = acc[ai][0][m][0], v1 = acc[ai][0][m][1];
                    if (wc < 2) { u32x4 w; w.x = pkh(v0[0], v0[1]); w.y = pkh(v0[2], v0[3]); w.z = pkh(v1[0], v1[1]); w.w = pkh(v1[2], v1[3]);
                        *(u32x4*)(kidx + (((row >> 5) * 4 + 2 * wc + (fq >> 1)) * 64 + (fq & 1) * 32 + (row & 31)) * 8) = w; }
                    else if (wc == 2) {
                        if (fq == 0) { *(f32x4*)(widx + row * 8) = v0 * IDX_SCALE; *(f32x4*)(widx + row * 8 + 4) = v1 * IDX_SCALE; }
                        else if (fq < 3) { *(f32x4*)(glr + row * 16 + (fq - 1) * 8) = v0; *(f32x4*)(glr + row * 16 + (fq - 1) * 8 + 4) = v1; } } }
        }
    }
};
template <bool BASE_HALF>
struct EpiRes {
    static constexpr bool PERM = false, AFTER_DRAIN = false;
    const void* base; u16* out; const float* mod; float* ss; int gate_off; int pad;
    __device__ __forceinline__ void operator()(const f32x4 (&acc)[2][2][4][2], const Unit& u, int wr, int wc, int fr, int fq) const {
        const int row0 = u.pm * 256 + wr * 64 + fr, col0 = u.pn * 256 + wc * 32 + 4 * fq;
        const float* g = mod + (u.pm >> 5) * (6 * D) + gate_off;
        f32x4 gv[2][2];
#pragma unroll
        for (int bj = 0; bj < 2; ++bj)
#pragma unroll
            for (int n = 0; n < 2; ++n) gv[bj][n] = *(const f32x4*)(g + col0 + bj * 128 + n * 16);
#pragma unroll
        for (int ai = 0; ai < 2; ++ai)
#pragma unroll
            for (int m = 0; m < 4; ++m) { const size_t row = (size_t)(row0 + ai * 128 + m * 16); float s = 0.f;
#pragma unroll
                for (int bj = 0; bj < 2; ++bj)
#pragma unroll
                    for (int n = 0; n < 2; ++n) { const size_t off = row * D + col0 + bj * 128 + n * 16; f32x4 bs;
                        if (BASE_HALF) { const u32x2 wi = *(const u32x2*)((const u16*)base + off); const unsigned wx = wi.x, wy = wi.y;        const h2v a = __builtin_bit_cast(h2v, wx), b = __builtin_bit_cast(h2v, wy); bs = (f32x4){(float)a[0], (float)a[1], (float)b[0], (float)b[1]}; }
                        else bs = __builtin_nontemporal_load((const f32x4*)((const float*)base + off));
                        const f32x4 o = bs + gv[bj][n] * acc[ai][bj][m][n]; u32x2 w; w.x = pkh(o[0], o[1]); w.y = pkh(o[2], o[3]); *(u32x2*)(out + off) = w;
                        s += (o[0] * o[0] + o[1] * o[1]) + (o[2] * o[2] + o[3] * o[3]); }
                s = rows_sum(s);
                if (fq == 0) ss[row * 16 + u.pn * 4 + wc] = s; }
    }
};
struct EpiSwiGLU {
    static constexpr bool PERM = true, AFTER_DRAIN = false;
    u16* act;
    __device__ __forceinline__ void operator()(const f32x4 (&acc)[2][2][4][2], const Unit& u, int wr, int wc, int fr, int fq) const {
        const int row0 = u.pm * 256 + wr * 64 + fr, col0 = u.pn * 128 + wc * 32 + 8 * fq;
#pragma unroll
        for (int ai = 0; ai < 2; ++ai)
#pragma unroll
            for (int m = 0; m < 4; ++m) { const f32x4 g0 = acc[ai][0][m][0], g1 = acc[ai][0][m][1], u0 = acc[ai][1][m][0], u1 = acc[ai][1][m][1];
                float a[8];
#pragma unroll
                for (int j = 0; j < 4; ++j) { a[j] = silu_f(g0[j]) * u0[j]; a[4 + j] = silu_f(g1[j]) * u1[j]; }
                u32x4 w; w.x = pkh(a[0], a[1]); w.y = pkh(a[2], a[3]); w.z = pkh(a[4], a[5]); w.w = pkh(a[6], a[7]);
                __builtin_nontemporal_store(w, (u32x4*)(act + (size_t)(row0 + ai * 128 + m * 16) * DFF + col0)); }
    }
};
}
#define MK_HAVE_MIX 1
namespace mk {
constexpr size_t WS_GDEC = 52 * MiB;
constexpr size_t WS_SELM = WS_H + 64 * MiB;
constexpr size_t WS_X16 = WS_GLAS;
constexpr size_t WS_S16 = WS_H;
constexpr int NCH = L / 64;

__device__ __forceinline__ unsigned f2bf(float f) { unsigned u = __builtin_bit_cast(unsigned, f); return (u + 0x7fffu + ((u >> 16) & 1u)) >> 16; }
__device__ __forceinline__ unsigned pkbf(float lo, float hi) { return f2bf(lo) | (f2bf(hi) << 16); }
__device__ __forceinline__ float h2f(u16 h) { return (float)__builtin_bit_cast(_Float16, h); }
__device__ __forceinline__ float hlo(unsigned w) { return h2f((u16)(w & 0xffffu)); }
__device__ __forceinline__ float hhi(unsigned w) { return h2f((u16)(w >> 16)); }
__device__ __forceinline__ int kperm16(int o) { return 8 * ((o >> 2) & 1) + 4 * (o >> 3) + (o & 3); }

__device__ __forceinline__ void vt_item(const Params& p, LAS unsigned char* scr  , int item, int lane) {
    const int tb = item & 255, h = (item >> 8) & 3, b = item >> 10, t0 = tb * 32;
    const u16* src = (const u16*)(p.ws + WS_PROJ) + (size_t)(b * L + t0) * PJ + CV + h * 128;
#pragma unroll
    for (int i = 0; i < 8; ++i) { const int r = 4 * i + (lane >> 4), ch = lane & 15; const u32x4 v = *(const u32x4*)(src + (size_t)r * PJ + ch * 8);
        LAS unsigned* d = (LAS unsigned*)(scr + r * 264 + ch * 16); d[0] = v.x; d[1] = v.y; d[2] = v.z; d[3] = v.w; }
    LDS_WAIT(); asm volatile("" ::: "memory");
    u16* dst = (u16*)(p.ws + WS_VT) + ((size_t)(b * 4 + h) * 256 + tb) * 4096;
#pragma unroll
    for (int i = 0; i < 8; ++i) { const int c = i * 64 + lane, dv = c & 127, tg = c >> 7;
        unsigned w[4];
#pragma unroll
        for (int jp = 0; jp < 4; ++jp) { const int j = 2 * jp, tok = 16 * (tg >> 1) + 8 * (j >> 2) + 4 * (tg & 1) + (j & 3);
            const unsigned lo = *(LAS u16*)(scr + tok * 264 + dv * 2), hi = *(LAS u16*)(scr + (tok + 1) * 264 + dv * 2); w[jp] = lo | (hi << 16); }
        u32x4 o; o.x = w[0]; o.y = w[1]; o.z = w[2]; o.w = w[3];
        *(u32x4*)(dst + ((((dv >> 5) * 2 + (tg >> 1)) * 2 + (tg & 1)) * 32 + (dv & 31)) * 8) = o; }
    LDS_WAIT(); asm volatile("" ::: "memory");
}

constexpr int GL_SEG = 106496;
constexpr int GL_GLR = 0, GL_WG = 4096, GL_BG = 8192, GL_BC = 8448, GL_QD = 25088, GL_KD = 34304, GL_QP = 43520, GL_VT = 52736, GL_SSQ = 71168, GL_OST = 72192, GL_END = 105984;
constexpr int GST = 72;
__device__ __forceinline__ void gla_bcum(const Params& p, LAS unsigned char* lds, int b, int h, int c) {
    const int tid = threadIdx.x;
    LAS float* glr = (LAS float*)(lds + GL_GLR); LAS float* wg = (LAS float*)(lds + GL_WG); LAS float* bg = (LAS float*)(lds + GL_BG); LAS float* bc = (LAS float*)(lds + GL_BC);
    const float* gsrc = (const float*)(p.ws + WS_GLR) + (size_t)(b * L + c * 64) * 16;
    for (int i = tid; i < 1024; i += NT) { glr[i] = gsrc[i]; wg[i] = p.w_gate2[(i >> 6) * 256 + h * 64 + (i & 63)]; }
    if (tid < 64) bg[tid] = p.b_gate2[h * 64 + tid];
    __syncthreads();
    { const int dk = tid & 63; float wr[16];
#pragma unroll
      for (int r = 0; r < 16; ++r) wr[r] = wg[r * 64 + dk];
      const float bias = bg[dk];
#pragma unroll
      for (int i = 0; i < 8; ++i) { const int t = (tid >> 6) + 8 * i; float z = bias;
#pragma unroll
          for (int r4 = 0; r4 < 4; ++r4) { const f32x4 gq = *(const LAS f32x4*)(glr + t * 16 + 4 * r4); z += gq[0] * wr[4 * r4] + gq[1] * wr[4 * r4 + 1] + gq[2] * wr[4 * r4 + 2] + gq[3] * wr[4 * r4 + 3]; }
          bc[t * 65 + dk] = (fminf(z, 0.f) - __logf(1.f + __expf(-fabsf(z)))) * (1.f / 16.f); } }
    __syncthreads();
    { const int dk = tid & 63, sg = tid >> 6; LAS float* segt = (LAS float*)(lds + GL_SEG);
      float v[8], run = 0.f;
#pragma unroll
      for (int i = 0; i < 8; ++i) { run += bc[(sg * 8 + i) * 65 + dk]; v[i] = run; }
      segt[sg * 64 + dk] = run;
      __syncthreads();
      float off = 0.f;
#pragma unroll
      for (int j = 0; j < 7; ++j) off += (j < sg) ? segt[j * 64 + dk] : 0.f;
#pragma unroll
      for (int i = 0; i < 8; ++i) bc[(sg * 8 + i) * 65 + dk] = v[i] + off; }
    __syncthreads();
}

__device__ __forceinline__ void gla1_item(const Params& p, LAS unsigned char* lds, int item, int wave, int lane) {
    const int tid = threadIdx.x, c = item & (NCH - 1), h = (item >> 7) & 3, b = item >> 9;
    const u16* prow = (const u16*)(p.ws + WS_PROJ) + (size_t)(b * L + c * 64) * PJ;
    unsigned kw0[4], kw1[4], vw0[8], vw1[8];
#pragma unroll
    for (int i = 0; i < 4; ++i) { const int idx = tid + NT * i, dk = idx & 63, t = 2 * (idx >> 6);
        kw0[i] = prow[(size_t)t * PJ + CGK + h * 64 + dk]; kw1[i] = prow[(size_t)(t + 1) * PJ + CGK + h * 64 + dk]; }
#pragma unroll
    for (int i = 0; i < 8; ++i) { const int idx = tid + NT * i, dv = idx & 127, t = 2 * (idx >> 7);
        vw0[i] = prow[(size_t)t * PJ + CGV + h * 128 + dv]; vw1[i] = prow[(size_t)(t + 1) * PJ + CGV + h * 128 + dv]; }
    gla_bcum(p, lds, b, h, c);
    LAS float* bc = (LAS float*)(lds + GL_BC); LAS u16* KT = (LAS u16*)(lds + GL_KD); LAS u16* VTl = (LAS u16*)(lds + GL_VT);
#pragma unroll
    for (int i = 0; i < 4; ++i) { const int idx = tid + NT * i, dk = idx & 63, t = 2 * (idx >> 6); const float bl = bc[63 * 65 + dk];
        const float k0 = h2f((u16)kw0[i]) * __expf(bl - bc[t * 65 + dk]), k1 = h2f((u16)kw1[i]) * __expf(bl - bc[(t + 1) * 65 + dk]);
        *(LAS unsigned*)(KT + dk * GST + t) = pkh(k0, k1); }
#pragma unroll
    for (int i = 0; i < 8; ++i) { const int idx = tid + NT * i, dv = idx & 127, t = 2 * (idx >> 7);
        *(LAS unsigned*)(VTl + dv * GST + t) = vw0[i] | (vw1[i] << 16); }
    if (tid < 64) ((float*)(p.ws + WS_GDEC))[(size_t)item * 64 + tid] = __expf(bc[63 * 65 + tid]);
#pragma unroll
    for (int i = 0; i < 8; ++i) { const int idx = tid + NT * i, t = idx >> 6, dk = idx & 63;
        ((float*)((u16*)(p.ws + WS_PROJ) + (size_t)(b * L + c * 64 + t) * PJ + CK + h * 128))[dk] = bc[t * 65 + dk]; }
    __syncthreads();
    const int mbv = wave >> 1, nbk = wave & 1, hh = lane >> 5, l31 = lane & 31;
    f32x16 acc;
#pragma unroll
    for (int i = 0; i < 16; ++i) acc[i] = 0.f;
#pragma unroll
    for (int s = 0; s < 4; ++s) { const f16x8 a = *(const LAS f16x8*)(VTl + (mbv * 32 + l31) * GST + 16 * s + 8 * hh), bb = *(const LAS f16x8*)(KT + (nbk * 32 + l31) * GST + 16 * s + 8 * hh);
        acc = __builtin_amdgcn_mfma_f32_32x32x16_f16(a, bb, acc, 0, 0, 0); }
    float* dst = (float*)(p.ws + WS_GLAS) + (size_t)item * 8192;
#pragma unroll
    for (int i = 0; i < 16; ++i) { const int dv = mbv * 32 + (i & 3) + 8 * (i >> 2) + 4 * hh; dst[dv * 64 + nbk * 32 + l31] = acc[i]; }
    __syncthreads();
}

__device__ __forceinline__ void phase_p4(const Params& p, LAS unsigned char* lds, int wave, int lane) {
    const float* dS = (const float*)(p.ws + WS_GLAS); const float* dec = (const float*)(p.ws + WS_GDEC); unsigned* S16 = (unsigned*)(p.ws + WS_S16);
    for (int ch = blockIdx.x * NT + threadIdx.x; ch < 32 * 4096; ch += gridDim.x * NT) {
        const int bh = ch >> 12, e2 = ch & 4095, dk = (e2 * 2) & 63;
        f32x2 run = {0.f, 0.f};
#pragma unroll 16
        for (int c = 0; c < NCH; ++c) { const size_t item = (size_t)bh * NCH + c;
            const f32x2 d = *(const f32x2*)(dS + item * 8192 + e2 * 2), a = *(const f32x2*)(dec + item * 64 + dk);
            S16[item * 4096 + e2] = pkh(run.x, run.y);
            run = a * run + d; }
    }
}

struct G3Ops { unsigned qw[4], kw[4], vw0[8], vw1[8]; u32x4 g0, g1; f16x8 sfr[4]; float bw[8]; };
#define GL_SYNC() do { asm volatile("s_waitcnt lgkmcnt(0)" ::: "memory"); __builtin_amdgcn_s_barrier(); asm volatile("" ::: "memory"); } while (0)
__device__ __forceinline__ void gla3_load(const Params& p, G3Ops& o, int item, int wave, int lane) {
    const int tid = threadIdx.x, c = item & (NCH - 1), h = (item >> 7) & 3, b = item >> 9;
    const int mb = wave >> 1, hh = lane >> 5, l31 = lane & 31;
    const u16* prow = (const u16*)(p.ws + WS_PROJ) + (size_t)(b * L + c * 64) * PJ;
#pragma unroll
    for (int i = 0; i < 4; ++i) { const int idx = tid + NT * i, dk = 2 * (idx & 31), t = idx >> 5;
        o.qw[i] = *(const unsigned*)(prow + (size_t)t * PJ + CGQ + h * 64 + dk); o.kw[i] = *(const unsigned*)(prow + (size_t)t * PJ + CGK + h * 64 + dk); }
#pragma unroll
    for (int i = 0; i < 8; ++i) { const int idx = tid + NT * i, dv = idx & 127, t = 2 * (idx >> 7);
        o.vw0[i] = prow[(size_t)t * PJ + CGV + h * 128 + dv]; o.vw1[i] = prow[(size_t)(t + 1) * PJ + CGV + h * 128 + dv]; }
    const u16* gorow = prow + (size_t)(tid >> 3) * PJ + CGO + h * 128 + (tid & 7) * 16;
    o.g0 = *(const u32x4*)gorow; o.g1 = *(const u32x4*)(gorow + 8);
    { const u16* srow = (const u16*)(p.ws + WS_S16) + (size_t)item * 8192 + (size_t)(mb * 32 + l31) * 64;
#pragma unroll
      for (int s = 0; s < 4; ++s) o.sfr[s] = *(const f16x8*)(srow + 16 * s + 8 * hh); }
#pragma unroll
    for (int i = 0; i < 8; ++i) { const int idx = tid + NT * i, t = idx >> 6, dk = idx & 63; o.bw[i] = ((const float*)(prow + (size_t)t * PJ + CK + h * 128))[dk]; }
}
__device__ __forceinline__ void gla3_item(const Params& p, LAS unsigned char* lds, const G3Ops& ops, int item, int wave, int lane) {
    const int tid = threadIdx.x, c = item & (NCH - 1), h = (item >> 7) & 3, b = item >> 9;
    const int mb = wave >> 1, nb = wave & 1, hh = lane >> 5, l31 = lane & 31;
    const unsigned (&qw)[4] = ops.qw; const unsigned (&kw)[4] = ops.kw; const unsigned (&vw0)[8] = ops.vw0; const unsigned (&vw1)[8] = ops.vw1; const u32x4 g0 = ops.g0, g1 = ops.g1; const f16x8 (&sfr)[4] = ops.sfr;
    LAS float* bc = (LAS float*)(lds + GL_BC);
#pragma unroll
    for (int i = 0; i < 8; ++i) { const int idx = tid + NT * i, t = idx >> 6, dk = idx & 63; bc[t * 65 + dk] = ops.bw[i]; }
    GL_SYNC();
    LAS u16* QD = (LAS u16*)(lds + GL_QD); LAS u16* KD = (LAS u16*)(lds + GL_KD); LAS u16* QP = (LAS u16*)(lds + GL_QP); LAS u16* VTl = (LAS u16*)(lds + GL_VT);
    LAS float* ssq = (LAS float*)(lds + GL_SSQ); LAS float* ost = (LAS float*)(lds + GL_OST);
#pragma unroll
    for (int i = 0; i < 4; ++i) { const int idx = tid + NT * i, dk = 2 * (idx & 31), t = idx >> 5;
        const float b0 = bc[t * 65 + dk], b1 = bc[t * 65 + dk + 1], r0 = bc[31 * 65 + dk], r1 = bc[31 * 65 + dk + 1];
        const float q0 = hlo(qw[i]) * 0.125f, q1 = hhi(qw[i]) * 0.125f;
        *(LAS unsigned*)(QD + t * GST + dk) = pkbf(q0 * __expf(b0 - r0), q1 * __expf(b1 - r1));
        *(LAS unsigned*)(KD + t * GST + dk) = pkbf(hlo(kw[i]) * __expf(r0 - b0), hhi(kw[i]) * __expf(r1 - b1));
        *(LAS unsigned*)(QP + t * GST + dk) = pkh(q0 * __expf(b0), q1 * __expf(b1)); }
#pragma unroll
    for (int i = 0; i < 8; ++i) { const int idx = tid + NT * i, dv = idx & 127, t = 2 * (idx >> 7);
        *(LAS unsigned*)(VTl + dv * GST + (t & ~15) + kperm16(t & 15)) = vw0[i] | (vw1[i] << 16); }
    GL_SYNC();
    f16x8 pf[4];
#pragma unroll
    for (int jb = 0; jb < 2; ++jb) {
        if (jb > nb) {
#pragma unroll
            for (int e = 0; e < 8; ++e) { pf[2 * jb][e] = (_Float16)0.f; pf[2 * jb + 1][e] = (_Float16)0.f; }
            continue; }
        f32x16 x;
#pragma unroll
        for (int i = 0; i < 16; ++i) x[i] = 0.f;
#pragma unroll
        for (int s = 0; s < 4; ++s) { const bf16x8 a = *(const LAS bf16x8*)(KD + (jb * 32 + l31) * GST + 16 * s + 8 * hh), bb = *(const LAS bf16x8*)(QD + (nb * 32 + l31) * GST + 16 * s + 8 * hh);
            x = __builtin_amdgcn_mfma_f32_32x32x16_bf16(a, bb, x, 0, 0, 0); }
#pragma unroll
        for (int i = 0; i < 16; ++i) { const int rowi = (i & 3) + 8 * (i >> 2) + 4 * hh; const bool keep = (jb < nb) || (rowi <= l31); const float v = keep ? x[i] : 0.f;
            pf[2 * jb + (i >> 3)][i & 7] = (_Float16)v; }
    }
    f32x16 o;
#pragma unroll
    for (int i = 0; i < 16; ++i) o[i] = 0.f;
#pragma unroll
    for (int kk = 0; kk < 4; ++kk) { if ((kk >> 1) > nb) continue;
        const f16x8 a = *(const LAS f16x8*)(VTl + (mb * 32 + l31) * GST + 16 * kk + 8 * hh);
        o = __builtin_amdgcn_mfma_f32_32x32x16_f16(a, pf[kk], o, 0, 0, 0); }
#pragma unroll
    for (int s = 0; s < 4; ++s) { const f16x8 bb = *(const LAS f16x8*)(QP + (nb * 32 + l31) * GST + 16 * s + 8 * hh);
        o = __builtin_amdgcn_mfma_f32_32x32x16_f16(sfr[s], bb, o, 0, 0, 0); }
    float part = 0.f;
#pragma unroll
    for (int i = 0; i < 16; ++i) { part += o[i] * o[i]; ost[(nb * 32 + l31) * 132 + mb * 32 + (i & 3) + 8 * (i >> 2) + 4 * hh] = o[i]; }
    part += __shfl_xor(part, 32);
    if (lane < 32) ssq[mb * 64 + nb * 32 + lane] = part;
    GL_SYNC();
    { const int t = tid >> 3, dv0 = (tid & 7) * 16;
      const float rstd = rsqrtf((ssq[t] + ssq[64 + t] + ssq[128 + t] + ssq[192 + t]) * (1.f / 128.f) + EPS);
      const unsigned gw[8] = {g0.x, g0.y, g0.z, g0.w, g1.x, g1.y, g1.z, g1.w};
      unsigned ow[8];
#pragma unroll
      for (int e = 0; e < 8; ++e) { const int dv = dv0 + 2 * e;
          const float a0 = ost[t * 132 + dv] * rstd * p.gla_g[dv] * silu_f(hlo(gw[e])), a1 = ost[t * 132 + dv + 1] * rstd * p.gla_g[dv + 1] * silu_f(hhi(gw[e]));
          ow[e] = pkh(a0, a1); }
      u16* crow = (u16*)(p.ws + WS_CAT) + (size_t)(b * L + c * 64 + t) * D + 512 + h * 128 + dv0;
      u32x4 o0, o1; o0.x = ow[0]; o0.y = ow[1]; o0.z = ow[2]; o0.w = ow[3]; o1.x = ow[4]; o1.y = ow[5]; o1.z = ow[6]; o1.w = ow[7];
      *(u32x4*)crow = o0; *(u32x4*)(crow + 8) = o1; }
    GL_SYNC();
}
}
namespace mk {
__device__ __forceinline__ int idx_row_slot(int r) { return 2 * ((r >> 2) & 1) + (r >> 4); }
__device__ __forceinline__ int idx_row_head(int r) { return (r & 3) + 4 * ((r >> 3) & 1); }
__device__ __forceinline__ float relu_f(float x) { const int i = __builtin_bit_cast(int, x); return __builtin_bit_cast(float, i > 0 ? i : 0); }
__device__ __forceinline__ float fmul_s(float a, float b) { float r; asm("v_mul_f32_e32 %0, %1, %2" : "=v"(r) : "v"(a), "v"(b)); return r; }
__device__ __forceinline__ float fma_s(float a, float b, float c) { asm("v_fmac_f32_e32 %0, %1, %2" : "+v"(c) : "v"(a), "v"(b)); return c; }
template <int BASE> __device__ __forceinline__ float idx_score(const f32x16& acc, const f32x4 wa, const f32x4 wb) {
    float s = fmul_s(wa[0], relu_f(acc[BASE + 0]));
    s = fma_s(wa[1], relu_f(acc[BASE + 1]), s);
    s = fma_s(wa[2], relu_f(acc[BASE + 2]), s); s = fma_s(wa[3], relu_f(acc[BASE + 3]), s);
    s = fma_s(wb[0], relu_f(acc[BASE + 4]), s); s = fma_s(wb[1], relu_f(acc[BASE + 5]), s);
    s = fma_s(wb[2], relu_f(acc[BASE + 6]), s); s = fma_s(wb[3], relu_f(acc[BASE + 7]), s);
    return s;
}
__device__ __forceinline__ unsigned fkey(float f) { f = f + 0.0f; const unsigned u = __builtin_bit_cast(unsigned, f); return u ^ ((unsigned)((int)u >> 31) | 0x80000000u); }
__device__ __forceinline__ int opq(int v) { asm volatile("" : "+v"(v)); return v; }
__device__ __forceinline__ unsigned lds_add(LAS unsigned* p, unsigned v) { return __hip_atomic_fetch_add(p, v, __ATOMIC_RELAXED, __HIP_MEMORY_SCOPE_WORKGROUP); }
__device__ __forceinline__ unsigned wave_prefix_incl(unsigned v) {
#define MK_DPPADD(ctrl, rm) v += (unsigned)__builtin_amdgcn_update_dpp(0, (int)v, ctrl, rm, 0xf, false)
    MK_DPPADD(0x111, 0xf); MK_DPPADD(0x112, 0xf); MK_DPPADD(0x114, 0xf); MK_DPPADD(0x118, 0xf); MK_DPPADD(0x142, 0xa); MK_DPPADD(0x143, 0xc);
#undef MK_DPPADD
    return v;
}
__device__ __forceinline__ unsigned wave_suffix_sum(unsigned x, int lane) {
    const unsigned pre = wave_prefix_incl(x), tot = (unsigned)__builtin_amdgcn_readlane((int)pre, 63);
    return tot - pre + x;
}

template <int NP, int NC>
__device__ __forceinline__ void wave_select(const LAS unsigned* const (&cq)[NC], const unsigned (&sc)[NC][4], const unsigned (&kk0)[NC], LAS unsigned* const (&hq)[NC], int lane, const int (&rp0)[NC], const unsigned (&pre)[NC], unsigned (&out)[NC]) {
    unsigned prefix[NC], mask[NC], kk[NC];
#pragma unroll
    for (int c = 0; c < NC; ++c) { prefix[c] = pre[c]; mask[c] = rp0[c] ? (0xffffffffu << (32 - 8 * rp0[c])) : 0u; kk[c] = kk0[c]; }
    int rpmin = NP;
#pragma unroll
    for (int c = 0; c < NC; ++c) rpmin = rp0[c] < rpmin ? rp0[c] : rpmin;
    for (int rp = rpmin; rp < NP; ++rp) { const int shift = 24 - 8 * rp;
#pragma unroll
        for (int c = 0; c < NC; ++c) { u32x4 z = {0u, 0u, 0u, 0u}; *(LAS u32x4*)(hq[c] + 4 * lane) = z; }
#pragma unroll
        for (int sl = 0; sl < 4; ++sl)
#pragma unroll
            for (int i = 0; i < 4; ++i)
#pragma unroll
                for (int c = 0; c < NC; ++c) { const unsigned idx = lane + 64 * i; if (rp >= rp0[c] && idx < sc[c][sl]) { const unsigned key = fkey(__builtin_bit_cast(float, cq[c][256 * sl + idx])); if ((key & mask[c]) == prefix[c]) lds_add(hq[c] + ((key >> shift) & 255u), 1u); } }
        LDS_WAIT();
        u32x4 cw[NC]; unsigned cs[NC], incl[NC];
#pragma unroll
        for (int c = 0; c < NC; ++c) { cw[c] = *(LAS u32x4*)(hq[c] + 4 * lane); cs[c] = cw[c].x + cw[c].y + cw[c].z + cw[c].w; incl[c] = cs[c]; }
#pragma unroll
        for (int c = 0; c < NC; ++c) incl[c] = wave_suffix_sum(cs[c], lane);
#pragma unroll
        for (int c = 0; c < NC; ++c) { const unsigned above = incl[c] - cs[c]; const bool found = above < kk[c] && kk[c] <= incl[c];
            unsigned dig = 0u, kk2 = 0u;
            if (found) { unsigned cum = above; const unsigned cv[4] = {cw[c].x, cw[c].y, cw[c].z, cw[c].w};
#pragma unroll
                for (int i = 3; i >= 0; --i) { if (kk2 == 0u) { if (cum + cv[i] >= kk[c]) { dig = (unsigned)(4 * lane + i); kk2 = kk[c] - cum; } else cum += cv[i]; } } }
            const unsigned long long bal = __ballot(found); const int src = bal ? (int)__builtin_ctzll(bal) : 0;
            dig = (unsigned)__builtin_amdgcn_readlane((int)dig, src); kk2 = (unsigned)__builtin_amdgcn_readlane((int)kk2, src);
            if (rp >= rp0[c]) { prefix[c] |= dig << shift; mask[c] |= 255u << shift; kk[c] = kk2 ? kk2 : 1u; } }
    }
#pragma unroll
    for (int c = 0; c < NC; ++c) out[c] = prefix[c];
}

constexpr int TH_HIST = 0, TH_CAND = 65536, TH_ST = 131072, TH_A = 133120;
constexpr int ST_LO = 0, ST_RMAX = 16, ST_SH = 32, ST_NEED = 48, ST_MODE = 64, ST_CCNT = 80, ST_HI = 96, ST_ABOVE = 112, ST_WL = 128, ST_SAMP = 256, ST_SCNT = 272, ST_THR = 336, ST_DIRTY = 352;
__device__ __forceinline__ void thr_loadB(f16x8 (&Bf)[4], const u16* KI, int kt) {
#pragma unroll
    for (int s = 0; s < 4; ++s) Bf[s] = *(const f16x8*)(KI + (size_t)(kt * 4 + s) * 512);
}
__device__ __forceinline__ void thr_scores(const f32x16& acc, const LAS float* wl, int mb, int hh, unsigned& k0, unsigned& k1) {
    const LAS float* w0 = wl + (4 * mb + 2 * hh) * 8;
    const f32x4 a0 = *(const LAS f32x4*)(w0), b0 = *(const LAS f32x4*)(w0 + 4), a1 = *(const LAS f32x4*)(w0 + 8), b1 = *(const LAS f32x4*)(w0 + 12);
    k0 = fkey(idx_score<0>(acc, a0, b0)); k1 = fkey(idx_score<8>(acc, a1, b1));
}
constexpr int TH_MASK = 0, TH_CIDX = 16384, TH_SCR = 49152;
__device__ __forceinline__ float key2f(unsigned k) { return __builtin_bit_cast(float, (k & 0x80000000u) ? (k ^ 0x80000000u) : ~k); }
template <int KIND>
__device__ __forceinline__ void thr_sweep(LAS unsigned char* lds, const f16x8 (&A)[2][4], const u16* KI, int t0, int ntiles, int wave, int lane) {
    LAS unsigned* hist = (LAS unsigned*)(lds + TH_HIST); LAS unsigned* cand = (LAS unsigned*)(lds + TH_CAND); LAS unsigned* st = (LAS unsigned*)(lds + TH_ST);
    LAS unsigned* maskb = (LAS unsigned*)(lds + TH_MASK); LAS u16* cidx = (LAS u16*)(lds + TH_CIDX);
    const int hh = lane >> 5, l31 = lane & 31, mbp = wave & 1, ph = wave >> 1;
    unsigned lo[2][2], rmax[2][2], sh[2][2], ccn[2][2]; float lof[2][2], upf[2][2];
#pragma unroll
    for (int mbl = 0; mbl < 2; ++mbl)
#pragma unroll
        for (int jj = 0; jj < 2; ++jj) { const int ql = 8 * mbp + 4 * mbl + 2 * hh + jj; const unsigned lk = st[ST_LO + ql], rm = st[ST_RMAX + ql], uk = lk + rm;
            lo[mbl][jj] = lk; rmax[mbl][jj] = rm; sh[mbl][jj] = st[ST_SH + ql]; ccn[mbl][jj] = 0u;
            lof[mbl][jj] = lk <= 0x007fffffu ? -__builtin_inff() : key2f(lk); upf[mbl][jj] = uk >= 0xff800000u ? (lk == 0xffffffffu ? -__builtin_inff() : __builtin_inff()) : key2f(uk); }
    f16x8 B0[4], B1[4];
    const unsigned cbase4 = (unsigned)(__UINTPTR_TYPE__)(lds + TH_CAND) + ((8 * mbp + 2 * hh) * 1024 + ph * 256) * 4, cbase2 = (unsigned)(__UINTPTR_TYPE__)(lds + TH_CIDX) + ((8 * mbp + 2 * hh) * 1024 + ph * 256) * 2;
    float lofv[2][2] = {{lof[0][0], lof[0][1]}, {lof[1][0], lof[1][1]}};
    float lofc[2][2];
#pragma unroll
    for (int mbl = 0; mbl < 2; ++mbl)
#pragma unroll
        for (int jj = 0; jj < 2; ++jj) lofc[mbl][jj] = ((ntiles - 1) * 32 + l31 <= t0 + 8 * mbp + 4 * mbl + 2 * hh + jj) ? lof[mbl][jj] : __builtin_inff();
    const LAS float* wlb = (const LAS float*)(st + ST_WL) + (8 * mbp + 2 * hh) * 8;
    asm volatile("" : "+v"(wlb));
    f32x4 wreg[2][2][2];
    if (KIND == 1) {
#pragma unroll
        for (int mbl = 0; mbl < 2; ++mbl)
#pragma unroll
            for (int jj = 0; jj < 2; ++jj) { wreg[mbl][jj][0] = *(const LAS f32x4*)(wlb + (4 * mbl + jj) * 8); wreg[mbl][jj][1] = *(const LAS f32x4*)(wlb + (4 * mbl + jj) * 8 + 4); } }
    auto tile = [&](const f16x8 (&BX)[4], int kt, const bool chk) __attribute__((always_inline)) {
        const int skey = kt * 32 + l31;
        f32x16 acc[2];
#pragma unroll
        for (int mbl = 0; mbl < 2; ++mbl) {
#pragma unroll
            for (int i = 0; i < 16; ++i) acc[mbl][i] = 0.f;
#pragma unroll
            for (int s = 0; s < 4; ++s) acc[mbl] = __builtin_amdgcn_mfma_f32_32x32x16_f16(A[mbl][s], BX[s], acc[mbl], 0, 0, 0); }
#pragma unroll
        for (int mbl = 0; mbl < 2; ++mbl)
#pragma unroll
            for (int jj = 0; jj < 2; ++jj) { const int ql = 8 * mbp + 4 * mbl + 2 * hh + jj;
                const f32x4 wa = KIND == 1 ? wreg[mbl][jj][0] : *(const LAS f32x4*)(wlb + (4 * mbl + jj) * 8), wb = KIND == 1 ? wreg[mbl][jj][1] : *(const LAS f32x4*)(wlb + (4 * mbl + jj) * 8 + 4);
                const float sc = jj == 0 ? idx_score<0>(acc[mbl], wa, wb) : idx_score<8>(acc[mbl], wa, wb);
                if (KIND == 0) { const bool caus = !chk || skey <= t0 + ql;
                    const unsigned key = fkey(sc), d = key - lo[mbl][jj]; if (caus && d <= rmax[mbl][jj]) { const unsigned bin = d >> sh[mbl][jj]; lds_add(hist + ql * 1024 + (bin >> 1), 1u << (16 * (bin & 1u))); } }
                else {
                    const unsigned long long bal = __ballot(sc >= lofv[mbl][jj]);
                    const unsigned blo = (unsigned)bal, bhi = (unsigned)(bal >> 32), nlo = (unsigned)__builtin_popcount(blo), nhi = (unsigned)__builtin_popcount(bhi);
                    const unsigned cpk = ccn[mbl][jj] - (nlo << 16);
                    const int base = __builtin_amdgcn_sbfe((int)cpk, 16 * hh, 16);
                    unsigned pos = __builtin_amdgcn_mbcnt_hi(bhi, __builtin_amdgcn_mbcnt_lo(blo, (unsigned)base)); pos = pos < 255u ? pos : 255u;
                    { const unsigned a4 = cbase4 + (4 * mbl + jj) * 4096 + pos * 4, a2 = cbase2 + (4 * mbl + jj) * 2048 + pos * 2; unsigned long long sv;
                      asm volatile("s_and_saveexec_b64 %0, %1\n\tds_write_b32 %2, %3\n\tds_write_b16 %4, %5\n\ts_mov_b64 exec, %0" : "=&s"(sv) : "s"(bal), "v"(a4), "v"(sc), "v"(a2), "v"(skey) : "memory"); }
                    ccn[mbl][jj] += nlo + (nhi << 16); } }
    };
    int kt = ph; const int last = ntiles - 1;
    if (KIND == 0) {
        for (; kt < ntiles; kt += 4) { thr_loadB(B0, KI, kt); tile(B0, kt, true); }
        return; }
    thr_loadB(B0, KI, kt);
#define TH_LASTTHR() do { if (kt == last) { asm volatile("" ::: "memory");   _Pragma("unroll") for (int a = 0; a < 2; ++a) { _Pragma("unroll") for (int c = 0; c < 2; ++c) lofv[a][c] = lofc[a][c]; } } } while (0)
    for (;;) {
        thr_loadB(B1, KI, kt + 4 < last ? kt + 4 : last); TH_LASTTHR(); tile(B0, kt, kt == last); kt += 4; if (kt >= ntiles) break;
        thr_loadB(B0, KI, kt + 4 < last ? kt + 4 : last); TH_LASTTHR(); tile(B1, kt, kt == last); kt += 4; if (kt >= ntiles) break;
    }
#undef TH_LASTTHR
    if (KIND == 1) {
#pragma unroll
        for (int mbl = 0; mbl < 2; ++mbl)
#pragma unroll
            for (int jj = 0; jj < 2; ++jj) {
                if (l31 == 0) st[ST_SCNT + (8 * mbp + 4 * mbl + 2 * hh + jj) * 4 + ph] = (ccn[mbl][jj] >> (16 * hh)) & 0xffffu; } }
}
__device__ __forceinline__ void thr_write_masks(const Params& p, LAS unsigned char* lds, int b, int t0, int ntw) {
    const int tidw = opq(threadIdx.x);
    const LAS unsigned* maskb = (const LAS unsigned*)(lds + TH_MASK); const int q = tidw & 15;
    unsigned* dst = (unsigned*)(p.ws + WS_SELM) + ((size_t)(b * 128 + (t0 >> 6)) * 256) * 64 + (t0 & 63) + q;
    for (int kt = tidw >> 4; kt < ntw; kt += 32) dst[(size_t)kt * 64] = maskb[q * 256 + kt];
}
struct ThrOps { f16x8 A[2][4]; float wl; };
__device__ __forceinline__ void thr_load(const Params& p, ThrOps& o, int b, int qb, int wave) {
    const int tid = opq(threadIdx.x), lane = tid & 63, hh = lane >> 5, l31 = lane & 31, t0 = qb * 16, mbp = wave & 1;
    const u16* P16 = (const u16*)(p.ws + WS_PROJ); const int slot = idx_row_slot(l31), head = idx_row_head(l31);
#pragma unroll
    for (int mbl = 0; mbl < 2; ++mbl) { const u16* qr = P16 + (size_t)(b * L + t0 + 8 * mbp + 4 * mbl + slot) * PJ + CQI + head * 64 + 8 * hh;
#pragma unroll
        for (int s = 0; s < 4; ++s) o.A[mbl][s] = *(const f16x8*)(qr + 16 * s); }
    o.wl = ((const float*)(p.ws + WS_WIDX))[(size_t)(b * L + t0) * 8 + (tid & 127)];
}
#define TH_SYNC() do { asm volatile("s_waitcnt lgkmcnt(0)" ::: "memory"); __builtin_amdgcn_s_barrier(); asm volatile("" ::: "memory"); } while (0)
__device__ __forceinline__ void thr_item(const Params& p, LAS unsigned char* lds, const ThrOps& ops, int b, int qb, int wave, int lane) {
    int tid = opq(threadIdx.x); lane = tid & 63; int hh = lane >> 5, l31 = lane & 31; const int t0 = qb * 16;
#define TH_FRESH() do { tid = opq(tid); lane = tid & 63; hh = lane >> 5; l31 = lane & 31; } while (0)
    LAS unsigned* hist = (LAS unsigned*)(lds + TH_HIST); LAS unsigned* cand = (LAS unsigned*)(lds + TH_CAND); LAS unsigned* st = (LAS unsigned*)(lds + TH_ST);
    LAS unsigned* maskb = (LAS unsigned*)(lds + TH_MASK);
    const int ntw = 2 * (qb >> 2) + 2;
    if (tid < 16) { const int n = t0 + tid + 1;
        if (n <= 256) { st[ST_MODE + tid] = 2u; st[ST_THR + tid] = 0u; }
        else { st[ST_MODE + tid] = 0u; st[ST_LO + tid] = 0u; st[ST_RMAX + tid] = 0xffffffffu; st[ST_SH + tid] = 21u; st[ST_NEED + tid] = 256u; }
        st[ST_SAMP + tid] = 0u; }
    if (tid == 0) st[ST_DIRTY] = 0u;
    if (tid < 128) ((LAS float*)(st + ST_WL))[tid] = ops.wl;
    TH_SYNC();
    if (t0 + 16 <= 256) {
        for (int i = tid; i < 16 * 256; i += NT) { const int q = i >> 8, kt = i & 255, d = t0 + q - kt * 32; maskb[i] = d < 0 ? 0u : (d >= 31 ? 0xffffffffu : (2u << d) - 1u); }
        TH_SYNC(); thr_write_masks(p, lds, b, t0, ntw); TH_SYNC(); return; }
    const u16* P16 = (const u16*)(p.ws + WS_PROJ); const u16* KI = (const u16*)(p.ws + WS_KIDX) + (size_t)b * L * 64 + lane * 8;
    const int mbp = wave & 1, ph = wave >> 1;
    const f16x8 (&A)[2][4] = ops.A;
    const int ntiles = (t0 + 15) / 32 + 1;
    const int sd = ntiles >= 128 ? 16 : (ntiles >= 64 ? 8 : (ntiles >= 32 ? 4 : (ntiles >= 16 ? 2 : 1))), soff = sd == 16 ? 7 : (sd == 8 ? 3 : (sd == 4 ? 2 : 0)), mg = sd == 16 ? 17 : (sd == 8 ? 22 : (sd == 4 ? 30 : 35));
    const int ms = ntiles / sd;
    {
        { const LAS float* wlb = (const LAS float*)(st + ST_WL) + (8 * mbp + 2 * hh) * 8; asm volatile("" : "+v"(wlb));
          f16x8 Bs0[4], Bs1[4];
          auto stile = [&](const f16x8 (&Bs)[4], int j) __attribute__((always_inline)) { const int kt = sd * j + soff;
            f32x16 acc[2];
#pragma unroll
            for (int mbl = 0; mbl < 2; ++mbl) {
#pragma unroll
                for (int i = 0; i < 16; ++i) acc[mbl][i] = 0.f;
#pragma unroll
                for (int s = 0; s < 4; ++s) acc[mbl] = __builtin_amdgcn_mfma_f32_32x32x16_f16(A[mbl][s], Bs[s], acc[mbl], 0, 0, 0); }
#pragma unroll
            for (int mbl = 0; mbl < 2; ++mbl)
#pragma unroll
                for (int jj = 0; jj < 2; ++jj) { const int ql = 8 * mbp + 4 * mbl + 2 * hh + jj;
                    const f32x4 wa = *(const LAS f32x4*)(wlb + (4 * mbl + jj) * 8), wb = *(const LAS f32x4*)(wlb + (4 * mbl + jj) * 8 + 4);
                    const float sc = jj == 0 ? idx_score<0>(acc[mbl], wa, wb) : idx_score<8>(acc[mbl], wa, wb);
                    const bool caus = kt * 32 + l31 <= t0 + ql;
                    cand[ql * 1024 + j * 32 + l31] = caus ? __builtin_bit_cast(unsigned, sc) : 0xff800000u; }
          };
          if (ph < ms) { int j = ph; const int jl = ms - 1;
            thr_loadB(Bs0, KI, sd * j + soff);
            for (;;) {
                thr_loadB(Bs1, KI, sd * (j + 4 < jl ? j + 4 : jl) + soff); stile(Bs0, j); j += 4; if (j >= ms) break;
                thr_loadB(Bs0, KI, sd * (j + 4 < jl ? j + 4 : jl) + soff); stile(Bs1, j); j += 4; if (j >= ms) break;
            } } }
        TH_FRESH();
        if (sd == 1) { u32x4 z = {0u, 0u, 0u, 0u};
#pragma unroll
            for (int i = 0; i < 2; ++i) *(LAS u32x4*)(lds + TH_MASK + (tid + NT * i) * 16) = z; }
        TH_SYNC();
        const unsigned m = (unsigned)(ms * 32); const int qa = 2 * wave, qb2 = 2 * wave + 1;
        const unsigned s0 = m < 256u ? m : 256u, s1 = m < 256u ? 0u : (m < 512u ? m - 256u : 256u), s2 = m < 512u ? 0u : (m < 768u ? m - 512u : 256u), s3 = m < 768u ? 0u : m - 768u;
        if (sd == 1) {
            const LAS unsigned* const cq[2] = {cand + qa * 1024, cand + qb2 * 1024}; const unsigned sc[2][4] = {{s0, s1, s2, s3}, {s0, s1, s2, s3}}; const unsigned kk[2] = {256u, 256u};
            LAS unsigned* const hq[2] = {(LAS unsigned*)(lds + TH_SCR) + qa * 256, (LAS unsigned*)(lds + TH_SCR) + qb2 * 256}; const int rp0[2] = {0, 0}; const unsigned pre[2] = {0u, 0u}; unsigned res[2];
            wave_select<4, 2>(cq, sc, kk, hq, lane, rp0, pre, res);
#pragma unroll
            for (int c = 0; c < 2; ++c) { const int q = 2 * wave + c;
                for (int k2 = 0; 2 * k2 < ntiles; ++k2) { const int ki = k2 * 64 + lane; const bool sel = ki < (int)m && ki <= t0 + q && fkey(__builtin_bit_cast(float, cand[q * 1024 + ki])) >= res[c];
                    const unsigned long long bal = __ballot(sel); if (lane == 0) { maskb[q * 256 + 2 * k2] = (unsigned)bal; maskb[q * 256 + 2 * k2 + 1] = (unsigned)(bal >> 32); } }
                if (lane == 0) { st[ST_THR + q] = res[c]; st[ST_MODE + q] = 2u; } }
        } else {
          const float ra = 256.f * (float)m / (float)(t0 + qa + 1), rb = 256.f * (float)m / (float)(t0 + qb2 + 1);
          const int rloa = (int)ra + mg + 1, rlob = (int)rb + mg + 1;
          const LAS unsigned* const cq[2] = {cand + qa * 1024, cand + qb2 * 1024};
          const unsigned sc[2][4] = {{s0, s1, s2, s3}, {s0, s1, s2, s3}};
          const unsigned kk[2] = {(unsigned)(rloa <= (int)m ? rloa : (int)m), (unsigned)(rlob <= (int)m ? rlob : (int)m)};
          LAS unsigned* const hq[2] = {hist + (wave * 2 + 0) * 256, hist + (wave * 2 + 1) * 256};
          const int rp0[2] = {0, 0}; const unsigned pre[2] = {0u, 0u}; unsigned res[2];
          wave_select<2, 2>(cq, sc, kk, hq, lane, rp0, pre, res);
          if (lane == 0) {
              const unsigned loka = rloa <= (int)m ? res[0] : 0u, lokb = rlob <= (int)m ? res[1] : 0u;
              st[ST_MODE + qa] = 1u; st[ST_SAMP + qa] = 1u; st[ST_LO + qa] = loka; st[ST_RMAX + qa] = 0xffffffffu - loka;
              st[ST_MODE + qb2] = 1u; st[ST_SAMP + qb2] = 1u; st[ST_LO + qb2] = lokb; st[ST_RMAX + qb2] = 0xffffffffu - lokb; } }
        TH_SYNC();
    }
    bool clean = true, finalpass = false;
    for (int pass = 0; pass < 10 && sd != 1; ++pass) {
        TH_FRESH();
        { u32x4 z = {0u, 0u, 0u, 0u};
#pragma unroll
          for (int i = 0; i < 8; ++i) *(LAS u32x4*)(lds + TH_HIST + (tid + NT * i) * 16) = z;
          if (tid < 16) { st[ST_CCNT + tid] = 0u;
              if (finalpass) { const unsigned tk = st[ST_THR + tid]; st[ST_LO + tid] = tk; st[ST_RMAX + tid] = 0xffffffffu - tk; st[ST_MODE + tid] = 3u; } } }
        TH_SYNC();
        int kind; { const LAS u32x4* mv = (const LAS u32x4*)(st + ST_MODE); const u32x4 m0 = mv[0], m1 = mv[1], m2 = mv[2], m3 = mv[3];
            const unsigned w[16] = {m0.x, m0.y, m0.z, m0.w, m1.x, m1.y, m1.z, m1.w, m2.x, m2.y, m2.z, m2.w, m3.x, m3.y, m3.z, m3.w}; unsigned anyh = 0u;
#pragma unroll
            for (int q = 0; q < 16; ++q) anyh |= (w[q] == 0u) ? 1u : 0u;
            kind = __builtin_amdgcn_readfirstlane((int)anyh) ? 0 : 1; }
        const bool mpass = clean && pass == 0 && kind == 1;
        if (!mpass) clean = false;
        if (kind == 0) thr_sweep<0>(lds, A, KI, t0, ntiles, wave, lane); else thr_sweep<1>(lds, A, KI, t0, ntiles, wave, lane);
        TH_FRESH();
        TH_SYNC();
        if (finalpass) {
            for (int c = 0; c < 2; ++c) { const int q = 2 * wave + c; const LAS u16* ci = (const LAS u16*)(lds + TH_CIDX) + q * 1024;
#pragma unroll
                for (int sl = 0; sl < 4; ++sl) { const unsigned n = st[ST_SCNT + q * 4 + sl] < 256u ? st[ST_SCNT + q * 4 + sl] : 256u;
                    for (unsigned idx = lane; idx < n; idx += 64) { const unsigned ki = ci[256 * sl + idx];
                        __hip_atomic_fetch_or(maskb + q * 256 + (ki >> 5), 1u << (ki & 31u), __ATOMIC_RELAXED, __HIP_MEMORY_SCOPE_WORKGROUP); } } }
            break; }
        if (kind == 0) {
            for (int qq = 0; qq < 2; ++qq) { const int q = 2 * wave + qq;
                if (st[ST_MODE + q] != 0u) continue;
                const unsigned need = st[ST_NEED + q], shq = st[ST_SH + q], loq = st[ST_LO + q];
                LAS unsigned* hq = hist + q * 1024 + 16 * lane; unsigned c = 0u;
#pragma unroll
                for (int i = 0; i < 16; ++i) { const unsigned w = hq[i]; c += (w & 0xffffu) + (w >> 16); }
                const unsigned incl = wave_suffix_sum(c, lane), above = incl - c;
                if (above < need && need <= incl) {
                    unsigned cum = above, bsel = 0u, bcnt = 0u;
                    for (int i = 31; i >= 0; --i) { const unsigned w = hq[i >> 1], cnt = (i & 1) ? (w >> 16) : (w & 0xffffu); if (cum + cnt >= need) { bsel = (unsigned)(32 * lane + i); bcnt = cnt; break; } cum += cnt; }
                    const unsigned need2 = need - cum, newlo = loq + (bsel << shq);
                    if (bcnt == need2 || shq == 0u) { st[ST_THR + q] = newlo; st[ST_MODE + q] = 2u; st[ST_LO + q] = 0xffffffffu; st[ST_RMAX + q] = 0u; }
                    else { st[ST_LO + q] = newlo; st[ST_RMAX + q] = (1u << shq) - 1u; st[ST_NEED + q] = need2;
                        st[ST_SH + q] = shq > 11u ? shq - 11u : 0u; }
                } }
        } else {
            const LAS unsigned* cq[2]; unsigned sc[2][4], kk[2], pre[2], res[2]; LAS unsigned* hq[2]; int rp0[2]; bool act[2], good[2];
#pragma unroll
            for (int c = 0; c < 2; ++c) { const int q = 2 * wave + c; act[c] = st[ST_MODE + q] == 1u;
#pragma unroll
                for (int sl = 0; sl < 4; ++sl) sc[c][sl] = st[ST_SCNT + q * 4 + sl];
                const unsigned cnt = sc[c][0] + sc[c][1] + sc[c][2] + sc[c][3]; kk[c] = st[ST_NEED + q]; good[c] = sc[c][0] <= 256u && sc[c][1] <= 256u && sc[c][2] <= 256u && sc[c][3] <= 256u;
                good[c] = good[c] && kk[c] <= cnt;
                const unsigned loq = st[ST_LO + q], hiq = loq + st[ST_RMAX + q]; rp0[c] = (loq >> 24) != (hiq >> 24) ? 0 : ((loq >> 16) != (hiq >> 16) ? 1 : 2);
                pre[c] = rp0[c] == 0 ? 0u : (rp0[c] == 1 ? (loq & 0xff000000u) : (loq & 0xffff0000u));
                cq[c] = cand + q * 1024; hq[c] = (LAS unsigned*)(lds + TH_SCR) + q * 256;
                if (!(act[c] && good[c])) { sc[c][0] = 0u; sc[c][1] = 0u; sc[c][2] = 0u; sc[c][3] = 0u; kk[c] = 1u; rp0[c] = 4; } }
            wave_select<4, 2>(cq, sc, kk, hq, lane, rp0, pre, res);
#pragma unroll
            for (int c = 0; c < 2; ++c) { const int q = 2 * wave + c;
                if (!act[c]) continue;
                if (good[c]) { const unsigned key = res[c];
                    if (mpass) {
                        const LAS u16* ci = (const LAS u16*)(lds + TH_CIDX) + q * 1024;
#pragma unroll
                        for (int sl = 0; sl < 4; ++sl)
#pragma unroll
                            for (int i = 0; i < 4; ++i) { const unsigned idx = lane + 64 * i; if (idx < sc[c][sl] && fkey(__builtin_bit_cast(float, cand[q * 1024 + 256 * sl + idx])) >= key) { const unsigned ki = ci[256 * sl + idx];
                                __hip_atomic_fetch_or(maskb + q * 256 + (ki >> 5), 1u << (ki & 31u), __ATOMIC_RELAXED, __HIP_MEMORY_SCOPE_WORKGROUP); } } }
                    if (lane == 0) { st[ST_THR + q] = key; st[ST_MODE + q] = 2u; st[ST_LO + q] = 0xffffffffu; st[ST_RMAX + q] = 0u; } }
                else if (lane == 0) { st[ST_DIRTY] = 1u; st[ST_MODE + q] = 0u; st[ST_SAMP + q] = 0u; st[ST_LO + q] = 0u; st[ST_RMAX + q] = 0xffffffffu; st[ST_SH + q] = 21u; st[ST_NEED + q] = 256u; }
            }
        }
        TH_SYNC();
        bool alldone; { const LAS u32x4* mv = (const LAS u32x4*)(st + ST_MODE); const u32x4 m0 = mv[0], m1 = mv[1], m2 = mv[2], m3 = mv[3];
            const unsigned w[16] = {m0.x, m0.y, m0.z, m0.w, m1.x, m1.y, m1.z, m1.w, m2.x, m2.y, m2.z, m2.w, m3.x, m3.y, m3.z, m3.w}; unsigned nd = 0u;
#pragma unroll
            for (int q = 0; q < 16; ++q) nd |= (w[q] != 2u) ? 1u : 0u;
            alldone = __builtin_amdgcn_readfirstlane((int)nd) == 0; }
        if (alldone) { if (clean && st[ST_DIRTY] == 0u) break; finalpass = true; }
    }
    TH_SYNC();
    thr_write_masks(p, lds, b, t0, ntw);
    TH_SYNC();
#undef TH_FRESH
}
}
namespace mk {
constexpr int AT_MASKR = 0, AT_SSQ = 2560, AT_KVB = 16384, AT_OST = 16384;
#define AT_DMA(gp, lp) __builtin_amdgcn_global_load_lds((const unsigned*)(gp), (LAS unsigned*)(lp), 16, 0, 0)
#define AT_DMAO(gp, lp, off) __builtin_amdgcn_global_load_lds((const unsigned*)(gp), (LAS unsigned*)(lp), 16, off, 0)
#define AT_DMA4(gp, lp) __builtin_amdgcn_global_load_lds((const unsigned*)(gp), (LAS unsigned*)(lp), 4, 0, 0)
__device__ __forceinline__ void att_item(const Params& p, LAS unsigned char* lds, int b, int qblk, int wave, int lane) {
    const int q0 = qblk * 128, g = wave >> 1, h2 = wave & 1, hh = lane >> 5, l31 = lane & 31;
    LAS unsigned* maskr = (LAS unsigned*)(lds + AT_MASKR); LAS float* ssq = (LAS float*)(lds + AT_SSQ);
    const u16* P16 = (const u16*)(p.ws + WS_PROJ);
    const unsigned* SM = (const unsigned*)(p.ws + WS_SELM) + (size_t)(b * 128 + 2 * qblk + (wave & 1)) * 256 * 64 + lane;
    const int ntiles = 4 * qblk + 4, glast = q0 + 32 * g + 31;
    const float csc = 0.08838834764831845f * 1.4426950408889634f;
    LAS unsigned char* ostw = lds + AT_OST + wave * 8704;
    u16* cbase = (u16*)(p.ws + WS_CAT) + (size_t)(b * L + q0 + 32 * g) * D;
    for (int sp = 0; sp < 2; ++sp) {
        const int h = 2 * sp + h2;
        const unsigned char* KF = (const unsigned char*)(p.ws + WS_KF) + (size_t)(b * 4 + 2 * sp + (wave & 1)) * 256 * 8192 + (size_t)(2 * (wave >> 1)) * 1024 + lane * 16;
        const unsigned char* VF = (const unsigned char*)(p.ws + WS_VT) + (size_t)(b * 4 + 2 * sp + (wave & 1)) * 256 * 8192 + (size_t)(2 * (wave >> 1)) * 1024 + lane * 16;
        const int dofs = (wave & 1) * 8192 + 2 * (wave >> 1) * 1024;
        if (wave < 2) { AT_DMA4(SM, lds + AT_MASKR + wave * 256); AT_DMA4(SM + 64, lds + AT_MASKR + 512 + wave * 256); }
#pragma unroll
        for (int i = 0; i < 2; ++i) { AT_DMA(KF + i * 1024, lds + AT_KVB + dofs + i * 1024); AT_DMA(VF + i * 1024, lds + AT_KVB + 16384 + dofs + i * 1024); }
        f16x8 Qf[8];
        { const u16* qa = P16 + (size_t)(b * L + q0 + 32 * g + l31) * PJ + CQ + h * 128 + 8 * hh;
#pragma unroll
          for (int s = 0; s < 8; ++s) Qf[s] = *(const f16x8*)(qa + 16 * s); }
#pragma unroll
        for (int s = 0; s < 8; ++s) Qf[s] = Qf[s] * (_Float16)csc;
        f32x16 O[4];
#pragma unroll
        for (int d = 0; d < 4; ++d)
#pragma unroll
            for (int i = 0; i < 16; ++i) O[d][i] = 0.f;
        const unsigned char* kfp = KF; const unsigned char* vfp = VF; const unsigned* smp = SM + 64;
        float mrun = 0.f, lsum = 0.f;
        f32x16 negm;
#pragma unroll
        for (int i = 0; i < 16; ++i) negm[i] = 0.f;
        for (int kt = 0; kt < ntiles; ++kt) {
            asm volatile("s_waitcnt vmcnt(0)" ::: "memory");
            __syncthreads();
            const bool act = kt * 32 <= glast;
            const LAS f16x8* kb = (const LAS f16x8*)(lds + AT_KVB + (kt & 1) * 32768 + h2 * 8192) + lane;
            f16x8 kf[8];
            if (act) {
#pragma unroll
                for (int s = 0; s < 8; ++s) kf[s] = kb[s * 64]; }
            kfp += 8192; vfp += 8192; smp += 64;
            asm volatile("" : "+v"(kfp), "+v"(vfp), "+v"(smp));
            if (kt + 1 < ntiles) { const int bo = AT_KVB + ((kt + 1) & 1) * 32768 + dofs;
                AT_DMAO(kfp, lds + bo, 0); AT_DMAO(kfp, lds + bo, 1024); AT_DMAO(vfp, lds + bo + 16384, 0); AT_DMAO(vfp, lds + bo + 16384, 1024); }
            if (kt + 2 < ntiles && wave < 2) AT_DMA4(smp, lds + AT_MASKR + ((kt + 2) & 3) * 512 + wave * 256);
            if (act) {
                f32x16 S = negm;
#pragma unroll
                for (int s = 0; s < 8; ++s) S = __builtin_amdgcn_mfma_f32_32x32x16_f16(kf[s], Qf[s], S, 0, 0, 0);

                const unsigned bits = maskr[(kt & 3) * 128 + 32 * g + l31] >> (4 * hh);
                f16x8 vf[8];
                const unsigned av = (unsigned)(__UINTPTR_TYPE__)(lds + AT_KVB + (kt & 1) * 32768 + 16384 + h2 * 8192) + lane * 16;
#define AT_RD(dst, off, dep) asm volatile("ds_read_b128 %0, %1 offset:" #off : "=v"(dst) : "v"(av), "v"(dep))
                AT_RD(vf[0], 0, bits); AT_RD(vf[2], 2048, bits); AT_RD(vf[4], 4096, bits); AT_RD(vf[6], 6144, bits);
                int mxi = 0;
#pragma unroll
                for (int i = 0; i < 16; ++i) { const unsigned mk = (unsigned)__builtin_amdgcn_sbfe((int)bits, (i & 3) + 8 * (i >> 2), 1); const float si = S[i];
                    S[i] = __builtin_bit_cast(float, (__builtin_bit_cast(unsigned, si) & mk) | (0xff61b1e6u & ~mk)); }
#pragma unroll
                for (int i = 0; i < 16; i += 2) { const float a = S[i], c = S[i + 1]; const int ai = __builtin_bit_cast(int, a), ci = __builtin_bit_cast(int, c); const int t = mxi > ai ? mxi : ai; mxi = t > ci ? t : ci; }
                { const auto r = __builtin_amdgcn_permlane32_swap((unsigned)mxi, (unsigned)mxi, false, false); const int r0 = (int)r[0], r1 = (int)r[1]; mxi = r0 > r1 ? r0 : r1; }
                const float mx = __builtin_bit_cast(float, mxi);
                if (__ballot(mx > 8.f)) { const float dlt = mx > 8.f ? mx : 0.f, alpha = __builtin_amdgcn_exp2f(-dlt);
                    mrun += dlt; lsum *= alpha;
#pragma unroll
                    for (int d = 0; d < 4; ++d)
#pragma unroll
                        for (int i = 0; i < 16; ++i) O[d][i] *= alpha;
#pragma unroll
                    for (int i = 0; i < 16; ++i) { S[i] -= dlt; negm[i] = -mrun; } }
                float ps = 0.f; f16x8 pf[2];
#pragma unroll
                for (int i = 0; i < 16; ++i) { const float pe = __builtin_amdgcn_exp2f(S[i]); ps += pe; pf[i >> 3][i & 7] = (_Float16)pe; }
                lsum += ps;
                asm volatile("s_waitcnt lgkmcnt(0)" : "+v"(vf[0]), "+v"(vf[2]), "+v"(vf[4]), "+v"(vf[6]));
                AT_RD(vf[1], 1024, vf[0]); AT_RD(vf[3], 3072, vf[0]); AT_RD(vf[5], 5120, vf[0]); AT_RD(vf[7], 7168, vf[0]);
#undef AT_RD
#pragma unroll
                for (int d = 0; d < 4; ++d) O[d] = __builtin_amdgcn_mfma_f32_32x32x16_f16(vf[d * 2], pf[0], O[d], 0, 0, 0);
                asm volatile("s_waitcnt lgkmcnt(0)" : "+v"(vf[1]), "+v"(vf[3]), "+v"(vf[5]), "+v"(vf[7]));
#pragma unroll
                for (int d = 0; d < 4; ++d) O[d] = __builtin_amdgcn_mfma_f32_32x32x16_f16(vf[d * 2 + 1], pf[1], O[d], 0, 0, 0);
            }
        }
        int lane2 = lane; asm volatile("" : "+v"(lane2)); const int l31b = lane2 & 31, hhb = lane2 >> 5;
        const float ltot = lsum + __shfl_xor(lsum, 32), inv = 1.f / ltot;
        float part = 0.f;
#pragma unroll
        for (int d = 0; d < 4; ++d)
#pragma unroll
            for (int i = 0; i < 16; ++i) { O[d][i] *= inv; part += O[d][i] * O[d][i]; }
        part += __shfl_xor(part, 32);
        if (lane2 < 32) ssq[h * 128 + 32 * g + lane2] = part;
        __syncthreads();
        const int qi = 32 * g + l31b;
        const float rstd = sp == 0 ? 1.f : rsqrtf((ssq[qi] + ssq[128 + qi] + ssq[256 + qi] + ssq[384 + qi]) * (1.f / 512.f) + EPS);
#pragma unroll
        for (int d = 0; d < 4; ++d)
#pragma unroll
            for (int ip = 0; ip < 8; ++ip) { const int i = 2 * ip, dv = d * 32 + (i & 3) + 8 * (i >> 2) + 4 * hhb;
                const float g0 = sp == 0 ? 1.f : p.att_g[h * 128 + dv], g1 = sp == 0 ? 1.f : p.att_g[h * 128 + dv + 1];
                *(LAS unsigned*)(ostw + l31b * 272 + dv * 2) = pkh(O[d][i] * rstd * g0, O[d][i + 1] * rstd * g1); }
        LDS_WAIT(); asm volatile("" ::: "memory");
#pragma unroll
        for (int i = 0; i < 8; ++i) { const int idx = i * 64 + lane2, row = idx >> 4, ch = idx & 15;
            const u32x4 v = *(const LAS u32x4*)(ostw + row * 272 + ch * 16); *(u32x4*)(cbase + (size_t)row * D + h * 128 + ch * 8) = v; }
        if (sp == 0) __syncthreads();
    }
    {
            int lane2 = lane; asm volatile("" : "+v"(lane2));
            asm volatile("s_waitcnt vmcnt(0)" ::: "memory");
#pragma unroll
            for (int i = 0; i < 8; ++i) { const int idx = i * 64 + lane2, row = idx >> 4, ch = idx & 15;
                u16* ptr = cbase + (size_t)row * D + h2 * 128 + ch * 8; const u32x4 v = *(const u32x4*)ptr; const int qr = 32 * g + row;
                const float rs = rsqrtf((ssq[qr] + ssq[128 + qr] + ssq[256 + qr] + ssq[384 + qr]) * (1.f / 512.f) + EPS);
                const unsigned wv[4] = {v.x, v.y, v.z, v.w}; unsigned ov[4];
#pragma unroll
                for (int e = 0; e < 4; ++e) { const int dv = ch * 8 + 2 * e; ov[e] = pkh(hlo(wv[e]) * rs * p.att_g[h2 * 128 + dv], hhi(wv[e]) * rs * p.att_g[h2 * 128 + dv + 1]); }
                u32x4 o; o.x = ov[0]; o.y = ov[1]; o.z = ov[2]; o.w = ov[3]; *(u32x4*)ptr = o; } }
    __syncthreads();
}

__device__ __forceinline__ void phase_p3(const Params& p, LAS unsigned char* lds, int wave, int lane) {
    const int G = gridDim.x, bx = blockIdx.x;
    { LAS unsigned char* scr = lds + wave * 8704; const int gw = bx * NWAVES + wave, NGW = G * NWAVES;
      for (int it = gw; it < NB * 4 * (L / 32); it += NGW) vt_item(p, scr, it, lane); }
    __syncthreads();
    for (int it = bx; it < NB * 4 * NCH; it += G) gla1_item(p, lds, it, wave, lane);
    {
    if (G == 256) { const int bt = bx & 7, j = bx >> 3;
        ThrOps cur; thr_load(p, cur, bt, j, wave);
        for (int r = 0; r < 16; ++r) { const int qb = (r & 1) ? 511 - (32 * (r >> 1) + j) : 32 * (r >> 1) + j; const int rn = r < 15 ? r + 1 : r, qbn = (rn & 1) ? 511 - (32 * (rn >> 1) + j) : 32 * (rn >> 1) + j;
            ThrOps nxt; thr_load(p, nxt, bt, qbn, wave);
            thr_item(p, lds, cur, bt, qb, wave, lane); cur = nxt; } }
    else { for (int it = bx; it < NB * 512; it += G) { ThrOps cur; thr_load(p, cur, it >> 9, it & 511, wave); thr_item(p, lds, cur, it >> 9, it & 511, wave, lane); } } }
}
__device__ __forceinline__ void phase_p5(const Params& p, LAS unsigned char* lds, int wave, int lane) {
    const int G = gridDim.x, bx = blockIdx.x;
    if (G == 256) { const int bt = bx & 7, j = bx >> 3;
        for (int r = 0; r < 2; ++r) att_item(p, lds, bt, r == 0 ? 63 - j : j, wave, lane); }
    else { for (int it = bx; it < NB * 64; it += G) att_item(p, lds, it >> 6, it & 63, wave, lane); }
    { const int N = NB * 4 * NCH; G3Ops cur; if (bx < N) gla3_load(p, cur, bx, wave, lane);
      for (int it = bx; it < N; it += G) { G3Ops nxt; gla3_load(p, nxt, it + G < N ? it + G : it, wave, lane);
          gla3_item(p, lds, cur, it, wave, lane); cur = nxt; }
      __syncthreads(); }
}
}
namespace mk {
#define XB_TMO      128
#define XB_XCNT(j)  (256  + 64 * (j))
#define XB_XSUB(j)  (1280 + 64 * (j))
#define XB_XGEN(j)  (2304 + 64 * (j))
#define XB_TOP      3328
#define XB_TOPGEN   3392
#define XCD_BAR_WORDS 3456
#define XB_SPIN_CAP (1u << 18)

__device__ __forceinline__ unsigned xb_ld(unsigned* p)              { return __hip_atomic_load(p, __ATOMIC_RELAXED, __HIP_MEMORY_SCOPE_AGENT); }
__device__ __forceinline__ unsigned xb_add(unsigned* p, unsigned v) { return __hip_atomic_fetch_add(p, v, __ATOMIC_RELAXED, __HIP_MEMORY_SCOPE_AGENT); }
__device__ __forceinline__ unsigned xb_xcc_id() { return (unsigned)__builtin_amdgcn_s_getreg((3 << 11) | 20) & 0xFu; }
#define XB_SPIN(cond, bar) do { unsigned _sp = 0; while (cond) { __builtin_amdgcn_s_sleep(1); \
    if ((++_sp & 255u) == 0u) { if (xb_ld(&(bar)[XB_TMO])) break; if (_sp > XB_SPIN_CAP) { atomicAdd(&(bar)[XB_TMO], 1u); break; } } } } while (0)

struct XcdBarrier {
    unsigned* bar; unsigned x;
    volatile LAS unsigned* st;
};

__device__ __forceinline__ XcdBarrier xcd_barrier_post(unsigned* bar, volatile LAS unsigned* st) {
    XcdBarrier b; b.bar = bar; b.x = xb_xcc_id(); b.st = st;
    if (threadIdx.x == 0) (void)xb_add(&bar[XB_XCNT(b.x)], 1u);
    return b;
}
__device__ __forceinline__ void xcd_barrier_complete(unsigned* bar, unsigned x, unsigned& nloc, unsigned& nx) {
    const unsigned G = gridDim.x * gridDim.y * gridDim.z;
    unsigned sum, cnt, mine, sp = 0u;
    for (;;) {
        sum = 0u; cnt = 0u; mine = 0u;
#pragma unroll
        for (unsigned j = 0; j < 16; ++j) { const unsigned c = xb_ld(&bar[XB_XCNT(j)]); sum += c; cnt += (c > 0u) ? 1u : 0u; mine = (j == x) ? c : mine; }
        if (sum == G) break;
        __builtin_amdgcn_s_sleep(1);
        if ((++sp & 255u) == 0u) { if (xb_ld(&bar[XB_TMO])) break; if (sp > XB_SPIN_CAP) { atomicAdd(&bar[XB_TMO], 1u); break; } }
    }
    nloc = mine > 0u ? mine : 1u; nx = cnt > 0u ? cnt : 1u;
}

__device__ __forceinline__ void xcd_barrier(const XcdBarrier& b) {
    asm volatile("s_waitcnt vmcnt(0)" ::: "memory");
    __syncthreads();
    if (threadIdx.x == 0) {
        unsigned* bar = b.bar;
        __builtin_amdgcn_s_waitcnt(0);
        unsigned nloc = b.st[0], nx = b.st[1];
        if (nloc == 0u) { xcd_barrier_complete(bar, b.x, nloc, nx); b.st[0] = nloc; b.st[1] = nx; }
        const unsigned old = xb_add(&bar[XB_XSUB(b.x)], 1u);
        const unsigned gen = old / nloc;
        if (old + 1u == (gen + 1u) * nloc) {
            __builtin_amdgcn_fence(__ATOMIC_RELEASE, "agent");
            asm volatile("s_waitcnt vmcnt(0)" ::: "memory");
            const unsigned og = xb_add(&bar[XB_TOP], 1u);
            const unsigned tg = og / nx;
            if (og + 1u == (tg + 1u) * nx) xb_add(&bar[XB_TOPGEN], 1u);
            else XB_SPIN(xb_ld(&bar[XB_TOPGEN]) == tg, bar);
            __builtin_amdgcn_fence(__ATOMIC_ACQUIRE, "agent");
            xb_add(&bar[XB_XGEN(b.x)], 1u);
            asm volatile("s_waitcnt vmcnt(0)" ::: "memory");
        } else {
            XB_SPIN(xb_ld(&bar[XB_XGEN(b.x)]) == gen, bar);
            __builtin_amdgcn_fence(__ATOMIC_ACQUIRE, "agent");
            asm volatile("s_waitcnt vmcnt(0)" ::: "memory");
        }
    }
    __syncthreads();
}

}
namespace mk {
namespace cg = cooperative_groups;
constexpr int NPHASE = 11;
__global__ void __launch_bounds__(NT, 2) mk_fwd(Params p) {
    extern __shared__ __attribute__((aligned(16))) unsigned char lds_raw[];
    LAS unsigned char* lds = (LAS unsigned char*)lds_raw;
    cg::grid_group grid = cg::this_grid();
    const int tid = threadIdx.x, lane = tid & 63, wave = __builtin_amdgcn_readfirstlane(tid >> 6);
    unsigned char* ws = p.ws;
    float* mod = (float*)(ws + WS_MOD);
    volatile LAS unsigned* xst = (volatile LAS unsigned*)(lds + LDS_BYTES - 64);
    if (tid == 0) { xst[0] = 0u; xst[1] = 0u; }
    __syncthreads();
    const XcdBarrier xbar = xcd_barrier_post((unsigned*)(ws + WS_CTL), xst);
#define IN(k) (p.ph_lo <= (k) && (k) < p.ph_hi)
#define SEAM(k) do { if (IN(k) && IN((k) + 1)) { if ((k) == 0) grid.sync(); else xcd_barrier(xbar); } } while (0)
    if (IN(0)) { phase_p0a(p, lds, wave, lane); __syncthreads(); }
    SEAM(0);
    if (IN(1)) row_phase<0>(p.x, p.norm1_g, mod, 0, D, nullptr, ws + WS_H, wave, lane);
    SEAM(1);
    if (IN(2)) {
        pg8::Gemm g{(const pg8::bf16_t*)(ws + WS_H), (const pg8::bf16_t*)(ws + WS_WIN), T, 3840, D}; pg8::StaticOrder S; S.init(T, 3840, gridDim.x, blockIdx.x);
        EpiProj E{(u16*)(ws + WS_PROJ), (u16*)(ws + WS_KIDX), (float*)(ws + WS_WIDX), (float*)(ws + WS_GLR), (u16*)(ws + WS_KF)};
        pg8::gemm_phase<EpiProj, pg8::StaticOrder>(lds, g, S, E);
    }
    SEAM(2);
    if (IN(3)) phase_p3(p, lds, wave, lane);
    SEAM(3);
    if (IN(4)) phase_p4(p, lds, wave, lane);
    SEAM(4);
    if (IN(5)) phase_p5(p, lds, wave, lane);
    SEAM(5);
    if (IN(6)) {
        pg8::Gemm g{(const pg8::bf16_t*)(ws + WS_CAT), (const pg8::bf16_t*)(ws + WS_WOUT), T, D, D}; pg8::StaticOrder S; S.init(T, D, gridDim.x, blockIdx.x);
        EpiRes<false> E{p.x, (u16*)(ws + WS_X16), mod, (float*)(ws + WS_SS1), 2 * D, 0};
        pg8::gemm_phase<EpiRes<false>, pg8::StaticOrder>(lds, g, S, E);
    }
    SEAM(6);
    if (IN(7)) row_phase<1>(ws + WS_X16, p.norm2_g, mod, 3 * D, 4 * D, (const float*)(ws + WS_SS1), ws + WS_H, wave, lane);
    SEAM(7);
    if (IN(8)) {
        pg8::Gemm g{(const pg8::bf16_t*)(ws + WS_H), (const pg8::bf16_t*)(ws + WS_WGU), T, 2 * DFF, D}; pg8::StaticOrder S; S.init(T, 2 * DFF, gridDim.x, blockIdx.x);
        EpiSwiGLU E{(u16*)(ws + WS_ACT)};
        pg8::gemm_phase<EpiSwiGLU, pg8::StaticOrder>(lds, g, S, E);
    }
    SEAM(8);
    if (IN(9)) {
        pg8::Gemm g{(const pg8::bf16_t*)(ws + WS_ACT), (const pg8::bf16_t*)(ws + WS_WDN), T, D, DFF}; pg8::StaticOrder S; S.init(T, D, gridDim.x, blockIdx.x);
        EpiRes<true> E{ws + WS_X16, (u16*)(ws + WS_X16), mod, (float*)(ws + WS_SS2), 5 * D, 0};
        pg8::gemm_phase<EpiRes<true>, pg8::StaticOrder>(lds, g, S, E);
    }
    SEAM(9);
    if (IN(10)) row_phase<2>(ws + WS_X16, p.final_g, nullptr, 0, 0, (const float*)(ws + WS_SS2), p.out, wave, lane);
#undef IN
#undef SEAM
}

static int g_grid = 0;
static Params make_params(void* const* d_in, void* d_out, void* d_ws) {
    Params p{};
    p.x = (const float*)d_in[0]; p.c = (const float*)d_in[1]; p.w_mod = (const float*)d_in[2]; p.b_mod = (const float*)d_in[3]; p.norm1_g = (const float*)d_in[4];
    p.w_in = (const float*)d_in[5]; p.w_gate2 = (const float*)d_in[6]; p.b_gate2 = (const float*)d_in[7]; p.att_g = (const float*)d_in[8]; p.gla_g = (const float*)d_in[9];
    p.w_out = (const float*)d_in[10]; p.norm2_g = (const float*)d_in[11]; p.w_gu = (const float*)d_in[12]; p.w_down = (const float*)d_in[13]; p.final_g = (const float*)d_in[14];
    p.out = (float*)d_out; p.ws = (unsigned char*)d_ws; p.ph_lo = 0; p.ph_hi = NPHASE;
    return p;
}
static bool init_grid(size_t ws_size) {
    if (g_grid) return g_grid > 0;
    int dev = 0, cus = 0, per_cu = 0;
    if (hipGetDevice(&dev) != hipSuccess || hipDeviceGetAttribute(&cus, hipDeviceAttributeMultiprocessorCount, dev) != hipSuccess) { g_grid = -1; return false; }
    if (hipFuncSetAttribute((const void*)mk_fwd, hipFuncAttributeMaxDynamicSharedMemorySize, LDS_BYTES) != hipSuccess) { fprintf(stderr, "hipFuncSetAttribute failed\n"); g_grid = -1; return false; }
    if (hipOccupancyMaxActiveBlocksPerMultiprocessor(&per_cu, (const void*)mk_fwd, NT, LDS_BYTES) != hipSuccess || per_cu < 1) { fprintf(stderr, "occupancy query: %d blocks/CU\n", per_cu); g_grid = -1; return false; }
    if (ws_size < WS_END) { fprintf(stderr, "workspace too small: %zu < %zu\n", ws_size, (size_t)WS_END); g_grid = -1; return false; }
    g_grid = cus;
    fprintf(stderr, "mk: grid %d, per_cu %d, ws %zu\n", g_grid, per_cu, ws_size);
    return true;
}
static void launch(Params p, int lo, int hi, hipStream_t stream) {
    p.ph_lo = lo; p.ph_hi = hi;
    if (hipMemsetAsync(p.ws + WS_CTL, 0, 16384, stream) != hipSuccess) { fprintf(stderr, "hipMemsetAsync of the barrier words failed\n"); return; }
    void* args[] = {&p};
    const hipError_t e = hipLaunchCooperativeKernel((const void*)mk_fwd, dim3(g_grid), dim3(NT), args, LDS_BYTES, stream);
    if (e != hipSuccess) fprintf(stderr, "cooperative launch failed: %s (grid %d)\n", hipGetErrorString(e), g_grid);
}
}

extern "C" void kernel_launch(void* const* d_in, const int* in_sizes, int n_in, void* d_out, int out_size, void* d_ws, size_t ws_size, hipStream_t stream) {
    using namespace mk;
    if (n_in != 15 || out_size != T * D) { fprintf(stderr, "kernel_launch: unexpected problem shape\n"); return; }
    if (!init_grid(ws_size)) return;
    Params p = make_params(d_in, d_out, d_ws);
    launch(p, 0, NPHASE, stream);
}
```

```cpp
#include <hip/hip_runtime.h>
#include <hip/hip_cooperative_groups.h>
#include <cstdio>
#include <cstdint>
#include <cmath>
namespace pg8 {
#define PG8_LAS __attribute__((address_space(3)))
typedef unsigned short bf16_t;
typedef _Float16 bf16x8 __attribute__((ext_vector_type(8)));
typedef float f32x4 __attribute__((ext_vector_type(4)));
typedef unsigned u32x4 __attribute__((ext_vector_type(4)));
constexpr int BM = 256, BK = 64, HALF = 128, HTB = HALF * BK * 2  , STAGE_BYTES = 8 * HTB, NXCD = 8, WGM = 8;

__host__ __device__ __forceinline__ int lds_byte(int r, int c) { const int st = (r >> 4) * 2 + (c >> 5), rr = r & 15, cc = c & 31, ob = rr * 64 + cc * 2; return st * 1024 + (ob ^ (((ob >> 9) & 1) << 5)); }
__host__ __device__ __forceinline__ void stage_rc(int b, int& R, int& C) { const int st = b / 1024, sb = b % 1024, swz = sb ^ (((sb >> 9) & 1) << 5); R = (st >> 1) * 16 + swz / 64; C = (st & 1) * 32 + (swz % 64) / 2; }
__host__ __device__ __forceinline__ int perm32(int rho) { const int n = rho >> 4, i = rho & 15; return 8 * (i >> 2) + 4 * n + (i & 3); }

struct Unit { int pm, pn; };
struct Gemm { const bf16_t* A; const bf16_t* Bt; int M, N, K; };

struct StaticOrder {
    int nM, nN, nwg, G, c, wgm;
    __host__ __device__ void init(int M, int N, int G_, int c_, int wgm_ = WGM) { nM = M / BM; nN = N / BM; nwg = nM * nN; G = G_; c = c_; wgm = wgm_; }
    __host__ __device__ bool next(int i, Unit& u) const {
        const long L = (long)i * G + c; if (L >= nwg) return false;
        int wgid = (int)L; { const int q = nwg / NXCD, r = nwg % NXCD, xcd = wgid % NXCD, off = wgid / NXCD; wgid = (xcd < r ? xcd * (q + 1) : r * (q + 1) + (xcd - r) * q) + off; }
        const int nig = wgm * nN, gid = wgid / nig, fm = gid * wgm, gsz = (nM - fm) < wgm ? (nM - fm) : wgm;
        u.pm = fm + ((wgid % nig) % gsz); u.pn = (wgid % nig) / gsz; return true;
    }
    __device__ __forceinline__ void a_ready(const Unit&) const {}
    __device__ __forceinline__ void done(const Unit&) const {}
};
template <class Epi, class Sched>
__device__ __forceinline__ void gemm_phase(PG8_LAS unsigned char* lds, const Gemm g, const Sched& S, const Epi& E) {
    const int tid = threadIdx.x, wid = __builtin_amdgcn_readfirstlane(tid >> 6), lane = tid & 63, wr = wid >> 2, wc = wid & 3, fr = lane & 15, fq = lane >> 4;
    const int K = g.K, nt = K / BK;
    unsigned voffA[2], voffB[2];
#pragma unroll
    for (int i = 0; i < 2; ++i) { int R, C; stage_rc(tid * 16 + i * 8192, R, C); const int Rb = Epi::PERM ? ((R & ~31) + perm32(R & 31)) : R;
        voffA[i] = (unsigned)(R * K + C) * 2u; voffB[i] = (unsigned)(Rb * K + C) * 2u; }
    const size_t kstep = (size_t)(BK * 2);
    const size_t hstep = (size_t)HALF * K * 2;
    const size_t tstep = 2 * hstep;
    const unsigned ldsw = (unsigned)wid * 1024u;
    const int aoff = lds_byte(wr * 64 + fr, fq * 8), boff = lds_byte(wc * 32 + fr, fq * 8);
#define PG8_SA(b, h) (((b) * 2 + (h)) * HTB)
#define PG8_SB(b, h) ((4 + (b) * 2 + (h)) * HTB)
#define PG8_STAGE(bufoff, gbase, voff) do { _Pragma("unroll") for (int _i = 0; _i < 2; ++_i) \
        __builtin_amdgcn_global_load_lds((const unsigned*)((const char*)(gbase) + (voff)[_i]), (PG8_LAS unsigned*)(lds + (bufoff) + ldsw + _i * 8192), 16, 0, 0); } while (0)
#define PG8_LDA(dst, b, h) do { _Pragma("unroll") for (int m = 0; m < 4; ++m) _Pragma("unroll") for (int k = 0; k < 2; ++k) dst[m][k] = *(const PG8_LAS bf16x8*)(lds + PG8_SA(b, h) + aoff + m * 2048 + k * 1024); } while (0)
#define PG8_LDB(dst, b, h) do { _Pragma("unroll") for (int n = 0; n < 2; ++n) _Pragma("unroll") for (int k = 0; k < 2; ++k) dst[n][k] = *(const PG8_LAS bf16x8*)(lds + PG8_SB(b, h) + boff + n * 2048 + k * 1024); } while (0)
#define PG8_MMA(ai, bj, At, Bt) do { __builtin_amdgcn_s_setprio(1); _Pragma("unroll") for (int m = 0; m < 4; ++m) _Pragma("unroll") for (int n = 0; n < 2; ++n) _Pragma("unroll") for (int k = 0; k < 2; ++k) \
        acc[ai][bj][m][n] = __builtin_amdgcn_mfma_f32_16x16x32_f16(Bt[n][k], At[m][k], acc[ai][bj][m][n], 0, 0, 0); __builtin_amdgcn_s_setprio(0); } while (0)
#define PG8_WAIT_V(n) asm volatile("s_waitcnt vmcnt(" #n ")" ::: "memory")
#define PG8_WAIT_L(n) asm volatile("s_waitcnt lgkmcnt(" #n ")" ::: "memory")
#define PG8_BAR __builtin_amdgcn_s_barrier()
#define PG8_SCHED __builtin_amdgcn_sched_barrier(0)
    Unit cur, nxt; int ui = 0;
    if (!S.next(0, cur)) return;
    f32x4 acc[2][2][4][2];
#pragma unroll
    for (int a = 0; a < 2; ++a)
#pragma unroll
        for (int b = 0; b < 2; ++b)
#pragma unroll
            for (int m = 0; m < 4; ++m)
#pragma unroll
                for (int n = 0; n < 2; ++n) acc[a][b][m][n] = (f32x4){0.f, 0.f, 0.f, 0.f};
    bf16x8 At[4][2], B0[2][2], B1[2][2];
    const char* cA = (const char*)g.A + (size_t)cur.pm * tstep; const char* cB = (const char*)g.Bt + (size_t)cur.pn * tstep;
    S.a_ready(cur);
    PG8_STAGE(PG8_SB(0, 0), cB, voffB); PG8_STAGE(PG8_SA(0, 0), cA, voffA); PG8_STAGE(PG8_SB(0, 1), cB + hstep, voffB); PG8_STAGE(PG8_SA(0, 1), cA + hstep, voffA);
    if (wr == 1) PG8_BAR;
    PG8_WAIT_V(4); PG8_BAR;
    PG8_STAGE(PG8_SB(1, 0), cB + kstep, voffB); PG8_STAGE(PG8_SA(1, 0), cA + kstep, voffA); PG8_STAGE(PG8_SB(1, 1), cB + hstep + kstep, voffB);
    PG8_WAIT_V(6); PG8_BAR;
    for (;;) {
        const bool has_next = S.next(ui + 1, nxt);
        const char* nA = has_next ? (const char*)g.A + (size_t)nxt.pm * tstep : cA; const char* nB = has_next ? (const char*)g.Bt + (size_t)nxt.pn * tstep : cB;
        for (int t = 0; t < nt; t += 2) {
            const bool last = (t == nt - 2);
            const char* a1 = cA + (size_t)(t + 1) * kstep;
            const char* a2 = last ? nA : cA + (size_t)(t + 2) * kstep; const char* b2 = last ? nB : cB + (size_t)(t + 2) * kstep;
            const char* a3 = a2 + kstep; const char* b3 = b2 + kstep;
            if (last && has_next) S.a_ready(nxt);
            PG8_LDB(B0, 0, 0); PG8_SCHED; PG8_LDA(At, 0, 0); PG8_STAGE(PG8_SA(1, 1), a1 + hstep, voffA);
            PG8_WAIT_L(8); PG8_BAR; PG8_WAIT_L(0); PG8_MMA(0, 0, At, B0); PG8_BAR; PG8_SCHED;
            PG8_LDB(B1, 0, 1); PG8_STAGE(PG8_SB(0, 0), b2, voffB);
            PG8_BAR; PG8_WAIT_L(0); PG8_MMA(0, 1, At, B1); PG8_BAR;
            PG8_LDA(At, 0, 1); PG8_STAGE(PG8_SA(0, 0), a2, voffA);
            PG8_BAR; PG8_WAIT_L(0); PG8_MMA(1, 0, At, B0); PG8_BAR; PG8_SCHED;
            PG8_STAGE(PG8_SB(0, 1), b2 + hstep, voffB);
            PG8_WAIT_V(6); PG8_BAR; PG8_MMA(1, 1, At, B1); PG8_BAR;
            PG8_LDB(B0, 1, 0); PG8_SCHED; PG8_LDA(At, 1, 0); PG8_STAGE(PG8_SA(0, 1), a2 + hstep, voffA);
            PG8_WAIT_L(8); PG8_BAR; PG8_WAIT_L(0); PG8_MMA(0, 0, At, B0); PG8_BAR; PG8_SCHED;
            PG8_LDB(B1, 1, 1); PG8_STAGE(PG8_SB(1, 0), b3, voffB);
            PG8_BAR; PG8_WAIT_L(0); PG8_MMA(0, 1, At, B1); PG8_BAR;
            PG8_LDA(At, 1, 1); PG8_STAGE(PG8_SA(1, 0), a3, voffA);
            PG8_BAR; PG8_WAIT_L(0); PG8_MMA(1, 0, At, B0); PG8_BAR; PG8_SCHED;
            PG8_STAGE(PG8_SB(1, 1), b3 + hstep, voffB);
            PG8_WAIT_V(6); PG8_BAR; PG8_MMA(1, 1, At, B1); PG8_BAR;
        }
        if constexpr (!Epi::AFTER_DRAIN) { E(acc, cur, wr, wc, fr, fq); S.done(cur); }
        if (!has_next) break;
#pragma unroll
        for (int a = 0; a < 2; ++a)
#pragma unroll
            for (int b = 0; b < 2; ++b)
#pragma unroll
                for (int m = 0; m < 4; ++m)
#pragma unroll
                    for (int n = 0; n < 2; ++n) acc[a][b][m][n] = (f32x4){0.f, 0.f, 0.f, 0.f};
        cur = nxt; cA = nA; cB = nB; ++ui;
    }
    PG8_WAIT_V(0);
    if (wr == 0) PG8_BAR;
    PG8_BAR;
    if constexpr (Epi::AFTER_DRAIN) { E.fused(acc, cur, wr, wc, fr, fq, lds, wid, lane); S.done(cur); }
#undef PG8_SA
#undef PG8_SB
#undef PG8_STAGE
#undef PG8_LDA
#undef PG8_LDB
#undef PG8_MMA
#undef PG8_WAIT_V
#undef PG8_WAIT_L
#undef PG8_BAR
#undef PG8_SCHED
}
}
namespace mk {
#define LAS __attribute__((address_space(3)))
using pg8::f32x4; using pg8::u32x4; using pg8::Unit;
typedef float f32x2 __attribute__((ext_vector_type(2)));
typedef float f32x16 __attribute__((ext_vector_type(16)));
typedef _Float16 h2v __attribute__((ext_vector_type(2)));
typedef _Float16 f16x8 __attribute__((ext_vector_type(8)));
typedef _Float16 f16x4 __attribute__((ext_vector_type(4)));
typedef short bf16x8 __attribute__((ext_vector_type(8)));
typedef unsigned u32x2 __attribute__((ext_vector_type(2)));
typedef unsigned short u16;

constexpr int NWAVES = 8, NT = 512;
constexpr int D = 1024, NB = 8, L = 8192, T = NB * L, DIN = 3672, DFF = 2816;
constexpr int PJ = 3584;
constexpr int CQ = 0, CK = 512, CV = 1024, CQI = 1536, CGQ = 2048, CGK = 2304, CGV = 2560, CGO = 3072;
constexpr float EPS = 1e-6f;
constexpr float IDX_SCALE = 0.35355339059327373f * 0.125f;
constexpr size_t MiB = 1u << 20;
constexpr size_t WS_CTL = 0, WS_MOD = 1 * MiB, WS_WIN = 2 * MiB, WS_WOUT = 10 * MiB, WS_WGU = 12 * MiB, WS_WDN = 23 * MiB;
constexpr size_t WS_SS1 = 29 * MiB, WS_SS2 = 33 * MiB, WS_KIDX = 37 * MiB, WS_WIDX = 45 * MiB, WS_GLR = 47 * MiB, WS_THR = 51 * MiB;
constexpr size_t WS_H = 64 * MiB, WS_CAT = 192 * MiB, WS_PROJ = 320 * MiB, WS_ACT = 320 * MiB, WS_GLAS = 768 * MiB, WS_VT = 896 * MiB, WS_KF = 960 * MiB, WS_END = 1024 * MiB;
constexpr int LDS_BYTES = 163840;

struct Params {
    const float *x, *c, *w_mod, *b_mod, *norm1_g, *w_in, *w_gate2, *b_gate2, *att_g, *gla_g, *w_out, *norm2_g, *w_gu, *w_down, *final_g;
    float* out; unsigned char* ws; int ph_lo, ph_hi;
};

__device__ __forceinline__ unsigned pkh(float a, float b) { const h2v h = __builtin_convertvector((f32x2){a, b}, h2v); return __builtin_bit_cast(unsigned, h); }
__device__ __forceinline__ float silu_f(float v) { return v * __builtin_amdgcn_rcpf(1.f + __expf(-v)); }
__device__ __forceinline__ float wave_sum(float v) {
#pragma unroll
    for (int o = 1; o < 64; o <<= 1) v += __shfl_xor(v, o);
    return v;
}
__device__ __forceinline__ float rows_sum(float s) {
    { const unsigned u = __builtin_bit_cast(unsigned, s); const auto r = __builtin_amdgcn_permlane16_swap(u, u, false, false); const unsigned a = r[0], b = r[1]; s = __builtin_bit_cast(float, a) + __builtin_bit_cast(float, b); }
    { const unsigned u = __builtin_bit_cast(unsigned, s); const auto r = __builtin_amdgcn_permlane32_swap(u, u, false, false); const unsigned a = r[0], b = r[1]; s = __builtin_bit_cast(float, a) + __builtin_bit_cast(float, b); }
    return s;
}
#define LDS_WAIT() asm volatile("s_waitcnt lgkmcnt(0)" ::: "memory")

struct MapIn { __device__ __forceinline__ int operator()(int n) const {
    if (n < 2048) return n; if (n < 3584) return n + 72; if (n < 3648) return 2048 + (n - 3584); if (n < 3656) return 2112 + (n - 3648); if (n < 3672) return n; return -1; } };
struct MapGU { __device__ __forceinline__ int operator()(int n) const { const int pn = n >> 8, r = n & 255; return r < 128 ? 128 * pn + r : DFF + 128 * pn + (r - 128); } };
struct MapId { __device__ __forceinline__ int operator()(int n) const { return n; } };

template <class Map>
__device__ __forceinline__ void transpose_item(const float* __restrict__ W, int K, int Nsrc, u16* __restrict__ WT, int nblk, LAS float* scr, int item, int lane, Map map) {
    const int kb = item / nblk, nb = item % nblk, k0 = 64 * kb, n0 = 32 * nb;
    const int sc = map(n0 + (lane & 31));
#pragma unroll 8
    for (int i = 0; i < 32; ++i) { const int kk = 2 * i + (lane >> 5); scr[kk * 33 + (lane & 31)] = sc >= 0 ? W[(size_t)(k0 + kk) * Nsrc + sc] : 0.f; }
    LDS_WAIT(); asm volatile("" ::: "memory");
    const int c = lane & 7;
#pragma unroll
    for (int j = 0; j < 4; ++j) { const int n = (lane >> 3) + 8 * j; const LAS float* s = scr + (8 * c) * 33 + n;
        u32x4 o; o.x = pkh(s[0 * 33], s[1 * 33]); o.y = pkh(s[2 * 33], s[3 * 33]); o.z = pkh(s[4 * 33], s[5 * 33]); o.w = pkh(s[6 * 33], s[7 * 33]);
        *(u32x4*)(WT + (size_t)(n0 + n) * K + k0 + 8 * c) = o; }
    LDS_WAIT(); asm volatile("" ::: "memory");
}

__device__ __forceinline__ void phase_p0a(const Params& p, LAS unsigned char* lds, int wave, int lane) {
    LAS float* sct = (LAS float*)(lds + 98304);
    for (int i = threadIdx.x; i < NB * D; i += NT) { const float cv = p.c[i]; sct[i] = cv / (1.f + expf(-cv)); }
    __syncthreads();
    const int gw = blockIdx.x * NWAVES + wave, NGW = gridDim.x * NWAVES;
    float* mod = (float*)(p.ws + WS_MOD);
    for (int it = gw; it < 6 * D / 16; it += NGW) {
        const int j = it * 16 + (lane & 15), kq = lane >> 4;
        float acc[NB];
#pragma unroll
        for (int b = 0; b < NB; ++b) acc[b] = 0.f;
#pragma unroll 4
        for (int k4 = 0; k4 < D / 4; ++k4) { const int k = 4 * k4 + kq; const float w = p.w_mod[(size_t)k * (6 * D) + j];
#pragma unroll
            for (int b = 0; b < NB; ++b) acc[b] += sct[b * D + k] * w; }
#pragma unroll
        for (int b = 0; b < NB; ++b) acc[b] = rows_sum(acc[b]);
        if (lane < 16) { const float bm = p.b_mod[j];
#pragma unroll
            for (int b = 0; b < NB; ++b) mod[b * 6 * D + j] = acc[b] + bm; }
    }
    LAS float* scr = (LAS float*)(lds + wave * 8704);
    constexpr int I_IN = (D / 64) * (3840 / 32), I_OUT = (D / 64) * (D / 32), I_GU = (D / 64) * (2 * DFF / 32), I_DN = (DFF / 64) * (D / 32);
    constexpr int NITEMS = I_IN + I_OUT + I_GU + I_DN;
    for (int it = gw; it < NITEMS; it += NGW) {
        int r = it;
        if (r < I_IN) { transpose_item(p.w_in, D, DIN, (u16*)(p.ws + WS_WIN), 3840 / 32, scr, r, lane, MapIn()); continue; } r -= I_IN;
        if (r < I_OUT) { transpose_item(p.w_out, D, D, (u16*)(p.ws + WS_WOUT), D / 32, scr, r, lane, MapId()); continue; } r -= I_OUT;
        if (r < I_GU) { transpose_item(p.w_gu, D, 2 * DFF, (u16*)(p.ws + WS_WGU), 2 * DFF / 32, scr, r, lane, MapGU()); continue; } r -= I_GU;
        transpose_item(p.w_down, DFF, D, (u16*)(p.ws + WS_WDN), D / 32, scr, r, lane, MapId());
    }
}

template <int MODE>
__device__ __forceinline__ void row_phase(const void* xin, const float* __restrict__ g, const float* __restrict__ mod, int sh_off, int sc_off, const float* __restrict__ ss, void* outp, int wave, int lane) {
    const int gw = blockIdx.x * NWAVES + wave, NGW = gridDim.x * NWAVES;
    f32x4 gv[4];
#pragma unroll
    for (int j = 0; j < 4; ++j) gv[j] = ((const f32x4*)g)[lane + 64 * j];
    auto load = [&](f32x4 (&v)[4], int m) __attribute__((always_inline)) {
        if (MODE == 0) { const f32x4* xr = (const f32x4*)((const float*)xin + (size_t)m * D) + lane;
#pragma unroll
            for (int j = 0; j < 4; ++j) v[j] = __builtin_nontemporal_load(xr + 64 * j); }
        else { const u32x2* xr = (const u32x2*)((const u16*)xin + (size_t)m * D) + lane;
#pragma unroll
            for (int j = 0; j < 4; ++j) { const u32x2 w = xr[64 * j]; const unsigned wx = w.x, wy = w.y; const h2v a = __builtin_bit_cast(h2v, wx), b = __builtin_bit_cast(h2v, wy); v[j] = (f32x4){(float)a[0], (float)a[1], (float)b[0], (float)b[1]}; } }
    };
    auto finish = [&](f32x4 (&v)[4], int m) __attribute__((always_inline)) {
        float tot;
        if (MODE == 0) { float s = 0.f;
#pragma unroll
            for (int j = 0; j < 4; ++j) s += (v[j].x * v[j].x + v[j].y * v[j].y) + (v[j].z * v[j].z + v[j].w * v[j].w);
            tot = wave_sum(s); }
        else { const f32x4* sp = (const f32x4*)(ss + (size_t)m * 16); const f32x4 a = sp[0], b = sp[1], c = sp[2], d = sp[3];
            tot = ((a.x + a.y) + (a.z + a.w)) + ((b.x + b.y) + (b.z + b.w)) + ((c.x + c.y) + (c.z + c.w)) + ((d.x + d.y) + (d.z + d.w)); }
        const float rstd = rsqrtf(tot * (1.f / D) + EPS);
        if (MODE == 2) { f32x4* o = (f32x4*)((float*)outp + (size_t)m * D) + lane;
#pragma unroll
            for (int j = 0; j < 4; ++j) __builtin_nontemporal_store(v[j] * rstd * gv[j], o + 64 * j); }
        else { const float* mb = mod + (m >> 13) * (6 * D);
            u32x2* o = (u32x2*)((u16*)outp + (size_t)m * D) + lane;
#pragma unroll
            for (int j = 0; j < 4; ++j) { const f32x4 sc = ((const f32x4*)(mb + sc_off))[lane + 64 * j], sh = ((const f32x4*)(mb + sh_off))[lane + 64 * j];
                const f32x4 r = v[j] * rstd * gv[j] * (sc + 1.f) + sh; u32x2 w; w.x = pkh(r.x, r.y); w.y = pkh(r.z, r.w); o[64 * j] = w; } }
    };
    for (int m = gw; m < T; m += 2 * NGW) {
        f32x4 va[4], vb[4];
        load(va, m); const bool two = m + NGW < T; if (two) load(vb, m + NGW);
        finish(va, m); if (two) finish(vb, m + NGW);
    }
}

struct EpiProj {
    static constexpr bool PERM = true, AFTER_DRAIN = false;
    u16* P; u16* kidx; float* widx; float* glr; u16* kf;
    __device__ __forceinline__ void operator()(const f32x4 (&acc)[2][2][4][2], const Unit& u, int wr, int wc, int fr, int fq) const {
        const int row0 = u.pm * 256 + wr * 64 + fr;
        if (u.pn < 14) {
            const int col0 = u.pn * 256 + wc * 32 + 8 * fq;
#pragma unroll
            for (int ai = 0; ai < 2; ++ai)
#pragma unroll
                for (int m = 0; m < 4; ++m) { u16* rowp = P + (size_t)(row0 + ai * 128 + m * 16) * PJ + col0;
#pragma unroll
                    for (int bj = 0; bj < 2; ++bj) { const f32x4 v0 = acc[ai][bj][m][0], v1 = acc[ai][bj][m][1];
                        u32x4 w; w.x = pkh(v0[0], v0[1]); w.y = pkh(v0[2], v0[3]); w.z = pkh(v1[0], v1[1]); w.w = pkh(v1[2], v1[3]);
                        if (u.pn == 2 || u.pn == 3) {
                            const int row = row0 + ai * 128 + m * 16, hd = 2 * (u.pn - 2) + bj, bb = row >> 13, kt = (row & 8191) >> 5;
                            __builtin_nontemporal_store(w, (u32x4*)(kf + ((((size_t)(bb * 4 + hd) * 256 + kt) * 8 + 2 * wc + (fq >> 1)) * 64 + (fq & 1) * 32 + (row & 31)) * 8)); }
                        else __builtin_nontemporal_store(w, (u32x4*)(rowp + bj * 128)); } }
        } else {
#pragma unroll
            for (int ai = 0; ai < 2; ++ai)
#pragma unroll
                for (int m = 0; m < 4; ++m) { const size_t row = (size_t)(row0 + ai * 128 + m * 16); const f32x4 v0 = acc[ai][0][m][0], v1 = acc[ai][0][m][1];
                    if (wc < 2) { u32x4 w; w.x = pkh(v0[0], v0[1]); w.y = pkh(v0[2], v0[3]); w.z = pkh(v1[0], v1[1]); w.w = pkh(v1[2], v1[3]);
                        *(u32x4*)(kidx + (((row >> 5) * 4 + 2 * wc + (fq >> 1)) * 64 + (fq & 1) * 32 + (row & 31)) * 8) = w; }
                    else if (wc == 2) {
                        if (fq == 0) { *(f32x4*)(widx + row * 8) = v0 * IDX_SCALE; *(f32x4*)(widx + row * 8 + 4) = v1 * IDX_SCALE; }
                        else if (fq < 3) { *(f32x4*)(glr + row * 16 + (fq - 1) * 8) = v0; *(f32x4*)(glr + row * 16 + (fq - 1) * 8 + 4) = v1; } } }
        }
    }
};
template <bool BASE_HALF>
struct EpiRes {
    static constexpr bool PERM = false, AFTER_DRAIN = false;
    const void* base; u16* out; const float* mod; float* ss; int gate_off; int pad;
    __device__ __forceinline__ void operator()(const f32x4 (&acc)[2][2][4][2], const Unit& u, int wr, int wc, int fr, int fq) const {
        const int row0 = u.pm * 256 + wr * 64 + fr, col0 = u.pn * 256 + wc * 32 + 4 * fq;
        const float* g = mod + (u.pm >> 5) * (6 * D) + gate_off;
        f32x4 gv[2][2];
#pragma unroll
        for (int bj = 0; bj < 2; ++bj)
#pragma unroll
            for (int n = 0; n < 2; ++n) gv[bj][n] = *(const f32x4*)(g + col0 + bj * 128 + n * 16);
#pragma unroll
        for (int ai = 0; ai < 2; ++ai) {
            f32x4 bsf[4][2][2]; u32x2 bsh[4][2][2];
#pragma unroll
            for (int m = 0; m < 4; ++m)
#pragma unroll
                for (int bj = 0; bj < 2; ++bj)
#pragma unroll
                    for (int n = 0; n < 2; ++n) { const size_t off = (size_t)(row0 + ai * 128 + m * 16) * D + col0 + bj * 128 + n * 16;
                        if (BASE_HALF) bsh[m][bj][n] = *(const u32x2*)((const u16*)base + off);
                        else bsf[m][bj][n] = __builtin_nontemporal_load((const f32x4*)((const float*)base + off)); }
#pragma unroll
            for (int m = 0; m < 4; ++m) { const size_t row = (size_t)(row0 + ai * 128 + m * 16); float s = 0.f;
#pragma unroll
                for (int bj = 0; bj < 2; ++bj)
#pragma unroll
                    for (int n = 0; n < 2; ++n) { const size_t off = row * D + col0 + bj * 128 + n * 16; f32x4 bs;
                        if (BASE_HALF) { const u32x2 wi = bsh[m][bj][n]; const unsigned wx = wi.x, wy = wi.y;        const h2v a = __builtin_bit_cast(h2v, wx), b = __builtin_bit_cast(h2v, wy); bs = (f32x4){(float)a[0], (float)a[1], (float)b[0], (float)b[1]}; }
                        else bs = bsf[m][bj][n];
                        const f32x4 o = bs + gv[bj][n] * acc[ai][bj][m][n]; u32x2 w; w.x = pkh(o[0], o[1]); w.y = pkh(o[2], o[3]); *(u32x2*)(out + off) = w;
                        s += (o[0] * o[0] + o[1] * o[1]) + (o[2] * o[2] + o[3] * o[3]); }
                s = rows_sum(s);
                if (fq == 0) ss[row * 16 + u.pn * 4 + wc] = s; } }
    }
};
struct EpiSwiGLU {
    static constexpr bool PERM = true, AFTER_DRAIN = false;
    u16* act;
    __device__ __forceinline__ void operator()(const f32x4 (&acc)[2][2][4][2], const Unit& u, int wr, int wc, int fr, int fq) const {
        const int row0 = u.pm * 256 + wr * 64 + fr, col0 = u.pn * 128 + wc * 32 + 8 * fq;
#pragma unroll
        for (int ai = 0; ai < 2; ++ai)
#pragma unroll
            for (int m = 0; m < 4; ++m) { const f32x4 g0 = acc[ai][0][m][0], g1 = acc[ai][0][m][1], u0 = acc[ai][1][m][0], u1 = acc[ai][1][m][1];
                float a[8];
#pragma unroll
                for (int j = 0; j < 4; ++j) { a[j] = silu_f(g0[j]) * u0[j]; a[4 + j] = silu_f(g1[j]) * u1[j]; }
                u32x4 w; w.x = pkh(a[0], a[1]); w.y = pkh(a[2], a[3]); w.z = pkh(a[4], a[5]); w.w = pkh(a[6], a[7]);
                __builtin_nontemporal_store(w, (u32x4*)(act + (size_t)(row0 + ai * 128 + m * 16) * DFF + col0)); }
    }
};
}
#define MK_HAVE_MIX 1
namespace mk {
constexpr size_t WS_GDEC = 52 * MiB;
constexpr size_t WS_SELM = WS_H + 64 * MiB;
constexpr size_t WS_X16 = WS_GLAS;
constexpr size_t WS_S16 = WS_H;
constexpr int NCH = L / 64;

__device__ __forceinline__ unsigned f2bf(float f) { unsigned u = __builtin_bit_cast(unsigned, f); return (u + 0x7fffu + ((u >> 16) & 1u)) >> 16; }
__device__ __forceinline__ unsigned pkbf(float lo, float hi) { return f2bf(lo) | (f2bf(hi) << 16); }
__device__ __forceinline__ float h2f(u16 h) { return (float)__builtin_bit_cast(_Float16, h); }
__device__ __forceinline__ float hlo(unsigned w) { return h2f((u16)(w & 0xffffu)); }
__device__ __forceinline__ float hhi(unsigned w) { return h2f((u16)(w >> 16)); }
__device__ __forceinline__ int kperm16(int o) { return 8 * ((o >> 2) & 1) + 4 * (o >> 3) + (o & 3); }

__device__ __forceinline__ void vt_item(const Params& p, LAS unsigned char* scr  , int item, int lane) {
    const int tb = item & 255, h = (item >> 8) & 3, b = item >> 10, t0 = tb * 32;
    const u16* src = (const u16*)(p.ws + WS_PROJ) + (size_t)(b * L + t0) * PJ + CV + h * 128;
#pragma unroll
    for (int i = 0; i < 8; ++i) { const int r = 4 * i + (lane >> 4), ch = lane & 15; const u32x4 v = *(const u32x4*)(src + (size_t)r * PJ + ch * 8);
        LAS unsigned* d = (LAS unsigned*)(scr + r * 264 + ch * 16); d[0] = v.x; d[1] = v.y; d[2] = v.z; d[3] = v.w; }
    LDS_WAIT(); asm volatile("" ::: "memory");
    u16* dst = (u16*)(p.ws + WS_VT) + ((size_t)(b * 4 + h) * 256 + tb) * 4096;
#pragma unroll
    for (int i = 0; i < 8; ++i) { const int c = i * 64 + lane, dv = c & 127, tg = c >> 7;
        unsigned w[4];
#pragma unroll
        for (int jp = 0; jp < 4; ++jp) { const int j = 2 * jp, tok = 16 * (tg >> 1) + 8 * (j >> 2) + 4 * (tg & 1) + (j & 3);
            const unsigned lo = *(LAS u16*)(scr + tok * 264 + dv * 2), hi = *(LAS u16*)(scr + (tok + 1) * 264 + dv * 2); w[jp] = lo | (hi << 16); }
        u32x4 o; o.x = w[0]; o.y = w[1]; o.z = w[2]; o.w = w[3];
        *(u32x4*)(dst + ((((dv >> 5) * 2 + (tg >> 1)) * 2 + (tg & 1)) * 32 + (dv & 31)) * 8) = o; }
    LDS_WAIT(); asm volatile("" ::: "memory");
}

constexpr int GL_SEG = 106496;
constexpr int GL_GLR = 0, GL_WG = 4096, GL_BG = 8192, GL_BC = 8448, GL_QD = 25088, GL_KD = 34304, GL_QP = 43520, GL_VT = 52736, GL_SSQ = 71168, GL_OST = 72192, GL_END = 105984;
constexpr int GST = 72;
__device__ __forceinline__ void gla_bcum(const Params& p, LAS unsigned char* lds, int b, int h, int c) {
    const int tid = threadIdx.x;
    LAS float* glr = (LAS float*)(lds + GL_GLR); LAS float* wg = (LAS float*)(lds + GL_WG); LAS float* bg = (LAS float*)(lds + GL_BG); LAS float* bc = (LAS float*)(lds + GL_BC);
    const float* gsrc = (const float*)(p.ws + WS_GLR) + (size_t)(b * L + c * 64) * 16;
    for (int i = tid; i < 1024; i += NT) { glr[i] = gsrc[i]; wg[i] = p.w_gate2[(i >> 6) * 256 + h * 64 + (i & 63)]; }
    if (tid < 64) bg[tid] = p.b_gate2[h * 64 + tid];
    __syncthreads();
    { const int dk = tid & 63; float wr[16];
#pragma unroll
      for (int r = 0; r < 16; ++r) wr[r] = wg[r * 64 + dk];
      const float bias = bg[dk];
#pragma unroll
      for (int i = 0; i < 8; ++i) { const int t = (tid >> 6) + 8 * i; float z = bias;
#pragma unroll
          for (int r4 = 0; r4 < 4; ++r4) { const f32x4 gq = *(const LAS f32x4*)(glr + t * 16 + 4 * r4); z += gq[0] * wr[4 * r4] + gq[1] * wr[4 * r4 + 1] + gq[2] * wr[4 * r4 + 2] + gq[3] * wr[4 * r4 + 3]; }
          bc[t * 65 + dk] = (fminf(z, 0.f) - __logf(1.f + __expf(-fabsf(z)))) * (1.f / 16.f); } }
    __syncthreads();
    { const int dk = tid & 63, sg = tid >> 6; LAS float* segt = (LAS float*)(lds + GL_SEG);
      float v[8], run = 0.f;
#pragma unroll
      for (int i = 0; i < 8; ++i) { run += bc[(sg * 8 + i) * 65 + dk]; v[i] = run; }
      segt[sg * 64 + dk] = run;
      __syncthreads();
      float off = 0.f;
#pragma unroll
      for (int j = 0; j < 7; ++j) off += (j < sg) ? segt[j * 64 + dk] : 0.f;
#pragma unroll
      for (int i = 0; i < 8; ++i) bc[(sg * 8 + i) * 65 + dk] = v[i] + off; }
    __syncthreads();
}

__device__ __forceinline__ void gla1_item(const Params& p, LAS unsigned char* lds, int item, int wave, int lane) {
    const int tid = threadIdx.x, c = item & (NCH - 1), h = (item >> 7) & 3, b = item >> 9;
    const u16* prow = (const u16*)(p.ws + WS_PROJ) + (size_t)(b * L + c * 64) * PJ;
    unsigned kw0[4], kw1[4], vw0[8], vw1[8];
#pragma unroll
    for (int i = 0; i < 4; ++i) { const int idx = tid + NT * i, dk = idx & 63, t = 2 * (idx >> 6);
        kw0[i] = prow[(size_t)t * PJ + CGK + h * 64 + dk]; kw1[i] = prow[(size_t)(t + 1) * PJ + CGK + h * 64 + dk]; }
#pragma unroll
    for (int i = 0; i < 8; ++i) { const int idx = tid + NT * i, dv = idx & 127, t = 2 * (idx >> 7);
        vw0[i] = prow[(size_t)t * PJ + CGV + h * 128 + dv]; vw1[i] = prow[(size_t)(t + 1) * PJ + CGV + h * 128 + dv]; }
    gla_bcum(p, lds, b, h, c);
    LAS float* bc = (LAS float*)(lds + GL_BC); LAS u16* KT = (LAS u16*)(lds + GL_KD); LAS u16* VTl = (LAS u16*)(lds + GL_VT);
#pragma unroll
    for (int i = 0; i < 4; ++i) { const int idx = tid + NT * i, dk = idx & 63, t = 2 * (idx >> 6); const float bl = bc[63 * 65 + dk];
        const float k0 = h2f((u16)kw0[i]) * __expf(bl - bc[t * 65 + dk]), k1 = h2f((u16)kw1[i]) * __expf(bl - bc[(t + 1) * 65 + dk]);
        *(LAS unsigned*)(KT + dk * GST + t) = pkh(k0, k1); }
#pragma unroll
    for (int i = 0; i < 8; ++i) { const int idx = tid + NT * i, dv = idx & 127, t = 2 * (idx >> 7);
        *(LAS unsigned*)(VTl + dv * GST + t) = vw0[i] | (vw1[i] << 16); }
    if (tid < 64) ((float*)(p.ws + WS_GDEC))[(size_t)item * 64 + tid] = __expf(bc[63 * 65 + tid]);
#pragma unroll
    for (int i = 0; i < 8; ++i) { const int idx = tid + NT * i, t = idx >> 6, dk = idx & 63;
        ((float*)((u16*)(p.ws + WS_PROJ) + (size_t)(b * L + c * 64 + t) * PJ + CK + h * 128))[dk] = bc[t * 65 + dk]; }
    __syncthreads();
    const int mbv = wave >> 1, nbk = wave & 1, hh = lane >> 5, l31 = lane & 31;
    f32x16 acc;
#pragma unroll
    for (int i = 0; i < 16; ++i) acc[i] = 0.f;
#pragma unroll
    for (int s = 0; s < 4; ++s) { const f16x8 a = *(const LAS f16x8*)(VTl + (mbv * 32 + l31) * GST + 16 * s + 8 * hh), bb = *(const LAS f16x8*)(KT + (nbk * 32 + l31) * GST + 16 * s + 8 * hh);
        acc = __builtin_amdgcn_mfma_f32_32x32x16_f16(a, bb, acc, 0, 0, 0); }
    float* dst = (float*)(p.ws + WS_GLAS) + (size_t)item * 8192;
#pragma unroll
    for (int i = 0; i < 16; ++i) { const int dv = mbv * 32 + (i & 3) + 8 * (i >> 2) + 4 * hh; dst[dv * 64 + nbk * 32 + l31] = acc[i]; }
    __syncthreads();
}

__device__ __forceinline__ void phase_p4(const Params& p, LAS unsigned char* lds, int wave, int lane) {
    const float* dS = (const float*)(p.ws + WS_GLAS); const float* dec = (const float*)(p.ws + WS_GDEC); unsigned* S16 = (unsigned*)(p.ws + WS_S16);
    for (int ch = blockIdx.x * NT + threadIdx.x; ch < 32 * 4096; ch += gridDim.x * NT) {
        const int bh = ch >> 12, e2 = ch & 4095, dk = (e2 * 2) & 63;
        f32x2 run = {0.f, 0.f};
#pragma unroll 16
        for (int c = 0; c < NCH; ++c) { const size_t item = (size_t)bh * NCH + c;
            const f32x2 d = *(const f32x2*)(dS + item * 8192 + e2 * 2), a = *(const f32x2*)(dec + item * 64 + dk);
            S16[item * 4096 + e2] = pkh(run.x, run.y);
            run = a * run + d; }
    }
}

struct G3Ops { unsigned qw[4], kw[4], vw0[8], vw1[8]; u32x4 g0, g1; f16x8 sfr[4]; float bw[8]; };
#define GL_SYNC() do { asm volatile("s_waitcnt lgkmcnt(0)" ::: "memory"); __builtin_amdgcn_s_barrier(); asm volatile("" ::: "memory"); } while (0)
__device__ __forceinline__ void gla3_load(const Params& p, G3Ops& o, int item, int wave, int lane) {
    const int tid = threadIdx.x, c = item & (NCH - 1), h = (item >> 7) & 3, b = item >> 9;
    const int mb = wave >> 1, hh = lane >> 5, l31 = lane & 31;
    const u16* prow = (const u16*)(p.ws + WS_PROJ) + (size_t)(b * L + c * 64) * PJ;
#pragma unroll
    for (int i = 0; i < 4; ++i) { const int idx = tid + NT * i, dk = 2 * (idx & 31), t = idx >> 5;
        o.qw[i] = *(const unsigned*)(prow + (size_t)t * PJ + CGQ + h * 64 + dk); o.kw[i] = *(const unsigned*)(prow + (size_t)t * PJ + CGK + h * 64 + dk); }
#pragma unroll
    for (int i = 0; i < 8; ++i) { const int idx = tid + NT * i, dv = idx & 127, t = 2 * (idx >> 7);
        o.vw0[i] = prow[(size_t)t * PJ + CGV + h * 128 + dv]; o.vw1[i] = prow[(size_t)(t + 1) * PJ + CGV + h * 128 + dv]; }
    const u16* gorow = prow + (size_t)(tid >> 3) * PJ + CGO + h * 128 + (tid & 7) * 16;
    o.g0 = *(const u32x4*)gorow; o.g1 = *(const u32x4*)(gorow + 8);
    { const u16* srow = (const u16*)(p.ws + WS_S16) + (size_t)item * 8192 + (size_t)(mb * 32 + l31) * 64;
#pragma unroll
      for (int s = 0; s < 4; ++s) o.sfr[s] = *(const f16x8*)(srow + 16 * s + 8 * hh); }
#pragma unroll
    for (int i = 0; i < 8; ++i) { const int idx = tid + NT * i, t = idx >> 6, dk = idx & 63; o.bw[i] = ((const float*)(prow + (size_t)t * PJ + CK + h * 128))[dk]; }
}
__device__ __forceinline__ void gla3_item(const Params& p, LAS unsigned char* lds, const G3Ops& ops, int item, int wave, int lane) {
    const int tid = threadIdx.x, c = item & (NCH - 1), h = (item >> 7) & 3, b = item >> 9;
    const int mb = wave >> 1, nb = wave & 1, hh = lane >> 5, l31 = lane & 31;
    const unsigned (&qw)[4] = ops.qw; const unsigned (&kw)[4] = ops.kw; const unsigned (&vw0)[8] = ops.vw0; const unsigned (&vw1)[8] = ops.vw1; const u32x4 g0 = ops.g0, g1 = ops.g1; const f16x8 (&sfr)[4] = ops.sfr;
    LAS float* bc = (LAS float*)(lds + GL_BC);
#pragma unroll
    for (int i = 0; i < 8; ++i) { const int idx = tid + NT * i, t = idx >> 6, dk = idx & 63; bc[t * 65 + dk] = ops.bw[i]; }
    GL_SYNC();
    LAS u16* QD = (LAS u16*)(lds + GL_QD); LAS u16* KD = (LAS u16*)(lds + GL_KD); LAS u16* QP = (LAS u16*)(lds + GL_QP); LAS u16* VTl = (LAS u16*)(lds + GL_VT);
    LAS float* ssq = (LAS float*)(lds + GL_SSQ); LAS float* ost = (LAS float*)(lds + GL_OST);
#pragma unroll
    for (int i = 0; i < 4; ++i) { const int idx = tid + NT * i, dk = 2 * (idx & 31), t = idx >> 5;
        const float b0 = bc[t * 65 + dk], b1 = bc[t * 65 + dk + 1], r0 = bc[31 * 65 + dk], r1 = bc[31 * 65 + dk + 1];
        const float q0 = hlo(qw[i]) * 0.125f, q1 = hhi(qw[i]) * 0.125f;
        *(LAS unsigned*)(QD + t * GST + dk) = pkbf(q0 * __expf(b0 - r0), q1 * __expf(b1 - r1));
        *(LAS unsigned*)(KD + t * GST + dk) = pkbf(hlo(kw[i]) * __expf(r0 - b0), hhi(kw[i]) * __expf(r1 - b1));
        *(LAS unsigned*)(QP + t * GST + dk) = pkh(q0 * __expf(b0), q1 * __expf(b1)); }
#pragma unroll
    for (int i = 0; i < 8; ++i) { const int idx = tid + NT * i, dv = idx & 127, t = 2 * (idx >> 7);
        *(LAS unsigned*)(VTl + dv * GST + (t & ~15) + kperm16(t & 15)) = vw0[i] | (vw1[i] << 16); }
    GL_SYNC();
    f16x8 pf[4];
#pragma unroll
    for (int jb = 0; jb < 2; ++jb) {
        if (jb > nb) {
#pragma unroll
            for (int e = 0; e < 8; ++e) { pf[2 * jb][e] = (_Float16)0.f; pf[2 * jb + 1][e] = (_Float16)0.f; }
            continue; }
        f32x16 x;
#pragma unroll
        for (int i = 0; i < 16; ++i) x[i] = 0.f;
#pragma unroll
        for (int s = 0; s < 4; ++s) { const bf16x8 a = *(const LAS bf16x8*)(KD + (jb * 32 + l31) * GST + 16 * s + 8 * hh), bb = *(const LAS bf16x8*)(QD + (nb * 32 + l31) * GST + 16 * s + 8 * hh);
            x = __builtin_amdgcn_mfma_f32_32x32x16_bf16(a, bb, x, 0, 0, 0); }
#pragma unroll
        for (int i = 0; i < 16; ++i) { const int rowi = (i & 3) + 8 * (i >> 2) + 4 * hh; const bool keep = (jb < nb) || (rowi <= l31); const float v = keep ? x[i] : 0.f;
            pf[2 * jb + (i >> 3)][i & 7] = (_Float16)v; }
    }
    f32x16 o;
#pragma unroll
    for (int i = 0; i < 16; ++i) o[i] = 0.f;
#pragma unroll
    for (int kk = 0; kk < 4; ++kk) { if ((kk >> 1) > nb) continue;
        const f16x8 a = *(const LAS f16x8*)(VTl + (mb * 32 + l31) * GST + 16 * kk + 8 * hh);
        o = __builtin_amdgcn_mfma_f32_32x32x16_f16(a, pf[kk], o, 0, 0, 0); }
#pragma unroll
    for (int s = 0; s < 4; ++s) { const f16x8 bb = *(const LAS f16x8*)(QP + (nb * 32 + l31) * GST + 16 * s + 8 * hh);
        o = __builtin_amdgcn_mfma_f32_32x32x16_f16(sfr[s], bb, o, 0, 0, 0); }
    float part = 0.f;
#pragma unroll
    for (int i = 0; i < 16; ++i) { part += o[i] * o[i]; ost[(nb * 32 + l31) * 132 + mb * 32 + (i & 3) + 8 * (i >> 2) + 4 * hh] = o[i]; }
    part += __shfl_xor(part, 32);
    if (lane < 32) ssq[mb * 64 + nb * 32 + lane] = part;
    GL_SYNC();
    { const int t = tid >> 3, dv0 = (tid & 7) * 16;
      const float rstd = rsqrtf((ssq[t] + ssq[64 + t] + ssq[128 + t] + ssq[192 + t]) * (1.f / 128.f) + EPS);
      const unsigned gw[8] = {g0.x, g0.y, g0.z, g0.w, g1.x, g1.y, g1.z, g1.w};
      unsigned ow[8];
#pragma unroll
      for (int e = 0; e < 8; ++e) { const int dv = dv0 + 2 * e;
          const float a0 = ost[t * 132 + dv] * rstd * p.gla_g[dv] * silu_f(hlo(gw[e])), a1 = ost[t * 132 + dv + 1] * rstd * p.gla_g[dv + 1] * silu_f(hhi(gw[e]));
          ow[e] = pkh(a0, a1); }
      u16* crow = (u16*)(p.ws + WS_CAT) + (size_t)(b * L + c * 64 + t) * D + 512 + h * 128 + dv0;
      u32x4 o0, o1; o0.x = ow[0]; o0.y = ow[1]; o0.z = ow[2]; o0.w = ow[3]; o1.x = ow[4]; o1.y = ow[5]; o1.z = ow[6]; o1.w = ow[7];
      *(u32x4*)crow = o0; *(u32x4*)(crow + 8) = o1; }
    GL_SYNC();
}
}
namespace mk {
__device__ __forceinline__ int idx_row_slot(int r) { return 2 * ((r >> 2) & 1) + (r >> 4); }
__device__ __forceinline__ int idx_row_head(int r) { return (r & 3) + 4 * ((r >> 3) & 1); }
__device__ __forceinline__ float relu_f(float x) { const int i = __builtin_bit_cast(int, x); return __builtin_bit_cast(float, i > 0 ? i : 0); }
__device__ __forceinline__ float fmul_s(float a, float b) { float r; asm("v_mul_f32_e32 %0, %1, %2" : "=v"(r) : "v"(a), "v"(b)); return r; }
__device__ __forceinline__ float fma_s(float a, float b, float c) { asm("v_fmac_f32_e32 %0, %1, %2" : "+v"(c) : "v"(a), "v"(b)); return c; }
template <int BASE> __device__ __forceinline__ float idx_score(const f32x16& acc, const f32x4 wa, const f32x4 wb) {
    float s = fmul_s(wa[0], relu_f(acc[BASE + 0]));
    s = fma_s(wa[1], relu_f(acc[BASE + 1]), s);
    s = fma_s(wa[2], relu_f(acc[BASE + 2]), s); s = fma_s(wa[3], relu_f(acc[BASE + 3]), s);
    s = fma_s(wb[0], relu_f(acc[BASE + 4]), s); s = fma_s(wb[1], relu_f(acc[BASE + 5]), s);
    s = fma_s(wb[2], relu_f(acc[BASE + 6]), s); s = fma_s(wb[3], relu_f(acc[BASE + 7]), s);
    return s;
}
__device__ __forceinline__ unsigned fkey(float f) { f = f + 0.0f; const unsigned u = __builtin_bit_cast(unsigned, f); return u ^ ((unsigned)((int)u >> 31) | 0x80000000u); }
__device__ __forceinline__ int opq(int v) { asm volatile("" : "+v"(v)); return v; }
__device__ __forceinline__ unsigned lds_add(LAS unsigned* p, unsigned v) { return __hip_atomic_fetch_add(p, v, __ATOMIC_RELAXED, __HIP_MEMORY_SCOPE_WORKGROUP); }
__device__ __forceinline__ unsigned wave_prefix_incl(unsigned v) {
#define MK_DPPADD(ctrl, rm) v += (unsigned)__builtin_amdgcn_update_dpp(0, (int)v, ctrl, rm, 0xf, false)
    MK_DPPADD(0x111, 0xf); MK_DPPADD(0x112, 0xf); MK_DPPADD(0x114, 0xf); MK_DPPADD(0x118, 0xf); MK_DPPADD(0x142, 0xa); MK_DPPADD(0x143, 0xc);
#undef MK_DPPADD
    return v;
}
__device__ __forceinline__ unsigned wave_suffix_sum(unsigned x, int lane) {
    const unsigned pre = wave_prefix_incl(x), tot = (unsigned)__builtin_amdgcn_readlane((int)pre, 63);
    return tot - pre + x;
}

template <int NP, int NC>
__device__ __forceinline__ void wave_select(const LAS unsigned* const (&cq)[NC], const unsigned (&sc)[NC][4], const unsigned (&kk0)[NC], LAS unsigned* const (&hq)[NC], int lane, const int (&rp0)[NC], const unsigned (&pre)[NC], unsigned (&out)[NC]) {
    unsigned prefix[NC], mask[NC], kk[NC];
#pragma unroll
    for (int c = 0; c < NC; ++c) { prefix[c] = pre[c]; mask[c] = rp0[c] ? (0xffffffffu << (32 - 8 * rp0[c])) : 0u; kk[c] = kk0[c]; }
    int rpmin = NP;
#pragma unroll
    for (int c = 0; c < NC; ++c) rpmin = rp0[c] < rpmin ? rp0[c] : rpmin;
    for (int rp = rpmin; rp < NP; ++rp) { const int shift = 24 - 8 * rp;
#pragma unroll
        for (int c = 0; c < NC; ++c) { u32x4 z = {0u, 0u, 0u, 0u}; *(LAS u32x4*)(hq[c] + 4 * lane) = z; }
#pragma unroll
        for (int sl = 0; sl < 4; ++sl)
#pragma unroll
            for (int i = 0; i < 4; ++i)
#pragma unroll
                for (int c = 0; c < NC; ++c) { const unsigned idx = lane + 64 * i; if (rp >= rp0[c] && idx < sc[c][sl]) { const unsigned key = fkey(__builtin_bit_cast(float, cq[c][256 * sl + idx])); if ((key & mask[c]) == prefix[c]) lds_add(hq[c] + ((key >> shift) & 255u), 1u); } }
        LDS_WAIT();
        u32x4 cw[NC]; unsigned cs[NC], incl[NC];
#pragma unroll
        for (int c = 0; c < NC; ++c) { cw[c] = *(LAS u32x4*)(hq[c] + 4 * lane); cs[c] = cw[c].x + cw[c].y + cw[c].z + cw[c].w; incl[c] = cs[c]; }
#pragma unroll
        for (int c = 0; c < NC; ++c) incl[c] = wave_suffix_sum(cs[c], lane);
#pragma unroll
        for (int c = 0; c < NC; ++c) { const unsigned above = incl[c] - cs[c]; const bool found = above < kk[c] && kk[c] <= incl[c];
            unsigned dig = 0u, kk2 = 0u;
            if (found) { unsigned cum = above; const unsigned cv[4] = {cw[c].x, cw[c].y, cw[c].z, cw[c].w};
#pragma unroll
                for (int i = 3; i >= 0; --i) { if (kk2 == 0u) { if (cum + cv[i] >= kk[c]) { dig = (unsigned)(4 * lane + i); kk2 = kk[c] - cum; } else cum += cv[i]; } } }
            const unsigned long long bal = __ballot(found); const int src = bal ? (int)__builtin_ctzll(bal) : 0;
            dig = (unsigned)__builtin_amdgcn_readlane((int)dig, src); kk2 = (unsigned)__builtin_amdgcn_readlane((int)kk2, src);
            if (rp >= rp0[c]) { prefix[c] |= dig << shift; mask[c] |= 255u << shift; kk[c] = kk2 ? kk2 : 1u; } }
    }
#pragma unroll
    for (int c = 0; c < NC; ++c) out[c] = prefix[c];
}

constexpr int TH_HIST = 0, TH_CAND = 65536, TH_ST = 131072, TH_A = 133120;
constexpr int ST_LO = 0, ST_RMAX = 16, ST_SH = 32, ST_NEED = 48, ST_MODE = 64, ST_CCNT = 80, ST_HI = 96, ST_ABOVE = 112, ST_WL = 128, ST_SAMP = 256, ST_SCNT = 272, ST_THR = 336, ST_DIRTY = 352;
__device__ __forceinline__ void thr_loadB(f16x8 (&Bf)[4], const u16* KI, int kt) {
#pragma unroll
    for (int s = 0; s < 4; ++s) Bf[s] = *(const f16x8*)(KI + (size_t)(kt * 4 + s) * 512);
}
__device__ __forceinline__ void thr_scores(const f32x16& acc, const LAS float* wl, int mb, int hh, unsigned& k0, unsigned& k1) {
    const LAS float* w0 = wl + (4 * mb + 2 * hh) * 8;
    const f32x4 a0 = *(const LAS f32x4*)(w0), b0 = *(const LAS f32x4*)(w0 + 4), a1 = *(const LAS f32x4*)(w0 + 8), b1 = *(const LAS f32x4*)(w0 + 12);
    k0 = fkey(idx_score<0>(acc, a0, b0)); k1 = fkey(idx_score<8>(acc, a1, b1));
}
constexpr int TH_MASK = 0, TH_CIDX = 16384, TH_SCR = 49152;
__device__ __forceinline__ float key2f(unsigned k) { return __builtin_bit_cast(float, (k & 0x80000000u) ? (k ^ 0x80000000u) : ~k); }
template <int KIND>
__device__ __forceinline__ void thr_sweep(LAS unsigned char* lds, const f16x8 (&A)[2][4], const u16* KI, int t0, int ntiles, int wave, int lane) {
    LAS unsigned* hist = (LAS unsigned*)(lds + TH_HIST); LAS unsigned* cand = (LAS unsigned*)(lds + TH_CAND); LAS unsigned* st = (LAS unsigned*)(lds + TH_ST);
    LAS unsigned* maskb = (LAS unsigned*)(lds + TH_MASK); LAS u16* cidx = (LAS u16*)(lds + TH_CIDX);
    const int hh = lane >> 5, l31 = lane & 31, mbp = wave & 1, ph = wave >> 1;
    unsigned lo[2][2], rmax[2][2], sh[2][2], ccn[2][2]; float lof[2][2], upf[2][2];
#pragma unroll
    for (int mbl = 0; mbl < 2; ++mbl)
#pragma unroll
        for (int jj = 0; jj < 2; ++jj) { const int ql = 8 * mbp + 4 * mbl + 2 * hh + jj; const unsigned lk = st[ST_LO + ql], rm = st[ST_RMAX + ql], uk = lk + rm;
            lo[mbl][jj] = lk; rmax[mbl][jj] = rm; sh[mbl][jj] = st[ST_SH + ql]; ccn[mbl][jj] = 0u;
            lof[mbl][jj] = lk <= 0x007fffffu ? -__builtin_inff() : key2f(lk); upf[mbl][jj] = uk >= 0xff800000u ? (lk == 0xffffffffu ? -__builtin_inff() : __builtin_inff()) : key2f(uk); }
    f16x8 B0[4], B1[4];
    const unsigned cbase4 = (unsigned)(__UINTPTR_TYPE__)(lds + TH_CAND) + ((8 * mbp + 2 * hh) * 1024 + ph * 256) * 4, cbase2 = (unsigned)(__UINTPTR_TYPE__)(lds + TH_CIDX) + ((8 * mbp + 2 * hh) * 1024 + ph * 256) * 2;
    float lofv[2][2] = {{lof[0][0], lof[0][1]}, {lof[1][0], lof[1][1]}};
    float lofc[2][2];
#pragma unroll
    for (int mbl = 0; mbl < 2; ++mbl)
#pragma unroll
        for (int jj = 0; jj < 2; ++jj) lofc[mbl][jj] = ((ntiles - 1) * 32 + l31 <= t0 + 8 * mbp + 4 * mbl + 2 * hh + jj) ? lof[mbl][jj] : __builtin_inff();
    const LAS float* wlb = (const LAS float*)(st + ST_WL) + (8 * mbp + 2 * hh) * 8;
    asm volatile("" : "+v"(wlb));
    f32x4 wreg[2][2][2];
    if (KIND == 1) {
#pragma unroll
        for (int mbl = 0; mbl < 2; ++mbl)
#pragma unroll
            for (int jj = 0; jj < 2; ++jj) { wreg[mbl][jj][0] = *(const LAS f32x4*)(wlb + (4 * mbl + jj) * 8); wreg[mbl][jj][1] = *(const LAS f32x4*)(wlb + (4 * mbl + jj) * 8 + 4); } }
    auto tile = [&](const f16x8 (&BX)[4], int kt, const bool chk) __attribute__((always_inline)) {
        const int skey = kt * 32 + l31;
        f32x16 acc[2];
#pragma unroll
        for (int mbl = 0; mbl < 2; ++mbl) {
#pragma unroll
            for (int i = 0; i < 16; ++i) acc[mbl][i] = 0.f;
#pragma unroll
            for (int s = 0; s < 4; ++s) acc[mbl] = __builtin_amdgcn_mfma_f32_32x32x16_f16(A[mbl][s], BX[s], acc[mbl], 0, 0, 0); }
#pragma unroll
        for (int mbl = 0; mbl < 2; ++mbl)
#pragma unroll
            for (int jj = 0; jj < 2; ++jj) { const int ql = 8 * mbp + 4 * mbl + 2 * hh + jj;
                const f32x4 wa = KIND == 1 ? wreg[mbl][jj][0] : *(const LAS f32x4*)(wlb + (4 * mbl + jj) * 8), wb = KIND == 1 ? wreg[mbl][jj][1] : *(const LAS f32x4*)(wlb + (4 * mbl + jj) * 8 + 4);
                const float sc = jj == 0 ? idx_score<0>(acc[mbl], wa, wb) : idx_score<8>(acc[mbl], wa, wb);
                if (KIND == 0) { const bool caus = !chk || skey <= t0 + ql;
                    const unsigned key = fkey(sc), d = key - lo[mbl][jj]; if (caus && d <= rmax[mbl][jj]) { const unsigned bin = d >> sh[mbl][jj]; lds_add(hist + ql * 1024 + (bin >> 1), 1u << (16 * (bin & 1u))); } }
                else {
                    const unsigned long long bal = __ballot(sc >= lofv[mbl][jj]);
                    const unsigned blo = (unsigned)bal, bhi = (unsigned)(bal >> 32), nlo = (unsigned)__builtin_popcount(blo), nhi = (unsigned)__builtin_popcount(bhi);
                    const unsigned cpk = ccn[mbl][jj] - (nlo << 16);
                    const int base = __builtin_amdgcn_sbfe((int)cpk, 16 * hh, 16);
                    unsigned pos = __builtin_amdgcn_mbcnt_hi(bhi, __builtin_amdgcn_mbcnt_lo(blo, (unsigned)base)); pos = pos < 255u ? pos : 255u;
                    { const unsigned a4 = cbase4 + (4 * mbl + jj) * 4096 + pos * 4, a2 = cbase2 + (4 * mbl + jj) * 2048 + pos * 2; unsigned long long sv;
                      asm volatile("s_and_saveexec_b64 %0, %1\n\tds_write_b32 %2, %3\n\tds_write_b16 %4, %5\n\ts_mov_b64 exec, %0" : "=&s"(sv) : "s"(bal), "v"(a4), "v"(sc), "v"(a2), "v"(skey) : "memory"); }
                    ccn[mbl][jj] += nlo + (nhi << 16); } }
    };
    int kt = ph; const int last = ntiles - 1;
    if (KIND == 0) {
        for (; kt < ntiles; kt += 4) { thr_loadB(B0, KI, kt); tile(B0, kt, true); }
        return; }
    thr_loadB(B0, KI, kt);
#define TH_LASTTHR() do { if (kt == last) { asm volatile("" ::: "memory");   _Pragma("unroll") for (int a = 0; a < 2; ++a) { _Pragma("unroll") for (int c = 0; c < 2; ++c) lofv[a][c] = lofc[a][c]; } } } while (0)
    for (;;) {
        thr_loadB(B1, KI, kt + 4 < last ? kt + 4 : last); TH_LASTTHR(); tile(B0, kt, kt == last); kt += 4; if (kt >= ntiles) break;
        thr_loadB(B0, KI, kt + 4 < last ? kt + 4 : last); TH_LASTTHR(); tile(B1, kt, kt == last); kt += 4; if (kt >= ntiles) break;
    }
#undef TH_LASTTHR
    if (KIND == 1) {
#pragma unroll
        for (int mbl = 0; mbl < 2; ++mbl)
#pragma unroll
            for (int jj = 0; jj < 2; ++jj) {
                if (l31 == 0) st[ST_SCNT + (8 * mbp + 4 * mbl + 2 * hh + jj) * 4 + ph] = (ccn[mbl][jj] >> (16 * hh)) & 0xffffu; } }
}
__device__ __forceinline__ void thr_write_masks(const Params& p, LAS unsigned char* lds, int b, int t0, int ntw) {
    const int tidw = opq(threadIdx.x);
    const LAS unsigned* maskb = (const LAS unsigned*)(lds + TH_MASK); const int q = tidw & 15;
    unsigned* dst = (unsigned*)(p.ws + WS_SELM) + ((size_t)(b * 128 + (t0 >> 6)) * 256) * 64 + (t0 & 63) + q;
    for (int kt = tidw >> 4; kt < ntw; kt += 32) dst[(size_t)kt * 64] = maskb[q * 256 + kt];
}
struct ThrOps { f16x8 A[2][4]; float wl; };
__device__ __forceinline__ void thr_load(const Params& p, ThrOps& o, int b, int qb, int wave) {
    const int tid = opq(threadIdx.x), lane = tid & 63, hh = lane >> 5, l31 = lane & 31, t0 = qb * 16, mbp = wave & 1;
    const u16* P16 = (const u16*)(p.ws + WS_PROJ); const int slot = idx_row_slot(l31), head = idx_row_head(l31);
#pragma unroll
    for (int mbl = 0; mbl < 2; ++mbl) { const u16* qr = P16 + (size_t)(b * L + t0 + 8 * mbp + 4 * mbl + slot) * PJ + CQI + head * 64 + 8 * hh;
#pragma unroll
        for (int s = 0; s < 4; ++s) o.A[mbl][s] = *(const f16x8*)(qr + 16 * s); }
    o.wl = ((const float*)(p.ws + WS_WIDX))[(size_t)(b * L + t0) * 8 + (tid & 127)];
}
#define TH_SYNC() do { asm volatile("s_waitcnt lgkmcnt(0)" ::: "memory"); __builtin_amdgcn_s_barrier(); asm volatile("" ::: "memory"); } while (0)
__device__ __forceinline__ void thr_item(const Params& p, LAS unsigned char* lds, const ThrOps& ops, int b, int qb, int wave, int lane) {
    int tid = opq(threadIdx.x); lane = tid & 63; int hh = lane >> 5, l31 = lane & 31; const int t0 = qb * 16;
#define TH_FRESH() do { tid = opq(tid); lane = tid & 63; hh = lane >> 5; l31 = lane & 31; } while (0)
    LAS unsigned* hist = (LAS unsigned*)(lds + TH_HIST); LAS unsigned* cand = (LAS unsigned*)(lds + TH_CAND); LAS unsigned* st = (LAS unsigned*)(lds + TH_ST);
    LAS unsigned* maskb = (LAS unsigned*)(lds + TH_MASK);
    const int ntw = 2 * (qb >> 2) + 2;
    if (tid < 16) { const int n = t0 + tid + 1;
        if (n <= 256) { st[ST_MODE + tid] = 2u; st[ST_THR + tid] = 0u; }
        else { st[ST_MODE + tid] = 0u; st[ST_LO + tid] = 0u; st[ST_RMAX + tid] = 0xffffffffu; st[ST_SH + tid] = 21u; st[ST_NEED + tid] = 256u; }
        st[ST_SAMP + tid] = 0u; }
    if (tid == 0) st[ST_DIRTY] = 0u;
    if (tid < 128) ((LAS float*)(st + ST_WL))[tid] = ops.wl;
    TH_SYNC();
    if (t0 + 16 <= 256) {
        for (int i = tid; i < 16 * 256; i += NT) { const int q = i >> 8, kt = i & 255, d = t0 + q - kt * 32; maskb[i] = d < 0 ? 0u : (d >= 31 ? 0xffffffffu : (2u << d) - 1u); }
        TH_SYNC(); thr_write_masks(p, lds, b, t0, ntw); TH_SYNC(); return; }
    const u16* P16 = (const u16*)(p.ws + WS_PROJ); const u16* KI = (const u16*)(p.ws + WS_KIDX) + (size_t)b * L * 64 + lane * 8;
    const int mbp = wave & 1, ph = wave >> 1;
    const f16x8 (&A)[2][4] = ops.A;
    const int ntiles = (t0 + 15) / 32 + 1;
    const int sd = ntiles >= 128 ? 16 : (ntiles >= 64 ? 8 : (ntiles >= 32 ? 4 : (ntiles >= 16 ? 2 : 1))), soff = sd == 16 ? 7 : (sd == 8 ? 3 : (sd == 4 ? 2 : 0)), mg = sd == 16 ? 17 : (sd == 8 ? 22 : (sd == 4 ? 30 : 35));
    const int ms = ntiles / sd;
    {
        { const LAS float* wlb = (const LAS float*)(st + ST_WL) + (8 * mbp + 2 * hh) * 8; asm volatile("" : "+v"(wlb));
          f16x8 Bs0[4], Bs1[4];
          auto stile = [&](const f16x8 (&Bs)[4], int j) __attribute__((always_inline)) { const int kt = sd * j + soff;
            f32x16 acc[2];
#pragma unroll
            for (int mbl = 0; mbl < 2; ++mbl) {
#pragma unroll
                for (int i = 0; i < 16; ++i) acc[mbl][i] = 0.f;
#pragma unroll
                for (int s = 0; s < 4; ++s) acc[mbl] = __builtin_amdgcn_mfma_f32_32x32x16_f16(A[mbl][s], Bs[s], acc[mbl], 0, 0, 0); }
#pragma unroll
            for (int mbl = 0; mbl < 2; ++mbl)
#pragma unroll
                for (int jj = 0; jj < 2; ++jj) { const int ql = 8 * mbp + 4 * mbl + 2 * hh + jj;
                    const f32x4 wa = *(const LAS f32x4*)(wlb + (4 * mbl + jj) * 8), wb = *(const LAS f32x4*)(wlb + (4 * mbl + jj) * 8 + 4);
                    const float sc = jj == 0 ? idx_score<0>(acc[mbl], wa, wb) : idx_score<8>(acc[mbl], wa, wb);
                    const bool caus = kt * 32 + l31 <= t0 + ql;
                    cand[ql * 1024 + j * 32 + l31] = caus ? __builtin_bit_cast(unsigned, sc) : 0xff800000u; }
          };
          if (ph < ms) { int j = ph; const int jl = ms - 1;
            thr_loadB(Bs0, KI, sd * j + soff);
            for (;;) {
                thr_loadB(Bs1, KI, sd * (j + 4 < jl ? j + 4 : jl) + soff); stile(Bs0, j); j += 4; if (j >= ms) break;
                thr_loadB(Bs0, KI, sd * (j + 4 < jl ? j + 4 : jl) + soff); stile(Bs1, j); j += 4; if (j >= ms) break;
            } } }
        TH_FRESH();
        if (sd == 1) { u32x4 z = {0u, 0u, 0u, 0u};
#pragma unroll
            for (int i = 0; i < 2; ++i) *(LAS u32x4*)(lds + TH_MASK + (tid + NT * i) * 16) = z; }
        TH_SYNC();
        const unsigned m = (unsigned)(ms * 32); const int qa = 2 * wave, qb2 = 2 * wave + 1;
        const unsigned s0 = m < 256u ? m : 256u, s1 = m < 256u ? 0u : (m < 512u ? m - 256u : 256u), s2 = m < 512u ? 0u : (m < 768u ? m - 512u : 256u), s3 = m < 768u ? 0u : m - 768u;
        if (sd == 1) {
            const LAS unsigned* const cq[2] = {cand + qa * 1024, cand + qb2 * 1024}; const unsigned sc[2][4] = {{s0, s1, s2, s3}, {s0, s1, s2, s3}}; const unsigned kk[2] = {256u, 256u};
            LAS unsigned* const hq[2] = {(LAS unsigned*)(lds + TH_SCR) + qa * 256, (LAS unsigned*)(lds + TH_SCR) + qb2 * 256}; const int rp0[2] = {0, 0}; const unsigned pre[2] = {0u, 0u}; unsigned res[2];
            wave_select<4, 2>(cq, sc, kk, hq, lane, rp0, pre, res);
#pragma unroll
            for (int c = 0; c < 2; ++c) { const int q = 2 * wave + c;
                for (int k2 = 0; 2 * k2 < ntiles; ++k2) { const int ki = k2 * 64 + lane; const bool sel = ki < (int)m && ki <= t0 + q && fkey(__builtin_bit_cast(float, cand[q * 1024 + ki])) >= res[c];
                    const unsigned long long bal = __ballot(sel); if (lane == 0) { maskb[q * 256 + 2 * k2] = (unsigned)bal; maskb[q * 256 + 2 * k2 + 1] = (unsigned)(bal >> 32); } }
                if (lane == 0) { st[ST_THR + q] = res[c]; st[ST_MODE + q] = 2u; } }
        } else {
          const float ra = 256.f * (float)m / (float)(t0 + qa + 1), rb = 256.f * (float)m / (float)(t0 + qb2 + 1);
          const int rloa = (int)ra + mg + 1, rlob = (int)rb + mg + 1;
          const LAS unsigned* const cq[2] = {cand + qa * 1024, cand + qb2 * 1024};
          const unsigned sc[2][4] = {{s0, s1, s2, s3}, {s0, s1, s2, s3}};
          const unsigned kk[2] = {(unsigned)(rloa <= (int)m ? rloa : (int)m), (unsigned)(rlob <= (int)m ? rlob : (int)m)};
          LAS unsigned* const hq[2] = {hist + (wave * 2 + 0) * 256, hist + (wave * 2 + 1) * 256};
          const int rp0[2] = {0, 0}; const unsigned pre[2] = {0u, 0u}; unsigned res[2];
          wave_select<2, 2>(cq, sc, kk, hq, lane, rp0, pre, res);
          if (lane == 0) {
              const unsigned loka = rloa <= (int)m ? res[0] : 0u, lokb = rlob <= (int)m ? res[1] : 0u;
              st[ST_MODE + qa] = 1u; st[ST_SAMP + qa] = 1u; st[ST_LO + qa] = loka; st[ST_RMAX + qa] = 0xffffffffu - loka;
              st[ST_MODE + qb2] = 1u; st[ST_SAMP + qb2] = 1u; st[ST_LO + qb2] = lokb; st[ST_RMAX + qb2] = 0xffffffffu - lokb; } }
        TH_SYNC();
    }
    bool clean = true, finalpass = false;
    for (int pass = 0; pass < 10 && sd != 1; ++pass) {
        TH_FRESH();
        { u32x4 z = {0u, 0u, 0u, 0u};
#pragma unroll
          for (int i = 0; i < 8; ++i) *(LAS u32x4*)(lds + TH_HIST + (tid + NT * i) * 16) = z;
          if (tid < 16) { st[ST_CCNT + tid] = 0u;
              if (finalpass) { const unsigned tk = st[ST_THR + tid]; st[ST_LO + tid] = tk; st[ST_RMAX + tid] = 0xffffffffu - tk; st[ST_MODE + tid] = 3u; } } }
        TH_SYNC();
        int kind; { const LAS u32x4* mv = (const LAS u32x4*)(st + ST_MODE); const u32x4 m0 = mv[0], m1 = mv[1], m2 = mv[2], m3 = mv[3];
            const unsigned w[16] = {m0.x, m0.y, m0.z, m0.w, m1.x, m1.y, m1.z, m1.w, m2.x, m2.y, m2.z, m2.w, m3.x, m3.y, m3.z, m3.w}; unsigned anyh = 0u;
#pragma unroll
            for (int q = 0; q < 16; ++q) anyh |= (w[q] == 0u) ? 1u : 0u;
            kind = __builtin_amdgcn_readfirstlane((int)anyh) ? 0 : 1; }
        const bool mpass = clean && pass == 0 && kind == 1;
        if (!mpass) clean = false;
        if (kind == 0) thr_sweep<0>(lds, A, KI, t0, ntiles, wave, lane); else thr_sweep<1>(lds, A, KI, t0, ntiles, wave, lane);
        TH_FRESH();
        TH_SYNC();
        if (finalpass) {
            for (int c = 0; c < 2; ++c) { const int q = 2 * wave + c; const LAS u16* ci = (const LAS u16*)(lds + TH_CIDX) + q * 1024;
#pragma unroll
                for (int sl = 0; sl < 4; ++sl) { const unsigned n = st[ST_SCNT + q * 4 + sl] < 256u ? st[ST_SCNT + q * 4 + sl] : 256u;
                    for (unsigned idx = lane; idx < n; idx += 64) { const unsigned ki = ci[256 * sl + idx];
                        __hip_atomic_fetch_or(maskb + q * 256 + (ki >> 5), 1u << (ki & 31u), __ATOMIC_RELAXED, __HIP_MEMORY_SCOPE_WORKGROUP); } } }
            break; }
        if (kind == 0) {
            for (int qq = 0; qq < 2; ++qq) { const int q = 2 * wave + qq;
                if (st[ST_MODE + q] != 0u) continue;
                const unsigned need = st[ST_NEED + q], shq = st[ST_SH + q], loq = st[ST_LO + q];
                LAS unsigned* hq = hist + q * 1024 + 16 * lane; unsigned c = 0u;
#pragma unroll
                for (int i = 0; i < 16; ++i) { const unsigned w = hq[i]; c += (w & 0xffffu) + (w >> 16); }
                const unsigned incl = wave_suffix_sum(c, lane), above = incl - c;
                if (above < need && need <= incl) {
                    unsigned cum = above, bsel = 0u, bcnt = 0u;
                    for (int i = 31; i >= 0; --i) { const unsigned w = hq[i >> 1], cnt = (i & 1) ? (w >> 16) : (w & 0xffffu); if (cum + cnt >= need) { bsel = (unsigned)(32 * lane + i); bcnt = cnt; break; } cum += cnt; }
                    const unsigned need2 = need - cum, newlo = loq + (bsel << shq);
                    if (bcnt == need2 || shq == 0u) { st[ST_THR + q] = newlo; st[ST_MODE + q] = 2u; st[ST_LO + q] = 0xffffffffu; st[ST_RMAX + q] = 0u; }
                    else { st[ST_LO + q] = newlo; st[ST_RMAX + q] = (1u << shq) - 1u; st[ST_NEED + q] = need2;
                        st[ST_SH + q] = shq > 11u ? shq - 11u : 0u; }
                } }
        } else {
            const LAS unsigned* cq[2]; unsigned sc[2][4], kk[2], pre[2], res[2]; LAS unsigned* hq[2]; int rp0[2]; bool act[2], good[2];
#pragma unroll
            for (int c = 0; c < 2; ++c) { const int q = 2 * wave + c; act[c] = st[ST_MODE + q] == 1u;
#pragma unroll
                for (int sl = 0; sl < 4; ++sl) sc[c][sl] = st[ST_SCNT + q * 4 + sl];
                const unsigned cnt = sc[c][0] + sc[c][1] + sc[c][2] + sc[c][3]; kk[c] = st[ST_NEED + q]; good[c] = sc[c][0] <= 256u && sc[c][1] <= 256u && sc[c][2] <= 256u && sc[c][3] <= 256u;
                good[c] = good[c] && kk[c] <= cnt;
                const unsigned loq = st[ST_LO + q], hiq = loq + st[ST_RMAX + q]; rp0[c] = (loq >> 24) != (hiq >> 24) ? 0 : ((loq >> 16) != (hiq >> 16) ? 1 : 2);
                pre[c] = rp0[c] == 0 ? 0u : (rp0[c] == 1 ? (loq & 0xff000000u) : (loq & 0xffff0000u));
                cq[c] = cand + q * 1024; hq[c] = (LAS unsigned*)(lds + TH_SCR) + q * 256;
                if (!(act[c] && good[c])) { sc[c][0] = 0u; sc[c][1] = 0u; sc[c][2] = 0u; sc[c][3] = 0u; kk[c] = 1u; rp0[c] = 4; } }
            wave_select<4, 2>(cq, sc, kk, hq, lane, rp0, pre, res);
#pragma unroll
            for (int c = 0; c < 2; ++c) { const int q = 2 * wave + c;
                if (!act[c]) continue;
                if (good[c]) { const unsigned key = res[c];
                    if (mpass) {
                        const LAS u16* ci = (const LAS u16*)(lds + TH_CIDX) + q * 1024;
#pragma unroll
                        for (int sl = 0; sl < 4; ++sl)
#pragma unroll
                            for (int i = 0; i < 4; ++i) { const unsigned idx = lane + 64 * i; if (idx < sc[c][sl] && fkey(__builtin_bit_cast(float, cand[q * 1024 + 256 * sl + idx])) >= key) { const unsigned ki = ci[256 * sl + idx];
                                __hip_atomic_fetch_or(maskb + q * 256 + (ki >> 5), 1u << (ki & 31u), __ATOMIC_RELAXED, __HIP_MEMORY_SCOPE_WORKGROUP); } } }
                    if (lane == 0) { st[ST_THR + q] = key; st[ST_MODE + q] = 2u; st[ST_LO + q] = 0xffffffffu; st[ST_RMAX + q] = 0u; } }
                else if (lane == 0) { st[ST_DIRTY] = 1u; st[ST_MODE + q] = 0u; st[ST_SAMP + q] = 0u; st[ST_LO + q] = 0u; st[ST_RMAX + q] = 0xffffffffu; st[ST_SH + q] = 21u; st[ST_NEED + q] = 256u; }
            }
        }
        TH_SYNC();
        bool alldone; { const LAS u32x4* mv = (const LAS u32x4*)(st + ST_MODE); const u32x4 m0 = mv[0], m1 = mv[1], m2 = mv[2], m3 = mv[3];
            const unsigned w[16] = {m0.x, m0.y, m0.z, m0.w, m1.x, m1.y, m1.z, m1.w, m2.x, m2.y, m2.z, m2.w, m3.x, m3.y, m3.z, m3.w}; unsigned nd = 0u;
#pragma unroll
            for (int q = 0; q < 16; ++q) nd |= (w[q] != 2u) ? 1u : 0u;
            alldone = __builtin_amdgcn_readfirstlane((int)nd) == 0; }
        if (alldone) { if (clean && st[ST_DIRTY] == 0u) break; finalpass = true; }
    }
    TH_SYNC();
    thr_write_masks(p, lds, b, t0, ntw);
    TH_SYNC();
#undef TH_FRESH
}
}
namespace mk {
constexpr int AT_MASKR = 0, AT_SSQ = 2560, AT_KVB = 16384, AT_OST = 16384;
#define AT_DMA(gp, lp) __builtin_amdgcn_global_load_lds((const unsigned*)(gp), (LAS unsigned*)(lp), 16, 0, 0)
#define AT_DMAO(gp, lp, off) __builtin_amdgcn_global_load_lds((const unsigned*)(gp), (LAS unsigned*)(lp), 16, off, 0)
#define AT_DMA4(gp, lp) __builtin_amdgcn_global_load_lds((const unsigned*)(gp), (LAS unsigned*)(lp), 4, 0, 0)
__device__ __forceinline__ void att_item(const Params& p, LAS unsigned char* lds, int b, int qblk, int wave, int lane) {
    const int q0 = qblk * 128, g = wave >> 1, h2 = wave & 1, hh = lane >> 5, l31 = lane & 31;
    LAS unsigned* maskr = (LAS unsigned*)(lds + AT_MASKR); LAS float* ssq = (LAS float*)(lds + AT_SSQ);
    const u16* P16 = (const u16*)(p.ws + WS_PROJ);
    const unsigned* SM = (const unsigned*)(p.ws + WS_SELM) + (size_t)(b * 128 + 2 * qblk + (wave & 1)) * 256 * 64 + lane;
    const int ntiles = 4 * qblk + 4, glast = q0 + 32 * g + 31;
    const float csc = 0.08838834764831845f * 1.4426950408889634f;
    LAS unsigned char* ostw = lds + AT_OST + wave * 8704;
    u16* cbase = (u16*)(p.ws + WS_CAT) + (size_t)(b * L + q0 + 32 * g) * D;
    for (int sp = 0; sp < 2; ++sp) {
        const int h = 2 * sp + h2;
        const unsigned char* KF = (const unsigned char*)(p.ws + WS_KF) + (size_t)(b * 4 + 2 * sp + (wave & 1)) * 256 * 8192 + (size_t)(2 * (wave >> 1)) * 1024 + lane * 16;
        const unsigned char* VF = (const unsigned char*)(p.ws + WS_VT) + (size_t)(b * 4 + 2 * sp + (wave & 1)) * 256 * 8192 + (size_t)(2 * (wave >> 1)) * 1024 + lane * 16;
        const int dofs = (wave & 1) * 8192 + 2 * (wave >> 1) * 1024;
        if (wave < 2) { AT_DMA4(SM, lds + AT_MASKR + wave * 256); AT_DMA4(SM + 64, lds + AT_MASKR + 512 + wave * 256); }
#pragma unroll
        for (int i = 0; i < 2; ++i) { AT_DMA(KF + i * 1024, lds + AT_KVB + dofs + i * 1024); AT_DMA(VF + i * 1024, lds + AT_KVB + 16384 + dofs + i * 1024); }
        f16x8 Qf[8];
        { const u16* qa = P16 + (size_t)(b * L + q0 + 32 * g + l31) * PJ + CQ + h * 128 + 8 * hh;
#pragma unroll
          for (int s = 0; s < 8; ++s) Qf[s] = *(const f16x8*)(qa + 16 * s); }
#pragma unroll
        for (int s = 0; s < 8; ++s) Qf[s] = Qf[s] * (_Float16)csc;
        f32x16 O[4];
#pragma unroll
        for (int d = 0; d < 4; ++d)
#pragma unroll
            for (int i = 0; i < 16; ++i) O[d][i] = 0.f;
        const unsigned char* kfp = KF; const unsigned char* vfp = VF; const unsigned* smp = SM + 64;
        float mrun = 0.f, lsum = 0.f;
        f32x16 negm;
#pragma unroll
        for (int i = 0; i < 16; ++i) negm[i] = 0.f;
        for (int kt = 0; kt < ntiles; ++kt) {
            asm volatile("s_waitcnt vmcnt(0)" ::: "memory");
            __syncthreads();
            const bool act = kt * 32 <= glast;
            const LAS f16x8* kb = (const LAS f16x8*)(lds + AT_KVB + (kt & 1) * 32768 + h2 * 8192) + lane;
            f16x8 kf[8];
            if (act) {
#pragma unroll
                for (int s = 0; s < 8; ++s) kf[s] = kb[s * 64]; }
            kfp += 8192; vfp += 8192; smp += 64;
            asm volatile("" : "+v"(kfp), "+v"(vfp), "+v"(smp));
            if (kt + 1 < ntiles) { const int bo = AT_KVB + ((kt + 1) & 1) * 32768 + dofs;
                AT_DMAO(kfp, lds + bo, 0); AT_DMAO(kfp, lds + bo, 1024); AT_DMAO(vfp, lds + bo + 16384, 0); AT_DMAO(vfp, lds + bo + 16384, 1024); }
            if (kt + 2 < ntiles && wave < 2) AT_DMA4(smp, lds + AT_MASKR + ((kt + 2) & 3) * 512 + wave * 256);
            if (act) {
                f32x16 S = negm;
#pragma unroll
                for (int s = 0; s < 8; ++s) S = __builtin_amdgcn_mfma_f32_32x32x16_f16(kf[s], Qf[s], S, 0, 0, 0);

                const unsigned bits = maskr[(kt & 3) * 128 + 32 * g + l31] >> (4 * hh);
                f16x8 vf[8];
                const unsigned av = (unsigned)(__UINTPTR_TYPE__)(lds + AT_KVB + (kt & 1) * 32768 + 16384 + h2 * 8192) + lane * 16;
#define AT_RD(dst, off, dep) asm volatile("ds_read_b128 %0, %1 offset:" #off : "=v"(dst) : "v"(av), "v"(dep))
                AT_RD(vf[0], 0, bits); AT_RD(vf[2], 2048, bits); AT_RD(vf[4], 4096, bits); AT_RD(vf[6], 6144, bits);
                int mxi = 0;
#pragma unroll
                for (int i = 0; i < 16; ++i) { const unsigned mk = (unsigned)__builtin_amdgcn_sbfe((int)bits, (i & 3) + 8 * (i >> 2), 1); const float si = S[i];
                    S[i] = __builtin_bit_cast(float, (__builtin_bit_cast(unsigned, si) & mk) | (0xff61b1e6u & ~mk)); }
#pragma unroll
                for (int i = 0; i < 16; i += 2) { const float a = S[i], c = S[i + 1]; const int ai = __builtin_bit_cast(int, a), ci = __builtin_bit_cast(int, c); const int t = mxi > ai ? mxi : ai; mxi = t > ci ? t : ci; }
                { const auto r = __builtin_amdgcn_permlane32_swap((unsigned)mxi, (unsigned)mxi, false, false); const int r0 = (int)r[0], r1 = (int)r[1]; mxi = r0 > r1 ? r0 : r1; }
                const float mx = __builtin_bit_cast(float, mxi);
                if (__ballot(mx > 8.f)) { const float dlt = mx > 8.f ? mx : 0.f, alpha = __builtin_amdgcn_exp2f(-dlt);
                    mrun += dlt; lsum *= alpha;
#pragma unroll
                    for (int d = 0; d < 4; ++d)
#pragma unroll
                        for (int i = 0; i < 16; ++i) O[d][i] *= alpha;
#pragma unroll
                    for (int i = 0; i < 16; ++i) { S[i] -= dlt; negm[i] = -mrun; } }
                float ps = 0.f; f16x8 pf[2];
#pragma unroll
                for (int i = 0; i < 16; ++i) { const float pe = __builtin_amdgcn_exp2f(S[i]); ps += pe; pf[i >> 3][i & 7] = (_Float16)pe; }
                lsum += ps;
                asm volatile("s_waitcnt lgkmcnt(0)" : "+v"(vf[0]), "+v"(vf[2]), "+v"(vf[4]), "+v"(vf[6]));
                AT_RD(vf[1], 1024, vf[0]); AT_RD(vf[3], 3072, vf[0]); AT_RD(vf[5], 5120, vf[0]); AT_RD(vf[7], 7168, vf[0]);
#undef AT_RD
#pragma unroll
                for (int d = 0; d < 4; ++d) O[d] = __builtin_amdgcn_mfma_f32_32x32x16_f16(vf[d * 2], pf[0], O[d], 0, 0, 0);
                asm volatile("s_waitcnt lgkmcnt(0)" : "+v"(vf[1]), "+v"(vf[3]), "+v"(vf[5]), "+v"(vf[7]));
#pragma unroll
                for (int d = 0; d < 4; ++d) O[d] = __builtin_amdgcn_mfma_f32_32x32x16_f16(vf[d * 2 + 1], pf[1], O[d], 0, 0, 0);
            }
        }
        int lane2 = lane; asm volatile("" : "+v"(lane2)); const int l31b = lane2 & 31, hhb = lane2 >> 5;
        const float ltot = lsum + __shfl_xor(lsum, 32), inv = 1.f / ltot;
        float part = 0.f;
#pragma unroll
        for (int d = 0; d < 4; ++d)
#pragma unroll
            for (int i = 0; i < 16; ++i) { O[d][i] *= inv; part += O[d][i] * O[d][i]; }
        part += __shfl_xor(part, 32);
        if (lane2 < 32) ssq[h * 128 + 32 * g + lane2] = part;
        __syncthreads();
        const int qi = 32 * g + l31b;
        const float rstd = sp == 0 ? 1.f : rsqrtf((ssq[qi] + ssq[128 + qi] + ssq[256 + qi] + ssq[384 + qi]) * (1.f / 512.f) + EPS);
#pragma unroll
        for (int d = 0; d < 4; ++d)
#pragma unroll
            for (int ip = 0; ip < 8; ++ip) { const int i = 2 * ip, dv = d * 32 + (i & 3) + 8 * (i >> 2) + 4 * hhb;
                const float g0 = sp == 0 ? 1.f : p.att_g[h * 128 + dv], g1 = sp == 0 ? 1.f : p.att_g[h * 128 + dv + 1];
                *(LAS unsigned*)(ostw + l31b * 272 + dv * 2) = pkh(O[d][i] * rstd * g0, O[d][i + 1] * rstd * g1); }
        LDS_WAIT(); asm volatile("" ::: "memory");
#pragma unroll
        for (int i = 0; i < 8; ++i) { const int idx = i * 64 + lane2, row = idx >> 4, ch = idx & 15;
            const u32x4 v = *(const LAS u32x4*)(ostw + row * 272 + ch * 16); *(u32x4*)(cbase + (size_t)row * D + h * 128 + ch * 8) = v; }
        if (sp == 0) __syncthreads();
    }
    {
            int lane2 = lane; asm volatile("" : "+v"(lane2));
            asm volatile("s_waitcnt vmcnt(0)" ::: "memory");
#pragma unroll
            for (int i = 0; i < 8; ++i) { const int idx = i * 64 + lane2, row = idx >> 4, ch = idx & 15;
                u16* ptr = cbase + (size_t)row * D + h2 * 128 + ch * 8; const u32x4 v = *(const u32x4*)ptr; const int qr = 32 * g + row;
                const float rs = rsqrtf((ssq[qr] + ssq[128 + qr] + ssq[256 + qr] + ssq[384 + qr]) * (1.f / 512.f) + EPS);
                const unsigned wv[4] = {v.x, v.y, v.z, v.w}; unsigned ov[4];
#pragma unroll
                for (int e = 0; e < 4; ++e) { const int dv = ch * 8 + 2 * e; ov[e] = pkh(hlo(wv[e]) * rs * p.att_g[h2 * 128 + dv], hhi(wv[e]) * rs * p.att_g[h2 * 128 + dv + 1]); }
                u32x4 o; o.x = ov[0]; o.y = ov[1]; o.z = ov[2]; o.w = ov[3]; *(u32x4*)ptr = o; } }
    __syncthreads();
}

__device__ __forceinline__ void phase_p3(const Params& p, LAS unsigned char* lds, int wave, int lane) {
    const int G = gridDim.x, bx = blockIdx.x;
    { LAS unsigned char* scr = lds + wave * 8704; const int gw = bx * NWAVES + wave, NGW = G * NWAVES;
      for (int it = gw; it < NB * 4 * (L / 32); it += NGW) vt_item(p, scr, it, lane); }
    __syncthreads();
    for (int it = bx; it < NB * 4 * NCH; it += G) gla1_item(p, lds, it, wave, lane);
    {
    if (G == 256) { const int bt = bx & 7, j = bx >> 3;
        ThrOps cur; thr_load(p, cur, bt, j, wave);
        for (int r = 0; r < 16; ++r) { const int qb = (r & 1) ? 511 - (32 * (r >> 1) + j) : 32 * (r >> 1) + j; const int rn = r < 15 ? r + 1 : r, qbn = (rn & 1) ? 511 - (32 * (rn >> 1) + j) : 32 * (rn >> 1) + j;
            ThrOps nxt; thr_load(p, nxt, bt, qbn, wave);
            thr_item(p, lds, cur, bt, qb, wave, lane); cur = nxt; } }
    else { for (int it = bx; it < NB * 512; it += G) { ThrOps cur; thr_load(p, cur, it >> 9, it & 511, wave); thr_item(p, lds, cur, it >> 9, it & 511, wave, lane); } } }
}
__device__ __forceinline__ void phase_p5(const Params& p, LAS unsigned char* lds, int wave, int lane) {
    const int G = gridDim.x, bx = blockIdx.x;
    if (G == 256) { const int bt = bx & 7, j = bx >> 3;
        for (int r = 0; r < 2; ++r) att_item(p, lds, bt, r == 0 ? 63 - j : j, wave, lane); }
    else { for (int it = bx; it < NB * 64; it += G) att_item(p, lds, it >> 6, it & 63, wave, lane); }
    { const int N = NB * 4 * NCH; G3Ops cur; if (bx < N) gla3_load(p, cur, bx, wave, lane);
      for (int it = bx; it < N; it += G) { G3Ops nxt; gla3_load(p, nxt, it + G < N ? it + G : it, wave, lane);
          gla3_item(p, lds, cur, it, wave, lane); cur = nxt; }
      __syncthreads(); }
}
}
namespace mk {
#define XB_TMO      128
#define XB_XCNT(j)  (256  + 64 * (j))
#define XB_XSUB(j)  (1280 + 64 * (j))
#define XB_XGEN(j)  (2304 + 64 * (j))
#define XB_TOP      3328
#define XB_TOPGEN   3392
#define XCD_BAR_WORDS 3456
#define XB_SPIN_CAP (1u << 18)

__device__ __forceinline__ unsigned xb_ld(unsigned* p)              { return __hip_atomic_load(p, __ATOMIC_RELAXED, __HIP_MEMORY_SCOPE_AGENT); }
__device__ __forceinline__ unsigned xb_add(unsigned* p, unsigned v) { return __hip_atomic_fetch_add(p, v, __ATOMIC_RELAXED, __HIP_MEMORY_SCOPE_AGENT); }
__device__ __forceinline__ unsigned xb_xcc_id() { return (unsigned)__builtin_amdgcn_s_getreg((3 << 11) | 20) & 0xFu; }
#define XB_SPIN(cond, bar) do { unsigned _sp = 0; while (cond) { __builtin_amdgcn_s_sleep(1); \
    if ((++_sp & 255u) == 0u) { if (xb_ld(&(bar)[XB_TMO])) break; if (_sp > XB_SPIN_CAP) { atomicAdd(&(bar)[XB_TMO], 1u); break; } } } } while (0)

struct XcdBarrier {
    unsigned* bar; unsigned x;
    volatile LAS unsigned* st;
};

__device__ __forceinline__ XcdBarrier xcd_barrier_post(unsigned* bar, volatile LAS unsigned* st) {
    XcdBarrier b; b.bar = bar; b.x = xb_xcc_id(); b.st = st;
    if (threadIdx.x == 0) (void)xb_add(&bar[XB_XCNT(b.x)], 1u);
    return b;
}
__device__ __forceinline__ void xcd_barrier_complete(unsigned* bar, unsigned x, unsigned& nloc, unsigned& nx) {
    const unsigned G = gridDim.x * gridDim.y * gridDim.z;
    unsigned sum, cnt, mine, sp = 0u;
    for (;;) {
        sum = 0u; cnt = 0u; mine = 0u;
#pragma unroll
        for (unsigned j = 0; j < 16; ++j) { const unsigned c = xb_ld(&bar[XB_XCNT(j)]); sum += c; cnt += (c > 0u) ? 1u : 0u; mine = (j == x) ? c : mine; }
        if (sum == G) break;
        __builtin_amdgcn_s_sleep(1);
        if ((++sp & 255u) == 0u) { if (xb_ld(&bar[XB_TMO])) break; if (sp > XB_SPIN_CAP) { atomicAdd(&bar[XB_TMO], 1u); break; } }
    }
    nloc = mine > 0u ? mine : 1u; nx = cnt > 0u ? cnt : 1u;
}

__device__ __forceinline__ void xcd_barrier(const XcdBarrier& b) {
    asm volatile("s_waitcnt vmcnt(0)" ::: "memory");
    __syncthreads();
    if (threadIdx.x == 0) {
        unsigned* bar = b.bar;
        __builtin_amdgcn_s_waitcnt(0);
        unsigned nloc = b.st[0], nx = b.st[1];
        if (nloc == 0u) { xcd_barrier_complete(bar, b.x, nloc, nx); b.st[0] = nloc; b.st[1] = nx; }
        const unsigned old = xb_add(&bar[XB_XSUB(b.x)], 1u);
        const unsigned gen = old / nloc;
        if (old + 1u == (gen + 1u) * nloc) {
            __builtin_amdgcn_fence(__ATOMIC_RELEASE, "agent");
            asm volatile("s_waitcnt vmcnt(0)" ::: "memory");
            const unsigned og = xb_add(&bar[XB_TOP], 1u);
            const unsigned tg = og / nx;
            if (og + 1u == (tg + 1u) * nx) xb_add(&bar[XB_TOPGEN], 1u);
            else XB_SPIN(xb_ld(&bar[XB_TOPGEN]) == tg, bar);
            __builtin_amdgcn_fence(__ATOMIC_ACQUIRE, "agent");
            xb_add(&bar[XB_XGEN(b.x)], 1u);
            asm volatile("s_waitcnt vmcnt(0)" ::: "memory");
        } else {
            XB_SPIN(xb_ld(&bar[XB_XGEN(b.x)]) == gen, bar);
            __builtin_amdgcn_fence(__ATOMIC_ACQUIRE, "agent");
            asm volatile("s_waitcnt vmcnt(0)" ::: "memory");
        }
    }
    __syncthreads();
}

}
namespace mk {
namespace cg = cooperative_groups;
constexpr int NPHASE = 11;
__global__ void __launch_bounds__(NT, 2) mk_fwd(Params p) {
    extern __shared__ __attribute__((aligned(16))) unsigned char lds_raw[];
    LAS unsigned char* lds = (LAS unsigned char*)lds_raw;
    cg::grid_group grid = cg::this_grid();
    const int tid = threadIdx.x, lane = tid & 63, wave = __builtin_amdgcn_readfirstlane(tid >> 6);
    unsigned char* ws = p.ws;
    float* mod = (float*)(ws + WS_MOD);
    volatile LAS unsigned* xst = (volatile LAS unsigned*)(lds + LDS_BYTES - 64);
    if (tid == 0) { xst[0] = 0u; xst[1] = 0u; }
    __syncthreads();
    const XcdBarrier xbar = xcd_barrier_post((unsigned*)(ws + WS_CTL), xst);
#define IN(k) (p.ph_lo <= (k) && (k) < p.ph_hi)
#define SEAM(k) do { if (IN(k) && IN((k) + 1)) { if ((k) == 0) grid.sync(); else xcd_barrier(xbar); } } while (0)
    if (IN(0)) { phase_p0a(p, lds, wave, lane); __syncthreads(); }
    SEAM(0);
    if (IN(1)) row_phase<0>(p.x, p.norm1_g, mod, 0, D, nullptr, ws + WS_H, wave, lane);
    SEAM(1);
    if (IN(2)) {
        pg8::Gemm g{(const pg8::bf16_t*)(ws + WS_H), (const pg8::bf16_t*)(ws + WS_WIN), T, 3840, D}; pg8::StaticOrder S; S.init(T, 3840, gridDim.x, blockIdx.x);
        EpiProj E{(u16*)(ws + WS_PROJ), (u16*)(ws + WS_KIDX), (float*)(ws + WS_WIDX), (float*)(ws + WS_GLR), (u16*)(ws + WS_KF)};
        pg8::gemm_phase<EpiProj, pg8::StaticOrder>(lds, g, S, E);
    }
    SEAM(2);
    if (IN(3)) phase_p3(p, lds, wave, lane);
    SEAM(3);
    if (IN(4)) phase_p4(p, lds, wave, lane);
    SEAM(4);
    if (IN(5)) phase_p5(p, lds, wave, lane);
    SEAM(5);
    if (IN(6)) {
        pg8::Gemm g{(const pg8::bf16_t*)(ws + WS_CAT), (const pg8::bf16_t*)(ws + WS_WOUT), T, D, D}; pg8::StaticOrder S; S.init(T, D, gridDim.x, blockIdx.x);
        EpiRes<false> E{p.x, (u16*)(ws + WS_X16), mod, (float*)(ws + WS_SS1), 2 * D, 0};
        pg8::gemm_phase<EpiRes<false>, pg8::StaticOrder>(lds, g, S, E);
    }
    SEAM(6);
    if (IN(7)) row_phase<1>(ws + WS_X16, p.norm2_g, mod, 3 * D, 4 * D, (const float*)(ws + WS_SS1), ws + WS_H, wave, lane);
    SEAM(7);
    if (IN(8)) {
        pg8::Gemm g{(const pg8::bf16_t*)(ws + WS_H), (const pg8::bf16_t*)(ws + WS_WGU), T, 2 * DFF, D}; pg8::StaticOrder S; S.init(T, 2 * DFF, gridDim.x, blockIdx.x);
        EpiSwiGLU E{(u16*)(ws + WS_ACT)};
        pg8::gemm_phase<EpiSwiGLU, pg8::StaticOrder>(lds, g, S, E);
    }
    SEAM(8);
    if (IN(9)) {
        pg8::Gemm g{(const pg8::bf16_t*)(ws + WS_ACT), (const pg8::bf16_t*)(ws + WS_WDN), T, D, DFF}; pg8::StaticOrder S; S.init(T, D, gridDim.x, blockIdx.x);
        EpiRes<true> E{ws + WS_X16, (u16*)(ws + WS_X16), mod, (float*)(ws + WS_SS2), 5 * D, 0};
        pg8::gemm_phase<EpiRes<true>, pg8::StaticOrder>(lds, g, S, E);
    }
    SEAM(9);
    if (IN(10)) row_phase<2>(ws + WS_X16, p.final_g, nullptr, 0, 0, (const float*)(ws + WS_SS2), p.out, wave, lane);
#undef IN
#undef SEAM
}

static int g_grid = 0;
static Params make_params(void* const* d_in, void* d_out, void* d_ws) {
    Params p{};
    p.x = (const float*)d_in[0]; p.c = (const float*)d_in[1]; p.w_mod = (const float*)d_in[2]; p.b_mod = (const float*)d_in[3]; p.norm1_g = (const float*)d_in[4];
    p.w_in = (const float*)d_in[5]; p.w_gate2 = (const float*)d_in[6]; p.b_gate2 = (const float*)d_in[7]; p.att_g = (const float*)d_in[8]; p.gla_g = (const float*)d_in[9];
    p.w_out = (const float*)d_in[10]; p.norm2_g = (const float*)d_in[11]; p.w_gu = (const float*)d_in[12]; p.w_down = (const float*)d_in[13]; p.final_g = (const float*)d_in[14];
    p.out = (float*)d_out; p.ws = (unsigned char*)d_ws; p.ph_lo = 0; p.ph_hi = NPHASE;
    return p;
}
static bool init_grid(size_t ws_size) {
    if (g_grid) return g_grid > 0;
    int dev = 0, cus = 0, per_cu = 0;
    if (hipGetDevice(&dev) != hipSuccess || hipDeviceGetAttribute(&cus, hipDeviceAttributeMultiprocessorCount, dev) != hipSuccess) { g_grid = -1; return false; }
    if (hipFuncSetAttribute((const void*)mk_fwd, hipFuncAttributeMaxDynamicSharedMemorySize, LDS_BYTES) != hipSuccess) { fprintf(stderr, "hipFuncSetAttribute failed\n"); g_grid = -1; return false; }
    if (hipOccupancyMaxActiveBlocksPerMultiprocessor(&per_cu, (const void*)mk_fwd, NT, LDS_BYTES) != hipSuccess || per_cu < 1) { fprintf(stderr, "occupancy query: %d blocks/CU\n", per_cu); g_grid = -1; return false; }
    if (ws_size < WS_END) { fprintf(stderr, "workspace too small: %zu < %zu\n", ws_size, (size_t)WS_END); g_grid = -1; return false; }
    g_grid = cus;
    fprintf(stderr, "mk: grid %d, per_cu %d, ws %zu\n", g_grid, per_cu, ws_size);
    return true;
}
static void launch(Params p, int lo, int hi, hipStream_t stream) {
    p.ph_lo = lo; p.ph_hi = hi;
    if (hipMemsetAsync(p.ws + WS_CTL, 0, 16384, stream) != hipSuccess) { fprintf(stderr, "hipMemsetAsync of the barrier words failed\n"); return; }
    void* args[] = {&p};
    const hipError_t e = hipLaunchCooperativeKernel((const void*)mk_fwd, dim3(g_grid), dim3(NT), args, LDS_BYTES, stream);
    if (e != hipSuccess) fprintf(stderr, "cooperative launch failed: %s (grid %d)\n", hipGetErrorString(e), g_grid);
}
}

extern "C" void kernel_launch(void* const* d_in, const int* in_sizes, int n_in, void* d_out, int out_size, void* d_ws, size_t ws_size, hipStream_t stream) {
    using namespace mk;
    if (n_in != 15 || out_size != T * D) { fprintf(stderr, "kernel_launch: unexpected problem shape\n"); return; }
    if (!init_grid(ws_size)) return;
    Params p = make_params(d_in, d_out, d_ws);
    launch(p, 0, NPHASE, stream);
}
```

```cpp
#include <hip/hip_runtime.h>
#include <hip/hip_cooperative_groups.h>
#include <cstdio>
#include <cstdint>
#include <cmath>
namespace pg8 {
#define PG8_LAS __attribute__((address_space(3)))
typedef unsigned short bf16_t;
typedef _Float16 bf16x8 __attribute__((ext_vector_type(8)));
typedef float f32x4 __attribute__((ext_vector_type(4)));
typedef unsigned u32x4 __attribute__((ext_vector_type(4)));
constexpr int BM = 256, BK = 64, HALF = 128, HTB = HALF * BK * 2  , STAGE_BYTES = 8 * HTB, NXCD = 8, WGM = 8;

__host__ __device__ __forceinline__ int lds_byte(int r, int c) { const int st = (r >> 4) * 2 + (c >> 5), rr = r & 15, cc = c & 31, ob = rr * 64 + cc * 2; return st * 1024 + (ob ^ (((ob >> 9) & 1) << 5)); }
__host__ __device__ __forceinline__ void stage_rc(int b, int& R, int& C) { const int st = b / 1024, sb = b % 1024, swz = sb ^ (((sb >> 9) & 1) << 5); R = (st >> 1) * 16 + swz / 64; C = (st & 1) * 32 + (swz % 64) / 2; }
__host__ __device__ __forceinline__ int perm32(int rho) { const int n = rho >> 4, i = rho & 15; return 8 * (i >> 2) + 4 * n + (i & 3); }

struct Unit { int pm, pn; };
struct Gemm { const bf16_t* A; const bf16_t* Bt; int M, N, K; };

struct StaticOrder {
    int nM, nN, nwg, G, c, wgm;
    __host__ __device__ void init(int M, int N, int G_, int c_, int wgm_ = WGM) { nM = M / BM; nN = N / BM; nwg = nM * nN; G = G_; c = c_; wgm = wgm_; }
    __host__ __device__ bool next(int i, Unit& u) const {
        const long L = (long)i * G + c; if (L >= nwg) return false;
        int wgid = (int)L; { const int q = nwg / NXCD, r = nwg % NXCD, xcd = wgid % NXCD, off = wgid / NXCD; wgid = (xcd < r ? xcd * (q + 1) : r * (q + 1) + (xcd - r) * q) + off; }
        const int nig = wgm * nN, gid = wgid / nig, fm = gid * wgm, gsz = (nM - fm) < wgm ? (nM - fm) : wgm;
        u.pm = fm + ((wgid % nig) % gsz); u.pn = (wgid % nig) / gsz; return true;
    }
    __device__ __forceinline__ void a_ready(const Unit&) const {}
    __device__ __forceinline__ void done(const Unit&) const {}
};
template <class Epi, class Sched>
__device__ __forceinline__ void gemm_phase(PG8_LAS unsigned char* lds, const Gemm g, const Sched& S, const Epi& E) {
    const int tid = threadIdx.x, wid = __builtin_amdgcn_readfirstlane(tid >> 6), lane = tid & 63, wr = wid >> 2, wc = wid & 3, fr = lane & 15, fq = lane >> 4;
    const int K = g.K, nt = K / BK;
    unsigned voffA[2], voffB[2];
#pragma unroll
    for (int i = 0; i < 2; ++i) { int R, C; stage_rc(tid * 16 + i * 8192, R, C); const int Rb = Epi::PERM ? ((R & ~31) + perm32(R & 31)) : R;
        voffA[i] = (unsigned)(R * K + C) * 2u; voffB[i] = (unsigned)(Rb * K + C) * 2u; }
    const size_t kstep = (size_t)(BK * 2);
    const size_t hstep = (size_t)HALF * K * 2;
    const size_t tstep = 2 * hstep;
    const unsigned ldsw = (unsigned)wid * 1024u;
    const int aoff = lds_byte(wr * 64 + fr, fq * 8), boff = lds_byte(wc * 32 + fr, fq * 8);
#define PG8_SA(b, h) (((b) * 2 + (h)) * HTB)
#define PG8_SB(b, h) ((4 + (b) * 2 + (h)) * HTB)
#define PG8_STAGE(bufoff, gbase, voff) do { _Pragma("unroll") for (int _i = 0; _i < 2; ++_i) \
        __builtin_amdgcn_global_load_lds((const unsigned*)((const char*)(gbase) + (voff)[_i]), (PG8_LAS unsigned*)(lds + (bufoff) + ldsw + _i * 8192), 16, 0, 0); } while (0)
#define PG8_LDA(dst, b, h) do { _Pragma("unroll") for (int m = 0; m < 4; ++m) _Pragma("unroll") for (int k = 0; k < 2; ++k) dst[m][k] = *(const PG8_LAS bf16x8*)(lds + PG8_SA(b, h) + aoff + m * 2048 + k * 1024); } while (0)
#define PG8_LDB(dst, b, h) do { _Pragma("unroll") for (int n = 0; n < 2; ++n) _Pragma("unroll") for (int k = 0; k < 2; ++k) dst[n][k] = *(const PG8_LAS bf16x8*)(lds + PG8_SB(b, h) + boff + n * 2048 + k * 1024); } while (0)
#define PG8_MMA(ai, bj, At, Bt) do { __builtin_amdgcn_s_setprio(1); _Pragma("unroll") for (int m = 0; m < 4; ++m) _Pragma("unroll") for (int n = 0; n < 2; ++n) _Pragma("unroll") for (int k = 0; k < 2; ++k) \
        acc[ai][bj][m][n] = __builtin_amdgcn_mfma_f32_16x16x32_f16(Bt[n][k], At[m][k], acc[ai][bj][m][n], 0, 0, 0); __builtin_amdgcn_s_setprio(0); } while (0)
#define PG8_WAIT_V(n) asm volatile("s_waitcnt vmcnt(" #n ")" ::: "memory")
#define PG8_WAIT_L(n) asm volatile("s_waitcnt lgkmcnt(" #n ")" ::: "memory")
#define PG8_BAR __builtin_amdgcn_s_barrier()
#define PG8_SCHED __builtin_amdgcn_sched_barrier(0)
    Unit cur, nxt; int ui = 0;
    if (!S.next(0, cur)) return;
    f32x4 acc[2][2][4][2];
#pragma unroll
    for (int a = 0; a < 2; ++a)
#pragma unroll
        for (int b = 0; b < 2; ++b)
#pragma unroll
            for (int m = 0; m < 4; ++m)
#pragma unroll
                for (int n = 0; n < 2; ++n) acc[a][b][m][n] = (f32x4){0.f, 0.f, 0.f, 0.f};
    bf16x8 At[4][2], B0[2][2], B1[2][2];
    const char* cA = (const char*)g.A + (size_t)cur.pm * tstep; const char* cB = (const char*)g.Bt + (size_t)cur.pn * tstep;
    S.a_ready(cur);
    PG8_STAGE(PG8_SB(0, 0), cB, voffB); PG8_STAGE(PG8_SA(0, 0), cA, voffA); PG8_STAGE(PG8_SB(0, 1), cB + hstep, voffB); PG8_STAGE(PG8_SA(0, 1), cA + hstep, voffA);
    if (wr == 1) PG8_BAR;
    PG8_WAIT_V(4); PG8_BAR;
    PG8_STAGE(PG8_SB(1, 0), cB + kstep, voffB); PG8_STAGE(PG8_SA(1, 0), cA + kstep, voffA); PG8_STAGE(PG8_SB(1, 1), cB + hstep + kstep, voffB);
    PG8_WAIT_V(6); PG8_BAR;
    for (;;) {
        const bool has_next = S.next(ui + 1, nxt);
        const char* nA = has_next ? (const char*)g.A + (size_t)nxt.pm * tstep : cA; const char* nB = has_next ? (const char*)g.Bt + (size_t)nxt.pn * tstep : cB;
        for (int t = 0; t < nt; t += 2) {
            const bool last = (t == nt - 2);
            const char* a1 = cA + (size_t)(t + 1) * kstep;
            const char* a2 = last ? nA : cA + (size_t)(t + 2) * kstep; const char* b2 = last ? nB : cB + (size_t)(t + 2) * kstep;
            const char* a3 = a2 + kstep; const char* b3 = b2 + kstep;
            if (last && has_next) S.a_ready(nxt);
            PG8_LDB(B0, 0, 0); PG8_SCHED; PG8_LDA(At, 0, 0); PG8_STAGE(PG8_SA(1, 1), a1 + hstep, voffA);
            PG8_WAIT_L(8); PG8_BAR; PG8_WAIT_L(0); PG8_MMA(0, 0, At, B0); PG8_BAR; PG8_SCHED;
            PG8_LDB(B1, 0, 1); PG8_STAGE(PG8_SB(0, 0), b2, voffB);
            PG8_BAR; PG8_WAIT_L(0); PG8_MMA(0, 1, At, B1); PG8_BAR;
            PG8_LDA(At, 0, 1); PG8_STAGE(PG8_SA(0, 0), a2, voffA);
            PG8_BAR; PG8_WAIT_L(0); PG8_MMA(1, 0, At, B0); PG8_BAR; PG8_SCHED;
            PG8_STAGE(PG8_SB(0, 1), b2 + hstep, voffB);
            PG8_WAIT_V(6); PG8_BAR; PG8_MMA(1, 1, At, B1); PG8_BAR;
            PG8_LDB(B0, 1, 0); PG8_SCHED; PG8_LDA(At, 1, 0); PG8_STAGE(PG8_SA(0, 1), a2 + hstep, voffA);
            PG8_WAIT_L(8); PG8_BAR; PG8_WAIT_L(0); PG8_MMA(0, 0, At, B0); PG8_BAR; PG8_SCHED;
            PG8_LDB(B1, 1, 1); PG8_STAGE(PG8_SB(1, 0), b3, voffB);
            PG8_BAR; PG8_WAIT_L(0); PG8_MMA(0, 1, At, B1); PG8_BAR;
            PG8_LDA(At, 1, 1); PG8_STAGE(PG8_SA(1, 0), a3, voffA);
            PG8_BAR; PG8_WAIT_L(0); PG8_MMA(1, 0, At, B0); PG8_BAR; PG8_SCHED;
            PG8_STAGE(PG8_SB(1, 1), b3 + hstep, voffB);
            PG8_WAIT_V(6); PG8_BAR; PG8_MMA(1, 1, At, B1); PG8_BAR;
        }
        if constexpr (!Epi::AFTER_DRAIN) { E(acc, cur, wr, wc, fr, fq); S.done(cur); }
        if (!has_next) break;
#pragma unroll
        for (int a = 0; a < 2; ++a)
#pragma unroll
            for (int b = 0; b < 2; ++b)
#pragma unroll
                for (int m = 0; m < 4; ++m)
#pragma unroll
                    for (int n = 0; n < 2; ++n) acc[a][b][m][n] = (f32x4){0.f, 0.f, 0.f, 0.f};
        cur = nxt; cA = nA; cB = nB; ++ui;
    }
    PG8_WAIT_V(0);
    if (wr == 0) PG8_BAR;
    PG8_BAR;
    if constexpr (Epi::AFTER_DRAIN) { E.fused(acc, cur, wr, wc, fr, fq, lds, wid, lane); S.done(cur); }
#undef PG8_SA
#undef PG8_SB
#undef PG8_STAGE
#undef PG8_LDA
#undef PG8_LDB
#undef PG8_MMA
#undef PG8_WAIT_V
#undef PG8_WAIT_L
#undef PG8_BAR
#undef PG8_SCHED
}
}
namespace mk {
#define LAS __attribute__((address_space(3)))
using pg8::f32x4; using pg8::u32x4; using pg8::Unit;
typedef float f32x2 __attribute__((ext_vector_type(2)));
typedef float f32x16 __attribute__((ext_vector_type(16)));
typedef _Float16 h2v __attribute__((ext_vector_type(2)));
typedef _Float16 f16x8 __attribute__((ext_vector_type(8)));
typedef _Float16 f16x4 __attribute__((ext_vector_type(4)));
typedef short bf16x8 __attribute__((ext_vector_type(8)));
typedef unsigned u32x2 __attribute__((ext_vector_type(2)));
typedef unsigned short u16;

constexpr int NWAVES = 8, NT = 512;
constexpr int D = 1024, NB = 8, L = 8192, T = NB * L, DIN = 3672, DFF = 2816;
constexpr int PJ = 3584;
constexpr int CQ = 0, CK = 512, CV = 1024, CQI = 1536, CGQ = 2048, CGK = 2304, CGV = 2560, CGO = 3072;
constexpr float EPS = 1e-6f;
constexpr float IDX_SCALE = 0.35355339059327373f * 0.125f;
constexpr size_t MiB = 1u << 20;
constexpr size_t WS_CTL = 0, WS_MOD = 1 * MiB, WS_WIN = 2 * MiB, WS_WOUT = 10 * MiB, WS_WGU = 12 * MiB, WS_WDN = 23 * MiB;
constexpr size_t WS_SS1 = 29 * MiB, WS_SS2 = 33 * MiB, WS_KIDX = 37 * MiB, WS_WIDX = 45 * MiB, WS_GLR = 47 * MiB, WS_THR = 51 * MiB;
constexpr size_t WS_H = 64 * MiB, WS_CAT = 192 * MiB, WS_PROJ = 320 * MiB, WS_ACT = 320 * MiB, WS_GLAS = 768 * MiB, WS_VT = 896 * MiB, WS_KF = 960 * MiB, WS_END = 1024 * MiB;
constexpr int LDS_BYTES = 163840;

struct Params {
    const float *x, *c, *w_mod, *b_mod, *norm1_g, *w_in, *w_gate2, *b_gate2, *att_g, *gla_g, *w_out, *norm2_g, *w_gu, *w_down, *final_g;
    float* out; unsigned char* ws; int ph_lo, ph_hi;
};

__device__ __forceinline__ unsigned pkh(float a, float b) { const h2v h = __builtin_convertvector((f32x2){a, b}, h2v); return __builtin_bit_cast(unsigned, h); }
__device__ __forceinline__ float silu_f(float v) { return v * __builtin_amdgcn_rcpf(1.f + __expf(-v)); }
__device__ __forceinline__ float wave_sum(float v) {
#pragma unroll
    for (int o = 1; o < 64; o <<= 1) v += __shfl_xor(v, o);
    return v;
}
__device__ __forceinline__ float rows_sum(float s) {
    { const unsigned u = __builtin_bit_cast(unsigned, s); const auto r = __builtin_amdgcn_permlane16_swap(u, u, false, false); const unsigned a = r[0], b = r[1]; s = __builtin_bit_cast(float, a) + __builtin_bit_cast(float, b); }
    { const unsigned u = __builtin_bit_cast(unsigned, s); const auto r = __builtin_amdgcn_permlane32_swap(u, u, false, false); const unsigned a = r[0], b = r[1]; s = __builtin_bit_cast(float, a) + __builtin_bit_cast(float, b); }
    return s;
}
#define LDS_WAIT() asm volatile("s_waitcnt lgkmcnt(0)" ::: "memory")

struct MapIn { __device__ __forceinline__ int operator()(int n) const {
    if (n < 2048) return n; if (n < 3584) return n + 72; if (n < 3648) return 2048 + (n - 3584); if (n < 3656) return 2112 + (n - 3648); if (n < 3672) return n; return -1; } };
struct MapGU { __device__ __forceinline__ int operator()(int n) const { const int pn = n >> 8, r = n & 255; return r < 128 ? 128 * pn + r : DFF + 128 * pn + (r - 128); } };
struct MapId { __device__ __forceinline__ int operator()(int n) const { return n; } };

template <class Map>
__device__ __forceinline__ void transpose_item(const float* __restrict__ W, int K, int Nsrc, u16* __restrict__ WT, int nblk, LAS float* scr, int item, int lane, Map map) {
    const int kb = item / nblk, nb = item % nblk, k0 = 64 * kb, n0 = 32 * nb;
    const int sc = map(n0 + (lane & 31));
#pragma unroll 8
    for (int i = 0; i < 32; ++i) { const int kk = 2 * i + (lane >> 5); const float v = W[(size_t)(k0 + kk) * Nsrc + (sc >= 0 ? sc : 0)]; scr[kk * 33 + (lane & 31)] = sc >= 0 ? v : 0.f; }
    LDS_WAIT(); asm volatile("" ::: "memory");
    const int c = lane & 7;
#pragma unroll
    for (int j = 0; j < 4; ++j) { const int n = (lane >> 3) + 8 * j; const LAS float* s = scr + (8 * c) * 33 + n;
        u32x4 o; o.x = pkh(s[0 * 33], s[1 * 33]); o.y = pkh(s[2 * 33], s[3 * 33]); o.z = pkh(s[4 * 33], s[5 * 33]); o.w = pkh(s[6 * 33], s[7 * 33]);
        *(u32x4*)(WT + (size_t)(n0 + n) * K + k0 + 8 * c) = o; }
    LDS_WAIT(); asm volatile("" ::: "memory");
}

__device__ __forceinline__ void phase_p0a(const Params& p, LAS unsigned char* lds, int wave, int lane) {
    LAS float* sct = (LAS float*)(lds + 98304);
    for (int i = threadIdx.x; i < NB * D; i += NT) { const float cv = p.c[i]; sct[i] = cv / (1.f + expf(-cv)); }
    __syncthreads();
    const int gw = blockIdx.x * NWAVES + wave, NGW = gridDim.x * NWAVES;
    float* mod = (float*)(p.ws + WS_MOD);
    for (int it = gw; it < 6 * D / 16; it += NGW) {
        const int j = it * 16 + (lane & 15), kq = lane >> 4;
        float acc[NB];
#pragma unroll
        for (int b = 0; b < NB; ++b) acc[b] = 0.f;
#pragma unroll 4
        for (int k4 = 0; k4 < D / 4; ++k4) { const int k = 4 * k4 + kq; const float w = p.w_mod[(size_t)k * (6 * D) + j];
#pragma unroll
            for (int b = 0; b < NB; ++b) acc[b] += sct[b * D + k] * w; }
#pragma unroll
        for (int b = 0; b < NB; ++b) acc[b] = rows_sum(acc[b]);
        if (lane < 16) { const float bm = p.b_mod[j];
#pragma unroll
            for (int b = 0; b < NB; ++b) mod[b * 6 * D + j] = acc[b] + bm; }
    }
    LAS float* scr = (LAS float*)(lds + wave * 8704);
    constexpr int I_IN = (D / 64) * (3840 / 32), I_OUT = (D / 64) * (D / 32), I_GU = (D / 64) * (2 * DFF / 32), I_DN = (DFF / 64) * (D / 32);
    constexpr int NITEMS = I_IN + I_OUT + I_GU + I_DN;
    for (int it = gw; it < NITEMS; it += NGW) {
        int r = it;
        if (r < I_IN) { transpose_item(p.w_in, D, DIN, (u16*)(p.ws + WS_WIN), 3840 / 32, scr, r, lane, MapIn()); continue; } r -= I_IN;
        if (r < I_OUT) { transpose_item(p.w_out, D, D, (u16*)(p.ws + WS_WOUT), D / 32, scr, r, lane, MapId()); continue; } r -= I_OUT;
        if (r < I_GU) { transpose_item(p.w_gu, D, 2 * DFF, (u16*)(p.ws + WS_WGU), 2 * DFF / 32, scr, r, lane, MapGU()); continue; } r -= I_GU;
        transpose_item(p.w_down, DFF, D, (u16*)(p.ws + WS_WDN), D / 32, scr, r, lane, MapId());
    }
}

template <int MODE>
__device__ __forceinline__ void row_phase(const void* xin, const float* __restrict__ g, const float* __restrict__ mod, int sh_off, int sc_off, const float* __restrict__ ss, void* outp, int wave, int lane) {
    const int gw = blockIdx.x * NWAVES + wave, NGW = gridDim.x * NWAVES;
    f32x4 gv[4];
#pragma unroll
    for (int j = 0; j < 4; ++j) gv[j] = ((const f32x4*)g)[lane + 64 * j];
    auto load = [&](f32x4 (&v)[4], int m) __attribute__((always_inline)) {
        if (MODE == 0) { const f32x4* xr = (const f32x4*)((const float*)xin + (size_t)m * D) + lane;
#pragma unroll
            for (int j = 0; j < 4; ++j) v[j] = __builtin_nontemporal_load(xr + 64 * j); }
        else { const u32x2* xr = (const u32x2*)((const u16*)xin + (size_t)m * D) + lane;
#pragma unroll
            for (int j = 0; j < 4; ++j) { const u32x2 w = xr[64 * j]; const unsigned wx = w.x, wy = w.y; const h2v a = __builtin_bit_cast(h2v, wx), b = __builtin_bit_cast(h2v, wy); v[j] = (f32x4){(float)a[0], (float)a[1], (float)b[0], (float)b[1]}; } }
    };
    auto finish = [&](f32x4 (&v)[4], int m) __attribute__((always_inline)) {
        float tot;
        if (MODE == 0) { float s = 0.f;
#pragma unroll
            for (int j = 0; j < 4; ++j) s += (v[j].x * v[j].x + v[j].y * v[j].y) + (v[j].z * v[j].z + v[j].w * v[j].w);
            tot = wave_sum(s); }
        else { const f32x4* sp = (const f32x4*)(ss + (size_t)m * 16); const f32x4 a = sp[0], b = sp[1], c = sp[2], d = sp[3];
            tot = ((a.x + a.y) + (a.z + a.w)) + ((b.x + b.y) + (b.z + b.w)) + ((c.x + c.y) + (c.z + c.w)) + ((d.x + d.y) + (d.z + d.w)); }
        const float rstd = rsqrtf(tot * (1.f / D) + EPS);
        if (MODE == 2) { f32x4* o = (f32x4*)((float*)outp + (size_t)m * D) + lane;
#pragma unroll
            for (int j = 0; j < 4; ++j) __builtin_nontemporal_store(v[j] * rstd * gv[j], o + 64 * j); }
        else { const float* mb = mod + (m >> 13) * (6 * D);
            u32x2* o = (u32x2*)((u16*)outp + (size_t)m * D) + lane;
#pragma unroll
            for (int j = 0; j < 4; ++j) { const f32x4 sc = ((const f32x4*)(mb + sc_off))[lane + 64 * j], sh = ((const f32x4*)(mb + sh_off))[lane + 64 * j];
                const f32x4 r = v[j] * rstd * gv[j] * (sc + 1.f) + sh; u32x2 w; w.x = pkh(r.x, r.y); w.y = pkh(r.z, r.w); o[64 * j] = w; } }
    };
    for (int m = gw; m < T; m += 2 * NGW) {
        f32x4 va[4], vb[4];
        load(va, m); const bool two = m + NGW < T; if (two) load(vb, m + NGW);
        finish(va, m); if (two) finish(vb, m + NGW);
    }
}

struct EpiProj {
    static constexpr bool PERM = true, AFTER_DRAIN = false;
    u16* P; u16* kidx; float* widx; float* glr; u16* kf;
    __device__ __forceinline__ void operator()(const f32x4 (&acc)[2][2][4][2], const Unit& u, int wr, int wc, int fr, int fq) const {
        const int row0 = u.pm * 256 + wr * 64 + fr;
        if (u.pn < 14) {
            const int col0 = u.pn * 256 + wc * 32 + 8 * fq;
#pragma unroll
            for (int ai = 0; ai < 2; ++ai)
#pragma unroll
                for (int m = 0; m < 4; ++m) { u16* rowp = P + (size_t)(row0 + ai * 128 + m * 16) * PJ + col0;
#pragma unroll
                    for (int bj = 0; bj < 2; ++bj) { const f32x4 v0 = acc[ai][bj][m][0], v1 = acc[ai][bj][m][1];
                        u32x4 w; w.x = pkh(v0[0], v0[1]); w.y = pkh(v0[2], v0[3]); w.z = pkh(v1[0], v1[1]); w.w = pkh(v1[2], v1[3]);
                        if (u.pn == 2 || u.pn == 3) {
                            const int row = row0 + ai * 128 + m * 16, hd = 2 * (u.pn - 2) + bj, bb = row >> 13, kt = (row & 8191) >> 5;
                            __builtin_nontemporal_store(w, (u32x4*)(kf + ((((size_t)(bb * 4 + hd) * 256 + kt) * 8 + 2 * wc + (fq >> 1)) * 64 + (fq & 1) * 32 + (row & 31)) * 8)); }
                        else __builtin_nontemporal_store(w, (u32x4*)(rowp + bj * 128)); } }
        } else {
#pragma unroll
            for (int ai = 0; ai < 2; ++ai)
#pragma unroll
                for (int m = 0; m < 4; ++m) { const size_t row = (size_t)(row0 + ai * 128 + m * 16); const f32x4 v0 = acc[ai][0][m][0], v1 = acc[ai][0][m][1];
                    if (wc < 2) { u32x4 w; w.x = pkh(v0[0], v0[1]); w.y = pkh(v0[2], v0[3]); w.z = pkh(v1[0], v1[1]); w.w = pkh(v1[2], v1[3]);
                        *(u32x4*)(kidx + (((row >> 5) * 4 + 2 * wc + (fq >> 1)) * 64 + (fq & 1) * 32 + (row & 31)) * 8) = w; }
                    else if (wc == 2) {
                        if (fq == 0) { *(f32x4*)(widx + row * 8) = v0 * IDX_SCALE; *(f32x4*)(widx + row * 8 + 4) = v1 * IDX_SCALE; }
                        else if (fq < 3) { *(f32x4*)(glr + row * 16 + (fq - 1) * 8) = v0; *(f32x4*)(glr + row * 16 + (fq - 1) * 8 + 4) = v1; } } }
        }
    }
};
template <bool BASE_HALF>
struct EpiRes {
    static constexpr bool PERM = false, AFTER_DRAIN = false;
    const void* base; u16* out; const float* mod; float* ss; int gate_off; int pad;
    __device__ __forceinline__ void operator()(const f32x4 (&acc)[2][2][4][2], const Unit& u, int wr, int wc, int fr, int fq) const {
        const int row0 = u.pm * 256 + wr * 64 + fr, col0 = u.pn * 256 + wc * 32 + 4 * fq;
        const float* g = mod + (u.pm >> 5) * (6 * D) + gate_off;
        f32x4 gv[2][2];
#pragma unroll
        for (int bj = 0; bj < 2; ++bj)
#pragma unroll
            for (int n = 0; n < 2; ++n) gv[bj][n] = *(const f32x4*)(g + col0 + bj * 128 + n * 16);
#pragma unroll
        for (int ai = 0; ai < 2; ++ai) {
            f32x4 bsf[4][2][2]; u32x2 bsh[4][2][2];
#pragma unroll
            for (int m = 0; m < 4; ++m)
#pragma unroll
                for (int bj = 0; bj < 2; ++bj)
#pragma unroll
                    for (int n = 0; n < 2; ++n) { const size_t off = (size_t)(row0 + ai * 128 + m * 16) * D + col0 + bj * 128 + n * 16;
                        if (BASE_HALF) bsh[m][bj][n] = *(const u32x2*)((const u16*)base + off);
                        else bsf[m][bj][n] = __builtin_nontemporal_load((const f32x4*)((const float*)base + off)); }
#pragma unroll
            for (int m = 0; m < 4; ++m) { const size_t row = (size_t)(row0 + ai * 128 + m * 16); float s = 0.f;
#pragma unroll
                for (int bj = 0; bj < 2; ++bj)
#pragma unroll
                    for (int n = 0; n < 2; ++n) { const size_t off = row * D + col0 + bj * 128 + n * 16; f32x4 bs;
                        if (BASE_HALF) { const u32x2 wi = bsh[m][bj][n]; const unsigned wx = wi.x, wy = wi.y;        const h2v a = __builtin_bit_cast(h2v, wx), b = __builtin_bit_cast(h2v, wy); bs = (f32x4){(float)a[0], (float)a[1], (float)b[0], (float)b[1]}; }
                        else bs = bsf[m][bj][n];
                        const f32x4 o = bs + gv[bj][n] * acc[ai][bj][m][n]; u32x2 w; w.x = pkh(o[0], o[1]); w.y = pkh(o[2], o[3]); *(u32x2*)(out + off) = w;
                        s += (o[0] * o[0] + o[1] * o[1]) + (o[2] * o[2] + o[3] * o[3]); }
                s = rows_sum(s);
                if (fq == 0) ss[row * 16 + u.pn * 4 + wc] = s; } }
    }
};
struct EpiSwiGLU {
    static constexpr bool PERM = true, AFTER_DRAIN = false;
    u16* act;
    __device__ __forceinline__ void operator()(const f32x4 (&acc)[2][2][4][2], const Unit& u, int wr, int wc, int fr, int fq) const {
        const int row0 = u.pm * 256 + wr * 64 + fr, col0 = u.pn * 128 + wc * 32 + 8 * fq;
#pragma unroll
        for (int ai = 0; ai < 2; ++ai)
#pragma unroll
            for (int m = 0; m < 4; ++m) { const f32x4 g0 = acc[ai][0][m][0], g1 = acc[ai][0][m][1], u0 = acc[ai][1][m][0], u1 = acc[ai][1][m][1];
                float a[8];
#pragma unroll
                for (int j = 0; j < 4; ++j) { a[j] = silu_f(g0[j]) * u0[j]; a[4 + j] = silu_f(g1[j]) * u1[j]; }
                u32x4 w; w.x = pkh(a[0], a[1]); w.y = pkh(a[2], a[3]); w.z = pkh(a[4], a[5]); w.w = pkh(a[6], a[7]);
                __builtin_nontemporal_store(w, (u32x4*)(act + (size_t)(row0 + ai * 128 + m * 16) * DFF + col0)); }
    }
};
}
#define MK_HAVE_MIX 1
namespace mk {
constexpr size_t WS_GDEC = 52 * MiB;
constexpr size_t WS_SELM = WS_H + 64 * MiB;
constexpr size_t WS_X16 = WS_GLAS;
constexpr size_t WS_S16 = WS_H;
constexpr int NCH = L / 64;

__device__ __forceinline__ unsigned f2bf(float f) { unsigned u = __builtin_bit_cast(unsigned, f); return (u + 0x7fffu + ((u >> 16) & 1u)) >> 16; }
__device__ __forceinline__ unsigned pkbf(float lo, float hi) { return f2bf(lo) | (f2bf(hi) << 16); }
__device__ __forceinline__ float h2f(u16 h) { return (float)__builtin_bit_cast(_Float16, h); }
__device__ __forceinline__ float hlo(unsigned w) { return h2f((u16)(w & 0xffffu)); }
__device__ __forceinline__ float hhi(unsigned w) { return h2f((u16)(w >> 16)); }
__device__ __forceinline__ int kperm16(int o) { return 8 * ((o >> 2) & 1) + 4 * (o >> 3) + (o & 3); }

__device__ __forceinline__ void vt_item(const Params& p, LAS unsigned char* scr  , int item, int lane) {
    const int tb = item & 255, h = (item >> 8) & 3, b = item >> 10, t0 = tb * 32;
    const u16* src = (const u16*)(p.ws + WS_PROJ) + (size_t)(b * L + t0) * PJ + CV + h * 128;
#pragma unroll
    for (int i = 0; i < 8; ++i) { const int r = 4 * i + (lane >> 4), ch = lane & 15; const u32x4 v = *(const u32x4*)(src + (size_t)r * PJ + ch * 8);
        LAS unsigned* d = (LAS unsigned*)(scr + r * 264 + ch * 16); d[0] = v.x; d[1] = v.y; d[2] = v.z; d[3] = v.w; }
    LDS_WAIT(); asm volatile("" ::: "memory");
    u16* dst = (u16*)(p.ws + WS_VT) + ((size_t)(b * 4 + h) * 256 + tb) * 4096;
#pragma unroll
    for (int i = 0; i < 8; ++i) { const int c = i * 64 + lane, dv = c & 127, tg = c >> 7;
        unsigned w[4];
#pragma unroll
        for (int jp = 0; jp < 4; ++jp) { const int j = 2 * jp, tok = 16 * (tg >> 1) + 8 * (j >> 2) + 4 * (tg & 1) + (j & 3);
            const unsigned lo = *(LAS u16*)(scr + tok * 264 + dv * 2), hi = *(LAS u16*)(scr + (tok + 1) * 264 + dv * 2); w[jp] = lo | (hi << 16); }
        u32x4 o; o.x = w[0]; o.y = w[1]; o.z = w[2]; o.w = w[3];
        *(u32x4*)(dst + ((((dv >> 5) * 2 + (tg >> 1)) * 2 + (tg & 1)) * 32 + (dv & 31)) * 8) = o; }
    LDS_WAIT(); asm volatile("" ::: "memory");
}

constexpr int GL_SEG = 106496;
constexpr int GL_GLR = 0, GL_WG = 4096, GL_BG = 8192, GL_BC = 8448, GL_QD = 25088, GL_KD = 34304, GL_QP = 43520, GL_VT = 52736, GL_SSQ = 71168, GL_OST = 72192, GL_END = 105984;
constexpr int GST = 72;
__device__ __forceinline__ void gla_bcum(const Params& p, LAS unsigned char* lds, int b, int h, int c) {
    const int tid = threadIdx.x;
    LAS float* glr = (LAS float*)(lds + GL_GLR); LAS float* wg = (LAS float*)(lds + GL_WG); LAS float* bg = (LAS float*)(lds + GL_BG); LAS float* bc = (LAS float*)(lds + GL_BC);
    const float* gsrc = (const float*)(p.ws + WS_GLR) + (size_t)(b * L + c * 64) * 16;
    for (int i = tid; i < 1024; i += NT) { glr[i] = gsrc[i]; wg[i] = p.w_gate2[(i >> 6) * 256 + h * 64 + (i & 63)]; }
    if (tid < 64) bg[tid] = p.b_gate2[h * 64 + tid];
    __syncthreads();
    { const int dk = tid & 63; float wr[16];
#pragma unroll
      for (int r = 0; r < 16; ++r) wr[r] = wg[r * 64 + dk];
      const float bias = bg[dk];
#pragma unroll
      for (int i = 0; i < 8; ++i) { const int t = (tid >> 6) + 8 * i; float z = bias;
#pragma unroll
          for (int r4 = 0; r4 < 4; ++r4) { const f32x4 gq = *(const LAS f32x4*)(glr + t * 16 + 4 * r4); z += gq[0] * wr[4 * r4] + gq[1] * wr[4 * r4 + 1] + gq[2] * wr[4 * r4 + 2] + gq[3] * wr[4 * r4 + 3]; }
          bc[t * 65 + dk] = (fminf(z, 0.f) - __logf(1.f + __expf(-fabsf(z)))) * (1.f / 16.f); } }
    __syncthreads();
    { const int dk = tid & 63, sg = tid >> 6; LAS float* segt = (LAS float*)(lds + GL_SEG);
      float v[8], run = 0.f;
#pragma unroll
      for (int i = 0; i < 8; ++i) { run += bc[(sg * 8 + i) * 65 + dk]; v[i] = run; }
      segt[sg * 64 + dk] = run;
      __syncthreads();
      float off = 0.f;
#pragma unroll
      for (int j = 0; j < 7; ++j) off += (j < sg) ? segt[j * 64 + dk] : 0.f;
#pragma unroll
      for (int i = 0; i < 8; ++i) bc[(sg * 8 + i) * 65 + dk] = v[i] + off; }
    __syncthreads();
}

__device__ __forceinline__ void gla1_item(const Params& p, LAS unsigned char* lds, int item, int wave, int lane) {
    const int tid = threadIdx.x, c = item & (NCH - 1), h = (item >> 7) & 3, b = item >> 9;
    const u16* prow = (const u16*)(p.ws + WS_PROJ) + (size_t)(b * L + c * 64) * PJ;
    unsigned kw0[4], kw1[4], vw0[8], vw1[8];
#pragma unroll
    for (int i = 0; i < 4; ++i) { const int idx = tid + NT * i, dk = idx & 63, t = 2 * (idx >> 6);
        kw0[i] = prow[(size_t)t * PJ + CGK + h * 64 + dk]; kw1[i] = prow[(size_t)(t + 1) * PJ + CGK + h * 64 + dk]; }
#pragma unroll
    for (int i = 0; i < 8; ++i) { const int idx = tid + NT * i, dv = idx & 127, t = 2 * (idx >> 7);
        vw0[i] = prow[(size_t)t * PJ + CGV + h * 128 + dv]; vw1[i] = prow[(size_t)(t + 1) * PJ + CGV + h * 128 + dv]; }
    gla_bcum(p, lds, b, h, c);
    LAS float* bc = (LAS float*)(lds + GL_BC); LAS u16* KT = (LAS u16*)(lds + GL_KD); LAS u16* VTl = (LAS u16*)(lds + GL_VT);
#pragma unroll
    for (int i = 0; i < 4; ++i) { const int idx = tid + NT * i, dk = idx & 63, t = 2 * (idx >> 6); const float bl = bc[63 * 65 + dk];
        const float k0 = h2f((u16)kw0[i]) * __expf(bl - bc[t * 65 + dk]), k1 = h2f((u16)kw1[i]) * __expf(bl - bc[(t + 1) * 65 + dk]);
        *(LAS unsigned*)(KT + dk * GST + t) = pkh(k0, k1); }
#pragma unroll
    for (int i = 0; i < 8; ++i) { const int idx = tid + NT * i, dv = idx & 127, t = 2 * (idx >> 7);
        *(LAS unsigned*)(VTl + dv * GST + t) = vw0[i] | (vw1[i] << 16); }
    if (tid < 64) ((float*)(p.ws + WS_GDEC))[(size_t)item * 64 + tid] = __expf(bc[63 * 65 + tid]);
#pragma unroll
    for (int i = 0; i < 8; ++i) { const int idx = tid + NT * i, t = idx >> 6, dk = idx & 63;
        ((float*)((u16*)(p.ws + WS_PROJ) + (size_t)(b * L + c * 64 + t) * PJ + CK + h * 128))[dk] = bc[t * 65 + dk]; }
    __syncthreads();
    const int mbv = wave >> 1, nbk = wave & 1, hh = lane >> 5, l31 = lane & 31;
    f32x16 acc;
#pragma unroll
    for (int i = 0; i < 16; ++i) acc[i] = 0.f;
#pragma unroll
    for (int s = 0; s < 4; ++s) { const f16x8 a = *(const LAS f16x8*)(VTl + (mbv * 32 + l31) * GST + 16 * s + 8 * hh), bb = *(const LAS f16x8*)(KT + (nbk * 32 + l31) * GST + 16 * s + 8 * hh);
        acc = __builtin_amdgcn_mfma_f32_32x32x16_f16(a, bb, acc, 0, 0, 0); }
    float* dst = (float*)(p.ws + WS_GLAS) + (size_t)item * 8192;
#pragma unroll
    for (int i = 0; i < 16; ++i) { const int dv = mbv * 32 + (i & 3) + 8 * (i >> 2) + 4 * hh; dst[dv * 64 + nbk * 32 + l31] = acc[i]; }
    __syncthreads();
}

__device__ __forceinline__ void phase_p4(const Params& p, LAS unsigned char* lds, int wave, int lane) {
    const float* dS = (const float*)(p.ws + WS_GLAS); const float* dec = (const float*)(p.ws + WS_GDEC); unsigned* S16 = (unsigned*)(p.ws + WS_S16);
    for (int ch = blockIdx.x * NT + threadIdx.x; ch < 32 * 4096; ch += gridDim.x * NT) {
        const int bh = ch >> 12, e2 = ch & 4095, dk = (e2 * 2) & 63;
        f32x2 run = {0.f, 0.f};
#pragma unroll 16
        for (int c = 0; c < NCH; ++c) { const size_t item = (size_t)bh * NCH + c;
            const f32x2 d = *(const f32x2*)(dS + item * 8192 + e2 * 2), a = *(const f32x2*)(dec + item * 64 + dk);
            S16[item * 4096 + e2] = pkh(run.x, run.y);
            run = a * run + d; }
    }
}

struct G3Ops { unsigned qw[4], kw[4], vw0[8], vw1[8]; u32x4 g0, g1; f16x8 sfr[4]; float bw[8]; };
#define GL_SYNC() do { asm volatile("s_waitcnt lgkmcnt(0)" ::: "memory"); __builtin_amdgcn_s_barrier(); asm volatile("" ::: "memory"); } while (0)
__device__ __forceinline__ void gla3_load(const Params& p, G3Ops& o, int item, int wave, int lane) {
    const int tid = threadIdx.x, c = item & (NCH - 1), h = (item >> 7) & 3, b = item >> 9;
    const int mb = wave >> 1, hh = lane >> 5, l31 = lane & 31;
    const u16* prow = (const u16*)(p.ws + WS_PROJ) + (size_t)(b * L + c * 64) * PJ;
#pragma unroll
    for (int i = 0; i < 4; ++i) { const int idx = tid + NT * i, dk = 2 * (idx & 31), t = idx >> 5;
        o.qw[i] = *(const unsigned*)(prow + (size_t)t * PJ + CGQ + h * 64 + dk); o.kw[i] = *(const unsigned*)(prow + (size_t)t * PJ + CGK + h * 64 + dk); }
#pragma unroll
    for (int i = 0; i < 8; ++i) { const int idx = tid + NT * i, dv = idx & 127, t = 2 * (idx >> 7);
        o.vw0[i] = prow[(size_t)t * PJ + CGV + h * 128 + dv]; o.vw1[i] = prow[(size_t)(t + 1) * PJ + CGV + h * 128 + dv]; }
    const u16* gorow = prow + (size_t)(tid >> 3) * PJ + CGO + h * 128 + (tid & 7) * 16;
    o.g0 = *(const u32x4*)gorow; o.g1 = *(const u32x4*)(gorow + 8);
    { const u16* srow = (const u16*)(p.ws + WS_S16) + (size_t)item * 8192 + (size_t)(mb * 32 + l31) * 64;
#pragma unroll
      for (int s = 0; s < 4; ++s) o.sfr[s] = *(const f16x8*)(srow + 16 * s + 8 * hh); }
#pragma unroll
    for (int i = 0; i < 8; ++i) { const int idx = tid + NT * i, t = idx >> 6, dk = idx & 63; o.bw[i] = ((const float*)(prow + (size_t)t * PJ + CK + h * 128))[dk]; }
}
__device__ __forceinline__ void gla3_item(const Params& p, LAS unsigned char* lds, const G3Ops& ops, int item, int wave, int lane) {
    const int tid = threadIdx.x, c = item & (NCH - 1), h = (item >> 7) & 3, b = item >> 9;
    const int mb = wave >> 1, nb = wave & 1, hh = lane >> 5, l31 = lane & 31;
    const unsigned (&qw)[4] = ops.qw; const unsigned (&kw)[4] = ops.kw; const unsigned (&vw0)[8] = ops.vw0; const unsigned (&vw1)[8] = ops.vw1; const u32x4 g0 = ops.g0, g1 = ops.g1; const f16x8 (&sfr)[4] = ops.sfr;
    LAS float* bc = (LAS float*)(lds + GL_BC);
#pragma unroll
    for (int i = 0; i < 8; ++i) { const int idx = tid + NT * i, t = idx >> 6, dk = idx & 63; bc[t * 65 + dk] = ops.bw[i]; }
    GL_SYNC();
    LAS u16* QD = (LAS u16*)(lds + GL_QD); LAS u16* KD = (LAS u16*)(lds + GL_KD); LAS u16* QP = (LAS u16*)(lds + GL_QP); LAS u16* VTl = (LAS u16*)(lds + GL_VT);
    LAS float* ssq = (LAS float*)(lds + GL_SSQ); LAS float* ost = (LAS float*)(lds + GL_OST);
#pragma unroll
    for (int i = 0; i < 4; ++i) { const int idx = tid + NT * i, dk = 2 * (idx & 31), t = idx >> 5;
        const float b0 = bc[t * 65 + dk], b1 = bc[t * 65 + dk + 1], r0 = bc[31 * 65 + dk], r1 = bc[31 * 65 + dk + 1];
        const float q0 = hlo(qw[i]) * 0.125f, q1 = hhi(qw[i]) * 0.125f;
        *(LAS unsigned*)(QD + t * GST + dk) = pkbf(q0 * __expf(b0 - r0), q1 * __expf(b1 - r1));
        *(LAS unsigned*)(KD + t * GST + dk) = pkbf(hlo(kw[i]) * __expf(r0 - b0), hhi(kw[i]) * __expf(r1 - b1));
        *(LAS unsigned*)(QP + t * GST + dk) = pkh(q0 * __expf(b0), q1 * __expf(b1)); }
#pragma unroll
    for (int i = 0; i < 8; ++i) { const int idx = tid + NT * i, dv = idx & 127, t = 2 * (idx >> 7);
        *(LAS unsigned*)(VTl + dv * GST + (t & ~15) + kperm16(t & 15)) = vw0[i] | (vw1[i] << 16); }
    GL_SYNC();
    f16x8 pf[4];
#pragma unroll
    for (int jb = 0; jb < 2; ++jb) {
        if (jb > nb) {
#pragma unroll
            for (int e = 0; e < 8; ++e) { pf[2 * jb][e] = (_Float16)0.f; pf[2 * jb + 1][e] = (_Float16)0.f; }
            continue; }
        f32x16 x;
#pragma unroll
        for (int i = 0; i < 16; ++i) x[i] = 0.f;
#pragma unroll
        for (int s = 0; s < 4; ++s) { const bf16x8 a = *(const LAS bf16x8*)(KD + (jb * 32 + l31) * GST + 16 * s + 8 * hh), bb = *(const LAS bf16x8*)(QD + (nb * 32 + l31) * GST + 16 * s + 8 * hh);
            x = __builtin_amdgcn_mfma_f32_32x32x16_bf16(a, bb, x, 0, 0, 0); }
#pragma unroll
        for (int i = 0; i < 16; ++i) { const int rowi = (i & 3) + 8 * (i >> 2) + 4 * hh; const bool keep = (jb < nb) || (rowi <= l31); const float v = keep ? x[i] : 0.f;
            pf[2 * jb + (i >> 3)][i & 7] = (_Float16)v; }
    }
    f32x16 o;
#pragma unroll
    for (int i = 0; i < 16; ++i) o[i] = 0.f;
#pragma unroll
    for (int kk = 0; kk < 4; ++kk) { if ((kk >> 1) > nb) continue;
        const f16x8 a = *(const LAS f16x8*)(VTl + (mb * 32 + l31) * GST + 16 * kk + 8 * hh);
        o = __builtin_amdgcn_mfma_f32_32x32x16_f16(a, pf[kk], o, 0, 0, 0); }
#pragma unroll
    for (int s = 0; s < 4; ++s) { const f16x8 bb = *(const LAS f16x8*)(QP + (nb * 32 + l31) * GST + 16 * s + 8 * hh);
        o = __builtin_amdgcn_mfma_f32_32x32x16_f16(sfr[s], bb, o, 0, 0, 0); }
    float part = 0.f;
#pragma unroll
    for (int i = 0; i < 16; ++i) { part += o[i] * o[i]; ost[(nb * 32 + l31) * 132 + mb * 32 + (i & 3) + 8 * (i >> 2) + 4 * hh] = o[i]; }
    part += __shfl_xor(part, 32);
    if (lane < 32) ssq[mb * 64 + nb * 32 + lane] = part;
    GL_SYNC();
    { const int t = tid >> 3, dv0 = (tid & 7) * 16;
      const float rstd = rsqrtf((ssq[t] + ssq[64 + t] + ssq[128 + t] + ssq[192 + t]) * (1.f / 128.f) + EPS);
      const unsigned gw[8] = {g0.x, g0.y, g0.z, g0.w, g1.x, g1.y, g1.z, g1.w};
      unsigned ow[8];
#pragma unroll
      for (int e = 0; e < 8; ++e) { const int dv = dv0 + 2 * e;
          const float a0 = ost[t * 132 + dv] * rstd * p.gla_g[dv] * silu_f(hlo(gw[e])), a1 = ost[t * 132 + dv + 1] * rstd * p.gla_g[dv + 1] * silu_f(hhi(gw[e]));
          ow[e] = pkh(a0, a1); }
      u16* crow = (u16*)(p.ws + WS_CAT) + (size_t)(b * L + c * 64 + t) * D + 512 + h * 128 + dv0;
      u32x4 o0, o1; o0.x = ow[0]; o0.y = ow[1]; o0.z = ow[2]; o0.w = ow[3]; o1.x = ow[4]; o1.y = ow[5]; o1.z = ow[6]; o1.w = ow[7];
      *(u32x4*)crow = o0; *(u32x4*)(crow + 8) = o1; }
    GL_SYNC();
}
}
namespace mk {
__device__ __forceinline__ int idx_row_slot(int r) { return 2 * ((r >> 2) & 1) + (r >> 4); }
__device__ __forceinline__ int idx_row_head(int r) { return (r & 3) + 4 * ((r >> 3) & 1); }
__device__ __forceinline__ float relu_f(float x) { const int i = __builtin_bit_cast(int, x); return __builtin_bit_cast(float, i > 0 ? i : 0); }
__device__ __forceinline__ float fmul_s(float a, float b) { float r; asm("v_mul_f32_e32 %0, %1, %2" : "=v"(r) : "v"(a), "v"(b)); return r; }
__device__ __forceinline__ float fma_s(float a, float b, float c) { asm("v_fmac_f32_e32 %0, %1, %2" : "+v"(c) : "v"(a), "v"(b)); return c; }
template <int BASE> __device__ __forceinline__ float idx_score(const f32x16& acc, const f32x4 wa, const f32x4 wb) {
    float s = fmul_s(wa[0], relu_f(acc[BASE + 0]));
    s = fma_s(wa[1], relu_f(acc[BASE + 1]), s);
    s = fma_s(wa[2], relu_f(acc[BASE + 2]), s); s = fma_s(wa[3], relu_f(acc[BASE + 3]), s);
    s = fma_s(wb[0], relu_f(acc[BASE + 4]), s); s = fma_s(wb[1], relu_f(acc[BASE + 5]), s);
    s = fma_s(wb[2], relu_f(acc[BASE + 6]), s); s = fma_s(wb[3], relu_f(acc[BASE + 7]), s);
    return s;
}
__device__ __forceinline__ unsigned fkey(float f) { f = f + 0.0f; const unsigned u = __builtin_bit_cast(unsigned, f); return u ^ ((unsigned)((int)u >> 31) | 0x80000000u); }
__device__ __forceinline__ int opq(int v) { asm volatile("" : "+v"(v)); return v; }
__device__ __forceinline__ unsigned lds_add(LAS unsigned* p, unsigned v) { return __hip_atomic_fetch_add(p, v, __ATOMIC_RELAXED, __HIP_MEMORY_SCOPE_WORKGROUP); }
__device__ __forceinline__ unsigned wave_prefix_incl(unsigned v) {
#define MK_DPPADD(ctrl, rm) v += (unsigned)__builtin_amdgcn_update_dpp(0, (int)v, ctrl, rm, 0xf, false)
    MK_DPPADD(0x111, 0xf); MK_DPPADD(0x112, 0xf); MK_DPPADD(0x114, 0xf); MK_DPPADD(0x118, 0xf); MK_DPPADD(0x142, 0xa); MK_DPPADD(0x143, 0xc);
#undef MK_DPPADD
    return v;
}
__device__ __forceinline__ unsigned wave_suffix_sum(unsigned x, int lane) {
    const unsigned pre = wave_prefix_incl(x), tot = (unsigned)__builtin_amdgcn_readlane((int)pre, 63);
    return tot - pre + x;
}

template <int NP, int NC>
__device__ __forceinline__ void wave_select(const LAS unsigned* const (&cq)[NC], const unsigned (&sc)[NC][4], const unsigned (&kk0)[NC], LAS unsigned* const (&hq)[NC], int lane, const int (&rp0)[NC], const unsigned (&pre)[NC], unsigned (&out)[NC]) {
    unsigned prefix[NC], mask[NC], kk[NC];
#pragma unroll
    for (int c = 0; c < NC; ++c) { prefix[c] = pre[c]; mask[c] = rp0[c] ? (0xffffffffu << (32 - 8 * rp0[c])) : 0u; kk[c] = kk0[c]; }
    int rpmin = NP;
#pragma unroll
    for (int c = 0; c < NC; ++c) rpmin = rp0[c] < rpmin ? rp0[c] : rpmin;
    for (int rp = rpmin; rp < NP; ++rp) { const int shift = 24 - 8 * rp;
#pragma unroll
        for (int c = 0; c < NC; ++c) { u32x4 z = {0u, 0u, 0u, 0u}; *(LAS u32x4*)(hq[c] + 4 * lane) = z; }
#pragma unroll
        for (int sl = 0; sl < 4; ++sl)
#pragma unroll
            for (int i = 0; i < 4; ++i)
#pragma unroll
                for (int c = 0; c < NC; ++c) { const unsigned idx = lane + 64 * i; if (rp >= rp0[c] && idx < sc[c][sl]) { const unsigned key = fkey(__builtin_bit_cast(float, cq[c][256 * sl + idx])); if ((key & mask[c]) == prefix[c]) lds_add(hq[c] + ((key >> shift) & 255u), 1u); } }
        LDS_WAIT();
        u32x4 cw[NC]; unsigned cs[NC], incl[NC];
#pragma unroll
        for (int c = 0; c < NC; ++c) { cw[c] = *(LAS u32x4*)(hq[c] + 4 * lane); cs[c] = cw[c].x + cw[c].y + cw[c].z + cw[c].w; incl[c] = cs[c]; }
#pragma unroll
        for (int c = 0; c < NC; ++c) incl[c] = wave_suffix_sum(cs[c], lane);
#pragma unroll
        for (int c = 0; c < NC; ++c) { const unsigned above = incl[c] - cs[c]; const bool found = above < kk[c] && kk[c] <= incl[c];
            unsigned dig = 0u, kk2 = 0u;
            if (found) { unsigned cum = above; const unsigned cv[4] = {cw[c].x, cw[c].y, cw[c].z, cw[c].w};
#pragma unroll
                for (int i = 3; i >= 0; --i) { if (kk2 == 0u) { if (cum + cv[i] >= kk[c]) { dig = (unsigned)(4 * lane + i); kk2 = kk[c] - cum; } else cum += cv[i]; } } }
            const unsigned long long bal = __ballot(found); const int src = bal ? (int)__builtin_ctzll(bal) : 0;
            dig = (unsigned)__builtin_amdgcn_readlane((int)dig, src); kk2 = (unsigned)__builtin_amdgcn_readlane((int)kk2, src);
            if (rp >= rp0[c]) { prefix[c] |= dig << shift; mask[c] |= 255u << shift; kk[c] = kk2 ? kk2 : 1u; } }
    }
#pragma unroll
    for (int c = 0; c < NC; ++c) out[c] = prefix[c];
}

constexpr int TH_HIST = 0, TH_CAND = 65536, TH_ST = 131072, TH_A = 133120;
constexpr int ST_LO = 0, ST_RMAX = 16, ST_SH = 32, ST_NEED = 48, ST_MODE = 64, ST_CCNT = 80, ST_HI = 96, ST_ABOVE = 112, ST_WL = 128, ST_SAMP = 256, ST_SCNT = 272, ST_THR = 336, ST_DIRTY = 352;
__device__ __forceinline__ void thr_loadB(f16x8 (&Bf)[4], const u16* KI, int kt) {
#pragma unroll
    for (int s = 0; s < 4; ++s) Bf[s] = *(const f16x8*)(KI + (size_t)(kt * 4 + s) * 512);
}
__device__ __forceinline__ void thr_scores(const f32x16& acc, const LAS float* wl, int mb, int hh, unsigned& k0, unsigned& k1) {
    const LAS float* w0 = wl + (4 * mb + 2 * hh) * 8;
    const f32x4 a0 = *(const LAS f32x4*)(w0), b0 = *(const LAS f32x4*)(w0 + 4), a1 = *(const LAS f32x4*)(w0 + 8), b1 = *(const LAS f32x4*)(w0 + 12);
    k0 = fkey(idx_score<0>(acc, a0, b0)); k1 = fkey(idx_score<8>(acc, a1, b1));
}
constexpr int TH_MASK = 0, TH_CIDX = 16384, TH_SCR = 49152;
__device__ __forceinline__ float key2f(unsigned k) { return __builtin_bit_cast(float, (k & 0x80000000u) ? (k ^ 0x80000000u) : ~k); }
template <int KIND>
__device__ __forceinline__ void thr_sweep(LAS unsigned char* lds, const f16x8 (&A)[2][4], const u16* KI, int t0, int ntiles, int wave, int lane) {
    LAS unsigned* hist = (LAS unsigned*)(lds + TH_HIST); LAS unsigned* cand = (LAS unsigned*)(lds + TH_CAND); LAS unsigned* st = (LAS unsigned*)(lds + TH_ST);
    LAS unsigned* maskb = (LAS unsigned*)(lds + TH_MASK); LAS u16* cidx = (LAS u16*)(lds + TH_CIDX);
    const int hh = lane >> 5, l31 = lane & 31, mbp = wave & 1, ph = wave >> 1;
    unsigned lo[2][2], rmax[2][2], sh[2][2], ccn[2][2]; float lof[2][2], upf[2][2];
#pragma unroll
    for (int mbl = 0; mbl < 2; ++mbl)
#pragma unroll
        for (int jj = 0; jj < 2; ++jj) { const int ql = 8 * mbp + 4 * mbl + 2 * hh + jj; const unsigned lk = st[ST_LO + ql], rm = st[ST_RMAX + ql], uk = lk + rm;
            lo[mbl][jj] = lk; rmax[mbl][jj] = rm; sh[mbl][jj] = st[ST_SH + ql]; ccn[mbl][jj] = 0u;
            lof[mbl][jj] = lk <= 0x007fffffu ? -__builtin_inff() : key2f(lk); upf[mbl][jj] = uk >= 0xff800000u ? (lk == 0xffffffffu ? -__builtin_inff() : __builtin_inff()) : key2f(uk); }
    f16x8 B0[4], B1[4];
    const unsigned cbase4 = (unsigned)(__UINTPTR_TYPE__)(lds + TH_CAND) + ((8 * mbp + 2 * hh) * 1024 + ph * 256) * 4, cbase2 = (unsigned)(__UINTPTR_TYPE__)(lds + TH_CIDX) + ((8 * mbp + 2 * hh) * 1024 + ph * 256) * 2;
    float lofv[2][2] = {{lof[0][0], lof[0][1]}, {lof[1][0], lof[1][1]}};
    float lofc[2][2];
#pragma unroll
    for (int mbl = 0; mbl < 2; ++mbl)
#pragma unroll
        for (int jj = 0; jj < 2; ++jj) lofc[mbl][jj] = ((ntiles - 1) * 32 + l31 <= t0 + 8 * mbp + 4 * mbl + 2 * hh + jj) ? lof[mbl][jj] : __builtin_inff();
    const LAS float* wlb = (const LAS float*)(st + ST_WL) + (8 * mbp + 2 * hh) * 8;
    asm volatile("" : "+v"(wlb));
    f32x4 wreg[2][2][2];
    if (KIND == 1) {
#pragma unroll
        for (int mbl = 0; mbl < 2; ++mbl)
#pragma unroll
            for (int jj = 0; jj < 2; ++jj) { wreg[mbl][jj][0] = *(const LAS f32x4*)(wlb + (4 * mbl + jj) * 8); wreg[mbl][jj][1] = *(const LAS f32x4*)(wlb + (4 * mbl + jj) * 8 + 4); } }
    auto tile = [&](const f16x8 (&BX)[4], int kt, const bool chk) __attribute__((always_inline)) {
        const int skey = kt * 32 + l31;
        f32x16 acc[2];
#pragma unroll
        for (int mbl = 0; mbl < 2; ++mbl) {
#pragma unroll
            for (int i = 0; i < 16; ++i) acc[mbl][i] = 0.f;
#pragma unroll
            for (int s = 0; s < 4; ++s) acc[mbl] = __builtin_amdgcn_mfma_f32_32x32x16_f16(A[mbl][s], BX[s], acc[mbl], 0, 0, 0); }
#pragma unroll
        for (int mbl = 0; mbl < 2; ++mbl)
#pragma unroll
            for (int jj = 0; jj < 2; ++jj) { const int ql = 8 * mbp + 4 * mbl + 2 * hh + jj;
                const f32x4 wa = KIND == 1 ? wreg[mbl][jj][0] : *(const LAS f32x4*)(wlb + (4 * mbl + jj) * 8), wb = KIND == 1 ? wreg[mbl][jj][1] : *(const LAS f32x4*)(wlb + (4 * mbl + jj) * 8 + 4);
                const float sc = jj == 0 ? idx_score<0>(acc[mbl], wa, wb) : idx_score<8>(acc[mbl], wa, wb);
                if (KIND == 0) { const bool caus = !chk || skey <= t0 + ql;
                    const unsigned key = fkey(sc), d = key - lo[mbl][jj]; if (caus && d <= rmax[mbl][jj]) { const unsigned bin = d >> sh[mbl][jj]; lds_add(hist + ql * 1024 + (bin >> 1), 1u << (16 * (bin & 1u))); } }
                else {
                    const unsigned long long bal = __ballot(sc >= lofv[mbl][jj]);
                    const unsigned blo = (unsigned)bal, bhi = (unsigned)(bal >> 32), nlo = (unsigned)__builtin_popcount(blo), nhi = (unsigned)__builtin_popcount(bhi);
                    const unsigned cpk = ccn[mbl][jj] - (nlo << 16);
                    const int base = __builtin_amdgcn_sbfe((int)cpk, 16 * hh, 16);
                    unsigned pos = __builtin_amdgcn_mbcnt_hi(bhi, __builtin_amdgcn_mbcnt_lo(blo, (unsigned)base)); pos = pos < 255u ? pos : 255u;
                    { const unsigned a4 = cbase4 + (4 * mbl + jj) * 4096 + pos * 4, a2 = cbase2 + (4 * mbl + jj) * 2048 + pos * 2; unsigned long long sv;
                      asm volatile("s_and_saveexec_b64 %0, %1\n\tds_write_b32 %2, %3\n\tds_write_b16 %4, %5\n\ts_mov_b64 exec, %0" : "=&s"(sv) : "s"(bal), "v"(a4), "v"(sc), "v"(a2), "v"(skey) : "memory"); }
                    ccn[mbl][jj] += nlo + (nhi << 16); } }
    };
    int kt = ph; const int last = ntiles - 1;
    if (KIND == 0) {
        for (; kt < ntiles; kt += 4) { thr_loadB(B0, KI, kt); tile(B0, kt, true); }
        return; }
    thr_loadB(B0, KI, kt);
#define TH_LASTTHR() do { if (kt == last) { asm volatile("" ::: "memory");   _Pragma("unroll") for (int a = 0; a < 2; ++a) { _Pragma("unroll") for (int c = 0; c < 2; ++c) lofv[a][c] = lofc[a][c]; } } } while (0)
    for (;;) {
        thr_loadB(B1, KI, kt + 4 < last ? kt + 4 : last); TH_LASTTHR(); tile(B0, kt, kt == last); kt += 4; if (kt >= ntiles) break;
        thr_loadB(B0, KI, kt + 4 < last ? kt + 4 : last); TH_LASTTHR(); tile(B1, kt, kt == last); kt += 4; if (kt >= ntiles) break;
    }
#undef TH_LASTTHR
    if (KIND == 1) {
#pragma unroll
        for (int mbl = 0; mbl < 2; ++mbl)
#pragma unroll
            for (int jj = 0; jj < 2; ++jj) {
                if (l31 == 0) st[ST_SCNT + (8 * mbp + 4 * mbl + 2 * hh + jj) * 4 + ph] = (ccn[mbl][jj] >> (16 * hh)) & 0xffffu; } }
}
__device__ __forceinline__ void thr_write_masks(const Params& p, LAS unsigned char* lds, int b, int t0, int ntw) {
    const int tidw = opq(threadIdx.x);
    const LAS unsigned* maskb = (const LAS unsigned*)(lds + TH_MASK); const int q = tidw & 15;
    unsigned* dst = (unsigned*)(p.ws + WS_SELM) + ((size_t)(b * 128 + (t0 >> 6)) * 256) * 64 + (t0 & 63) + q;
    for (int kt = tidw >> 4; kt < ntw; kt += 32) dst[(size_t)kt * 64] = maskb[q * 256 + kt];
}
struct ThrOps { f16x8 A[2][4]; float wl; };
__device__ __forceinline__ void thr_load(const Params& p, ThrOps& o, int b, int qb, int wave) {
    const int tid = opq(threadIdx.x), lane = tid & 63, hh = lane >> 5, l31 = lane & 31, t0 = qb * 16, mbp = wave & 1;
    const u16* P16 = (const u16*)(p.ws + WS_PROJ); const int slot = idx_row_slot(l31), head = idx_row_head(l31);
#pragma unroll
    for (int mbl = 0; mbl < 2; ++mbl) { const u16* qr = P16 + (size_t)(b * L + t0 + 8 * mbp + 4 * mbl + slot) * PJ + CQI + head * 64 + 8 * hh;
#pragma unroll
        for (int s = 0; s < 4; ++s) o.A[mbl][s] = *(const f16x8*)(qr + 16 * s); }
    o.wl = ((const float*)(p.ws + WS_WIDX))[(size_t)(b * L + t0) * 8 + (tid & 127)];
}
#define TH_SYNC() do { asm volatile("s_waitcnt lgkmcnt(0)" ::: "memory"); __builtin_amdgcn_s_barrier(); asm volatile("" ::: "memory"); } while (0)
__device__ __forceinline__ void thr_item(const Params& p, LAS unsigned char* lds, const ThrOps& ops, int b, int qb, int wave, int lane) {
    int tid = opq(threadIdx.x); lane = tid & 63; int hh = lane >> 5, l31 = lane & 31; const int t0 = qb * 16;
#define TH_FRESH() do { tid = opq(tid); lane = tid & 63; hh = lane >> 5; l31 = lane & 31; } while (0)
    LAS unsigned* hist = (LAS unsigned*)(lds + TH_HIST); LAS unsigned* cand = (LAS unsigned*)(lds + TH_CAND); LAS unsigned* st = (LAS unsigned*)(lds + TH_ST);
    LAS unsigned* maskb = (LAS unsigned*)(lds + TH_MASK);
    const int ntw = 2 * (qb >> 2) + 2;
    if (tid < 16) { const int n = t0 + tid + 1;
        if (n <= 256) { st[ST_MODE + tid] = 2u; st[ST_THR + tid] = 0u; }
        else { st[ST_MODE + tid] = 0u; st[ST_LO + tid] = 0u; st[ST_RMAX + tid] = 0xffffffffu; st[ST_SH + tid] = 21u; st[ST_NEED + tid] = 256u; }
        st[ST_SAMP + tid] = 0u; }
    if (tid == 0) st[ST_DIRTY] = 0u;
    if (tid < 128) ((LAS float*)(st + ST_WL))[tid] = ops.wl;
    TH_SYNC();
    if (t0 + 16 <= 256) {
        for (int i = tid; i < 16 * 256; i += NT) { const int q = i >> 8, kt = i & 255, d = t0 + q - kt * 32; maskb[i] = d < 0 ? 0u : (d >= 31 ? 0xffffffffu : (2u << d) - 1u); }
        TH_SYNC(); thr_write_masks(p, lds, b, t0, ntw); TH_SYNC(); return; }
    const u16* P16 = (const u16*)(p.ws + WS_PROJ); const u16* KI = (const u16*)(p.ws + WS_KIDX) + (size_t)b * L * 64 + lane * 8;
    const int mbp = wave & 1, ph = wave >> 1;
    const f16x8 (&A)[2][4] = ops.A;
    const int ntiles = (t0 + 15) / 32 + 1;
    const int sd = ntiles >= 128 ? 16 : (ntiles >= 64 ? 8 : (ntiles >= 32 ? 4 : (ntiles >= 16 ? 2 : 1))), soff = sd == 16 ? 7 : (sd == 8 ? 3 : (sd == 4 ? 2 : 0)), mg = sd == 16 ? 17 : (sd == 8 ? 22 : (sd == 4 ? 30 : 35));
    const int ms = ntiles / sd;
    {
        { const LAS float* wlb = (const LAS float*)(st + ST_WL) + (8 * mbp + 2 * hh) * 8; asm volatile("" : "+v"(wlb));
          f16x8 Bs0[4], Bs1[4];
          auto stile = [&](const f16x8 (&Bs)[4], int j) __attribute__((always_inline)) { const int kt = sd * j + soff;
            f32x16 acc[2];
#pragma unroll
            for (int mbl = 0; mbl < 2; ++mbl) {
#pragma unroll
                for (int i = 0; i < 16; ++i) acc[mbl][i] = 0.f;
#pragma unroll
                for (int s = 0; s < 4; ++s) acc[mbl] = __builtin_amdgcn_mfma_f32_32x32x16_f16(A[mbl][s], Bs[s], acc[mbl], 0, 0, 0); }
#pragma unroll
            for (int mbl = 0; mbl < 2; ++mbl)
#pragma unroll
                for (int jj = 0; jj < 2; ++jj) { const int ql = 8 * mbp + 4 * mbl + 2 * hh + jj;
                    const f32x4 wa = *(const LAS f32x4*)(wlb + (4 * mbl + jj) * 8), wb = *(const LAS f32x4*)(wlb + (4 * mbl + jj) * 8 + 4);
                    const float sc = jj == 0 ? idx_score<0>(acc[mbl], wa, wb) : idx_score<8>(acc[mbl], wa, wb);
                    const bool caus = kt * 32 + l31 <= t0 + ql;
                    cand[ql * 1024 + j * 32 + l31] = caus ? __builtin_bit_cast(unsigned, sc) : 0xff800000u; }
          };
          if (ph < ms) { int j = ph; const int jl = ms - 1;
            thr_loadB(Bs0, KI, sd * j + soff);
            for (;;) {
                thr_loadB(Bs1, KI, sd * (j + 4 < jl ? j + 4 : jl) + soff); stile(Bs0, j); j += 4; if (j >= ms) break;
                thr_loadB(Bs0, KI, sd * (j + 4 < jl ? j + 4 : jl) + soff); stile(Bs1, j); j += 4; if (j >= ms) break;
            } } }
        TH_FRESH();
        if (sd == 1) { u32x4 z = {0u, 0u, 0u, 0u};
#pragma unroll
            for (int i = 0; i < 2; ++i) *(LAS u32x4*)(lds + TH_MASK + (tid + NT * i) * 16) = z; }
        TH_SYNC();
        const unsigned m = (unsigned)(ms * 32); const int qa = 2 * wave, qb2 = 2 * wave + 1;
        const unsigned s0 = m < 256u ? m : 256u, s1 = m < 256u ? 0u : (m < 512u ? m - 256u : 256u), s2 = m < 512u ? 0u : (m < 768u ? m - 512u : 256u), s3 = m < 768u ? 0u : m - 768u;
        if (sd == 1) {
            const LAS unsigned* const cq[2] = {cand + qa * 1024, cand + qb2 * 1024}; const unsigned sc[2][4] = {{s0, s1, s2, s3}, {s0, s1, s2, s3}}; const unsigned kk[2] = {256u, 256u};
            LAS unsigned* const hq[2] = {(LAS unsigned*)(lds + TH_SCR) + qa * 256, (LAS unsigned*)(lds + TH_SCR) + qb2 * 256}; const int rp0[2] = {0, 0}; const unsigned pre[2] = {0u, 0u}; unsigned res[2];
            wave_select<4, 2>(cq, sc, kk, hq, lane, rp0, pre, res);
#pragma unroll
            for (int c = 0; c < 2; ++c) { const int q = 2 * wave + c;
                for (int k2 = 0; 2 * k2 < ntiles; ++k2) { const int ki = k2 * 64 + lane; const bool sel = ki < (int)m && ki <= t0 + q && fkey(__builtin_bit_cast(float, cand[q * 1024 + ki])) >= res[c];
                    const unsigned long long bal = __ballot(sel); if (lane == 0) { maskb[q * 256 + 2 * k2] = (unsigned)bal; maskb[q * 256 + 2 * k2 + 1] = (unsigned)(bal >> 32); } }
                if (lane == 0) { st[ST_THR + q] = res[c]; st[ST_MODE + q] = 2u; } }
        } else {
          const float ra = 256.f * (float)m / (float)(t0 + qa + 1), rb = 256.f * (float)m / (float)(t0 + qb2 + 1);
          const int rloa = (int)ra + mg + 1, rlob = (int)rb + mg + 1;
          const LAS unsigned* const cq[2] = {cand + qa * 1024, cand + qb2 * 1024};
          const unsigned sc[2][4] = {{s0, s1, s2, s3}, {s0, s1, s2, s3}};
          const unsigned kk[2] = {(unsigned)(rloa <= (int)m ? rloa : (int)m), (unsigned)(rlob <= (int)m ? rlob : (int)m)};
          LAS unsigned* const hq[2] = {hist + (wave * 2 + 0) * 256, hist + (wave * 2 + 1) * 256};
          const int rp0[2] = {0, 0}; const unsigned pre[2] = {0u, 0u}; unsigned res[2];
          wave_select<2, 2>(cq, sc, kk, hq, lane, rp0, pre, res);
          if (lane == 0) {
              const unsigned loka = rloa <= (int)m ? res[0] : 0u, lokb = rlob <= (int)m ? res[1] : 0u;
              st[ST_MODE + qa] = 1u; st[ST_SAMP + qa] = 1u; st[ST_LO + qa] = loka; st[ST_RMAX + qa] = 0xffffffffu - loka;
              st[ST_MODE + qb2] = 1u; st[ST_SAMP + qb2] = 1u; st[ST_LO + qb2] = lokb; st[ST_RMAX + qb2] = 0xffffffffu - lokb; } }
        TH_SYNC();
    }
    bool clean = true, finalpass = false;
    for (int pass = 0; pass < 10 && sd != 1; ++pass) {
        TH_FRESH();
        { u32x4 z = {0u, 0u, 0u, 0u};
#pragma unroll
          for (int i = 0; i < 8; ++i) *(LAS u32x4*)(lds + TH_HIST + (tid + NT * i) * 16) = z;
          if (tid < 16) { st[ST_CCNT + tid] = 0u;
              if (finalpass) { const unsigned tk = st[ST_THR + tid]; st[ST_LO + tid] = tk; st[ST_RMAX + tid] = 0xffffffffu - tk; st[ST_MODE + tid] = 3u; } } }
        TH_SYNC();
        int kind; { const LAS u32x4* mv = (const LAS u32x4*)(st + ST_MODE); const u32x4 m0 = mv[0], m1 = mv[1], m2 = mv[2], m3 = mv[3];
            const unsigned w[16] = {m0.x, m0.y, m0.z, m0.w, m1.x, m1.y, m1.z, m1.w, m2.x, m2.y, m2.z, m2.w, m3.x, m3.y, m3.z, m3.w}; unsigned anyh = 0u;
#pragma unroll
            for (int q = 0; q < 16; ++q) anyh |= (w[q] == 0u) ? 1u : 0u;
            kind = __builtin_amdgcn_readfirstlane((int)anyh) ? 0 : 1; }
        const bool mpass = clean && pass == 0 && kind == 1;
        if (!mpass) clean = false;
        if (kind == 0) thr_sweep<0>(lds, A, KI, t0, ntiles, wave, lane); else thr_sweep<1>(lds, A, KI, t0, ntiles, wave, lane);
        TH_FRESH();
        TH_SYNC();
        if (finalpass) {
            for (int c = 0; c < 2; ++c) { const int q = 2 * wave + c; const LAS u16* ci = (const LAS u16*)(lds + TH_CIDX) + q * 1024;
#pragma unroll
                for (int sl = 0; sl < 4; ++sl) { const unsigned n = st[ST_SCNT + q * 4 + sl] < 256u ? st[ST_SCNT + q * 4 + sl] : 256u;
                    for (unsigned idx = lane; idx < n; idx += 64) { const unsigned ki = ci[256 * sl + idx];
                        __hip_atomic_fetch_or(maskb + q * 256 + (ki >> 5), 1u << (ki & 31u), __ATOMIC_RELAXED, __HIP_MEMORY_SCOPE_WORKGROUP); } } }
            break; }
        if (kind == 0) {
            for (int qq = 0; qq < 2; ++qq) { const int q = 2 * wave + qq;
                if (st[ST_MODE + q] != 0u) continue;
                const unsigned need = st[ST_NEED + q], shq = st[ST_SH + q], loq = st[ST_LO + q];
                LAS unsigned* hq = hist + q * 1024 + 16 * lane; unsigned c = 0u;
#pragma unroll
                for (int i = 0; i < 16; ++i) { const unsigned w = hq[i]; c += (w & 0xffffu) + (w >> 16); }
                const unsigned incl = wave_suffix_sum(c, lane), above = incl - c;
                if (above < need && need <= incl) {
                    unsigned cum = above, bsel = 0u, bcnt = 0u;
                    for (int i = 31; i >= 0; --i) { const unsigned w = hq[i >> 1], cnt = (i & 1) ? (w >> 16) : (w & 0xffffu); if (cum + cnt >= need) { bsel = (unsigned)(32 * lane + i); bcnt = cnt; break; } cum += cnt; }
                    const unsigned need2 = need - cum, newlo = loq + (bsel << shq);
                    if (bcnt == need2 || shq == 0u) { st[ST_THR + q] = newlo; st[ST_MODE + q] = 2u; st[ST_LO + q] = 0xffffffffu; st[ST_RMAX + q] = 0u; }
                    else { st[ST_LO + q] = newlo; st[ST_RMAX + q] = (1u << shq) - 1u; st[ST_NEED + q] = need2;
                        st[ST_SH + q] = shq > 11u ? shq - 11u : 0u; }
                } }
        } else {
            const LAS unsigned* cq[2]; unsigned sc[2][4], kk[2], pre[2], res[2]; LAS unsigned* hq[2]; int rp0[2]; bool act[2], good[2];
#pragma unroll
            for (int c = 0; c < 2; ++c) { const int q = 2 * wave + c; act[c] = st[ST_MODE + q] == 1u;
#pragma unroll
                for (int sl = 0; sl < 4; ++sl) sc[c][sl] = st[ST_SCNT + q * 4 + sl];
                const unsigned cnt = sc[c][0] + sc[c][1] + sc[c][2] + sc[c][3]; kk[c] = st[ST_NEED + q]; good[c] = sc[c][0] <= 256u && sc[c][1] <= 256u && sc[c][2] <= 256u && sc[c][3] <= 256u;
                good[c] = good[c] && kk[c] <= cnt;
                const unsigned loq = st[ST_LO + q], hiq = loq + st[ST_RMAX + q]; rp0[c] = (loq >> 24) != (hiq >> 24) ? 0 : ((loq >> 16) != (hiq >> 16) ? 1 : 2);
                pre[c] = rp0[c] == 0 ? 0u : (rp0[c] == 1 ? (loq & 0xff000000u) : (loq & 0xffff0000u));
                cq[c] = cand + q * 1024; hq[c] = (LAS unsigned*)(lds + TH_SCR) + q * 256;
                if (!(act[c] && good[c])) { sc[c][0] = 0u; sc[c][1] = 0u; sc[c][2] = 0u; sc[c][3] = 0u; kk[c] = 1u; rp0[c] = 4; } }
            wave_select<4, 2>(cq, sc, kk, hq, lane, rp0, pre, res);
#pragma unroll
            for (int c = 0; c < 2; ++c) { const int q = 2 * wave + c;
                if (!act[c]) continue;
                if (good[c]) { const unsigned key = res[c];
                    if (mpass) {
                        const LAS u16* ci = (const LAS u16*)(lds + TH_CIDX) + q * 1024;
#pragma unroll
                        for (int sl = 0; sl < 4; ++sl)
#pragma unroll
                            for (int i = 0; i < 4; ++i) { const unsigned idx = lane + 64 * i; if (idx < sc[c][sl] && fkey(__builtin_bit_cast(float, cand[q * 1024 + 256 * sl + idx])) >= key) { const unsigned ki = ci[256 * sl + idx];
                                __hip_atomic_fetch_or(maskb + q * 256 + (ki >> 5), 1u << (ki & 31u), __ATOMIC_RELAXED, __HIP_MEMORY_SCOPE_WORKGROUP); } } }
                    if (lane == 0) { st[ST_THR + q] = key; st[ST_MODE + q] = 2u; st[ST_LO + q] = 0xffffffffu; st[ST_RMAX + q] = 0u; } }
                else if (lane == 0) { st[ST_DIRTY] = 1u; st[ST_MODE + q] = 0u; st[ST_SAMP + q] = 0u; st[ST_LO + q] = 0u; st[ST_RMAX + q] = 0xffffffffu; st[ST_SH + q] = 21u; st[ST_NEED + q] = 256u; }
            }
        }
        TH_SYNC();
        bool alldone; { const LAS u32x4* mv = (const LAS u32x4*)(st + ST_MODE); const u32x4 m0 = mv[0], m1 = mv[1], m2 = mv[2], m3 = mv[3];
            const unsigned w[16] = {m0.x, m0.y, m0.z, m0.w, m1.x, m1.y, m1.z, m1.w, m2.x, m2.y, m2.z, m2.w, m3.x, m3.y, m3.z, m3.w}; unsigned nd = 0u;
#pragma unroll
            for (int q = 0; q < 16; ++q) nd |= (w[q] != 2u) ? 1u : 0u;
            alldone = __builtin_amdgcn_readfirstlane((int)nd) == 0; }
        if (alldone) { if (clean && st[ST_DIRTY] == 0u) break; finalpass = true; }
    }
    TH_SYNC();
    thr_write_masks(p, lds, b, t0, ntw);
    TH_SYNC();
#undef TH_FRESH
}
}
namespace mk {
constexpr int AT_MASKR = 0, AT_SSQ = 2560, AT_G = 8192, AT_KVB = 16384, AT_OST = 16384;
#define AT_DMA(gp, lp) __builtin_amdgcn_global_load_lds((const unsigned*)(gp), (LAS unsigned*)(lp), 16, 0, 0)
#define AT_DMAO(gp, lp, off) __builtin_amdgcn_global_load_lds((const unsigned*)(gp), (LAS unsigned*)(lp), 16, off, 0)
#define AT_DMA4(gp, lp) __builtin_amdgcn_global_load_lds((const unsigned*)(gp), (LAS unsigned*)(lp), 4, 0, 0)
__device__ __forceinline__ void att_item(const Params& p, LAS unsigned char* lds, int b, int qblk, int wave, int lane) {
    const int q0 = qblk * 128, g = wave >> 1, h2 = wave & 1, hh = lane >> 5, l31 = lane & 31;
    LAS unsigned* maskr = (LAS unsigned*)(lds + AT_MASKR); LAS float* ssq = (LAS float*)(lds + AT_SSQ);
    LAS float* atg = (LAS float*)(lds + AT_G); atg[threadIdx.x] = p.att_g[threadIdx.x];
    const u16* P16 = (const u16*)(p.ws + WS_PROJ);
    const unsigned* SM = (const unsigned*)(p.ws + WS_SELM) + (size_t)(b * 128 + 2 * qblk + (wave & 1)) * 256 * 64 + lane;
    const int ntiles = 4 * qblk + 4, glast = q0 + 32 * g + 31;
    const float csc = 0.08838834764831845f * 1.4426950408889634f;
    LAS unsigned char* ostw = lds + AT_OST + wave * 8704;
    u16* cbase = (u16*)(p.ws + WS_CAT) + (size_t)(b * L + q0 + 32 * g) * D;
    for (int sp = 0; sp < 2; ++sp) {
        const int h = 2 * sp + h2;
        const unsigned char* KF = (const unsigned char*)(p.ws + WS_KF) + (size_t)(b * 4 + 2 * sp + (wave & 1)) * 256 * 8192 + (size_t)(2 * (wave >> 1)) * 1024 + lane * 16;
        const unsigned char* VF = (const unsigned char*)(p.ws + WS_VT) + (size_t)(b * 4 + 2 * sp + (wave & 1)) * 256 * 8192 + (size_t)(2 * (wave >> 1)) * 1024 + lane * 16;
        const int dofs = (wave & 1) * 8192 + 2 * (wave >> 1) * 1024;
        if (wave < 2) { AT_DMA4(SM, lds + AT_MASKR + wave * 256); AT_DMA4(SM + 64, lds + AT_MASKR + 512 + wave * 256); }
#pragma unroll
        for (int i = 0; i < 2; ++i) { AT_DMA(KF + i * 1024, lds + AT_KVB + dofs + i * 1024); AT_DMA(VF + i * 1024, lds + AT_KVB + 16384 + dofs + i * 1024); }
        f16x8 Qf[8];
        { const u16* qa = P16 + (size_t)(b * L + q0 + 32 * g + l31) * PJ + CQ + h * 128 + 8 * hh;
#pragma unroll
          for (int s = 0; s < 8; ++s) Qf[s] = *(const f16x8*)(qa + 16 * s); }
#pragma unroll
        for (int s = 0; s < 8; ++s) Qf[s] = Qf[s] * (_Float16)csc;
        f32x16 O[4];
#pragma unroll
        for (int d = 0; d < 4; ++d)
#pragma unroll
            for (int i = 0; i < 16; ++i) O[d][i] = 0.f;
        const unsigned char* kfp = KF; const unsigned char* vfp = VF; const unsigned* smp = SM + 64;
        float mrun = 0.f, lsum = 0.f;
        f32x16 negm;
#pragma unroll
        for (int i = 0; i < 16; ++i) negm[i] = 0.f;
        for (int kt = 0; kt < ntiles; ++kt) {
            asm volatile("s_waitcnt vmcnt(0)" ::: "memory");
            __syncthreads();
            const bool act = kt * 32 <= glast;
            const LAS f16x8* kb = (const LAS f16x8*)(lds + AT_KVB + (kt & 1) * 32768 + h2 * 8192) + lane;
            f16x8 kf[8];
            if (act) {
#pragma unroll
                for (int s = 0; s < 8; ++s) kf[s] = kb[s * 64]; }
            kfp += 8192; vfp += 8192; smp += 64;
            asm volatile("" : "+v"(kfp), "+v"(vfp), "+v"(smp));
            if (kt + 1 < ntiles) { const int bo = AT_KVB + ((kt + 1) & 1) * 32768 + dofs;
                AT_DMAO(kfp, lds + bo, 0); AT_DMAO(kfp, lds + bo, 1024); AT_DMAO(vfp, lds + bo + 16384, 0); AT_DMAO(vfp, lds + bo + 16384, 1024); }
            if (kt + 2 < ntiles && wave < 2) AT_DMA4(smp, lds + AT_MASKR + ((kt + 2) & 3) * 512 + wave * 256);
            if (act) {
                f32x16 S = negm;
#pragma unroll
                for (int s = 0; s < 8; ++s) S = __builtin_amdgcn_mfma_f32_32x32x16_f16(kf[s], Qf[s], S, 0, 0, 0);

                const unsigned bits = maskr[(kt & 3) * 128 + 32 * g + l31] >> (4 * hh);
                f16x8 vf[8];
                const unsigned av = (unsigned)(__UINTPTR_TYPE__)(lds + AT_KVB + (kt & 1) * 32768 + 16384 + h2 * 8192) + lane * 16;
#define AT_RD(dst, off, dep) asm volatile("ds_read_b128 %0, %1 offset:" #off : "=v"(dst) : "v"(av), "v"(dep))
                AT_RD(vf[0], 0, bits); AT_RD(vf[2], 2048, bits); AT_RD(vf[4], 4096, bits); AT_RD(vf[6], 6144, bits);
                int mxi = 0;
#pragma unroll
                for (int i = 0; i < 16; ++i) { const unsigned mk = (unsigned)__builtin_amdgcn_sbfe((int)bits, (i & 3) + 8 * (i >> 2), 1); const float si = S[i];
                    S[i] = __builtin_bit_cast(float, (__builtin_bit_cast(unsigned, si) & mk) | (0xff61b1e6u & ~mk)); }
#pragma unroll
                for (int i = 0; i < 16; i += 2) { const float a = S[i], c = S[i + 1]; const int ai = __builtin_bit_cast(int, a), ci = __builtin_bit_cast(int, c); const int t = mxi > ai ? mxi : ai; mxi = t > ci ? t : ci; }
                { const auto r = __builtin_amdgcn_permlane32_swap((unsigned)mxi, (unsigned)mxi, false, false); const int r0 = (int)r[0], r1 = (int)r[1]; mxi = r0 > r1 ? r0 : r1; }
                const float mx = __builtin_bit_cast(float, mxi);
                if (__ballot(mx > 8.f)) { const float dlt = mx > 8.f ? mx : 0.f, alpha = __builtin_amdgcn_exp2f(-dlt);
                    mrun += dlt; lsum *= alpha;
#pragma unroll
                    for (int d = 0; d < 4; ++d)
#pragma unroll
                        for (int i = 0; i < 16; ++i) O[d][i] *= alpha;
#pragma unroll
                    for (int i = 0; i < 16; ++i) { S[i] -= dlt; negm[i] = -mrun; } }
                float ps = 0.f; f16x8 pf[2];
#pragma unroll
                for (int i = 0; i < 16; ++i) { const float pe = __builtin_amdgcn_exp2f(S[i]); ps += pe; pf[i >> 3][i & 7] = (_Float16)pe; }
                lsum += ps;
                asm volatile("s_waitcnt lgkmcnt(0)" : "+v"(vf[0]), "+v"(vf[2]), "+v"(vf[4]), "+v"(vf[6]));
                AT_RD(vf[1], 1024, vf[0]); AT_RD(vf[3], 3072, vf[0]); AT_RD(vf[5], 5120, vf[0]); AT_RD(vf[7], 7168, vf[0]);
#undef AT_RD
#pragma unroll
                for (int d = 0; d < 4; ++d) O[d] = __builtin_amdgcn_mfma_f32_32x32x16_f16(vf[d * 2], pf[0], O[d], 0, 0, 0);
                asm volatile("s_waitcnt lgkmcnt(0)" : "+v"(vf[1]), "+v"(vf[3]), "+v"(vf[5]), "+v"(vf[7]));
#pragma unroll
                for (int d = 0; d < 4; ++d) O[d] = __builtin_amdgcn_mfma_f32_32x32x16_f16(vf[d * 2 + 1], pf[1], O[d], 0, 0, 0);
            }
        }
        int lane2 = lane; asm volatile("" : "+v"(lane2)); const int l31b = lane2 & 31, hhb = lane2 >> 5;
        const float ltot = lsum + __shfl_xor(lsum, 32), inv = 1.f / ltot;
        float part = 0.f;
#pragma unroll
        for (int d = 0; d < 4; ++d)
#pragma unroll
            for (int i = 0; i < 16; ++i) { O[d][i] *= inv; part += O[d][i] * O[d][i]; }
        part += __shfl_xor(part, 32);
        if (lane2 < 32) ssq[h * 128 + 32 * g + lane2] = part;
        __syncthreads();
        const int qi = 32 * g + l31b;
        const float rstd = sp == 0 ? 1.f : rsqrtf((ssq[qi] + ssq[128 + qi] + ssq[256 + qi] + ssq[384 + qi]) * (1.f / 512.f) + EPS);
#pragma unroll
        for (int d = 0; d < 4; ++d)
#pragma unroll
            for (int ip = 0; ip < 8; ++ip) { const int i = 2 * ip, dv = d * 32 + (i & 3) + 8 * (i >> 2) + 4 * hhb;
                const f32x2 gp = *(const LAS f32x2*)(atg + h * 128 + dv); const float g0 = sp == 0 ? 1.f : gp.x, g1 = sp == 0 ? 1.f : gp.y;
                *(LAS unsigned*)(ostw + l31b * 272 + dv * 2) = pkh(O[d][i] * rstd * g0, O[d][i + 1] * rstd * g1); }
        LDS_WAIT(); asm volatile("" ::: "memory");
#pragma unroll
        for (int i = 0; i < 8; ++i) { const int idx = i * 64 + lane2, row = idx >> 4, ch = idx & 15;
            const u32x4 v = *(const LAS u32x4*)(ostw + row * 272 + ch * 16); *(u32x4*)(cbase + (size_t)row * D + h * 128 + ch * 8) = v; }
        if (sp == 0) __syncthreads();
    }
    {
            int lane2 = lane; asm volatile("" : "+v"(lane2));
            asm volatile("s_waitcnt vmcnt(0)" ::: "memory");
#pragma unroll
            for (int i = 0; i < 8; ++i) { const int idx = i * 64 + lane2, row = idx >> 4, ch = idx & 15;
                u16* ptr = cbase + (size_t)row * D + h2 * 128 + ch * 8; const u32x4 v = *(const u32x4*)ptr; const int qr = 32 * g + row;
                const float rs = rsqrtf((ssq[qr] + ssq[128 + qr] + ssq[256 + qr] + ssq[384 + qr]) * (1.f / 512.f) + EPS);
                const unsigned wv[4] = {v.x, v.y, v.z, v.w}; unsigned ov[4];
#pragma unroll
                for (int e = 0; e < 4; ++e) { const int dv = ch * 8 + 2 * e; const f32x2 gp = *(const LAS f32x2*)(atg + h2 * 128 + dv); ov[e] = pkh(hlo(wv[e]) * rs * gp.x, hhi(wv[e]) * rs * gp.y); }
                u32x4 o; o.x = ov[0]; o.y = ov[1]; o.z = ov[2]; o.w = ov[3]; *(u32x4*)ptr = o; } }
    __syncthreads();
}

__device__ __forceinline__ void phase_p3(const Params& p, LAS unsigned char* lds, int wave, int lane) {
    const int G = gridDim.x, bx = blockIdx.x;
    { LAS unsigned char* scr = lds + wave * 8704; const int gw = bx * NWAVES + wave, NGW = G * NWAVES;
      for (int it = gw; it < NB * 4 * (L / 32); it += NGW) vt_item(p, scr, it, lane); }
    __syncthreads();
    for (int it = bx; it < NB * 4 * NCH; it += G) gla1_item(p, lds, it, wave, lane);
    {
    if (G == 256) { const int bt = bx & 7, j = bx >> 3;
        ThrOps cur; thr_load(p, cur, bt, j, wave);
        for (int r = 0; r < 16; ++r) { const int qb = (r & 1) ? 511 - (32 * (r >> 1) + j) : 32 * (r >> 1) + j; const int rn = r < 15 ? r + 1 : r, qbn = (rn & 1) ? 511 - (32 * (rn >> 1) + j) : 32 * (rn >> 1) + j;
            ThrOps nxt; thr_load(p, nxt, bt, qbn, wave);
            thr_item(p, lds, cur, bt, qb, wave, lane); cur = nxt; } }
    else { for (int it = bx; it < NB * 512; it += G) { ThrOps cur; thr_load(p, cur, it >> 9, it & 511, wave); thr_item(p, lds, cur, it >> 9, it & 511, wave, lane); } } }
}
__device__ __forceinline__ void phase_p5(const Params& p, LAS unsigned char* lds, int wave, int lane) {
    const int G = gridDim.x, bx = blockIdx.x;
    if (G == 256) { const int bt = bx & 7, j = bx >> 3;
        for (int r = 0; r < 2; ++r) att_item(p, lds, bt, r == 0 ? 63 - j : j, wave, lane); }
    else { for (int it = bx; it < NB * 64; it += G) att_item(p, lds, it >> 6, it & 63, wave, lane); }
    { const int N = NB * 4 * NCH; G3Ops cur; if (bx < N) gla3_load(p, cur, bx, wave, lane);
      for (int it = bx; it < N; it += G) { G3Ops nxt; gla3_load(p, nxt, it + G < N ? it + G : it, wave, lane);
          gla3_item(p, lds, cur, it, wave, lane); cur = nxt; }
      __syncthreads(); }
}
}
namespace mk {
#define XB_TMO      128
#define XB_XCNT(j)  (256  + 64 * (j))
#define XB_XSUB(j)  (1280 + 64 * (j))
#define XB_XGEN(j)  (2304 + 64 * (j))
#define XB_TOP      3328
#define XB_TOPGEN   3392
#define XCD_BAR_WORDS 3456
#define XB_SPIN_CAP (1u << 18)

__device__ __forceinline__ unsigned xb_ld(unsigned* p)              { return __hip_atomic_load(p, __ATOMIC_RELAXED, __HIP_MEMORY_SCOPE_AGENT); }
__device__ __forceinline__ unsigned xb_add(unsigned* p, unsigned v) { return __hip_atomic_fetch_add(p, v, __ATOMIC_RELAXED, __HIP_MEMORY_SCOPE_AGENT); }
__device__ __forceinline__ unsigned xb_xcc_id() { return (unsigned)__builtin_amdgcn_s_getreg((3 << 11) | 20) & 0xFu; }
#define XB_SPIN(cond, bar) do { unsigned _sp = 0; while (cond) { __builtin_amdgcn_s_sleep(1); \
    if ((++_sp & 255u) == 0u) { if (xb_ld(&(bar)[XB_TMO])) break; if (_sp > XB_SPIN_CAP) { atomicAdd(&(bar)[XB_TMO], 1u); break; } } } } while (0)

struct XcdBarrier {
    unsigned* bar; unsigned x;
    volatile LAS unsigned* st;
};

__device__ __forceinline__ XcdBarrier xcd_barrier_post(unsigned* bar, volatile LAS unsigned* st) {
    XcdBarrier b; b.bar = bar; b.x = xb_xcc_id(); b.st = st;
    if (threadIdx.x == 0) (void)xb_add(&bar[XB_XCNT(b.x)], 1u);
    return b;
}
__device__ __forceinline__ void xcd_barrier_complete(unsigned* bar, unsigned x, unsigned& nloc, unsigned& nx) {
    const unsigned G = gridDim.x * gridDim.y * gridDim.z;
    unsigned sum, cnt, mine, sp = 0u;
    for (;;) {
        sum = 0u; cnt = 0u; mine = 0u;
#pragma unroll
        for (unsigned j = 0; j < 16; ++j) { const unsigned c = xb_ld(&bar[XB_XCNT(j)]); sum += c; cnt += (c > 0u) ? 1u : 0u; mine = (j == x) ? c : mine; }
        if (sum == G) break;
        __builtin_amdgcn_s_sleep(1);
        if ((++sp & 255u) == 0u) { if (xb_ld(&bar[XB_TMO])) break; if (sp > XB_SPIN_CAP) { atomicAdd(&bar[XB_TMO], 1u); break; } }
    }
    nloc = mine > 0u ? mine : 1u; nx = cnt > 0u ? cnt : 1u;
}

__device__ __forceinline__ void xcd_barrier(const XcdBarrier& b) {
    asm volatile("s_waitcnt vmcnt(0)" ::: "memory");
    __syncthreads();
    if (threadIdx.x == 0) {
        unsigned* bar = b.bar;
        __builtin_amdgcn_s_waitcnt(0);
        unsigned nloc = b.st[0], nx = b.st[1];
        if (nloc == 0u) { xcd_barrier_complete(bar, b.x, nloc, nx); b.st[0] = nloc; b.st[1] = nx; }
        const unsigned old = xb_add(&bar[XB_XSUB(b.x)], 1u);
        const unsigned gen = old / nloc;
        if (old + 1u == (gen + 1u) * nloc) {
            __builtin_amdgcn_fence(__ATOMIC_RELEASE, "agent");
            asm volatile("s_waitcnt vmcnt(0)" ::: "memory");
            const unsigned og = xb_add(&bar[XB_TOP], 1u);
            const unsigned tg = og / nx;
            if (og + 1u == (tg + 1u) * nx) xb_add(&bar[XB_TOPGEN], 1u);
            else XB_SPIN(xb_ld(&bar[XB_TOPGEN]) == tg, bar);
            __builtin_amdgcn_fence(__ATOMIC_ACQUIRE, "agent");
            xb_add(&bar[XB_XGEN(b.x)], 1u);
            asm volatile("s_waitcnt vmcnt(0)" ::: "memory");
        } else {
            XB_SPIN(xb_ld(&bar[XB_XGEN(b.x)]) == gen, bar);
            __builtin_amdgcn_fence(__ATOMIC_ACQUIRE, "agent");
            asm volatile("s_waitcnt vmcnt(0)" ::: "memory");
        }
    }
    __syncthreads();
}

}
namespace mk {
namespace cg = cooperative_groups;
constexpr int NPHASE = 11;
__global__ void __launch_bounds__(NT, 2) mk_fwd(Params p) {
    extern __shared__ __attribute__((aligned(16))) unsigned char lds_raw[];
    LAS unsigned char* lds = (LAS unsigned char*)lds_raw;
    cg::grid_group grid = cg::this_grid();
    const int tid = threadIdx.x, lane = tid & 63, wave = __builtin_amdgcn_readfirstlane(tid >> 6);
    unsigned char* ws = p.ws;
    float* mod = (float*)(ws + WS_MOD);
    volatile LAS unsigned* xst = (volatile LAS unsigned*)(lds + LDS_BYTES - 64);
    if (tid == 0) { xst[0] = 0u; xst[1] = 0u; }
    __syncthreads();
    const XcdBarrier xbar = xcd_barrier_post((unsigned*)(ws + WS_CTL), xst);
#define IN(k) (p.ph_lo <= (k) && (k) < p.ph_hi)
#define SEAM(k) do { if (IN(k) && IN((k) + 1)) { if ((k) == 0) grid.sync(); else xcd_barrier(xbar); } } while (0)
    if (IN(0)) { phase_p0a(p, lds, wave, lane); __syncthreads(); }
    SEAM(0);
    if (IN(1)) row_phase<0>(p.x, p.norm1_g, mod, 0, D, nullptr, ws + WS_H, wave, lane);
    SEAM(1);
    if (IN(2)) {
        pg8::Gemm g{(const pg8::bf16_t*)(ws + WS_H), (const pg8::bf16_t*)(ws + WS_WIN), T, 3840, D}; pg8::StaticOrder S; S.init(T, 3840, gridDim.x, blockIdx.x);
        EpiProj E{(u16*)(ws + WS_PROJ), (u16*)(ws + WS_KIDX), (float*)(ws + WS_WIDX), (float*)(ws + WS_GLR), (u16*)(ws + WS_KF)};
        pg8::gemm_phase<EpiProj, pg8::StaticOrder>(lds, g, S, E);
    }
    SEAM(2);
    if (IN(3)) phase_p3(p, lds, wave, lane);
    SEAM(3);
    if (IN(4)) phase_p4(p, lds, wave, lane);
    SEAM(4);
    if (IN(5)) phase_p5(p, lds, wave, lane);
    SEAM(5);
    if (IN(6)) {
        pg8::Gemm g{(const pg8::bf16_t*)(ws + WS_CAT), (const pg8::bf16_t*)(ws + WS_WOUT), T, D, D}; pg8::StaticOrder S; S.init(T, D, gridDim.x, blockIdx.x);
        EpiRes<false> E{p.x, (u16*)(ws + WS_X16), mod, (float*)(ws + WS_SS1), 2 * D, 0};
        pg8::gemm_phase<EpiRes<false>, pg8::StaticOrder>(lds, g, S, E);
    }
    SEAM(6);
    if (IN(7)) row_phase<1>(ws + WS_X16, p.norm2_g, mod, 3 * D, 4 * D, (const float*)(ws + WS_SS1), ws + WS_H, wave, lane);
    SEAM(7);
    if (IN(8)) {
        pg8::Gemm g{(const pg8::bf16_t*)(ws + WS_H), (const pg8::bf16_t*)(ws + WS_WGU), T, 2 * DFF, D}; pg8::StaticOrder S; S.init(T, 2 * DFF, gridDim.x, blockIdx.x);
        EpiSwiGLU E{(u16*)(ws + WS_ACT)};
        pg8::gemm_phase<EpiSwiGLU, pg8::StaticOrder>(lds, g, S, E);
    }
    SEAM(8);
    if (IN(9)) {
        pg8::Gemm g{(const pg8::bf16_t*)(ws + WS_ACT), (const pg8::bf16_t*)(ws + WS_WDN), T, D, DFF}; pg8::StaticOrder S; S.init(T, D, gridDim.x, blockIdx.x);
        EpiRes<true> E{ws + WS_X16, (u16*)(ws + WS_X16), mod, (float*)(ws + WS_SS2), 5 * D, 0};
        pg8::gemm_phase<EpiRes<true>, pg8::StaticOrder>(lds, g, S, E);
    }
    SEAM(9);
    if (IN(10)) row_phase<2>(ws + WS_X16, p.final_g, nullptr, 0, 0, (const float*)(ws + WS_SS2), p.out, wave, lane);
#undef IN
#undef SEAM
}

static int g_grid = 0;
static Params make_params(void* const* d_in, void* d_out, void* d_ws) {
    Params p{};
    p.x = (const float*)d_in[0]; p.c = (const float*)d_in[1]; p.w_mod = (const float*)d_in[2]; p.b_mod = (const float*)d_in[3]; p.norm1_g = (const float*)d_in[4];
    p.w_in = (const float*)d_in[5]; p.w_gate2 = (const float*)d_in[6]; p.b_gate2 = (const float*)d_in[7]; p.att_g = (const float*)d_in[8]; p.gla_g = (const float*)d_in[9];
    p.w_out = (const float*)d_in[10]; p.norm2_g = (const float*)d_in[11]; p.w_gu = (const float*)d_in[12]; p.w_down = (const float*)d_in[13]; p.final_g = (const float*)d_in[14];
    p.out = (float*)d_out; p.ws = (unsigned char*)d_ws; p.ph_lo = 0; p.ph_hi = NPHASE;
    return p;
}
static bool init_grid(size_t ws_size) {
    if (g_grid) return g_grid > 0;
    int dev = 0, cus = 0, per_cu = 0;
    if (hipGetDevice(&dev) != hipSuccess || hipDeviceGetAttribute(&cus, hipDeviceAttributeMultiprocessorCount, dev) != hipSuccess) { g_grid = -1; return false; }
    if (hipFuncSetAttribute((const void*)mk_fwd, hipFuncAttributeMaxDynamicSharedMemorySize, LDS_BYTES) != hipSuccess) { fprintf(stderr, "hipFuncSetAttribute failed\n"); g_grid = -1; return false; }
    if (hipOccupancyMaxActiveBlocksPerMultiprocessor(&per_cu, (const void*)mk_fwd, NT, LDS_BYTES) != hipSuccess || per_cu < 1) { fprintf(stderr, "occupancy query: %d blocks/CU\n", per_cu); g_grid = -1; return false; }
    if (ws_size < WS_END) { fprintf(stderr, "workspace too small: %zu < %zu\n", ws_size, (size_t)WS_END); g_grid = -1; return false; }
    g_grid = cus;
    fprintf(stderr, "mk: grid %d, per_cu %d, ws %zu\n", g_grid, per_cu, ws_size);
    return true;
}
static void launch(Params p, int lo, int hi, hipStream_t stream) {
    p.ph_lo = lo; p.ph_hi = hi;
    if (hipMemsetAsync(p.ws + WS_CTL, 0, 16384, stream) != hipSuccess) { fprintf(stderr, "hipMemsetAsync of the barrier words failed\n"); return; }
    void* args[] = {&p};
    const hipError_t e = hipLaunchCooperativeKernel((const void*)mk_fwd, dim3(g_grid), dim3(NT), args, LDS_BYTES, stream);
    if (e != hipSuccess) fprintf(stderr, "cooperative launch failed: %s (grid %d)\n", hipGetErrorString(e), g_grid);
}
}

extern "C" void kernel_launch(void* const* d_in, const int* in_sizes, int n_in, void* d_out, int out_size, void* d_ws, size_t ws_size, hipStream_t stream) {
    using namespace mk;
    if (n_in != 15 || out_size != T * D) { fprintf(stderr, "kernel_launch: unexpected problem shape\n"); return; }
    if (!init_grid(ws_size)) return;
    Params p = make_params(d_in, d_out, d_ws);
    launch(p, 0, NPHASE, stream);
}
```

```cpp
#include <hip/hip_runtime.h>
#include <hip/hip_cooperative_groups.h>
#include <cstdio>
#include <cstdint>
#include <cmath>
namespace pg8 {
#define PG8_LAS __attribute__((address_space(3)))
typedef unsigned short bf16_t;
typedef _Float16 bf16x8 __attribute__((ext_vector_type(8)));
typedef float f32x4 __attribute__((ext_vector_type(4)));
typedef unsigned u32x4 __attribute__((ext_vector_type(4)));
constexpr int BM = 256, BK = 64, HALF = 128, HTB = HALF * BK * 2  , STAGE_BYTES = 8 * HTB, NXCD = 8, WGM = 8;

__host__ __device__ __forceinline__ int lds_byte(int r, int c) { const int st = (r >> 4) * 2 + (c >> 5), rr = r & 15, cc = c & 31, ob = rr * 64 + cc * 2; return st * 1024 + (ob ^ (((ob >> 9) & 1) << 5)); }
__host__ __device__ __forceinline__ void stage_rc(int b, int& R, int& C) { const int st = b / 1024, sb = b % 1024, swz = sb ^ (((sb >> 9) & 1) << 5); R = (st >> 1) * 16 + swz / 64; C = (st & 1) * 32 + (swz % 64) / 2; }
__host__ __device__ __forceinline__ int perm32(int rho) { const int n = rho >> 4, i = rho & 15; return 8 * (i >> 2) + 4 * n + (i & 3); }

struct Unit { int pm, pn; };
struct Gemm { const bf16_t* A; const bf16_t* Bt; int M, N, K; };

struct StaticOrder {
    int nM, nN, nwg, G, c, wgm;
    __host__ __device__ void init(int M, int N, int G_, int c_, int wgm_ = WGM) { nM = M / BM; nN = N / BM; nwg = nM * nN; G = G_; c = c_; wgm = wgm_; }
    __host__ __device__ bool next(int i, Unit& u) const {
        const long L = (long)i * G + c; if (L >= nwg) return false;
        int wgid = (int)L; { const int q = nwg / NXCD, r = nwg % NXCD, xcd = wgid % NXCD, off = wgid / NXCD; wgid = (xcd < r ? xcd * (q + 1) : r * (q + 1) + (xcd - r) * q) + off; }
        const int nig = wgm * nN, gid = wgid / nig, fm = gid * wgm, gsz = (nM - fm) < wgm ? (nM - fm) : wgm;
        u.pm = fm + ((wgid % nig) % gsz); u.pn = (wgid % nig) / gsz; return true;
    }
    __device__ __forceinline__ void a_ready(const Unit&) const {}
    __device__ __forceinline__ void done(const Unit&) const {}
};
template <class Epi, class Sched>
__device__ __forceinline__ void gemm_phase(PG8_LAS unsigned char* lds, const Gemm g, const Sched& S, const Epi& E) {
    const int tid = threadIdx.x, wid = __builtin_amdgcn_readfirstlane(tid >> 6), lane = tid & 63, wr = wid >> 2, wc = wid & 3, fr = lane & 15, fq = lane >> 4;
    const int K = g.K, nt = K / BK;
    unsigned voffA[2], voffB[2];
#pragma unroll
    for (int i = 0; i < 2; ++i) { int R, C; stage_rc(tid * 16 + i * 8192, R, C); const int Rb = Epi::PERM ? ((R & ~31) + perm32(R & 31)) : R;
        voffA[i] = (unsigned)(R * K + C) * 2u; voffB[i] = (unsigned)(Rb * K + C) * 2u; }
    const size_t kstep = (size_t)(BK * 2);
    const size_t hstep = (size_t)HALF * K * 2;
    const size_t tstep = 2 * hstep;
    const unsigned ldsw = (unsigned)wid * 1024u;
    const int aoff = lds_byte(wr * 64 + fr, fq * 8), boff = lds_byte(wc * 32 + fr, fq * 8);
#define PG8_SA(b, h) (((b) * 2 + (h)) * HTB)
#define PG8_SB(b, h) ((4 + (b) * 2 + (h)) * HTB)
#define PG8_STAGE(bufoff, gbase, voff) do { _Pragma("unroll") for (int _i = 0; _i < 2; ++_i) \
        __builtin_amdgcn_global_load_lds((const unsigned*)((const char*)(gbase) + (voff)[_i]), (PG8_LAS unsigned*)(lds + (bufoff) + ldsw + _i * 8192), 16, 0, 0); } while (0)
#define PG8_LDA(dst, b, h) do { _Pragma("unroll") for (int m = 0; m < 4; ++m) _Pragma("unroll") for (int k = 0; k < 2; ++k) dst[m][k] = *(const PG8_LAS bf16x8*)(lds + PG8_SA(b, h) + aoff + m * 2048 + k * 1024); } while (0)
#define PG8_LDB(dst, b, h) do { _Pragma("unroll") for (int n = 0; n < 2; ++n) _Pragma("unroll") for (int k = 0; k < 2; ++k) dst[n][k] = *(const PG8_LAS bf16x8*)(lds + PG8_SB(b, h) + boff + n * 2048 + k * 1024); } while (0)
#define PG8_MMA(ai, bj, At, Bt) do { __builtin_amdgcn_s_setprio(1); _Pragma("unroll") for (int m = 0; m < 4; ++m) _Pragma("unroll") for (int n = 0; n < 2; ++n) _Pragma("unroll") for (int k = 0; k < 2; ++k) \
        acc[ai][bj][m][n] = __builtin_amdgcn_mfma_f32_16x16x32_f16(Bt[n][k], At[m][k], acc[ai][bj][m][n], 0, 0, 0); __builtin_amdgcn_s_setprio(0); } while (0)
#define PG8_WAIT_V(n) asm volatile("s_waitcnt vmcnt(" #n ")" ::: "memory")
#define PG8_WAIT_L(n) asm volatile("s_waitcnt lgkmcnt(" #n ")" ::: "memory")
#define PG8_BAR __builtin_amdgcn_s_barrier()
#define PG8_SCHED __builtin_amdgcn_sched_barrier(0)
    Unit cur, nxt; int ui = 0;
    if (!S.next(0, cur)) return;
    f32x4 acc[2][2][4][2];
#pragma unroll
    for (int a = 0; a < 2; ++a)
#pragma unroll
        for (int b = 0; b < 2; ++b)
#pragma unroll
            for (int m = 0; m < 4; ++m)
#pragma unroll
                for (int n = 0; n < 2; ++n) acc[a][b][m][n] = (f32x4){0.f, 0.f, 0.f, 0.f};
    bf16x8 At[4][2], B0[2][2], B1[2][2];
    const char* cA = (const char*)g.A + (size_t)cur.pm * tstep; const char* cB = (const char*)g.Bt + (size_t)cur.pn * tstep;
    S.a_ready(cur);
    PG8_STAGE(PG8_SB(0, 0), cB, voffB); PG8_STAGE(PG8_SA(0, 0), cA, voffA); PG8_STAGE(PG8_SB(0, 1), cB + hstep, voffB); PG8_STAGE(PG8_SA(0, 1), cA + hstep, voffA);
    if (wr == 1) PG8_BAR;
    PG8_WAIT_V(4); PG8_BAR;
    PG8_STAGE(PG8_SB(1, 0), cB + kstep, voffB); PG8_STAGE(PG8_SA(1, 0), cA + kstep, voffA); PG8_STAGE(PG8_SB(1, 1), cB + hstep + kstep, voffB);
    PG8_WAIT_V(6); PG8_BAR;
    for (;;) {
        const bool has_next = S.next(ui + 1, nxt);
        const char* nA = has_next ? (const char*)g.A + (size_t)nxt.pm * tstep : cA; const char* nB = has_next ? (const char*)g.Bt + (size_t)nxt.pn * tstep : cB;
        for (int t = 0; t < nt; t += 2) {
            const bool last = (t == nt - 2);
            const char* a1 = cA + (size_t)(t + 1) * kstep;
            const char* a2 = last ? nA : cA + (size_t)(t + 2) * kstep; const char* b2 = last ? nB : cB + (size_t)(t + 2) * kstep;
            const char* a3 = a2 + kstep; const char* b3 = b2 + kstep;
            if (last && has_next) S.a_ready(nxt);
            PG8_LDB(B0, 0, 0); PG8_SCHED; PG8_LDA(At, 0, 0); PG8_STAGE(PG8_SA(1, 1), a1 + hstep, voffA);
            PG8_WAIT_L(8); PG8_BAR; PG8_WAIT_L(0); PG8_MMA(0, 0, At, B0); PG8_BAR; PG8_SCHED;
            PG8_LDB(B1, 0, 1); PG8_STAGE(PG8_SB(0, 0), b2, voffB);
            PG8_BAR; PG8_WAIT_L(0); PG8_MMA(0, 1, At, B1); PG8_BAR;
            PG8_LDA(At, 0, 1); PG8_STAGE(PG8_SA(0, 0), a2, voffA);
            PG8_BAR; PG8_WAIT_L(0); PG8_MMA(1, 0, At, B0); PG8_BAR; PG8_SCHED;
            PG8_STAGE(PG8_SB(0, 1), b2 + hstep, voffB);
            PG8_WAIT_V(6); PG8_BAR; PG8_MMA(1, 1, At, B1); PG8_BAR;
            PG8_LDB(B0, 1, 0); PG8_SCHED; PG8_LDA(At, 1, 0); PG8_STAGE(PG8_SA(0, 1), a2 + hstep, voffA);
            PG8_WAIT_L(8); PG8_BAR; PG8_WAIT_L(0); PG8_MMA(0, 0, At, B0); PG8_BAR; PG8_SCHED;
            PG8_LDB(B1, 1, 1); PG8_STAGE(PG8_SB(1, 0), b3, voffB);
            PG8_BAR; PG8_WAIT_L(0); PG8_MMA(0, 1, At, B1); PG8_BAR;
            PG8_LDA(At, 1, 1); PG8_STAGE(PG8_SA(1, 0), a3, voffA);
            PG8_BAR; PG8_WAIT_L(0); PG8_MMA(1, 0, At, B0); PG8_BAR; PG8_SCHED;
            PG8_STAGE(PG8_SB(1, 1), b3 + hstep, voffB);
            PG8_WAIT_V(6); PG8_BAR; PG8_MMA(1, 1, At, B1); PG8_BAR;
        }
        if constexpr (!Epi::AFTER_DRAIN) { E(acc, cur, wr, wc, fr, fq); S.done(cur); }
        if (!has_next) break;
#pragma unroll
        for (int a = 0; a < 2; ++a)
#pragma unroll
            for (int b = 0; b < 2; ++b)
#pragma unroll
                for (int m = 0; m < 4; ++m)
#pragma unroll
                    for (int n = 0; n < 2; ++n) acc[a][b][m][n] = (f32x4){0.f, 0.f, 0.f, 0.f};
        cur = nxt; cA = nA; cB = nB; ++ui;
    }
    PG8_WAIT_V(0);
    if (wr == 0) PG8_BAR;
    PG8_BAR;
    if constexpr (Epi::AFTER_DRAIN) { E.fused(acc, cur, wr, wc, fr, fq, lds, wid, lane); S.done(cur); }
#undef PG8_SA
#undef PG8_SB
#undef PG8_STAGE
#undef PG8_LDA
#undef PG8_LDB
#undef PG8_MMA
#undef PG8_WAIT_V
#undef PG8_WAIT_L
#undef PG8_BAR
#undef PG8_SCHED
}
}
namespace mk {
#define LAS __attribute__((address_space(3)))
using pg8::f32x4; using pg8::u32x4; using pg8::Unit;
typedef float f32x2 __attribute__((ext_vector_type(2)));
typedef float f32x16 __attribute__((ext_vector_type(16)));
typedef _Float16 h2v __attribute__((ext_vector_type(2)));
typedef _Float16 f16x8 __attribute__((ext_vector_type(8)));
typedef _Float16 f16x4 __attribute__((ext_vector_type(4)));
typedef short bf16x8 __attribute__((ext_vector_type(8)));
typedef unsigned u32x2 __attribute__((ext_vector_type(2)));
typedef unsigned short u16;

constexpr int NWAVES = 8, NT = 512;
constexpr int D = 1024, NB = 8, L = 8192, T = NB * L, DIN = 3672, DFF = 2816;
constexpr int PJ = 3584;
constexpr int CQ = 0, CK = 512, CV = 1024, CQI = 1536, CGQ = 2048, CGK = 2304, CGV = 2560, CGO = 3072;
constexpr float EPS = 1e-6f;
constexpr float IDX_SCALE = 0.35355339059327373f * 0.125f;
constexpr size_t MiB = 1u << 20;
constexpr size_t WS_CTL = 0, WS_MOD = 1 * MiB, WS_WIN = 2 * MiB, WS_WOUT = 10 * MiB, WS_WGU = 12 * MiB, WS_WDN = 23 * MiB;
constexpr size_t WS_SS1 = 29 * MiB, WS_SS2 = 33 * MiB, WS_KIDX = 37 * MiB, WS_WIDX = 45 * MiB, WS_GLR = 47 * MiB, WS_THR = 51 * MiB;
constexpr size_t WS_H = 64 * MiB, WS_CAT = 192 * MiB, WS_PROJ = 320 * MiB, WS_ACT = 320 * MiB, WS_GLAS = 768 * MiB, WS_VT = 896 * MiB, WS_KF = 960 * MiB, WS_END = 1024 * MiB;
constexpr int LDS_BYTES = 163840;

struct Params {
    const float *x, *c, *w_mod, *b_mod, *norm1_g, *w_in, *w_gate2, *b_gate2, *att_g, *gla_g, *w_out, *norm2_g, *w_gu, *w_down, *final_g;
    float* out; unsigned char* ws; int ph_lo, ph_hi;
};

__device__ __forceinline__ unsigned pkh(float a, float b) { const h2v h = __builtin_convertvector((f32x2){a, b}, h2v); return __builtin_bit_cast(unsigned, h); }
__device__ __forceinline__ float silu_f(float v) { return v * __builtin_amdgcn_rcpf(1.f + __expf(-v)); }
__device__ __forceinline__ float wave_sum(float v) {
#pragma unroll
    for (int o = 1; o < 64; o <<= 1) v += __shfl_xor(v, o);
    return v;
}
__device__ __forceinline__ float rows_sum(float s) {
    { const unsigned u = __builtin_bit_cast(unsigned, s); const auto r = __builtin_amdgcn_permlane16_swap(u, u, false, false); const unsigned a = r[0], b = r[1]; s = __builtin_bit_cast(float, a) + __builtin_bit_cast(float, b); }
    { const unsigned u = __builtin_bit_cast(unsigned, s); const auto r = __builtin_amdgcn_permlane32_swap(u, u, false, false); const unsigned a = r[0], b = r[1]; s = __builtin_bit_cast(float, a) + __builtin_bit_cast(float, b); }
    return s;
}
#define LDS_WAIT() asm volatile("s_waitcnt lgkmcnt(0)" ::: "memory")

struct MapIn { __device__ __forceinline__ int operator()(int n) const {
    if (n < 2048) return n; if (n < 3584) return n + 72; if (n < 3648) return 2048 + (n - 3584); if (n < 3656) return 2112 + (n - 3648); if (n < 3672) return n; return -1; } };
struct MapGU { __device__ __forceinline__ int operator()(int n) const { const int pn = n >> 8, r = n & 255; return r < 128 ? 128 * pn + r : DFF + 128 * pn + (r - 128); } };
struct MapId { __device__ __forceinline__ int operator()(int n) const { return n; } };

template <class Map>
__device__ __forceinline__ void transpose_item(const float* __restrict__ W, int K, int Nsrc, u16* __restrict__ WT, int nblk, LAS float* scr, int item, int lane, Map map) {
    const int kb = item / nblk, nb = item % nblk, k0 = 64 * kb, n0 = 32 * nb;
    const int sc = map(n0 + (lane & 31));
#pragma unroll 8
    for (int i = 0; i < 32; ++i) { const int kk = 2 * i + (lane >> 5); const float v = W[(size_t)(k0 + kk) * Nsrc + (sc >= 0 ? sc : 0)]; scr[kk * 33 + (lane & 31)] = sc >= 0 ? v : 0.f; }
    LDS_WAIT(); asm volatile("" ::: "memory");
    const int c = lane & 7;
#pragma unroll
    for (int j = 0; j < 4; ++j) { const int n = (lane >> 3) + 8 * j; const LAS float* s = scr + (8 * c) * 33 + n;
        u32x4 o; o.x = pkh(s[0 * 33], s[1 * 33]); o.y = pkh(s[2 * 33], s[3 * 33]); o.z = pkh(s[4 * 33], s[5 * 33]); o.w = pkh(s[6 * 33], s[7 * 33]);
        *(u32x4*)(WT + (size_t)(n0 + n) * K + k0 + 8 * c) = o; }
    LDS_WAIT(); asm volatile("" ::: "memory");
}

__device__ __forceinline__ void phase_p0a(const Params& p, LAS unsigned char* lds, int wave, int lane) {
    LAS float* sct = (LAS float*)(lds + 98304);
    for (int i = threadIdx.x; i < NB * D; i += NT) { const float cv = p.c[i]; sct[i] = cv / (1.f + expf(-cv)); }
    __syncthreads();
    const int gw = blockIdx.x * NWAVES + wave, NGW = gridDim.x * NWAVES;
    float* mod = (float*)(p.ws + WS_MOD);
    for (int it = gw; it < 6 * D / 16; it += NGW) {
        const int j = it * 16 + (lane & 15), kq = lane >> 4;
        float acc[NB];
#pragma unroll
        for (int b = 0; b < NB; ++b) acc[b] = 0.f;
#pragma unroll 4
        for (int k4 = 0; k4 < D / 4; ++k4) { const int k = 4 * k4 + kq; const float w = p.w_mod[(size_t)k * (6 * D) + j];
#pragma unroll
            for (int b = 0; b < NB; ++b) acc[b] += sct[b * D + k] * w; }
#pragma unroll
        for (int b = 0; b < NB; ++b) acc[b] = rows_sum(acc[b]);
        if (lane < 16) { const float bm = p.b_mod[j];
#pragma unroll
            for (int b = 0; b < NB; ++b) mod[b * 6 * D + j] = acc[b] + bm; }
    }
}
__device__ __forceinline__ void phase_p0b(const Params& p, LAS unsigned char* lds, int wave, int lane) {
    const int gw = blockIdx.x * NWAVES + wave, NGW = gridDim.x * NWAVES;
    LAS float* scr = (LAS float*)(lds + wave * 8704);
    constexpr int I_IN = (D / 64) * (3840 / 32), I_OUT = (D / 64) * (D / 32), I_GU = (D / 64) * (2 * DFF / 32), I_DN = (DFF / 64) * (D / 32);
    constexpr int NITEMS = I_IN + I_OUT + I_GU + I_DN;
    for (int it = gw; it < NITEMS; it += NGW) {
        int r = it;
        if (r < I_IN) { transpose_item(p.w_in, D, DIN, (u16*)(p.ws + WS_WIN), 3840 / 32, scr, r, lane, MapIn()); continue; } r -= I_IN;
        if (r < I_OUT) { transpose_item(p.w_out, D, D, (u16*)(p.ws + WS_WOUT), D / 32, scr, r, lane, MapId()); continue; } r -= I_OUT;
        if (r < I_GU) { transpose_item(p.w_gu, D, 2 * DFF, (u16*)(p.ws + WS_WGU), 2 * DFF / 32, scr, r, lane, MapGU()); continue; } r -= I_GU;
        transpose_item(p.w_down, DFF, D, (u16*)(p.ws + WS_WDN), D / 32, scr, r, lane, MapId());
    }
}

template <int MODE>
__device__ __forceinline__ void row_phase(const void* xin, const float* __restrict__ g, const float* __restrict__ mod, int sh_off, int sc_off, const float* __restrict__ ss, void* outp, int wave, int lane) {
    const int gw = blockIdx.x * NWAVES + wave, NGW = gridDim.x * NWAVES;
    f32x4 gv[4];
#pragma unroll
    for (int j = 0; j < 4; ++j) gv[j] = ((const f32x4*)g)[lane + 64 * j];
    auto load = [&](f32x4 (&v)[4], int m) __attribute__((always_inline)) {
        if (MODE == 0) { const f32x4* xr = (const f32x4*)((const float*)xin + (size_t)m * D) + lane;
#pragma unroll
            for (int j = 0; j < 4; ++j) v[j] = __builtin_nontemporal_load(xr + 64 * j); }
        else { const u32x2* xr = (const u32x2*)((const u16*)xin + (size_t)m * D) + lane;
#pragma unroll
            for (int j = 0; j < 4; ++j) { const u32x2 w = xr[64 * j]; const unsigned wx = w.x, wy = w.y; const h2v a = __builtin_bit_cast(h2v, wx), b = __builtin_bit_cast(h2v, wy); v[j] = (f32x4){(float)a[0], (float)a[1], (float)b[0], (float)b[1]}; } }
    };
    auto finish = [&](f32x4 (&v)[4], int m) __attribute__((always_inline)) {
        float tot;
        if (MODE == 0) { float s = 0.f;
#pragma unroll
            for (int j = 0; j < 4; ++j) s += (v[j].x * v[j].x + v[j].y * v[j].y) + (v[j].z * v[j].z + v[j].w * v[j].w);
            tot = wave_sum(s); }
        else { const f32x4* sp = (const f32x4*)(ss + (size_t)m * 16); const f32x4 a = sp[0], b = sp[1], c = sp[2], d = sp[3];
            tot = ((a.x + a.y) + (a.z + a.w)) + ((b.x + b.y) + (b.z + b.w)) + ((c.x + c.y) + (c.z + c.w)) + ((d.x + d.y) + (d.z + d.w)); }
        const float rstd = rsqrtf(tot * (1.f / D) + EPS);
        if (MODE == 2) { f32x4* o = (f32x4*)((float*)outp + (size_t)m * D) + lane;
#pragma unroll
            for (int j = 0; j < 4; ++j) __builtin_nontemporal_store(v[j] * rstd * gv[j], o + 64 * j); }
        else { const float* mb = mod + (m >> 13) * (6 * D);
            u32x2* o = (u32x2*)((u16*)outp + (size_t)m * D) + lane;
#pragma unroll
            for (int j = 0; j < 4; ++j) { const f32x4 sc = ((const f32x4*)(mb + sc_off))[lane + 64 * j], sh = ((const f32x4*)(mb + sh_off))[lane + 64 * j];
                const f32x4 r = v[j] * rstd * gv[j] * (sc + 1.f) + sh; u32x2 w; w.x = pkh(r.x, r.y); w.y = pkh(r.z, r.w); o[64 * j] = w; } }
    };
    for (int m = gw; m < T; m += 2 * NGW) {
        f32x4 va[4], vb[4];
        load(va, m); const bool two = m + NGW < T; if (two) load(vb, m + NGW);
        finish(va, m); if (two) finish(vb, m + NGW);
    }
}

struct EpiProj {
    static constexpr bool PERM = true, AFTER_DRAIN = false;
    u16* P; u16* kidx; float* widx; float* glr; u16* kf;
    __device__ __forceinline__ void operator()(const f32x4 (&acc)[2][2][4][2], const Unit& u, int wr, int wc, int fr, int fq) const {
        const int row0 = u.pm * 256 + wr * 64 + fr;
        if (u.pn < 14) {
            const int col0 = u.pn * 256 + wc * 32 + 8 * fq;
#pragma unroll
            for (int ai = 0; ai < 2; ++ai)
#pragma unroll
                for (int m = 0; m < 4; ++m) { u16* rowp = P + (size_t)(row0 + ai * 128 + m * 16) * PJ + col0;
#pragma unroll
                    for (int bj = 0; bj < 2; ++bj) { const f32x4 v0 = acc[ai][bj][m][0], v1 = acc[ai][bj][m][1];
                        u32x4 w; w.x = pkh(v0[0], v0[1]); w.y = pkh(v0[2], v0[3]); w.z = pkh(v1[0], v1[1]); w.w = pkh(v1[2], v1[3]);
                        if (u.pn == 2 || u.pn == 3) {
                            const int row = row0 + ai * 128 + m * 16, hd = 2 * (u.pn - 2) + bj, bb = row >> 13, kt = (row & 8191) >> 5;
                            __builtin_nontemporal_store(w, (u32x4*)(kf + ((((size_t)(bb * 4 + hd) * 256 + kt) * 8 + 2 * wc + (fq >> 1)) * 64 + (fq & 1) * 32 + (row & 31)) * 8)); }
                        else __builtin_nontemporal_store(w, (u32x4*)(rowp + bj * 128)); } }
        } else {
#pragma unroll
            for (int ai = 0; ai < 2; ++ai)
#pragma unroll
                for (int m = 0; m < 4; ++m) { const size_t row = (size_t)(row0 + ai * 128 + m * 16); const f32x4 v0 = acc[ai][0][m][0], v1 = acc[ai][0][m][1];
                    if (wc < 2) { u32x4 w; w.x = pkh(v0[0], v0[1]); w.y = pkh(v0[2], v0[3]); w.z = pkh(v1[0], v1[1]); w.w = pkh(v1[2], v1[3]);
                        *(u32x4*)(kidx + (((row >> 5) * 4 + 2 * wc + (fq >> 1)) * 64 + (fq & 1) * 32 + (row & 31)) * 8) = w; }
                    else if (wc == 2) {
                        if (fq == 0) { *(f32x4*)(widx + row * 8) = v0 * IDX_SCALE; *(f32x4*)(widx + row * 8 + 4) = v1 * IDX_SCALE; }
                        else if (fq < 3) { *(f32x4*)(glr + row * 16 + (fq - 1) * 8) = v0; *(f32x4*)(glr + row * 16 + (fq - 1) * 8 + 4) = v1; } } }
        }
    }
};
template <bool BASE_HALF>
struct EpiRes {
    static constexpr bool PERM = false, AFTER_DRAIN = false;
    const void* base; u16* out; const float* mod; float* ss; int gate_off; int pad;
    __device__ __forceinline__ void operator()(const f32x4 (&acc)[2][2][4][2], const Unit& u, int wr, int wc, int fr, int fq) const {
        const int row0 = u.pm * 256 + wr * 64 + fr, col0 = u.pn * 256 + wc * 32 + 4 * fq;
        const float* g = mod + (u.pm >> 5) * (6 * D) + gate_off;
        f32x4 gv[2][2];
#pragma unroll
        for (int bj = 0; bj < 2; ++bj)
#pragma unroll
            for (int n = 0; n < 2; ++n) gv[bj][n] = *(const f32x4*)(g + col0 + bj * 128 + n * 16);
#pragma unroll
        for (int ai = 0; ai < 2; ++ai) {
            f32x4 bsf[4][2][2]; u32x2 bsh[4][2][2];
#pragma unroll
            for (int m = 0; m < 4; ++m)
#pragma unroll
                for (int bj = 0; bj < 2; ++bj)
#pragma unroll
                    for (int n = 0; n < 2; ++n) { const size_t off = (size_t)(row0 + ai * 128 + m * 16) * D + col0 + bj * 128 + n * 16;
                        if (BASE_HALF) bsh[m][bj][n] = *(const u32x2*)((const u16*)base + off);
                        else bsf[m][bj][n] = __builtin_nontemporal_load((const f32x4*)((const float*)base + off)); }
#pragma unroll
            for (int m = 0; m < 4; ++m) { const size_t row = (size_t)(row0 + ai * 128 + m * 16); float s = 0.f;
#pragma unroll
                for (int bj = 0; bj < 2; ++bj)
#pragma unroll
                    for (int n = 0; n < 2; ++n) { const size_t off = row * D + col0 + bj * 128 + n * 16; f32x4 bs;
                        if (BASE_HALF) { const u32x2 wi = bsh[m][bj][n]; const unsigned wx = wi.x, wy = wi.y;        const h2v a = __builtin_bit_cast(h2v, wx), b = __builtin_bit_cast(h2v, wy); bs = (f32x4){(float)a[0], (float)a[1], (float)b[0], (float)b[1]}; }
                        else bs = bsf[m][bj][n];
                        const f32x4 o = bs + gv[bj][n] * acc[ai][bj][m][n]; u32x2 w; w.x = pkh(o[0], o[1]); w.y = pkh(o[2], o[3]); *(u32x2*)(out + off) = w;
                        s += (o[0] * o[0] + o[1] * o[1]) + (o[2] * o[2] + o[3] * o[3]); }
                s = rows_sum(s);
                if (fq == 0) ss[row * 16 + u.pn * 4 + wc] = s; } }
    }
};
struct EpiSwiGLU {
    static constexpr bool PERM = true, AFTER_DRAIN = false;
    u16* act;
    __device__ __forceinline__ void operator()(const f32x4 (&acc)[2][2][4][2], const Unit& u, int wr, int wc, int fr, int fq) const {
        const int row0 = u.pm * 256 + wr * 64 + fr, col0 = u.pn * 128 + wc * 32 + 8 * fq;
#pragma unroll
        for (int ai = 0; ai < 2; ++ai)
#pragma unroll
            for (int m = 0; m < 4; ++m) { const f32x4 g0 = acc[ai][0][m][0], g1 = acc[ai][0][m][1], u0 = acc[ai][1][m][0], u1 = acc[ai][1][m][1];
                float a[8];
#pragma unroll
                for (int j = 0; j < 4; ++j) { a[j] = silu_f(g0[j]) * u0[j]; a[4 + j] = silu_f(g1[j]) * u1[j]; }
                u32x4 w; w.x = pkh(a[0], a[1]); w.y = pkh(a[2], a[3]); w.z = pkh(a[4], a[5]); w.w = pkh(a[6], a[7]);
                __builtin_nontemporal_store(w, (u32x4*)(act + (size_t)(row0 + ai * 128 + m * 16) * DFF + col0)); }
    }
};
}
#define MK_HAVE_MIX 1
namespace mk {
constexpr size_t WS_GDEC = 52 * MiB;
constexpr size_t WS_SELM = WS_H + 64 * MiB;
constexpr size_t WS_X16 = WS_GLAS;
constexpr size_t WS_S16 = WS_H;
constexpr int NCH = L / 64;

__device__ __forceinline__ unsigned f2bf(float f) { unsigned u = __builtin_bit_cast(unsigned, f); return (u + 0x7fffu + ((u >> 16) & 1u)) >> 16; }
__device__ __forceinline__ unsigned pkbf(float lo, float hi) { return f2bf(lo) | (f2bf(hi) << 16); }
__device__ __forceinline__ float h2f(u16 h) { return (float)__builtin_bit_cast(_Float16, h); }
__device__ __forceinline__ float hlo(unsigned w) { return h2f((u16)(w & 0xffffu)); }
__device__ __forceinline__ float hhi(unsigned w) { return h2f((u16)(w >> 16)); }
__device__ __forceinline__ int kperm16(int o) { return 8 * ((o >> 2) & 1) + 4 * (o >> 3) + (o & 3); }

__device__ __forceinline__ void vt_item(const Params& p, LAS unsigned char* scr  , int item, int lane) {
    const int tb = item & 255, h = (item >> 8) & 3, b = item >> 10, t0 = tb * 32;
    const u16* src = (const u16*)(p.ws + WS_PROJ) + (size_t)(b * L + t0) * PJ + CV + h * 128;
#pragma unroll
    for (int i = 0; i < 8; ++i) { const int r = 4 * i + (lane >> 4), ch = lane & 15; const u32x4 v = *(const u32x4*)(src + (size_t)r * PJ + ch * 8);
        LAS unsigned* d = (LAS unsigned*)(scr + r * 264 + ch * 16); d[0] = v.x; d[1] = v.y; d[2] = v.z; d[3] = v.w; }
    LDS_WAIT(); asm volatile("" ::: "memory");
    u16* dst = (u16*)(p.ws + WS_VT) + ((size_t)(b * 4 + h) * 256 + tb) * 4096;
#pragma unroll
    for (int i = 0; i < 8; ++i) { const int c = i * 64 + lane, dv = c & 127, tg = c >> 7;
        unsigned w[4];
#pragma unroll
        for (int jp = 0; jp < 4; ++jp) { const int j = 2 * jp, tok = 16 * (tg >> 1) + 8 * (j >> 2) + 4 * (tg & 1) + (j & 3);
            const unsigned lo = *(LAS u16*)(scr + tok * 264 + dv * 2), hi = *(LAS u16*)(scr + (tok + 1) * 264 + dv * 2); w[jp] = lo | (hi << 16); }
        u32x4 o; o.x = w[0]; o.y = w[1]; o.z = w[2]; o.w = w[3];
        *(u32x4*)(dst + ((((dv >> 5) * 2 + (tg >> 1)) * 2 + (tg & 1)) * 32 + (dv & 31)) * 8) = o; }
    LDS_WAIT(); asm volatile("" ::: "memory");
}

constexpr int GL_SEG = 106496;
constexpr int GL_GLR = 0, GL_WG = 4096, GL_BG = 8192, GL_BC = 8448, GL_QD = 25088, GL_KD = 34304, GL_QP = 43520, GL_VT = 52736, GL_SSQ = 71168, GL_OST = 72192, GL_END = 105984;
constexpr int GST = 72;
__device__ __forceinline__ void gla_bcum(const Params& p, LAS unsigned char* lds, int b, int h, int c) {
    const int tid = threadIdx.x;
    LAS float* glr = (LAS float*)(lds + GL_GLR); LAS float* wg = (LAS float*)(lds + GL_WG); LAS float* bg = (LAS float*)(lds + GL_BG); LAS float* bc = (LAS float*)(lds + GL_BC);
    const float* gsrc = (const float*)(p.ws + WS_GLR) + (size_t)(b * L + c * 64) * 16;
    for (int i = tid; i < 1024; i += NT) { glr[i] = gsrc[i]; wg[i] = p.w_gate2[(i >> 6) * 256 + h * 64 + (i & 63)]; }
    if (tid < 64) bg[tid] = p.b_gate2[h * 64 + tid];
    __syncthreads();
    { const int dk = tid & 63; float wr[16];
#pragma unroll
      for (int r = 0; r < 16; ++r) wr[r] = wg[r * 64 + dk];
      const float bias = bg[dk];
#pragma unroll
      for (int i = 0; i < 8; ++i) { const int t = (tid >> 6) + 8 * i; float z = bias;
#pragma unroll
          for (int r4 = 0; r4 < 4; ++r4) { const f32x4 gq = *(const LAS f32x4*)(glr + t * 16 + 4 * r4); z += gq[0] * wr[4 * r4] + gq[1] * wr[4 * r4 + 1] + gq[2] * wr[4 * r4 + 2] + gq[3] * wr[4 * r4 + 3]; }
          bc[t * 65 + dk] = (fminf(z, 0.f) - __logf(1.f + __expf(-fabsf(z)))) * (1.f / 16.f); } }
    __syncthreads();
    { const int dk = tid & 63, sg = tid >> 6; LAS float* segt = (LAS float*)(lds + GL_SEG);
      float v[8], run = 0.f;
#pragma unroll
      for (int i = 0; i < 8; ++i) { run += bc[(sg * 8 + i) * 65 + dk]; v[i] = run; }
      segt[sg * 64 + dk] = run;
      __syncthreads();
      float off = 0.f;
#pragma unroll
      for (int j = 0; j < 7; ++j) off += (j < sg) ? segt[j * 64 + dk] : 0.f;
#pragma unroll
      for (int i = 0; i < 8; ++i) bc[(sg * 8 + i) * 65 + dk] = v[i] + off; }
    __syncthreads();
}

__device__ __forceinline__ void gla1_item(const Params& p, LAS unsigned char* lds, int item, int wave, int lane) {
    const int tid = threadIdx.x, c = item & (NCH - 1), h = (item >> 7) & 3, b = item >> 9;
    const u16* prow = (const u16*)(p.ws + WS_PROJ) + (size_t)(b * L + c * 64) * PJ;
    unsigned kw0[4], kw1[4], vw0[8], vw1[8];
#pragma unroll
    for (int i = 0; i < 4; ++i) { const int idx = tid + NT * i, dk = idx & 63, t = 2 * (idx >> 6);
        kw0[i] = prow[(size_t)t * PJ + CGK + h * 64 + dk]; kw1[i] = prow[(size_t)(t + 1) * PJ + CGK + h * 64 + dk]; }
#pragma unroll
    for (int i = 0; i < 8; ++i) { const int idx = tid + NT * i, dv = idx & 127, t = 2 * (idx >> 7);
        vw0[i] = prow[(size_t)t * PJ + CGV + h * 128 + dv]; vw1[i] = prow[(size_t)(t + 1) * PJ + CGV + h * 128 + dv]; }
    gla_bcum(p, lds, b, h, c);
    LAS float* bc = (LAS float*)(lds + GL_BC); LAS u16* KT = (LAS u16*)(lds + GL_KD); LAS u16* VTl = (LAS u16*)(lds + GL_VT);
#pragma unroll
    for (int i = 0; i < 4; ++i) { const int idx = tid + NT * i, dk = idx & 63, t = 2 * (idx >> 6); const float bl = bc[63 * 65 + dk];
        const float k0 = h2f((u16)kw0[i]) * __expf(bl - bc[t * 65 + dk]), k1 = h2f((u16)kw1[i]) * __expf(bl - bc[(t + 1) * 65 + dk]);
        *(LAS unsigned*)(KT + dk * GST + t) = pkh(k0, k1); }
#pragma unroll
    for (int i = 0; i < 8; ++i) { const int idx = tid + NT * i, dv = idx & 127, t = 2 * (idx >> 7);
        *(LAS unsigned*)(VTl + dv * GST + t) = vw0[i] | (vw1[i] << 16); }
    if (tid < 64) ((float*)(p.ws + WS_GDEC))[(size_t)item * 64 + tid] = __expf(bc[63 * 65 + tid]);
#pragma unroll
    for (int i = 0; i < 8; ++i) { const int idx = tid + NT * i, t = idx >> 6, dk = idx & 63;
        ((float*)((u16*)(p.ws + WS_PROJ) + (size_t)(b * L + c * 64 + t) * PJ + CK + h * 128))[dk] = bc[t * 65 + dk]; }
    __syncthreads();
    const int mbv = wave >> 1, nbk = wave & 1, hh = lane >> 5, l31 = lane & 31;
    f32x16 acc;
#pragma unroll
    for (int i = 0; i < 16; ++i) acc[i] = 0.f;
#pragma unroll
    for (int s = 0; s < 4; ++s) { const f16x8 a = *(const LAS f16x8*)(VTl + (mbv * 32 + l31) * GST + 16 * s + 8 * hh), bb = *(const LAS f16x8*)(KT + (nbk * 32 + l31) * GST + 16 * s + 8 * hh);
        acc = __builtin_amdgcn_mfma_f32_32x32x16_f16(a, bb, acc, 0, 0, 0); }
    float* dst = (float*)(p.ws + WS_GLAS) + (size_t)item * 8192;
#pragma unroll
    for (int i = 0; i < 16; ++i) { const int dv = mbv * 32 + (i & 3) + 8 * (i >> 2) + 4 * hh; dst[dv * 64 + nbk * 32 + l31] = acc[i]; }
    __syncthreads();
}

__device__ __forceinline__ void phase_p4(const Params& p, LAS unsigned char* lds, int wave, int lane) {
    const float* dS = (const float*)(p.ws + WS_GLAS); const float* dec = (const float*)(p.ws + WS_GDEC); unsigned* S16 = (unsigned*)(p.ws + WS_S16);
    for (int ch = blockIdx.x * NT + threadIdx.x; ch < 32 * 4096; ch += gridDim.x * NT) {
        const int bh = ch >> 12, e2 = ch & 4095, dk = (e2 * 2) & 63;
        f32x2 run = {0.f, 0.f};
#pragma unroll 16
        for (int c = 0; c < NCH; ++c) { const size_t item = (size_t)bh * NCH + c;
            const f32x2 d = *(const f32x2*)(dS + item * 8192 + e2 * 2), a = *(const f32x2*)(dec + item * 64 + dk);
            S16[item * 4096 + e2] = pkh(run.x, run.y);
            run = a * run + d; }
    }
}

struct G3Ops { unsigned qw[4], kw[4], vw0[8], vw1[8]; u32x4 g0, g1; f16x8 sfr[4]; float bw[8]; };
#define GL_SYNC() do { asm volatile("s_waitcnt lgkmcnt(0)" ::: "memory"); __builtin_amdgcn_s_barrier(); asm volatile("" ::: "memory"); } while (0)
__device__ __forceinline__ void gla3_load(const Params& p, G3Ops& o, int item, int wave, int lane) {
    const int tid = threadIdx.x, c = item & (NCH - 1), h = (item >> 7) & 3, b = item >> 9;
    const int mb = wave >> 1, hh = lane >> 5, l31 = lane & 31;
    const u16* prow = (const u16*)(p.ws + WS_PROJ) + (size_t)(b * L + c * 64) * PJ;
#pragma unroll
    for (int i = 0; i < 4; ++i) { const int idx = tid + NT * i, dk = 2 * (idx & 31), t = idx >> 5;
        o.qw[i] = *(const unsigned*)(prow + (size_t)t * PJ + CGQ + h * 64 + dk); o.kw[i] = *(const unsigned*)(prow + (size_t)t * PJ + CGK + h * 64 + dk); }
#pragma unroll
    for (int i = 0; i < 8; ++i) { const int idx = tid + NT * i, dv = idx & 127, t = 2 * (idx >> 7);
        o.vw0[i] = prow[(size_t)t * PJ + CGV + h * 128 + dv]; o.vw1[i] = prow[(size_t)(t + 1) * PJ + CGV + h * 128 + dv]; }
    const u16* gorow = prow + (size_t)(tid >> 3) * PJ + CGO + h * 128 + (tid & 7) * 16;
    o.g0 = *(const u32x4*)gorow; o.g1 = *(const u32x4*)(gorow + 8);
    { const u16* srow = (const u16*)(p.ws + WS_S16) + (size_t)item * 8192 + (size_t)(mb * 32 + l31) * 64;
#pragma unroll
      for (int s = 0; s < 4; ++s) o.sfr[s] = *(const f16x8*)(srow + 16 * s + 8 * hh); }
#pragma unroll
    for (int i = 0; i < 8; ++i) { const int idx = tid + NT * i, t = idx >> 6, dk = idx & 63; o.bw[i] = ((const float*)(prow + (size_t)t * PJ + CK + h * 128))[dk]; }
}
__device__ __forceinline__ void gla3_item(const Params& p, LAS unsigned char* lds, const G3Ops& ops, int item, int wave, int lane) {
    const int tid = threadIdx.x, c = item & (NCH - 1), h = (item >> 7) & 3, b = item >> 9;
    const int mb = wave >> 1, nb = wave & 1, hh = lane >> 5, l31 = lane & 31;
    const unsigned (&qw)[4] = ops.qw; const unsigned (&kw)[4] = ops.kw; const unsigned (&vw0)[8] = ops.vw0; const unsigned (&vw1)[8] = ops.vw1; const u32x4 g0 = ops.g0, g1 = ops.g1; const f16x8 (&sfr)[4] = ops.sfr;
    LAS float* bc = (LAS float*)(lds + GL_BC);
#pragma unroll
    for (int i = 0; i < 8; ++i) { const int idx = tid + NT * i, t = idx >> 6, dk = idx & 63; bc[t * 65 + dk] = ops.bw[i]; }
    GL_SYNC();
    LAS u16* QD = (LAS u16*)(lds + GL_QD); LAS u16* KD = (LAS u16*)(lds + GL_KD); LAS u16* QP = (LAS u16*)(lds + GL_QP); LAS u16* VTl = (LAS u16*)(lds + GL_VT);
    LAS float* ssq = (LAS float*)(lds + GL_SSQ); LAS float* ost = (LAS float*)(lds + GL_OST);
#pragma unroll
    for (int i = 0; i < 4; ++i) { const int idx = tid + NT * i, dk = 2 * (idx & 31), t = idx >> 5;
        const float b0 = bc[t * 65 + dk], b1 = bc[t * 65 + dk + 1], r0 = bc[31 * 65 + dk], r1 = bc[31 * 65 + dk + 1];
        const float q0 = hlo(qw[i]) * 0.125f, q1 = hhi(qw[i]) * 0.125f;
        *(LAS unsigned*)(QD + t * GST + dk) = pkbf(q0 * __expf(b0 - r0), q1 * __expf(b1 - r1));
        *(LAS unsigned*)(KD + t * GST + dk) = pkbf(hlo(kw[i]) * __expf(r0 - b0), hhi(kw[i]) * __expf(r1 - b1));
        *(LAS unsigned*)(QP + t * GST + dk) = pkh(q0 * __expf(b0), q1 * __expf(b1)); }
#pragma unroll
    for (int i = 0; i < 8; ++i) { const int idx = tid + NT * i, dv = idx & 127, t = 2 * (idx >> 7);
        *(LAS unsigned*)(VTl + dv * GST + (t & ~15) + kperm16(t & 15)) = vw0[i] | (vw1[i] << 16); }
    GL_SYNC();
    f16x8 pf[4];
#pragma unroll
    for (int jb = 0; jb < 2; ++jb) {
        if (jb > nb) {
#pragma unroll
            for (int e = 0; e < 8; ++e) { pf[2 * jb][e] = (_Float16)0.f; pf[2 * jb + 1][e] = (_Float16)0.f; }
            continue; }
        f32x16 x;
#pragma unroll
        for (int i = 0; i < 16; ++i) x[i] = 0.f;
#pragma unroll
        for (int s = 0; s < 4; ++s) { const bf16x8 a = *(const LAS bf16x8*)(KD + (jb * 32 + l31) * GST + 16 * s + 8 * hh), bb = *(const LAS bf16x8*)(QD + (nb * 32 + l31) * GST + 16 * s + 8 * hh);
            x = __builtin_amdgcn_mfma_f32_32x32x16_bf16(a, bb, x, 0, 0, 0); }
#pragma unroll
        for (int i = 0; i < 16; ++i) { const int rowi = (i & 3) + 8 * (i >> 2) + 4 * hh; const bool keep = (jb < nb) || (rowi <= l31); const float v = keep ? x[i] : 0.f;
            pf[2 * jb + (i >> 3)][i & 7] = (_Float16)v; }
    }
    f32x16 o;
#pragma unroll
    for (int i = 0; i < 16; ++i) o[i] = 0.f;
#pragma unroll
    for (int kk = 0; kk < 4; ++kk) { if ((kk >> 1) > nb) continue;
        const f16x8 a = *(const LAS f16x8*)(VTl + (mb * 32 + l31) * GST + 16 * kk + 8 * hh);
        o = __builtin_amdgcn_mfma_f32_32x32x16_f16(a, pf[kk], o, 0, 0, 0); }
#pragma unroll
    for (int s = 0; s < 4; ++s) { const f16x8 bb = *(const LAS f16x8*)(QP + (nb * 32 + l31) * GST + 16 * s + 8 * hh);
        o = __builtin_amdgcn_mfma_f32_32x32x16_f16(sfr[s], bb, o, 0, 0, 0); }
    float part = 0.f;
#pragma unroll
    for (int i = 0; i < 16; ++i) { part += o[i] * o[i]; ost[(nb * 32 + l31) * 132 + mb * 32 + (i & 3) + 8 * (i >> 2) + 4 * hh] = o[i]; }
    part += __shfl_xor(part, 32);
    if (lane < 32) ssq[mb * 64 + nb * 32 + lane] = part;
    GL_SYNC();
    { const int t = tid >> 3, dv0 = (tid & 7) * 16;
      const float rstd = rsqrtf((ssq[t] + ssq[64 + t] + ssq[128 + t] + ssq[192 + t]) * (1.f / 128.f) + EPS);
      const unsigned gw[8] = {g0.x, g0.y, g0.z, g0.w, g1.x, g1.y, g1.z, g1.w};
      unsigned ow[8];
#pragma unroll
      for (int e = 0; e < 8; ++e) { const int dv = dv0 + 2 * e;
          const float a0 = ost[t * 132 + dv] * rstd * p.gla_g[dv] * silu_f(hlo(gw[e])), a1 = ost[t * 132 + dv + 1] * rstd * p.gla_g[dv + 1] * silu_f(hhi(gw[e]));
          ow[e] = pkh(a0, a1); }
      u16* crow = (u16*)(p.ws + WS_CAT) + (size_t)(b * L + c * 64 + t) * D + 512 + h * 128 + dv0;
      u32x4 o0, o1; o0.x = ow[0]; o0.y = ow[1]; o0.z = ow[2]; o0.w = ow[3]; o1.x = ow[4]; o1.y = ow[5]; o1.z = ow[6]; o1.w = ow[7];
      *(u32x4*)crow = o0; *(u32x4*)(crow + 8) = o1; }
    GL_SYNC();
}
}
namespace mk {
__device__ __forceinline__ int idx_row_slot(int r) { return 2 * ((r >> 2) & 1) + (r >> 4); }
__device__ __forceinline__ int idx_row_head(int r) { return (r & 3) + 4 * ((r >> 3) & 1); }
__device__ __forceinline__ float relu_f(float x) { const int i = __builtin_bit_cast(int, x); return __builtin_bit_cast(float, i > 0 ? i : 0); }
__device__ __forceinline__ float fmul_s(float a, float b) { float r; asm("v_mul_f32_e32 %0, %1, %2" : "=v"(r) : "v"(a), "v"(b)); return r; }
__device__ __forceinline__ float fma_s(float a, float b, float c) { asm("v_fmac_f32_e32 %0, %1, %2" : "+v"(c) : "v"(a), "v"(b)); return c; }
template <int BASE> __device__ __forceinline__ float idx_score(const f32x16& acc, const f32x4 wa, const f32x4 wb) {
    float s = fmul_s(wa[0], relu_f(acc[BASE + 0]));
    s = fma_s(wa[1], relu_f(acc[BASE + 1]), s);
    s = fma_s(wa[2], relu_f(acc[BASE + 2]), s); s = fma_s(wa[3], relu_f(acc[BASE + 3]), s);
    s = fma_s(wb[0], relu_f(acc[BASE + 4]), s); s = fma_s(wb[1], relu_f(acc[BASE + 5]), s);
    s = fma_s(wb[2], relu_f(acc[BASE + 6]), s); s = fma_s(wb[3], relu_f(acc[BASE + 7]), s);
    return s;
}
__device__ __forceinline__ unsigned fkey(float f) { f = f + 0.0f; const unsigned u = __builtin_bit_cast(unsigned, f); return u ^ ((unsigned)((int)u >> 31) | 0x80000000u); }
__device__ __forceinline__ int opq(int v) { asm volatile("" : "+v"(v)); return v; }
__device__ __forceinline__ unsigned lds_add(LAS unsigned* p, unsigned v) { return __hip_atomic_fetch_add(p, v, __ATOMIC_RELAXED, __HIP_MEMORY_SCOPE_WORKGROUP); }
__device__ __forceinline__ unsigned wave_prefix_incl(unsigned v) {
#define MK_DPPADD(ctrl, rm) v += (unsigned)__builtin_amdgcn_update_dpp(0, (int)v, ctrl, rm, 0xf, false)
    MK_DPPADD(0x111, 0xf); MK_DPPADD(0x112, 0xf); MK_DPPADD(0x114, 0xf); MK_DPPADD(0x118, 0xf); MK_DPPADD(0x142, 0xa); MK_DPPADD(0x143, 0xc);
#undef MK_DPPADD
    return v;
}
__device__ __forceinline__ unsigned wave_suffix_sum(unsigned x, int lane) {
    const unsigned pre = wave_prefix_incl(x), tot = (unsigned)__builtin_amdgcn_readlane((int)pre, 63);
    return tot - pre + x;
}

template <int NP, int NC>
__device__ __forceinline__ void wave_select(const LAS unsigned* const (&cq)[NC], const unsigned (&sc)[NC][4], const unsigned (&kk0)[NC], LAS unsigned* const (&hq)[NC], int lane, const int (&rp0)[NC], const unsigned (&pre)[NC], unsigned (&out)[NC]) {
    unsigned prefix[NC], mask[NC], kk[NC];
#pragma unroll
    for (int c = 0; c < NC; ++c) { prefix[c] = pre[c]; mask[c] = rp0[c] ? (0xffffffffu << (32 - 8 * rp0[c])) : 0u; kk[c] = kk0[c]; }
    int rpmin = NP;
#pragma unroll
    for (int c = 0; c < NC; ++c) rpmin = rp0[c] < rpmin ? rp0[c] : rpmin;
    for (int rp = rpmin; rp < NP; ++rp) { const int shift = 24 - 8 * rp;
#pragma unroll
        for (int c = 0; c < NC; ++c) { u32x4 z = {0u, 0u, 0u, 0u}; *(LAS u32x4*)(hq[c] + 4 * lane) = z; }
#pragma unroll
        for (int sl = 0; sl < 4; ++sl)
#pragma unroll
            for (int i = 0; i < 4; ++i)
#pragma unroll
                for (int c = 0; c < NC; ++c) { const unsigned idx = lane + 64 * i; if (rp >= rp0[c] && idx < sc[c][sl]) { const unsigned key = fkey(__builtin_bit_cast(float, cq[c][256 * sl + idx])); if ((key & mask[c]) == prefix[c]) lds_add(hq[c] + ((key >> shift) & 255u), 1u); } }
        LDS_WAIT();
        u32x4 cw[NC]; unsigned cs[NC], incl[NC];
#pragma unroll
        for (int c = 0; c < NC; ++c) { cw[c] = *(LAS u32x4*)(hq[c] + 4 * lane); cs[c] = cw[c].x + cw[c].y + cw[c].z + cw[c].w; incl[c] = cs[c]; }
#pragma unroll
        for (int c = 0; c < NC; ++c) incl[c] = wave_suffix_sum(cs[c], lane);
#pragma unroll
        for (int c = 0; c < NC; ++c) { const unsigned above = incl[c] - cs[c]; const bool found = above < kk[c] && kk[c] <= incl[c];
            unsigned dig = 0u, kk2 = 0u;
            if (found) { unsigned cum = above; const unsigned cv[4] = {cw[c].x, cw[c].y, cw[c].z, cw[c].w};
#pragma unroll
                for (int i = 3; i >= 0; --i) { if (kk2 == 0u) { if (cum + cv[i] >= kk[c]) { dig = (unsigned)(4 * lane + i); kk2 = kk[c] - cum; } else cum += cv[i]; } } }
            const unsigned long long bal = __ballot(found); const int src = bal ? (int)__builtin_ctzll(bal) : 0;
            dig = (unsigned)__builtin_amdgcn_readlane((int)dig, src); kk2 = (unsigned)__builtin_amdgcn_readlane((int)kk2, src);
            if (rp >= rp0[c]) { prefix[c] |= dig << shift; mask[c] |= 255u << shift; kk[c] = kk2 ? kk2 : 1u; } }
    }
#pragma unroll
    for (int c = 0; c < NC; ++c) out[c] = prefix[c];
}

constexpr int TH_HIST = 0, TH_CAND = 65536, TH_ST = 131072, TH_A = 133120;
constexpr int ST_LO = 0, ST_RMAX = 16, ST_SH = 32, ST_NEED = 48, ST_MODE = 64, ST_CCNT = 80, ST_HI = 96, ST_ABOVE = 112, ST_WL = 128, ST_SAMP = 256, ST_SCNT = 272, ST_THR = 336, ST_DIRTY = 352;
__device__ __forceinline__ void thr_loadB(f16x8 (&Bf)[4], const u16* KI, int kt) {
#pragma unroll
    for (int s = 0; s < 4; ++s) Bf[s] = *(const f16x8*)(KI + (size_t)(kt * 4 + s) * 512);
}
__device__ __forceinline__ void thr_scores(const f32x16& acc, const LAS float* wl, int mb, int hh, unsigned& k0, unsigned& k1) {
    const LAS float* w0 = wl + (4 * mb + 2 * hh) * 8;
    const f32x4 a0 = *(const LAS f32x4*)(w0), b0 = *(const LAS f32x4*)(w0 + 4), a1 = *(const LAS f32x4*)(w0 + 8), b1 = *(const LAS f32x4*)(w0 + 12);
    k0 = fkey(idx_score<0>(acc, a0, b0)); k1 = fkey(idx_score<8>(acc, a1, b1));
}
constexpr int TH_MASK = 0, TH_CIDX = 16384, TH_SCR = 49152;
__device__ __forceinline__ float key2f(unsigned k) { return __builtin_bit_cast(float, (k & 0x80000000u) ? (k ^ 0x80000000u) : ~k); }
template <int KIND>
__device__ __forceinline__ void thr_sweep(LAS unsigned char* lds, const f16x8 (&A)[2][4], const u16* KI, int t0, int ntiles, int wave, int lane) {
    LAS unsigned* hist = (LAS unsigned*)(lds + TH_HIST); LAS unsigned* cand = (LAS unsigned*)(lds + TH_CAND); LAS unsigned* st = (LAS unsigned*)(lds + TH_ST);
    LAS unsigned* maskb = (LAS unsigned*)(lds + TH_MASK); LAS u16* cidx = (LAS u16*)(lds + TH_CIDX);
    const int hh = lane >> 5, l31 = lane & 31, mbp = wave & 1, ph = wave >> 1;
    unsigned lo[2][2], rmax[2][2], sh[2][2], ccn[2][2]; float lof[2][2], upf[2][2];
#pragma unroll
    for (int mbl = 0; mbl < 2; ++mbl)
#pragma unroll
        for (int jj = 0; jj < 2; ++jj) { const int ql = 8 * mbp + 4 * mbl + 2 * hh + jj; const unsigned lk = st[ST_LO + ql], rm = st[ST_RMAX + ql], uk = lk + rm;
            lo[mbl][jj] = lk; rmax[mbl][jj] = rm; sh[mbl][jj] = st[ST_SH + ql]; ccn[mbl][jj] = 0u;
            lof[mbl][jj] = lk <= 0x007fffffu ? -__builtin_inff() : key2f(lk); upf[mbl][jj] = uk >= 0xff800000u ? (lk == 0xffffffffu ? -__builtin_inff() : __builtin_inff()) : key2f(uk); }
    f16x8 B0[4], B1[4];
    const unsigned cbase4 = (unsigned)(__UINTPTR_TYPE__)(lds + TH_CAND) + ((8 * mbp + 2 * hh) * 1024 + ph * 256) * 4, cbase2 = (unsigned)(__UINTPTR_TYPE__)(lds + TH_CIDX) + ((8 * mbp + 2 * hh) * 1024 + ph * 256) * 2;
    float lofv[2][2] = {{lof[0][0], lof[0][1]}, {lof[1][0], lof[1][1]}};
    float lofc[2][2];
#pragma unroll
    for (int mbl = 0; mbl < 2; ++mbl)
#pragma unroll
        for (int jj = 0; jj < 2; ++jj) lofc[mbl][jj] = ((ntiles - 1) * 32 + l31 <= t0 + 8 * mbp + 4 * mbl + 2 * hh + jj) ? lof[mbl][jj] : __builtin_inff();
    const LAS float* wlb = (const LAS float*)(st + ST_WL) + (8 * mbp + 2 * hh) * 8;
    asm volatile("" : "+v"(wlb));
    f32x4 wreg[2][2][2];
    if (KIND == 1) {
#pragma unroll
        for (int mbl = 0; mbl < 2; ++mbl)
#pragma unroll
            for (int jj = 0; jj < 2; ++jj) { wreg[mbl][jj][0] = *(const LAS f32x4*)(wlb + (4 * mbl + jj) * 8); wreg[mbl][jj][1] = *(const LAS f32x4*)(wlb + (4 * mbl + jj) * 8 + 4); } }
    auto tile = [&](const f16x8 (&BX)[4], int kt, const bool chk) __attribute__((always_inline)) {
        const int skey = kt * 32 + l31;
        f32x16 acc[2];
#pragma unroll
        for (int mbl = 0; mbl < 2; ++mbl) {
#pragma unroll
            for (int i = 0; i < 16; ++i) acc[mbl][i] = 0.f;
#pragma unroll
            for (int s = 0; s < 4; ++s) acc[mbl] = __builtin_amdgcn_mfma_f32_32x32x16_f16(A[mbl][s], BX[s], acc[mbl], 0, 0, 0); }
#pragma unroll
        for (int mbl = 0; mbl < 2; ++mbl)
#pragma unroll
            for (int jj = 0; jj < 2; ++jj) { const int ql = 8 * mbp + 4 * mbl + 2 * hh + jj;
                const f32x4 wa = KIND == 1 ? wreg[mbl][jj][0] : *(const LAS f32x4*)(wlb + (4 * mbl + jj) * 8), wb = KIND == 1 ? wreg[mbl][jj][1] : *(const LAS f32x4*)(wlb + (4 * mbl + jj) * 8 + 4);
                const float sc = jj == 0 ? idx_score<0>(acc[mbl], wa, wb) : idx_score<8>(acc[mbl], wa, wb);
                if (KIND == 0) { const bool caus = !chk || skey <= t0 + ql;
                    const unsigned key = fkey(sc), d = key - lo[mbl][jj]; if (caus && d <= rmax[mbl][jj]) { const unsigned bin = d >> sh[mbl][jj]; lds_add(hist + ql * 1024 + (bin >> 1), 1u << (16 * (bin & 1u))); } }
                else {
                    const unsigned long long bal = __ballot(sc >= lofv[mbl][jj]);
                    const unsigned blo = (unsigned)bal, bhi = (unsigned)(bal >> 32), nlo = (unsigned)__builtin_popcount(blo), nhi = (unsigned)__builtin_popcount(bhi);
                    const unsigned cpk = ccn[mbl][jj] - (nlo << 16);
                    const int base = __builtin_amdgcn_sbfe((int)cpk, 16 * hh, 16);
                    unsigned pos = __builtin_amdgcn_mbcnt_hi(bhi, __builtin_amdgcn_mbcnt_lo(blo, (unsigned)base)); pos = pos < 255u ? pos : 255u;
                    { const unsigned a4 = cbase4 + (4 * mbl + jj) * 4096 + pos * 4, a2 = cbase2 + (4 * mbl + jj) * 2048 + pos * 2; unsigned long long sv;
                      asm volatile("s_and_saveexec_b64 %0, %1\n\tds_write_b32 %2, %3\n\tds_write_b16 %4, %5\n\ts_mov_b64 exec, %0" : "=&s"(sv) : "s"(bal), "v"(a4), "v"(sc), "v"(a2), "v"(skey) : "memory"); }
                    ccn[mbl][jj] += nlo + (nhi << 16); } }
    };
    int kt = ph; const int last = ntiles - 1;
    if (KIND == 0) {
        for (; kt < ntiles; kt += 4) { thr_loadB(B0, KI, kt); tile(B0, kt, true); }
        return; }
    thr_loadB(B0, KI, kt);
#define TH_LASTTHR() do { if (kt == last) { asm volatile("" ::: "memory");   _Pragma("unroll") for (int a = 0; a < 2; ++a) { _Pragma("unroll") for (int c = 0; c < 2; ++c) lofv[a][c] = lofc[a][c]; } } } while (0)
    for (;;) {
        thr_loadB(B1, KI, kt + 4 < last ? kt + 4 : last); TH_LASTTHR(); tile(B0, kt, kt == last); kt += 4; if (kt >= ntiles) break;
        thr_loadB(B0, KI, kt + 4 < last ? kt + 4 : last); TH_LASTTHR(); tile(B1, kt, kt == last); kt += 4; if (kt >= ntiles) break;
    }
#undef TH_LASTTHR
    if (KIND == 1) {
#pragma unroll
        for (int mbl = 0; mbl < 2; ++mbl)
#pragma unroll
            for (int jj = 0; jj < 2; ++jj) {
                if (l31 == 0) st[ST_SCNT + (8 * mbp + 4 * mbl + 2 * hh + jj) * 4 + ph] = (ccn[mbl][jj] >> (16 * hh)) & 0xffffu; } }
}
__device__ __forceinline__ void thr_write_masks(const Params& p, LAS unsigned char* lds, int b, int t0, int ntw) {
    const int tidw = opq(threadIdx.x);
    const LAS unsigned* maskb = (const LAS unsigned*)(lds + TH_MASK); const int q = tidw & 15;
    unsigned* dst = (unsigned*)(p.ws + WS_SELM) + ((size_t)(b * 128 + (t0 >> 6)) * 256) * 64 + (t0 & 63) + q;
    for (int kt = tidw >> 4; kt < ntw; kt += 32) dst[(size_t)kt * 64] = maskb[q * 256 + kt];
}
struct ThrOps { f16x8 A[2][4]; float wl; };
__device__ __forceinline__ void thr_load(const Params& p, ThrOps& o, int b, int qb, int wave) {
    const int tid = opq(threadIdx.x), lane = tid & 63, hh = lane >> 5, l31 = lane & 31, t0 = qb * 16, mbp = wave & 1;
    const u16* P16 = (const u16*)(p.ws + WS_PROJ); const int slot = idx_row_slot(l31), head = idx_row_head(l31);
#pragma unroll
    for (int mbl = 0; mbl < 2; ++mbl) { const u16* qr = P16 + (size_t)(b * L + t0 + 8 * mbp + 4 * mbl + slot) * PJ + CQI + head * 64 + 8 * hh;
#pragma unroll
        for (int s = 0; s < 4; ++s) o.A[mbl][s] = *(const f16x8*)(qr + 16 * s); }
    o.wl = ((const float*)(p.ws + WS_WIDX))[(size_t)(b * L + t0) * 8 + (tid & 127)];
}
#define TH_SYNC() do { asm volatile("s_waitcnt lgkmcnt(0)" ::: "memory"); __builtin_amdgcn_s_barrier(); asm volatile("" ::: "memory"); } while (0)
__device__ __forceinline__ void thr_item(const Params& p, LAS unsigned char* lds, const ThrOps& ops, int b, int qb, int wave, int lane) {
    int tid = opq(threadIdx.x); lane = tid & 63; int hh = lane >> 5, l31 = lane & 31; const int t0 = qb * 16;
#define TH_FRESH() do { tid = opq(tid); lane = tid & 63; hh = lane >> 5; l31 = lane & 31; } while (0)
    LAS unsigned* hist = (LAS unsigned*)(lds + TH_HIST); LAS unsigned* cand = (LAS unsigned*)(lds + TH_CAND); LAS unsigned* st = (LAS unsigned*)(lds + TH_ST);
    LAS unsigned* maskb = (LAS unsigned*)(lds + TH_MASK);
    const int ntw = 2 * (qb >> 2) + 2;
    if (tid < 16) { const int n = t0 + tid + 1;
        if (n <= 256) { st[ST_MODE + tid] = 2u; st[ST_THR + tid] = 0u; }
        else { st[ST_MODE + tid] = 0u; st[ST_LO + tid] = 0u; st[ST_RMAX + tid] = 0xffffffffu; st[ST_SH + tid] = 21u; st[ST_NEED + tid] = 256u; }
        st[ST_SAMP + tid] = 0u; }
    if (tid == 0) st[ST_DIRTY] = 0u;
    if (tid < 128) ((LAS float*)(st + ST_WL))[tid] = ops.wl;
    TH_SYNC();
    if (t0 + 16 <= 256) {
        for (int i = tid; i < 16 * 256; i += NT) { const int q = i >> 8, kt = i & 255, d = t0 + q - kt * 32; maskb[i] = d < 0 ? 0u : (d >= 31 ? 0xffffffffu : (2u << d) - 1u); }
        TH_SYNC(); thr_write_masks(p, lds, b, t0, ntw); TH_SYNC(); return; }
    const u16* P16 = (const u16*)(p.ws + WS_PROJ); const u16* KI = (const u16*)(p.ws + WS_KIDX) + (size_t)b * L * 64 + lane * 8;
    const int mbp = wave & 1, ph = wave >> 1;
    const f16x8 (&A)[2][4] = ops.A;
    const int ntiles = (t0 + 15) / 32 + 1;
    const int sd = ntiles >= 128 ? 16 : (ntiles >= 64 ? 8 : (ntiles >= 32 ? 4 : (ntiles >= 16 ? 2 : 1))), soff = sd == 16 ? 7 : (sd == 8 ? 3 : (sd == 4 ? 2 : 0)), mg = sd == 16 ? 17 : (sd == 8 ? 22 : (sd == 4 ? 30 : 35));
    const int ms = ntiles / sd;
    {
        { const LAS float* wlb = (const LAS float*)(st + ST_WL) + (8 * mbp + 2 * hh) * 8; asm volatile("" : "+v"(wlb));
          f16x8 Bs0[4], Bs1[4];
          auto stile = [&](const f16x8 (&Bs)[4], int j) __attribute__((always_inline)) { const int kt = sd * j + soff;
            f32x16 acc[2];
#pragma unroll
            for (int mbl = 0; mbl < 2; ++mbl) {
#pragma unroll
                for (int i = 0; i < 16; ++i) acc[mbl][i] = 0.f;
#pragma unroll
                for (int s = 0; s < 4; ++s) acc[mbl] = __builtin_amdgcn_mfma_f32_32x32x16_f16(A[mbl][s], Bs[s], acc[mbl], 0, 0, 0); }
#pragma unroll
            for (int mbl = 0; mbl < 2; ++mbl)
#pragma unroll
                for (int jj = 0; jj < 2; ++jj) { const int ql = 8 * mbp + 4 * mbl + 2 * hh + jj;
                    const f32x4 wa = *(const LAS f32x4*)(wlb + (4 * mbl + jj) * 8), wb = *(const LAS f32x4*)(wlb + (4 * mbl + jj) * 8 + 4);
                    const float sc = jj == 0 ? idx_score<0>(acc[mbl], wa, wb) : idx_score<8>(acc[mbl], wa, wb);
                    const bool caus = kt * 32 + l31 <= t0 + ql;
                    cand[ql * 1024 + j * 32 + l31] = caus ? __builtin_bit_cast(unsigned, sc) : 0xff800000u; }
          };
          if (ph < ms) { int j = ph; const int jl = ms - 1;
            thr_loadB(Bs0, KI, sd * j + soff);
            for (;;) {
                thr_loadB(Bs1, KI, sd * (j + 4 < jl ? j + 4 : jl) + soff); stile(Bs0, j); j += 4; if (j >= ms) break;
                thr_loadB(Bs0, KI, sd * (j + 4 < jl ? j + 4 : jl) + soff); stile(Bs1, j); j += 4; if (j >= ms) break;
            } } }
        TH_FRESH();
        if (sd == 1) { u32x4 z = {0u, 0u, 0u, 0u};
#pragma unroll
            for (int i = 0; i < 2; ++i) *(LAS u32x4*)(lds + TH_MASK + (tid + NT * i) * 16) = z; }
        TH_SYNC();
        const unsigned m = (unsigned)(ms * 32); const int qa = 2 * wave, qb2 = 2 * wave + 1;
        const unsigned s0 = m < 256u ? m : 256u, s1 = m < 256u ? 0u : (m < 512u ? m - 256u : 256u), s2 = m < 512u ? 0u : (m < 768u ? m - 512u : 256u), s3 = m < 768u ? 0u : m - 768u;
        if (sd == 1) {
            const LAS unsigned* const cq[2] = {cand + qa * 1024, cand + qb2 * 1024}; const unsigned sc[2][4] = {{s0, s1, s2, s3}, {s0, s1, s2, s3}}; const unsigned kk[2] = {256u, 256u};
            LAS unsigned* const hq[2] = {(LAS unsigned*)(lds + TH_SCR) + qa * 256, (LAS unsigned*)(lds + TH_SCR) + qb2 * 256}; const int rp0[2] = {0, 0}; const unsigned pre[2] = {0u, 0u}; unsigned res[2];
            wave_select<4, 2>(cq, sc, kk, hq, lane, rp0, pre, res);
#pragma unroll
            for (int c = 0; c < 2; ++c) { const int q = 2 * wave + c;
                for (int k2 = 0; 2 * k2 < ntiles; ++k2) { const int ki = k2 * 64 + lane; const bool sel = ki < (int)m && ki <= t0 + q && fkey(__builtin_bit_cast(float, cand[q * 1024 + ki])) >= res[c];
                    const unsigned long long bal = __ballot(sel); if (lane == 0) { maskb[q * 256 + 2 * k2] = (unsigned)bal; maskb[q * 256 + 2 * k2 + 1] = (unsigned)(bal >> 32); } }
                if (lane == 0) { st[ST_THR + q] = res[c]; st[ST_MODE + q] = 2u; } }
        } else {
          const float ra = 256.f * (float)m / (float)(t0 + qa + 1), rb = 256.f * (float)m / (float)(t0 + qb2 + 1);
          const int rloa = (int)ra + mg + 1, rlob = (int)rb + mg + 1;
          const LAS unsigned* const cq[2] = {cand + qa * 1024, cand + qb2 * 1024};
          const unsigned sc[2][4] = {{s0, s1, s2, s3}, {s0, s1, s2, s3}};
          const unsigned kk[2] = {(unsigned)(rloa <= (int)m ? rloa : (int)m), (unsigned)(rlob <= (int)m ? rlob : (int)m)};
          LAS unsigned* const hq[2] = {hist + (wave * 2 + 0) * 256, hist + (wave * 2 + 1) * 256};
          const int rp0[2] = {0, 0}; const unsigned pre[2] = {0u, 0u}; unsigned res[2];
          wave_select<2, 2>(cq, sc, kk, hq, lane, rp0, pre, res);
          if (lane == 0) {
              const unsigned loka = rloa <= (int)m ? res[0] : 0u, lokb = rlob <= (int)m ? res[1] : 0u;
              st[ST_MODE + qa] = 1u; st[ST_SAMP + qa] = 1u; st[ST_LO + qa] = loka; st[ST_RMAX + qa] = 0xffffffffu - loka;
              st[ST_MODE + qb2] = 1u; st[ST_SAMP + qb2] = 1u; st[ST_LO + qb2] = lokb; st[ST_RMAX + qb2] = 0xffffffffu - lokb; } }
        TH_SYNC();
    }
    bool clean = true, finalpass = false;
    for (int pass = 0; pass < 10 && sd != 1; ++pass) {
        TH_FRESH();
        { u32x4 z = {0u, 0u, 0u, 0u};
#pragma unroll
          for (int i = 0; i < 8; ++i) *(LAS u32x4*)(lds + TH_HIST + (tid + NT * i) * 16) = z;
          if (tid < 16) { st[ST_CCNT + tid] = 0u;
              if (finalpass) { const unsigned tk = st[ST_THR + tid]; st[ST_LO + tid] = tk; st[ST_RMAX + tid] = 0xffffffffu - tk; st[ST_MODE + tid] = 3u; } } }
        TH_SYNC();
        int kind; { const LAS u32x4* mv = (const LAS u32x4*)(st + ST_MODE); const u32x4 m0 = mv[0], m1 = mv[1], m2 = mv[2], m3 = mv[3];
            const unsigned w[16] = {m0.x, m0.y, m0.z, m0.w, m1.x, m1.y, m1.z, m1.w, m2.x, m2.y, m2.z, m2.w, m3.x, m3.y, m3.z, m3.w}; unsigned anyh = 0u;
#pragma unroll
            for (int q = 0; q < 16; ++q) anyh |= (w[q] == 0u) ? 1u : 0u;
            kind = __builtin_amdgcn_readfirstlane((int)anyh) ? 0 : 1; }
        const bool mpass = clean && pass == 0 && kind == 1;
        if (!mpass) clean = false;
        if (kind == 0) thr_sweep<0>(lds, A, KI, t0, ntiles, wave, lane); else thr_sweep<1>(lds, A, KI, t0, ntiles, wave, lane);
        TH_FRESH();
        TH_SYNC();
        if (finalpass) {
            for (int c = 0; c < 2; ++c) { const int q = 2 * wave + c; const LAS u16* ci = (const LAS u16*)(lds + TH_CIDX) + q * 1024;
#pragma unroll
                for (int sl = 0; sl < 4; ++sl) { const unsigned n = st[ST_SCNT + q * 4 + sl] < 256u ? st[ST_SCNT + q * 4 + sl] : 256u;
                    for (unsigned idx = lane; idx < n; idx += 64) { const unsigned ki = ci[256 * sl + idx];
                        __hip_atomic_fetch_or(maskb + q * 256 + (ki >> 5), 1u << (ki & 31u), __ATOMIC_RELAXED, __HIP_MEMORY_SCOPE_WORKGROUP); } } }
            break; }
        if (kind == 0) {
            for (int qq = 0; qq < 2; ++qq) { const int q = 2 * wave + qq;
                if (st[ST_MODE + q] != 0u) continue;
                const unsigned need = st[ST_NEED + q], shq = st[ST_SH + q], loq = st[ST_LO + q];
                LAS unsigned* hq = hist + q * 1024 + 16 * lane; unsigned c = 0u;
#pragma unroll
                for (int i = 0; i < 16; ++i) { const unsigned w = hq[i]; c += (w & 0xffffu) + (w >> 16); }
                const unsigned incl = wave_suffix_sum(c, lane), above = incl - c;
                if (above < need && need <= incl) {
                    unsigned cum = above, bsel = 0u, bcnt = 0u;
                    for (int i = 31; i >= 0; --i) { const unsigned w = hq[i >> 1], cnt = (i & 1) ? (w >> 16) : (w & 0xffffu); if (cum + cnt >= need) { bsel = (unsigned)(32 * lane + i); bcnt = cnt; break; } cum += cnt; }
                    const unsigned need2 = need - cum, newlo = loq + (bsel << shq);
                    if (bcnt == need2 || shq == 0u) { st[ST_THR + q] = newlo; st[ST_MODE + q] = 2u; st[ST_LO + q] = 0xffffffffu; st[ST_RMAX + q] = 0u; }
                    else { st[ST_LO + q] = newlo; st[ST_RMAX + q] = (1u << shq) - 1u; st[ST_NEED + q] = need2;
                        st[ST_SH + q] = shq > 11u ? shq - 11u : 0u; }
                } }
        } else {
            const LAS unsigned* cq[2]; unsigned sc[2][4], kk[2], pre[2], res[2]; LAS unsigned* hq[2]; int rp0[2]; bool act[2], good[2];
#pragma unroll
            for (int c = 0; c < 2; ++c) { const int q = 2 * wave + c; act[c] = st[ST_MODE + q] == 1u;
#pragma unroll
                for (int sl = 0; sl < 4; ++sl) sc[c][sl] = st[ST_SCNT + q * 4 + sl];
                const unsigned cnt = sc[c][0] + sc[c][1] + sc[c][2] + sc[c][3]; kk[c] = st[ST_NEED + q]; good[c] = sc[c][0] <= 256u && sc[c][1] <= 256u && sc[c][2] <= 256u && sc[c][3] <= 256u;
                good[c] = good[c] && kk[c] <= cnt;
                const unsigned loq = st[ST_LO + q], hiq = loq + st[ST_RMAX + q]; rp0[c] = (loq >> 24) != (hiq >> 24) ? 0 : ((loq >> 16) != (hiq >> 16) ? 1 : 2);
                pre[c] = rp0[c] == 0 ? 0u : (rp0[c] == 1 ? (loq & 0xff000000u) : (loq & 0xffff0000u));
                cq[c] = cand + q * 1024; hq[c] = (LAS unsigned*)(lds + TH_SCR) + q * 256;
                if (!(act[c] && good[c])) { sc[c][0] = 0u; sc[c][1] = 0u; sc[c][2] = 0u; sc[c][3] = 0u; kk[c] = 1u; rp0[c] = 4; } }
            wave_select<4, 2>(cq, sc, kk, hq, lane, rp0, pre, res);
#pragma unroll
            for (int c = 0; c < 2; ++c) { const int q = 2 * wave + c;
                if (!act[c]) continue;
                if (good[c]) { const unsigned key = res[c];
                    if (mpass) {
                        const LAS u16* ci = (const LAS u16*)(lds + TH_CIDX) + q * 1024;
#pragma unroll
                        for (int sl = 0; sl < 4; ++sl)
#pragma unroll
                            for (int i = 0; i < 4; ++i) { const unsigned idx = lane + 64 * i; if (idx < sc[c][sl] && fkey(__builtin_bit_cast(float, cand[q * 1024 + 256 * sl + idx])) >= key) { const unsigned ki = ci[256 * sl + idx];
                                __hip_atomic_fetch_or(maskb + q * 256 + (ki >> 5), 1u << (ki & 31u), __ATOMIC_RELAXED, __HIP_MEMORY_SCOPE_WORKGROUP); } } }
                    if (lane == 0) { st[ST_THR + q] = key; st[ST_MODE + q] = 2u; st[ST_LO + q] = 0xffffffffu; st[ST_RMAX + q] = 0u; } }
                else if (lane == 0) { st[ST_DIRTY] = 1u; st[ST_MODE + q] = 0u; st[ST_SAMP + q] = 0u; st[ST_LO + q] = 0u; st[ST_RMAX + q] = 0xffffffffu; st[ST_SH + q] = 21u; st[ST_NEED + q] = 256u; }
            }
        }
        TH_SYNC();
        bool alldone; { const LAS u32x4* mv = (const LAS u32x4*)(st + ST_MODE); const u32x4 m0 = mv[0], m1 = mv[1], m2 = mv[2], m3 = mv[3];
            const unsigned w[16] = {m0.x, m0.y, m0.z, m0.w, m1.x, m1.y, m1.z, m1.w, m2.x, m2.y, m2.z, m2.w, m3.x, m3.y, m3.z, m3.w}; unsigned nd = 0u;
#pragma unroll
            for (int q = 0; q < 16; ++q) nd |= (w[q] != 2u) ? 1u : 0u;
            alldone = __builtin_amdgcn_readfirstlane((int)nd) == 0; }
        if (alldone) { if (clean && st[ST_DIRTY] == 0u) break; finalpass = true; }
    }
    TH_SYNC();
    thr_write_masks(p, lds, b, t0, ntw);
    TH_SYNC();
#undef TH_FRESH
}
}
namespace mk {
constexpr int AT_MASKR = 0, AT_SSQ = 2560, AT_G = 8192, AT_KVB = 16384, AT_OST = 16384;
#define AT_DMA(gp, lp) __builtin_amdgcn_global_load_lds((const unsigned*)(gp), (LAS unsigned*)(lp), 16, 0, 0)
#define AT_DMAO(gp, lp, off) __builtin_amdgcn_global_load_lds((const unsigned*)(gp), (LAS unsigned*)(lp), 16, off, 0)
#define AT_DMA4(gp, lp) __builtin_amdgcn_global_load_lds((const unsigned*)(gp), (LAS unsigned*)(lp), 4, 0, 0)
__device__ __forceinline__ void att_item(const Params& p, LAS unsigned char* lds, int b, int qblk, int wave, int lane) {
    const int q0 = qblk * 128, g = wave >> 1, h2 = wave & 1, hh = lane >> 5, l31 = lane & 31;
    LAS unsigned* maskr = (LAS unsigned*)(lds + AT_MASKR); LAS float* ssq = (LAS float*)(lds + AT_SSQ);
    LAS float* atg = (LAS float*)(lds + AT_G); atg[threadIdx.x] = p.att_g[threadIdx.x];
    const u16* P16 = (const u16*)(p.ws + WS_PROJ);
    const unsigned* SM = (const unsigned*)(p.ws + WS_SELM) + (size_t)(b * 128 + 2 * qblk + (wave & 1)) * 256 * 64 + lane;
    const int ntiles = 4 * qblk + 4, glast = q0 + 32 * g + 31;
    const float csc = 0.08838834764831845f * 1.4426950408889634f;
    LAS unsigned char* ostw = lds + AT_OST + wave * 8704;
    u16* cbase = (u16*)(p.ws + WS_CAT) + (size_t)(b * L + q0 + 32 * g) * D;
    for (int sp = 0; sp < 2; ++sp) {
        const int h = 2 * sp + h2;
        const unsigned char* KF = (const unsigned char*)(p.ws + WS_KF) + (size_t)(b * 4 + 2 * sp + (wave & 1)) * 256 * 8192 + (size_t)(2 * (wave >> 1)) * 1024 + lane * 16;
        const unsigned char* VF = (const unsigned char*)(p.ws + WS_VT) + (size_t)(b * 4 + 2 * sp + (wave & 1)) * 256 * 8192 + (size_t)(2 * (wave >> 1)) * 1024 + lane * 16;
        const int dofs = (wave & 1) * 8192 + 2 * (wave >> 1) * 1024;
        if (wave < 2) { AT_DMA4(SM, lds + AT_MASKR + wave * 256); AT_DMA4(SM + 64, lds + AT_MASKR + 512 + wave * 256); }
#pragma unroll
        for (int i = 0; i < 2; ++i) { AT_DMA(KF + i * 1024, lds + AT_KVB + dofs + i * 1024); AT_DMA(VF + i * 1024, lds + AT_KVB + 16384 + dofs + i * 1024); }
        f16x8 Qf[8];
        { const u16* qa = P16 + (size_t)(b * L + q0 + 32 * g + l31) * PJ + CQ + h * 128 + 8 * hh;
#pragma unroll
          for (int s = 0; s < 8; ++s) Qf[s] = *(const f16x8*)(qa + 16 * s); }
#pragma unroll
        for (int s = 0; s < 8; ++s) Qf[s] = Qf[s] * (_Float16)csc;
        f32x16 O[4];
#pragma unroll
        for (int d = 0; d < 4; ++d)
#pragma unroll
            for (int i = 0; i < 16; ++i) O[d][i] = 0.f;
        const unsigned char* kfp = KF; const unsigned char* vfp = VF; const unsigned* smp = SM + 64;
        float mrun = 0.f, lsum = 0.f;
        f32x16 negm;
#pragma unroll
        for (int i = 0; i < 16; ++i) negm[i] = 0.f;
        for (int kt = 0; kt < ntiles; ++kt) {
            asm volatile("s_waitcnt vmcnt(0)" ::: "memory");
            __syncthreads();
            const bool act = kt * 32 <= glast;
            const LAS f16x8* kb = (const LAS f16x8*)(lds + AT_KVB + (kt & 1) * 32768 + h2 * 8192) + lane;
            f16x8 kf[8];
            if (act) {
#pragma unroll
                for (int s = 0; s < 8; ++s) kf[s] = kb[s * 64]; }
            kfp += 8192; vfp += 8192; smp += 64;
            asm volatile("" : "+v"(kfp), "+v"(vfp), "+v"(smp));
            if (kt + 1 < ntiles) { const int bo = AT_KVB + ((kt + 1) & 1) * 32768 + dofs;
                AT_DMAO(kfp, lds + bo, 0); AT_DMAO(kfp, lds + bo, 1024); AT_DMAO(vfp, lds + bo + 16384, 0); AT_DMAO(vfp, lds + bo + 16384, 1024); }
            if (kt + 2 < ntiles && wave < 2) AT_DMA4(smp, lds + AT_MASKR + ((kt + 2) & 3) * 512 + wave * 256);
            if (act) {
                f32x16 S = negm;
#pragma unroll
                for (int s = 0; s < 8; ++s) S = __builtin_amdgcn_mfma_f32_32x32x16_f16(kf[s], Qf[s], S, 0, 0, 0);

                const unsigned bits = maskr[(kt & 3) * 128 + 32 * g + l31] >> (4 * hh);
                f16x8 vf[8];
                const unsigned av = (unsigned)(__UINTPTR_TYPE__)(lds + AT_KVB + (kt & 1) * 32768 + 16384 + h2 * 8192) + lane * 16;
#define AT_RD(dst, off, dep) asm volatile("ds_read_b128 %0, %1 offset:" #off : "=v"(dst) : "v"(av), "v"(dep))
                AT_RD(vf[0], 0, bits); AT_RD(vf[2], 2048, bits); AT_RD(vf[4], 4096, bits); AT_RD(vf[6], 6144, bits);
                int mxi = 0;
#pragma unroll
                for (int i = 0; i < 16; ++i) { const unsigned mk = (unsigned)__builtin_amdgcn_sbfe((int)bits, (i & 3) + 8 * (i >> 2), 1); const float si = S[i];
                    S[i] = __builtin_bit_cast(float, (__builtin_bit_cast(unsigned, si) & mk) | (0xff61b1e6u & ~mk)); }
#pragma unroll
                for (int i = 0; i < 16; i += 2) { const float a = S[i], c = S[i + 1]; const int ai = __builtin_bit_cast(int, a), ci = __builtin_bit_cast(int, c); const int t = mxi > ai ? mxi : ai; mxi = t > ci ? t : ci; }
                { const auto r = __builtin_amdgcn_permlane32_swap((unsigned)mxi, (unsigned)mxi, false, false); const int r0 = (int)r[0], r1 = (int)r[1]; mxi = r0 > r1 ? r0 : r1; }
                const float mx = __builtin_bit_cast(float, mxi);
                if (__ballot(mx > 8.f)) { const float dlt = mx > 8.f ? mx : 0.f, alpha = __builtin_amdgcn_exp2f(-dlt);
                    mrun += dlt; lsum *= alpha;
#pragma unroll
                    for (int d = 0; d < 4; ++d)
#pragma unroll
                        for (int i = 0; i < 16; ++i) O[d][i] *= alpha;
#pragma unroll
                    for (int i = 0; i < 16; ++i) { S[i] -= dlt; negm[i] = -mrun; } }
                float ps = 0.f; f16x8 pf[2];
#pragma unroll
                for (int i = 0; i < 16; ++i) { const float pe = __builtin_amdgcn_exp2f(S[i]); ps += pe; pf[i >> 3][i & 7] = (_Float16)pe; }
                lsum += ps;
                asm volatile("s_waitcnt lgkmcnt(0)" : "+v"(vf[0]), "+v"(vf[2]), "+v"(vf[4]), "+v"(vf[6]));
                AT_RD(vf[1], 1024, vf[0]); AT_RD(vf[3], 3072, vf[0]); AT_RD(vf[5], 5120, vf[0]); AT_RD(vf[7], 7168, vf[0]);
#undef AT_RD
#pragma unroll
                for (int d = 0; d < 4; ++d) O[d] = __builtin_amdgcn_mfma_f32_32x32x16_f16(vf[d * 2], pf[0], O[d], 0, 0, 0);
                asm volatile("s_waitcnt lgkmcnt(0)" : "+v"(vf[1]), "+v"(vf[3]), "+v"(vf[5]), "+v"(vf[7]));
#pragma unroll
                for (int d = 0; d < 4; ++d) O[d] = __builtin_amdgcn_mfma_f32_32x32x16_f16(vf[d * 2 + 1], pf[1], O[d], 0, 0, 0);
            }
        }
        int lane2 = lane; asm volatile("" : "+v"(lane2)); const int l31b = lane2 & 31, hhb = lane2 >> 5;
        const float ltot = lsum + __shfl_xor(lsum, 32), inv = 1.f / ltot;
        float part = 0.f;
#pragma unroll
        for (int d = 0; d < 4; ++d)
#pragma unroll
            for (int i = 0; i < 16; ++i) { O[d][i] *= inv; part += O[d][i] * O[d][i]; }
        part += __shfl_xor(part, 32);
        if (lane2 < 32) ssq[h * 128 + 32 * g + lane2] = part;
        __syncthreads();
        const int qi = 32 * g + l31b;
        const float rstd = sp == 0 ? 1.f : rsqrtf((ssq[qi] + ssq[128 + qi] + ssq[256 + qi] + ssq[384 + qi]) * (1.f / 512.f) + EPS);
#pragma unroll
        for (int d = 0; d < 4; ++d)
#pragma unroll
            for (int ip = 0; ip < 8; ++ip) { const int i = 2 * ip, dv = d * 32 + (i & 3) + 8 * (i >> 2) + 4 * hhb;
                const f32x2 gp = *(const LAS f32x2*)(atg + h * 128 + dv); const float g0 = sp == 0 ? 1.f : gp.x, g1 = sp == 0 ? 1.f : gp.y;
                *(LAS unsigned*)(ostw + l31b * 272 + dv * 2) = pkh(O[d][i] * rstd * g0, O[d][i + 1] * rstd * g1); }
        LDS_WAIT(); asm volatile("" ::: "memory");
#pragma unroll
        for (int i = 0; i < 8; ++i) { const int idx = i * 64 + lane2, row = idx >> 4, ch = idx & 15;
            const u32x4 v = *(const LAS u32x4*)(ostw + row * 272 + ch * 16); *(u32x4*)(cbase + (size_t)row * D + h * 128 + ch * 8) = v; }
        if (sp == 0) __syncthreads();
    }
    {
            int lane2 = lane; asm volatile("" : "+v"(lane2));
            asm volatile("s_waitcnt vmcnt(0)" ::: "memory");
#pragma unroll
            for (int i = 0; i < 8; ++i) { const int idx = i * 64 + lane2, row = idx >> 4, ch = idx & 15;
                u16* ptr = cbase + (size_t)row * D + h2 * 128 + ch * 8; const u32x4 v = *(const u32x4*)ptr; const int qr = 32 * g + row;
                const float rs = rsqrtf((ssq[qr] + ssq[128 + qr] + ssq[256 + qr] + ssq[384 + qr]) * (1.f / 512.f) + EPS);
                const unsigned wv[4] = {v.x, v.y, v.z, v.w}; unsigned ov[4];
#pragma unroll
                for (int e = 0; e < 4; ++e) { const int dv = ch * 8 + 2 * e; const f32x2 gp = *(const LAS f32x2*)(atg + h2 * 128 + dv); ov[e] = pkh(hlo(wv[e]) * rs * gp.x, hhi(wv[e]) * rs * gp.y); }
                u32x4 o; o.x = ov[0]; o.y = ov[1]; o.z = ov[2]; o.w = ov[3]; *(u32x4*)ptr = o; } }
    __syncthreads();
}

__device__ __forceinline__ void phase_p3(const Params& p, LAS unsigned char* lds, int wave, int lane) {
    const int G = gridDim.x, bx = blockIdx.x;
    { LAS unsigned char* scr = lds + wave * 8704; const int gw = bx * NWAVES + wave, NGW = G * NWAVES;
      for (int it = gw; it < NB * 4 * (L / 32); it += NGW) vt_item(p, scr, it, lane); }
    __syncthreads();
    for (int it = bx; it < NB * 4 * NCH; it += G) gla1_item(p, lds, it, wave, lane);
    {
    if (G == 256) { const int bt = bx & 7, j = bx >> 3;
        ThrOps cur; thr_load(p, cur, bt, j, wave);
        for (int r = 0; r < 16; ++r) { const int qb = (r & 1) ? 511 - (32 * (r >> 1) + j) : 32 * (r >> 1) + j; const int rn = r < 15 ? r + 1 : r, qbn = (rn & 1) ? 511 - (32 * (rn >> 1) + j) : 32 * (rn >> 1) + j;
            ThrOps nxt; thr_load(p, nxt, bt, qbn, wave);
            thr_item(p, lds, cur, bt, qb, wave, lane); cur = nxt; } }
    else { for (int it = bx; it < NB * 512; it += G) { ThrOps cur; thr_load(p, cur, it >> 9, it & 511, wave); thr_item(p, lds, cur, it >> 9, it & 511, wave, lane); } } }
}
__device__ __forceinline__ void phase_p5(const Params& p, LAS unsigned char* lds, int wave, int lane) {
    const int G = gridDim.x, bx = blockIdx.x;
    if (G == 256) { const int bt = bx & 7, j = bx >> 3;
        for (int r = 0; r < 2; ++r) att_item(p, lds, bt, r == 0 ? 63 - j : j, wave, lane); }
    else { for (int it = bx; it < NB * 64; it += G) att_item(p, lds, it >> 6, it & 63, wave, lane); }
    { const int N = NB * 4 * NCH; G3Ops cur; if (bx < N) gla3_load(p, cur, bx, wave, lane);
      for (int it = bx; it < N; it += G) { G3Ops nxt; gla3_load(p, nxt, it + G < N ? it + G : it, wave, lane);
          gla3_item(p, lds, cur, it, wave, lane); cur = nxt; }
      __syncthreads(); }
}
}
namespace mk {
#define XB_TMO      128
#define XB_XCNT(j)  (256  + 64 * (j))
#define XB_XSUB(j)  (1280 + 64 * (j))
#define XB_XGEN(j)  (2304 + 64 * (j))
#define XB_TOP      3328
#define XB_TOPGEN   3392
#define XCD_BAR_WORDS 3456
#define XB_SPIN_CAP (1u << 18)

__device__ __forceinline__ unsigned xb_ld(unsigned* p)              { return __hip_atomic_load(p, __ATOMIC_RELAXED, __HIP_MEMORY_SCOPE_AGENT); }
__device__ __forceinline__ unsigned xb_add(unsigned* p, unsigned v) { return __hip_atomic_fetch_add(p, v, __ATOMIC_RELAXED, __HIP_MEMORY_SCOPE_AGENT); }
__device__ __forceinline__ unsigned xb_xcc_id() { return (unsigned)__builtin_amdgcn_s_getreg((3 << 11) | 20) & 0xFu; }
#define XB_SPIN(cond, bar) do { unsigned _sp = 0; while (cond) { __builtin_amdgcn_s_sleep(1); \
    if ((++_sp & 255u) == 0u) { if (xb_ld(&(bar)[XB_TMO])) break; if (_sp > XB_SPIN_CAP) { atomicAdd(&(bar)[XB_TMO], 1u); break; } } } } while (0)

struct XcdBarrier {
    unsigned* bar; unsigned x;
    volatile LAS unsigned* st;
};

__device__ __forceinline__ XcdBarrier xcd_barrier_post(unsigned* bar, volatile LAS unsigned* st) {
    XcdBarrier b; b.bar = bar; b.x = xb_xcc_id(); b.st = st;
    if (threadIdx.x == 0) (void)xb_add(&bar[XB_XCNT(b.x)], 1u);
    return b;
}
__device__ __forceinline__ void xcd_barrier_complete(unsigned* bar, unsigned x, unsigned& nloc, unsigned& nx) {
    const unsigned G = gridDim.x * gridDim.y * gridDim.z;
    unsigned sum, cnt, mine, sp = 0u;
    for (;;) {
        sum = 0u; cnt = 0u; mine = 0u;
#pragma unroll
        for (unsigned j = 0; j < 16; ++j) { const unsigned c = xb_ld(&bar[XB_XCNT(j)]); sum += c; cnt += (c > 0u) ? 1u : 0u; mine = (j == x) ? c : mine; }
        if (sum == G) break;
        __builtin_amdgcn_s_sleep(1);
        if ((++sp & 255u) == 0u) { if (xb_ld(&bar[XB_TMO])) break; if (sp > XB_SPIN_CAP) { atomicAdd(&bar[XB_TMO], 1u); break; } }
    }
    nloc = mine > 0u ? mine : 1u; nx = cnt > 0u ? cnt : 1u;
}

__device__ __forceinline__ void xcd_barrier(const XcdBarrier& b) {
    asm volatile("s_waitcnt vmcnt(0)" ::: "memory");
    __syncthreads();
    if (threadIdx.x == 0) {
        unsigned* bar = b.bar;
        __builtin_amdgcn_s_waitcnt(0);
        unsigned nloc = b.st[0], nx = b.st[1];
        if (nloc == 0u) { xcd_barrier_complete(bar, b.x, nloc, nx); b.st[0] = nloc; b.st[1] = nx; }
        const unsigned old = xb_add(&bar[XB_XSUB(b.x)], 1u);
        const unsigned gen = old / nloc;
        if (old + 1u == (gen + 1u) * nloc) {
            __builtin_amdgcn_fence(__ATOMIC_RELEASE, "agent");
            asm volatile("s_waitcnt vmcnt(0)" ::: "memory");
            const unsigned og = xb_add(&bar[XB_TOP], 1u);
            const unsigned tg = og / nx;
            if (og + 1u == (tg + 1u) * nx) xb_add(&bar[XB_TOPGEN], 1u);
            else XB_SPIN(xb_ld(&bar[XB_TOPGEN]) == tg, bar);
            __builtin_amdgcn_fence(__ATOMIC_ACQUIRE, "agent");
            xb_add(&bar[XB_XGEN(b.x)], 1u);
            asm volatile("s_waitcnt vmcnt(0)" ::: "memory");
        } else {
            XB_SPIN(xb_ld(&bar[XB_XGEN(b.x)]) == gen, bar);
            __builtin_amdgcn_fence(__ATOMIC_ACQUIRE, "agent");
            asm volatile("s_waitcnt vmcnt(0)" ::: "memory");
        }
    }
    __syncthreads();
}

}
namespace mk {
namespace cg = cooperative_groups;
constexpr int NPHASE = 11;
__global__ void __launch_bounds__(NT, 2) mk_fwd(Params p) {
    extern __shared__ __attribute__((aligned(16))) unsigned char lds_raw[];
    LAS unsigned char* lds = (LAS unsigned char*)lds_raw;
    cg::grid_group grid = cg::this_grid();
    const int tid = threadIdx.x, lane = tid & 63, wave = __builtin_amdgcn_readfirstlane(tid >> 6);
    unsigned char* ws = p.ws;
    float* mod = (float*)(ws + WS_MOD);
    volatile LAS unsigned* xst = (volatile LAS unsigned*)(lds + LDS_BYTES - 64);
    if (tid == 0) { xst[0] = 0u; xst[1] = 0u; }
    __syncthreads();
    const XcdBarrier xbar = xcd_barrier_post((unsigned*)(ws + WS_CTL), xst);
#define IN(k) (p.ph_lo <= (k) && (k) < p.ph_hi)
#define SEAM(k) do { if (IN(k) && IN((k) + 1)) { if ((k) == 0) grid.sync(); else xcd_barrier(xbar); } } while (0)
    if (IN(0)) { phase_p0a(p, lds, wave, lane); __syncthreads(); }
    SEAM(0);
    if (IN(1)) { row_phase<0>(p.x, p.norm1_g, mod, 0, D, nullptr, ws + WS_H, wave, lane); phase_p0b(p, lds, wave, lane); }
    SEAM(1);
    if (IN(2)) {
        pg8::Gemm g{(const pg8::bf16_t*)(ws + WS_H), (const pg8::bf16_t*)(ws + WS_WIN), T, 3840, D}; pg8::StaticOrder S; S.init(T, 3840, gridDim.x, blockIdx.x);
        EpiProj E{(u16*)(ws + WS_PROJ), (u16*)(ws + WS_KIDX), (float*)(ws + WS_WIDX), (float*)(ws + WS_GLR), (u16*)(ws + WS_KF)};
        pg8::gemm_phase<EpiProj, pg8::StaticOrder>(lds, g, S, E);
    }
    SEAM(2);
    if (IN(3)) phase_p3(p, lds, wave, lane);
    SEAM(3);
    if (IN(4)) phase_p4(p, lds, wave, lane);
    SEAM(4);
    if (IN(5)) phase_p5(p, lds, wave, lane);
    SEAM(5);
    if (IN(6)) {
        pg8::Gemm g{(const pg8::bf16_t*)(ws + WS_CAT), (const pg8::bf16_t*)(ws + WS_WOUT), T, D, D}; pg8::StaticOrder S; S.init(T, D, gridDim.x, blockIdx.x);
        EpiRes<false> E{p.x, (u16*)(ws + WS_X16), mod, (float*)(ws + WS_SS1), 2 * D, 0};
        pg8::gemm_phase<EpiRes<false>, pg8::StaticOrder>(lds, g, S, E);
    }
    SEAM(6);
    if (IN(7)) row_phase<1>(ws + WS_X16, p.norm2_g, mod, 3 * D, 4 * D, (const float*)(ws + WS_SS1), ws + WS_H, wave, lane);
    SEAM(7);
    if (IN(8)) {
        pg8::Gemm g{(const pg8::bf16_t*)(ws + WS_H), (const pg8::bf16_t*)(ws + WS_WGU), T, 2 * DFF, D}; pg8::StaticOrder S; S.init(T, 2 * DFF, gridDim.x, blockIdx.x);
        EpiSwiGLU E{(u16*)(ws + WS_ACT)};
        pg8::gemm_phase<EpiSwiGLU, pg8::StaticOrder>(lds, g, S, E);
    }
    SEAM(8);
    if (IN(9)) {
        pg8::Gemm g{(const pg8::bf16_t*)(ws + WS_ACT), (const pg8::bf16_t*)(ws + WS_WDN), T, D, DFF}; pg8::StaticOrder S; S.init(T, D, gridDim.x, blockIdx.x);
        EpiRes<true> E{ws + WS_X16, (u16*)(ws + WS_X16), mod, (float*)(ws + WS_SS2), 5 * D, 0};
        pg8::gemm_phase<EpiRes<true>, pg8::StaticOrder>(lds, g, S, E);
    }
    SEAM(9);
    if (IN(10)) row_phase<2>(ws + WS_X16, p.final_g, nullptr, 0, 0, (const float*)(ws + WS_SS2), p.out, wave, lane);
#undef IN
#undef SEAM
}

static int g_grid = 0;
static Params make_params(void* const* d_in, void* d_out, void* d_ws) {
    Params p{};
    p.x = (const float*)d_in[0]; p.c = (const float*)d_in[1]; p.w_mod = (const float*)d_in[2]; p.b_mod = (const float*)d_in[3]; p.norm1_g = (const float*)d_in[4];
    p.w_in = (const float*)d_in[5]; p.w_gate2 = (const float*)d_in[6]; p.b_gate2 = (const float*)d_in[7]; p.att_g = (const float*)d_in[8]; p.gla_g = (const float*)d_in[9];
    p.w_out = (const float*)d_in[10]; p.norm2_g = (const float*)d_in[11]; p.w_gu = (const float*)d_in[12]; p.w_down = (const float*)d_in[13]; p.final_g = (const float*)d_in[14];
    p.out = (float*)d_out; p.ws = (unsigned char*)d_ws; p.ph_lo = 0; p.ph_hi = NPHASE;
    return p;
}
static bool init_grid(size_t ws_size) {
    if (g_grid) return g_grid > 0;
    int dev = 0, cus = 0, per_cu = 0;
    if (hipGetDevice(&dev) != hipSuccess || hipDeviceGetAttribute(&cus, hipDeviceAttributeMultiprocessorCount, dev) != hipSuccess) { g_grid = -1; return false; }
    if (hipFuncSetAttribute((const void*)mk_fwd, hipFuncAttributeMaxDynamicSharedMemorySize, LDS_BYTES) != hipSuccess) { fprintf(stderr, "hipFuncSetAttribute failed\n"); g_grid = -1; return false; }
    if (hipOccupancyMaxActiveBlocksPerMultiprocessor(&per_cu, (const void*)mk_fwd, NT, LDS_BYTES) != hipSuccess || per_cu < 1) { fprintf(stderr, "occupancy query: %d blocks/CU\n", per_cu); g_grid = -1; return false; }
    if (ws_size < WS_END) { fprintf(stderr, "workspace too small: %zu < %zu\n", ws_size, (size_t)WS_END); g_grid = -1; return false; }
    g_grid = cus;
    fprintf(stderr, "mk: grid %d, per_cu %d, ws %zu\n", g_grid, per_cu, ws_size);
    return true;
}
static void launch(Params p, int lo, int hi, hipStream_t stream) {
    p.ph_lo = lo; p.ph_hi = hi;
    if (hipMemsetAsync(p.ws + WS_CTL, 0, 16384, stream) != hipSuccess) { fprintf(stderr, "hipMemsetAsync of the barrier words failed\n"); return; }
    void* args[] = {&p};
    const hipError_t e = hipLaunchCooperativeKernel((const void*)mk_fwd, dim3(g_grid), dim3(NT), args, LDS_BYTES, stream);
    if (e != hipSuccess) fprintf(stderr, "cooperative launch failed: %s (grid %d)\n", hipGetErrorString(e), g_grid);
}
}

extern "C" void kernel_launch(void* const* d_in, const int* in_sizes, int n_in, void* d_out, int out_size, void* d_ws, size_t ws_size, hipStream_t stream) {
    using namespace mk;
    if (n_in != 15 || out_size != T * D) { fprintf(stderr, "kernel_launch: unexpected problem shape\n"); return; }
    if (!init_grid(ws_size)) return;
    Params p = make_params(d_in, d_out, d_ws);
    launch(p, 0, NPHASE, stream);
}
```

```cpp
#include <hip/hip_runtime.h>
#include <hip/hip_cooperative_groups.h>
#include <cstdio>
#include <cstdint>
#include <cmath>
namespace pg8 {
#define PG8_LAS __attribute__((address_space(3)))
typedef unsigned short bf16_t;
typedef _Float16 bf16x8 __attribute__((ext_vector_type(8)));
typedef float f32x4 __attribute__((ext_vector_type(4)));
typedef unsigned u32x4 __attribute__((ext_vector_type(4)));
constexpr int BM = 256, BK = 64, HALF = 128, HTB = HALF * BK * 2  , STAGE_BYTES = 8 * HTB, NXCD = 8, WGM = 8;

__host__ __device__ __forceinline__ int lds_byte(int r, int c) { const int st = (r >> 4) * 2 + (c >> 5), rr = r & 15, cc = c & 31, ob = rr * 64 + cc * 2; return st * 1024 + (ob ^ (((ob >> 9) & 1) << 5)); }
__host__ __device__ __forceinline__ void stage_rc(int b, int& R, int& C) { const int st = b / 1024, sb = b % 1024, swz = sb ^ (((sb >> 9) & 1) << 5); R = (st >> 1) * 16 + swz / 64; C = (st & 1) * 32 + (swz % 64) / 2; }
__host__ __device__ __forceinline__ int perm32(int rho) { const int n = rho >> 4, i = rho & 15; return 8 * (i >> 2) + 4 * n + (i & 3); }

struct Unit { int pm, pn; };
struct Gemm { const bf16_t* A; const bf16_t* Bt; int M, N, K; };

struct StaticOrder {
    int nM, nN, nwg, G, c, wgm;
    __host__ __device__ void init(int M, int N, int G_, int c_, int wgm_ = WGM) { nM = M / BM; nN = N / BM; nwg = nM * nN; G = G_; c = c_; wgm = wgm_; }
    __host__ __device__ bool next(int i, Unit& u) const {
        const long L = (long)i * G + c; if (L >= nwg) return false;
        int wgid = (int)L; { const int q = nwg / NXCD, r = nwg % NXCD, xcd = wgid % NXCD, off = wgid / NXCD; wgid = (xcd < r ? xcd * (q + 1) : r * (q + 1) + (xcd - r) * q) + off; }
        const int nig = wgm * nN, gid = wgid / nig, fm = gid * wgm, gsz = (nM - fm) < wgm ? (nM - fm) : wgm;
        u.pm = fm + ((wgid % nig) % gsz); u.pn = (wgid % nig) / gsz; return true;
    }
    __device__ __forceinline__ void a_ready(const Unit&) const {}
    __device__ __forceinline__ void done(const Unit&) const {}
};
template <class Epi, class Sched>
__device__ __forceinline__ void gemm_phase(PG8_LAS unsigned char* lds, const Gemm g, const Sched& S, const Epi& E) {
    const int tid = threadIdx.x, wid = __builtin_amdgcn_readfirstlane(tid >> 6), lane = tid & 63, wr = wid >> 2, wc = wid & 3, fr = lane & 15, fq = lane >> 4;
    const int K = g.K, nt = K / BK;
    unsigned voffA[2], voffB[2];
#pragma unroll
    for (int i = 0; i < 2; ++i) { int R, C; stage_rc(tid * 16 + i * 8192, R, C); const int Rb = Epi::PERM ? ((R & ~31) + perm32(R & 31)) : R;
        voffA[i] = (unsigned)(R * K + C) * 2u; voffB[i] = (unsigned)(Rb * K + C) * 2u; }
    const size_t kstep = (size_t)(BK * 2);
    const size_t hstep = (size_t)HALF * K * 2;
    const size_t tstep = 2 * hstep;
    const unsigned ldsw = (unsigned)wid * 1024u;
    const int aoff = lds_byte(wr * 64 + fr, fq * 8), boff = lds_byte(wc * 32 + fr, fq * 8);
#define PG8_SA(b, h) (((b) * 2 + (h)) * HTB)
#define PG8_SB(b, h) ((4 + (b) * 2 + (h)) * HTB)
#define PG8_STAGE(bufoff, gbase, voff) do { _Pragma("unroll") for (int _i = 0; _i < 2; ++_i) \
        __builtin_amdgcn_global_load_lds((const unsigned*)((const char*)(gbase) + (voff)[_i]), (PG8_LAS unsigned*)(lds + (bufoff) + ldsw + _i * 8192), 16, 0, 0); } while (0)
#define PG8_LDA(dst, b, h) do { _Pragma("unroll") for (int m = 0; m < 4; ++m) _Pragma("unroll") for (int k = 0; k < 2; ++k) dst[m][k] = *(const PG8_LAS bf16x8*)(lds + PG8_SA(b, h) + aoff + m * 2048 + k * 1024); } while (0)
#define PG8_LDB(dst, b, h) do { _Pragma("unroll") for (int n = 0; n < 2; ++n) _Pragma("unroll") for (int k = 0; k < 2; ++k) dst[n][k] = *(const PG8_LAS bf16x8*)(lds + PG8_SB(b, h) + boff + n * 2048 + k * 1024); } while (0)
#define PG8_MMA(ai, bj, At, Bt) do { __builtin_amdgcn_s_setprio(1); _Pragma("unroll") for (int m = 0; m < 4; ++m) _Pragma("unroll") for (int n = 0; n < 2; ++n) _Pragma("unroll") for (int k = 0; k < 2; ++k) \
        acc[ai][bj][m][n] = __builtin_amdgcn_mfma_f32_16x16x32_f16(Bt[n][k], At[m][k], acc[ai][bj][m][n], 0, 0, 0); __builtin_amdgcn_s_setprio(0); } while (0)
#define PG8_WAIT_V(n) asm volatile("s_waitcnt vmcnt(" #n ")" ::: "memory")
#define PG8_WAIT_L(n) asm volatile("s_waitcnt lgkmcnt(" #n ")" ::: "memory")
#define PG8_BAR __builtin_amdgcn_s_barrier()
#define PG8_SCHED __builtin_amdgcn_sched_barrier(0)
    Unit cur, nxt; int ui = 0;
    if (!S.next(0, cur)) return;
    f32x4 acc[2][2][4][2];
#pragma unroll
    for (int a = 0; a < 2; ++a)
#pragma unroll
        for (int b = 0; b < 2; ++b)
#pragma unroll
            for (int m = 0; m < 4; ++m)
#pragma unroll
                for (int n = 0; n < 2; ++n) acc[a][b][m][n] = (f32x4){0.f, 0.f, 0.f, 0.f};
    bf16x8 At[4][2], B0[2][2], B1[2][2];
    const char* cA = (const char*)g.A + (size_t)cur.pm * tstep; const char* cB = (const char*)g.Bt + (size_t)cur.pn * tstep;
    S.a_ready(cur);
    PG8_STAGE(PG8_SB(0, 0), cB, voffB); PG8_STAGE(PG8_SA(0, 0), cA, voffA); PG8_STAGE(PG8_SB(0, 1), cB + hstep, voffB); PG8_STAGE(PG8_SA(0, 1), cA + hstep, voffA);
    if (wr == 1) PG8_BAR;
    PG8_WAIT_V(4); PG8_BAR;
    PG8_STAGE(PG8_SB(1, 0), cB + kstep, voffB); PG8_STAGE(PG8_SA(1, 0), cA + kstep, voffA); PG8_STAGE(PG8_SB(1, 1), cB + hstep + kstep, voffB);
    PG8_WAIT_V(6); PG8_BAR;
    for (;;) {
        const bool has_next = S.next(ui + 1, nxt);
        const char* nA = has_next ? (const char*)g.A + (size_t)nxt.pm * tstep : cA; const char* nB = has_next ? (const char*)g.Bt + (size_t)nxt.pn * tstep : cB;
        for (int t = 0; t < nt; t += 2) {
            const bool last = (t == nt - 2);
            const char* a1 = cA + (size_t)(t + 1) * kstep;
            const char* a2 = last ? nA : cA + (size_t)(t + 2) * kstep; const char* b2 = last ? nB : cB + (size_t)(t + 2) * kstep;
            const char* a3 = a2 + kstep; const char* b3 = b2 + kstep;
            if (last && has_next) S.a_ready(nxt);
            PG8_LDB(B0, 0, 0); PG8_SCHED; PG8_LDA(At, 0, 0); PG8_STAGE(PG8_SA(1, 1), a1 + hstep, voffA);
            PG8_WAIT_L(8); PG8_BAR; PG8_WAIT_L(0); PG8_MMA(0, 0, At, B0); PG8_BAR; PG8_SCHED;
            PG8_LDB(B1, 0, 1); PG8_STAGE(PG8_SB(0, 0), b2, voffB);
            PG8_BAR; PG8_WAIT_L(0); PG8_MMA(0, 1, At, B1); PG8_BAR;
            PG8_LDA(At, 0, 1); PG8_STAGE(PG8_SA(0, 0), a2, voffA);
            PG8_BAR; PG8_WAIT_L(0); PG8_MMA(1, 0, At, B0); PG8_BAR; PG8_SCHED;
            PG8_STAGE(PG8_SB(0, 1), b2 + hstep, voffB);
            PG8_WAIT_V(6); PG8_BAR; PG8_MMA(1, 1, At, B1); PG8_BAR;
            PG8_LDB(B0, 1, 0); PG8_SCHED; PG8_LDA(At, 1, 0); PG8_STAGE(PG8_SA(0, 1), a2 + hstep, voffA);
            PG8_WAIT_L(8); PG8_BAR; PG8_WAIT_L(0); PG8_MMA(0, 0, At, B0); PG8_BAR; PG8_SCHED;
            PG8_LDB(B1, 1, 1); PG8_STAGE(PG8_SB(1, 0), b3, voffB);
            PG8_BAR; PG8_WAIT_L(0); PG8_MMA(0, 1, At, B1); PG8_BAR;
            PG8_LDA(At, 1, 1); PG8_STAGE(PG8_SA(1, 0), a3, voffA);
            PG8_BAR; PG8_WAIT_L(0); PG8_MMA(1, 0, At, B0); PG8_BAR; PG8_SCHED;
            PG8_STAGE(PG8_SB(1, 1), b3 + hstep, voffB);
            PG8_WAIT_V(6); PG8_BAR; PG8_MMA(1, 1, At, B1); PG8_BAR;
        }
        if constexpr (!Epi::AFTER_DRAIN) { E(acc, cur, wr, wc, fr, fq); S.done(cur); }
        if (!has_next) break;
#pragma unroll
        for (int a = 0; a < 2; ++a)
#pragma unroll
            for (int b = 0; b < 2; ++b)
#pragma unroll
                for (int m = 0; m < 4; ++m)
#pragma unroll
                    for (int n = 0; n < 2; ++n) acc[a][b][m][n] = (f32x4){0.f, 0.f, 0.f, 0.f};
        cur = nxt; cA = nA; cB = nB; ++ui;
    }
    PG8_WAIT_V(0);
    if (wr == 0) PG8_BAR;
    PG8_BAR;
    if constexpr (Epi::AFTER_DRAIN) { E.fused(acc, cur, wr, wc, fr, fq, lds, wid, lane); S.done(cur); }
#undef PG8_SA
#undef PG8_SB
#undef PG8_STAGE
#undef PG8_LDA
#undef PG8_LDB
#undef PG8_MMA
#undef PG8_WAIT_V
#undef PG8_WAIT_L
#undef PG8_BAR
#undef PG8_SCHED
}
}
namespace mk {
#define LAS __attribute__((address_space(3)))
using pg8::f32x4; using pg8::u32x4; using pg8::Unit;
typedef float f32x2 __attribute__((ext_vector_type(2)));
typedef float f32x16 __attribute__((ext_vector_type(16)));
typedef _Float16 h2v __attribute__((ext_vector_type(2)));
typedef _Float16 f16x8 __attribute__((ext_vector_type(8)));
typedef _Float16 f16x4 __attribute__((ext_vector_type(4)));
typedef short bf16x8 __attribute__((ext_vector_type(8)));
typedef unsigned u32x2 __attribute__((ext_vector_type(2)));
typedef unsigned short u16;

constexpr int NWAVES = 8, NT = 512;
constexpr int D = 1024, NB = 8, L = 8192, T = NB * L, DIN = 3672, DFF = 2816;
constexpr int PJ = 3584;
constexpr int CQ = 0, CK = 512, CV = 1024, CQI = 1536, CGQ = 2048, CGK = 2304, CGV = 2560, CGO = 3072;
constexpr float EPS = 1e-6f;
constexpr float IDX_SCALE = 0.35355339059327373f * 0.125f;
constexpr size_t MiB = 1u << 20;
constexpr size_t WS_CTL = 0, WS_MOD = 1 * MiB, WS_WIN = 2 * MiB, WS_WOUT = 10 * MiB, WS_WGU = 12 * MiB, WS_WDN = 23 * MiB;
constexpr size_t WS_SS1 = 29 * MiB, WS_SS2 = 33 * MiB, WS_KIDX = 37 * MiB, WS_WIDX = 45 * MiB, WS_GLR = 47 * MiB, WS_THR = 51 * MiB;
constexpr size_t WS_H = 64 * MiB, WS_CAT = 192 * MiB, WS_PROJ = 320 * MiB, WS_ACT = 320 * MiB, WS_GLAS = 768 * MiB, WS_VT = 896 * MiB, WS_KF = 960 * MiB, WS_END = 1024 * MiB;
constexpr int LDS_BYTES = 163840;

struct Params {
    const float *x, *c, *w_mod, *b_mod, *norm1_g, *w_in, *w_gate2, *b_gate2, *att_g, *gla_g, *w_out, *norm2_g, *w_gu, *w_down, *final_g;
    float* out; unsigned char* ws; int ph_lo, ph_hi;
};

__device__ __forceinline__ unsigned pkh(float a, float b) { const h2v h = __builtin_convertvector((f32x2){a, b}, h2v); return __builtin_bit_cast(unsigned, h); }
__device__ __forceinline__ float silu_f(float v) { return v * __builtin_amdgcn_rcpf(1.f + __expf(-v)); }
__device__ __forceinline__ float wave_sum(float v) {
#pragma unroll
    for (int o = 1; o < 64; o <<= 1) v += __shfl_xor(v, o);
    return v;
}
__device__ __forceinline__ float rows_sum(float s) {
    { const unsigned u = __builtin_bit_cast(unsigned, s); const auto r = __builtin_amdgcn_permlane16_swap(u, u, false, false); const unsigned a = r[0], b = r[1]; s = __builtin_bit_cast(float, a) + __builtin_bit_cast(float, b); }
    { const unsigned u = __builtin_bit_cast(unsigned, s); const auto r = __builtin_amdgcn_permlane32_swap(u, u, false, false); const unsigned a = r[0], b = r[1]; s = __builtin_bit_cast(float, a) + __builtin_bit_cast(float, b); }
    return s;
}
#define LDS_WAIT() asm volatile("s_waitcnt lgkmcnt(0)" ::: "memory")

struct MapIn { __device__ __forceinline__ int operator()(int n) const {
    if (n < 2048) return n; if (n < 3584) return n + 72; if (n < 3648) return 2048 + (n - 3584); if (n < 3656) return 2112 + (n - 3648); if (n < 3672) return n; return -1; } };
struct MapGU { __device__ __forceinline__ int operator()(int n) const { const int pn = n >> 8, r = n & 255; return r < 128 ? 128 * pn + r : DFF + 128 * pn + (r - 128); } };
struct MapId { __device__ __forceinline__ int operator()(int n) const { return n; } };

template <class Map>
__device__ __forceinline__ void transpose_item(const float* __restrict__ W, int K, int Nsrc, u16* __restrict__ WT, int nblk, LAS float* scr, int item, int lane, Map map) {
    const int kb = item / nblk, nb = item % nblk, k0 = 64 * kb, n0 = 32 * nb;
    const int sc = map(n0 + (lane & 31));
#pragma unroll 8
    for (int i = 0; i < 32; ++i) { const int kk = 2 * i + (lane >> 5); const float v = W[(size_t)(k0 + kk) * Nsrc + (sc >= 0 ? sc : 0)]; scr[kk * 33 + (lane & 31)] = sc >= 0 ? v : 0.f; }
    LDS_WAIT(); asm volatile("" ::: "memory");
    const int c = lane & 7;
#pragma unroll
    for (int j = 0; j < 4; ++j) { const int n = (lane >> 3) + 8 * j; const LAS float* s = scr + (8 * c) * 33 + n;
        u32x4 o; o.x = pkh(s[0 * 33], s[1 * 33]); o.y = pkh(s[2 * 33], s[3 * 33]); o.z = pkh(s[4 * 33], s[5 * 33]); o.w = pkh(s[6 * 33], s[7 * 33]);
        *(u32x4*)(WT + (size_t)(n0 + n) * K + k0 + 8 * c) = o; }
    LDS_WAIT(); asm volatile("" ::: "memory");
}

__device__ __forceinline__ void phase_p0a(const Params& p, LAS unsigned char* lds, int wave, int lane) {
    LAS float* sct = (LAS float*)(lds + 98304);
    for (int i = threadIdx.x; i < NB * D; i += NT) { const float cv = p.c[i]; sct[i] = cv / (1.f + expf(-cv)); }
    __syncthreads();
    const int gw = blockIdx.x * NWAVES + wave, NGW = gridDim.x * NWAVES;
    float* mod = (float*)(p.ws + WS_MOD);
    for (int it = gw; it < 6 * D / 16; it += NGW) {
        const int j = it * 16 + (lane & 15), kq = lane >> 4;
        float acc[NB];
#pragma unroll
        for (int b = 0; b < NB; ++b) acc[b] = 0.f;
#pragma unroll 4
        for (int k4 = 0; k4 < D / 4; ++k4) { const int k = 4 * k4 + kq; const float w = p.w_mod[(size_t)k * (6 * D) + j];
#pragma unroll
            for (int b = 0; b < NB; ++b) acc[b] += sct[b * D + k] * w; }
#pragma unroll
        for (int b = 0; b < NB; ++b) acc[b] = rows_sum(acc[b]);
        if (lane < 16) { const float bm = p.b_mod[j];
#pragma unroll
            for (int b = 0; b < NB; ++b) mod[b * 6 * D + j] = acc[b] + bm; }
    }
}
__device__ __forceinline__ void phase_p0b(const Params& p, LAS unsigned char* lds, int wave, int lane) {
    const int gw = blockIdx.x * NWAVES + wave, NGW = gridDim.x * NWAVES;
    LAS float* scr = (LAS float*)(lds + wave * 8704);
    constexpr int I_IN = (D / 64) * (3840 / 32), I_OUT = (D / 64) * (D / 32), I_GU = (D / 64) * (2 * DFF / 32), I_DN = (DFF / 64) * (D / 32);
    constexpr int NITEMS = I_IN + I_OUT + I_GU + I_DN;
    for (int it = gw; it < NITEMS; it += NGW) {
        int r = it;
        if (r < I_IN) { transpose_item(p.w_in, D, DIN, (u16*)(p.ws + WS_WIN), 3840 / 32, scr, r, lane, MapIn()); continue; } r -= I_IN;
        if (r < I_OUT) { transpose_item(p.w_out, D, D, (u16*)(p.ws + WS_WOUT), D / 32, scr, r, lane, MapId()); continue; } r -= I_OUT;
        if (r < I_GU) { transpose_item(p.w_gu, D, 2 * DFF, (u16*)(p.ws + WS_WGU), 2 * DFF / 32, scr, r, lane, MapGU()); continue; } r -= I_GU;
        transpose_item(p.w_down, DFF, D, (u16*)(p.ws + WS_WDN), D / 32, scr, r, lane, MapId());
    }
}

template <int MODE>
__device__ __forceinline__ void row_phase(const void* xin, const float* __restrict__ g, const float* __restrict__ mod, int sh_off, int sc_off, const float* __restrict__ ss, void* outp, int wave, int lane) {
    const int gw = blockIdx.x * NWAVES + wave, NGW = gridDim.x * NWAVES;
    f32x4 gv[4];
#pragma unroll
    for (int j = 0; j < 4; ++j) gv[j] = ((const f32x4*)g)[lane + 64 * j];
    auto load = [&](f32x4 (&v)[4], int m) __attribute__((always_inline)) {
        if (MODE == 0) { const f32x4* xr = (const f32x4*)((const float*)xin + (size_t)m * D) + lane;
#pragma unroll
            for (int j = 0; j < 4; ++j) v[j] = __builtin_nontemporal_load(xr + 64 * j); }
        else { const u32x2* xr = (const u32x2*)((const u16*)xin + (size_t)m * D) + lane;
#pragma unroll
            for (int j = 0; j < 4; ++j) { const u32x2 w = xr[64 * j]; const unsigned wx = w.x, wy = w.y; const h2v a = __builtin_bit_cast(h2v, wx), b = __builtin_bit_cast(h2v, wy); v[j] = (f32x4){(float)a[0], (float)a[1], (float)b[0], (float)b[1]}; } }
    };
    auto finish = [&](f32x4 (&v)[4], int m) __attribute__((always_inline)) {
        float tot;
        if (MODE == 0) { float s = 0.f;
#pragma unroll
            for (int j = 0; j < 4; ++j) s += (v[j].x * v[j].x + v[j].y * v[j].y) + (v[j].z * v[j].z + v[j].w * v[j].w);
            tot = wave_sum(s); }
        else { const f32x4* sp = (const f32x4*)(ss + (size_t)m * 16); const f32x4 a = sp[0], b = sp[1], c = sp[2], d = sp[3];
            tot = ((a.x + a.y) + (a.z + a.w)) + ((b.x + b.y) + (b.z + b.w)) + ((c.x + c.y) + (c.z + c.w)) + ((d.x + d.y) + (d.z + d.w)); }
        const float rstd = rsqrtf(tot * (1.f / D) + EPS);
        if (MODE == 2) { f32x4* o = (f32x4*)((float*)outp + (size_t)m * D) + lane;
#pragma unroll
            for (int j = 0; j < 4; ++j) __builtin_nontemporal_store(v[j] * rstd * gv[j], o + 64 * j); }
        else { const float* mb = mod + (m >> 13) * (6 * D);
            u32x2* o = (u32x2*)((u16*)outp + (size_t)m * D) + lane;
#pragma unroll
            for (int j = 0; j < 4; ++j) { const f32x4 sc = ((const f32x4*)(mb + sc_off))[lane + 64 * j], sh = ((const f32x4*)(mb + sh_off))[lane + 64 * j];
                const f32x4 r = v[j] * rstd * gv[j] * (sc + 1.f) + sh; u32x2 w; w.x = pkh(r.x, r.y); w.y = pkh(r.z, r.w); o[64 * j] = w; } }
    };
    for (int m = gw; m < T; m += 2 * NGW) {
        f32x4 va[4], vb[4];
        load(va, m); const bool two = m + NGW < T; if (two) load(vb, m + NGW);
        finish(va, m); if (two) finish(vb, m + NGW);
    }
}

struct EpiProj {
    static constexpr bool PERM = true, AFTER_DRAIN = false;
    u16* P; u16* kidx; float* widx; float* glr; u16* kf;
    __device__ __forceinline__ void operator()(const f32x4 (&acc)[2][2][4][2], const Unit& u, int wr, int wc, int fr, int fq) const {
        const int row0 = u.pm * 256 + wr * 64 + fr;
        if (u.pn < 14) {
            const int col0 = u.pn * 256 + wc * 32 + 8 * fq;
#pragma unroll
            for (int ai = 0; ai < 2; ++ai)
#pragma unroll
                for (int m = 0; m < 4; ++m) { u16* rowp = P + (size_t)(row0 + ai * 128 + m * 16) * PJ + col0;
#pragma unroll
                    for (int bj = 0; bj < 2; ++bj) { const f32x4 v0 = acc[ai][bj][m][0], v1 = acc[ai][bj][m][1];
                        u32x4 w; w.x = pkh(v0[0], v0[1]); w.y = pkh(v0[2], v0[3]); w.z = pkh(v1[0], v1[1]); w.w = pkh(v1[2], v1[3]);
                        if (u.pn == 2 || u.pn == 3) {
                            const int row = row0 + ai * 128 + m * 16, hd = 2 * (u.pn - 2) + bj, bb = row >> 13, kt = (row & 8191) >> 5;
                            __builtin_nontemporal_store(w, (u32x4*)(kf + ((((size_t)(bb * 4 + hd) * 256 + kt) * 8 + 2 * wc + (fq >> 1)) * 64 + (fq & 1) * 32 + (row & 31)) * 8)); }
                        else __builtin_nontemporal_store(w, (u32x4*)(rowp + bj * 128)); } }
        } else {
#pragma unroll
            for (int ai = 0; ai < 2; ++ai)
#pragma unroll
                for (int m = 0; m < 4; ++m) { const size_t row = (size_t)(row0 + ai * 128 + m * 16); const f32x4 v0 = acc[ai][0][m][0], v1 = acc[ai][0][m][1];
                    if (wc < 2) { u32x4 w; w.x = pkh(v0[0], v0[1]); w.y = pkh(v0[2], v0[3]); w.z = pkh(v1[0], v1[1]); w.w = pkh(v1[2], v1[3]);
                        *(u32x4*)(kidx + (((row >> 5) * 4 + 2 * wc + (fq >> 1)) * 64 + (fq & 1) * 32 + (row & 31)) * 8) = w; }
                    else if (wc == 2) {
                        if (fq == 0) { *(f32x4*)(widx + row * 8) = v0 * IDX_SCALE; *(f32x4*)(widx + row * 8 + 4) = v1 * IDX_SCALE; }
                        else if (fq < 3) { *(f32x4*)(glr + row * 16 + (fq - 1) * 8) = v0; *(f32x4*)(glr + row * 16 + (fq - 1) * 8 + 4) = v1; } } }
        }
    }
};
template <bool BASE_HALF>
struct EpiRes {
    static constexpr bool PERM = false, AFTER_DRAIN = false;
    const void* base; u16* out; const float* mod; float* ss; int gate_off; int pad;
    __device__ __forceinline__ void operator()(const f32x4 (&acc)[2][2][4][2], const Unit& u, int wr, int wc, int fr, int fq) const {
        const int row0 = u.pm * 256 + wr * 64 + fr, col0 = u.pn * 256 + wc * 32 + 4 * fq;
        const float* g = mod + (u.pm >> 5) * (6 * D) + gate_off;
        f32x4 gv[2][2];
#pragma unroll
        for (int bj = 0; bj < 2; ++bj)
#pragma unroll
            for (int n = 0; n < 2; ++n) gv[bj][n] = *(const f32x4*)(g + col0 + bj * 128 + n * 16);
#pragma unroll
        for (int ai = 0; ai < 2; ++ai) {
            f32x4 bsf[4][2][2]; u32x2 bsh[4][2][2];
#pragma unroll
            for (int m = 0; m < 4; ++m)
#pragma unroll
                for (int bj = 0; bj < 2; ++bj)
#pragma unroll
                    for (int n = 0; n < 2; ++n) { const size_t off = (size_t)(row0 + ai * 128 + m * 16) * D + col0 + bj * 128 + n * 16;
                        if (BASE_HALF) bsh[m][bj][n] = *(const u32x2*)((const u16*)base + off);
                        else bsf[m][bj][n] = __builtin_nontemporal_load((const f32x4*)((const float*)base + off)); }
#pragma unroll
            for (int m = 0; m < 4; ++m) { const size_t row = (size_t)(row0 + ai * 128 + m * 16); float s = 0.f;
#pragma unroll
                for (int bj = 0; bj < 2; ++bj)
#pragma unroll
                    for (int n = 0; n < 2; ++n) { const size_t off = row * D + col0 + bj * 128 + n * 16; f32x4 bs;
                        if (BASE_HALF) { const u32x2 wi = bsh[m][bj][n]; const unsigned wx = wi.x, wy = wi.y;        const h2v a = __builtin_bit_cast(h2v, wx), b = __builtin_bit_cast(h2v, wy); bs = (f32x4){(float)a[0], (float)a[1], (float)b[0], (float)b[1]}; }
                        else bs = bsf[m][bj][n];
                        const f32x4 o = bs + gv[bj][n] * acc[ai][bj][m][n]; u32x2 w; w.x = pkh(o[0], o[1]); w.y = pkh(o[2], o[3]); *(u32x2*)(out + off) = w;
                        s += (o[0] * o[0] + o[1] * o[1]) + (o[2] * o[2] + o[3] * o[3]); }
                s = rows_sum(s);
                if (fq == 0) ss[row * 16 + u.pn * 4 + wc] = s; } }
    }
};
struct EpiSwiGLU {
    static constexpr bool PERM = true, AFTER_DRAIN = false;
    u16* act;
    __device__ __forceinline__ void operator()(const f32x4 (&acc)[2][2][4][2], const Unit& u, int wr, int wc, int fr, int fq) const {
        const int row0 = u.pm * 256 + wr * 64 + fr, col0 = u.pn * 128 + wc * 32 + 8 * fq;
#pragma unroll
        for (int ai = 0; ai < 2; ++ai)
#pragma unroll
            for (int m = 0; m < 4; ++m) { const f32x4 g0 = acc[ai][0][m][0], g1 = acc[ai][0][m][1], u0 = acc[ai][1][m][0], u1 = acc[ai][1][m][1];
                float a[8];
#pragma unroll
                for (int j = 0; j < 4; ++j) { a[j] = silu_f(g0[j]) * u0[j]; a[4 + j] = silu_f(g1[j]) * u1[j]; }
                u32x4 w; w.x = pkh(a[0], a[1]); w.y = pkh(a[2], a[3]); w.z = pkh(a[4], a[5]); w.w = pkh(a[6], a[7]);
                __builtin_nontemporal_store(w, (u32x4*)(act + (size_t)(row0 + ai * 128 + m * 16) * DFF + col0)); }
    }
};
}
#define MK_HAVE_MIX 1
namespace mk {
constexpr size_t WS_GDEC = 52 * MiB;
constexpr size_t WS_SELM = WS_H + 64 * MiB;
constexpr size_t WS_X16 = WS_GLAS;
constexpr size_t WS_S16 = WS_H;
constexpr int NCH = L / 64;

__device__ __forceinline__ unsigned f2bf(float f) { unsigned u = __builtin_bit_cast(unsigned, f); return (u + 0x7fffu + ((u >> 16) & 1u)) >> 16; }
__device__ __forceinline__ unsigned pkbf(float lo, float hi) { return f2bf(lo) | (f2bf(hi) << 16); }
__device__ __forceinline__ float h2f(u16 h) { return (float)__builtin_bit_cast(_Float16, h); }
__device__ __forceinline__ float hlo(unsigned w) { return h2f((u16)(w & 0xffffu)); }
__device__ __forceinline__ float hhi(unsigned w) { return h2f((u16)(w >> 16)); }
__device__ __forceinline__ int kperm16(int o) { return 8 * ((o >> 2) & 1) + 4 * (o >> 3) + (o & 3); }

__device__ __forceinline__ void vt_item(const Params& p, LAS unsigned char* scr  , int item, int lane) {
    const int tb = item & 255, h = (item >> 8) & 3, b = item >> 10, t0 = tb * 32;
    const u16* src = (const u16*)(p.ws + WS_PROJ) + (size_t)(b * L + t0) * PJ + CV + h * 128;
#pragma unroll
    for (int i = 0; i < 8; ++i) { const int r = 4 * i + (lane >> 4), ch = lane & 15; const u32x4 v = *(const u32x4*)(src + (size_t)r * PJ + ch * 8);
        LAS unsigned* d = (LAS unsigned*)(scr + r * 264 + ch * 16); d[0] = v.x; d[1] = v.y; d[2] = v.z; d[3] = v.w; }
    LDS_WAIT(); asm volatile("" ::: "memory");
    u16* dst = (u16*)(p.ws + WS_VT) + ((size_t)(b * 4 + h) * 256 + tb) * 4096;
#pragma unroll
    for (int i = 0; i < 8; ++i) { const int c = i * 64 + lane, dv = c & 127, tg = c >> 7;
        unsigned w[4];
#pragma unroll
        for (int jp = 0; jp < 4; ++jp) { const int j = 2 * jp, tok = 16 * (tg >> 1) + 8 * (j >> 2) + 4 * (tg & 1) + (j & 3);
            const unsigned lo = *(LAS u16*)(scr + tok * 264 + dv * 2), hi = *(LAS u16*)(scr + (tok + 1) * 264 + dv * 2); w[jp] = lo | (hi << 16); }
        u32x4 o; o.x = w[0]; o.y = w[1]; o.z = w[2]; o.w = w[3];
        *(u32x4*)(dst + ((((dv >> 5) * 2 + (tg >> 1)) * 2 + (tg & 1)) * 32 + (dv & 31)) * 8) = o; }
    LDS_WAIT(); asm volatile("" ::: "memory");
}

constexpr int GL_SEG = 106496;
constexpr int GL_GLR = 0, GL_WG = 4096, GL_BG = 8192, GL_BC = 8448, GL_QD = 25088, GL_KD = 34304, GL_QP = 43520, GL_VT = 52736, GL_SSQ = 71168, GL_OST = 72192, GL_END = 105984;
constexpr int GST = 72;
__device__ __forceinline__ void gla_bcum(const Params& p, LAS unsigned char* lds, int b, int h, int c) {
    const int tid = threadIdx.x;
    LAS float* glr = (LAS float*)(lds + GL_GLR); LAS float* wg = (LAS float*)(lds + GL_WG); LAS float* bg = (LAS float*)(lds + GL_BG); LAS float* bc = (LAS float*)(lds + GL_BC);
    const float* gsrc = (const float*)(p.ws + WS_GLR) + (size_t)(b * L + c * 64) * 16;
    for (int i = tid; i < 1024; i += NT) { glr[i] = gsrc[i]; wg[i] = p.w_gate2[(i >> 6) * 256 + h * 64 + (i & 63)]; }
    if (tid < 64) bg[tid] = p.b_gate2[h * 64 + tid];
    __syncthreads();
    { const int dk = tid & 63; float wr[16];
#pragma unroll
      for (int r = 0; r < 16; ++r) wr[r] = wg[r * 64 + dk];
      const float bias = bg[dk];
#pragma unroll
      for (int i = 0; i < 8; ++i) { const int t = (tid >> 6) + 8 * i; float z = bias;
#pragma unroll
          for (int r4 = 0; r4 < 4; ++r4) { const f32x4 gq = *(const LAS f32x4*)(glr + t * 16 + 4 * r4); z += gq[0] * wr[4 * r4] + gq[1] * wr[4 * r4 + 1] + gq[2] * wr[4 * r4 + 2] + gq[3] * wr[4 * r4 + 3]; }
          bc[t * 65 + dk] = (fminf(z, 0.f) - __logf(1.f + __expf(-fabsf(z)))) * (1.f / 16.f); } }
    __syncthreads();
    { const int dk = tid & 63, sg = tid >> 6; LAS float* segt = (LAS float*)(lds + GL_SEG);
      float v[8], run = 0.f;
#pragma unroll
      for (int i = 0; i < 8; ++i) { run += bc[(sg * 8 + i) * 65 + dk]; v[i] = run; }
      segt[sg * 64 + dk] = run;
      __syncthreads();
      float off = 0.f;
#pragma unroll
      for (int j = 0; j < 7; ++j) off += (j < sg) ? segt[j * 64 + dk] : 0.f;
#pragma unroll
      for (int i = 0; i < 8; ++i) bc[(sg * 8 + i) * 65 + dk] = v[i] + off; }
    __syncthreads();
}

__device__ __forceinline__ void gla1_item(const Params& p, LAS unsigned char* lds, int item, int wave, int lane) {
    const int tid = threadIdx.x, c = item & (NCH - 1), h = (item >> 7) & 3, b = item >> 9;
    const u16* prow = (const u16*)(p.ws + WS_PROJ) + (size_t)(b * L + c * 64) * PJ;
    unsigned kw0[4], kw1[4], vw0[8], vw1[8];
#pragma unroll
    for (int i = 0; i < 4; ++i) { const int idx = tid + NT * i, dk = idx & 63, t = 2 * (idx >> 6);
        kw0[i] = prow[(size_t)t * PJ + CGK + h * 64 + dk]; kw1[i] = prow[(size_t)(t + 1) * PJ + CGK + h * 64 + dk]; }
#pragma unroll
    for (int i = 0; i < 8; ++i) { const int idx = tid + NT * i, dv = idx & 127, t = 2 * (idx >> 7);
        vw0[i] = prow[(size_t)t * PJ + CGV + h * 128 + dv]; vw1[i] = prow[(size_t)(t + 1) * PJ + CGV + h * 128 + dv]; }
    gla_bcum(p, lds, b, h, c);
    LAS float* bc = (LAS float*)(lds + GL_BC); LAS u16* KT = (LAS u16*)(lds + GL_KD); LAS u16* VTl = (LAS u16*)(lds + GL_VT);
#pragma unroll
    for (int i = 0; i < 4; ++i) { const int idx = tid + NT * i, dk = idx & 63, t = 2 * (idx >> 6); const float bl = bc[63 * 65 + dk];
        const float k0 = h2f((u16)kw0[i]) * __expf(bl - bc[t * 65 + dk]), k1 = h2f((u16)kw1[i]) * __expf(bl - bc[(t + 1) * 65 + dk]);
        *(LAS unsigned*)(KT + dk * GST + t) = pkh(k0, k1); }
#pragma unroll
    for (int i = 0; i < 8; ++i) { const int idx = tid + NT * i, dv = idx & 127, t = 2 * (idx >> 7);
        *(LAS unsigned*)(VTl + dv * GST + t) = vw0[i] | (vw1[i] << 16); }
    if (tid < 64) ((float*)(p.ws + WS_GDEC))[(size_t)item * 64 + tid] = __expf(bc[63 * 65 + tid]);
#pragma unroll
    for (int i = 0; i < 8; ++i) { const int idx = tid + NT * i, t = idx >> 6, dk = idx & 63;
        ((float*)((u16*)(p.ws + WS_PROJ) + (size_t)(b * L + c * 64 + t) * PJ + CK + h * 128))[dk] = bc[t * 65 + dk]; }
    __syncthreads();
    const int mbv = wave >> 1, nbk = wave & 1, hh = lane >> 5, l31 = lane & 31;
    f32x16 acc;
#pragma unroll
    for (int i = 0; i < 16; ++i) acc[i] = 0.f;
#pragma unroll
    for (int s = 0; s < 4; ++s) { const f16x8 a = *(const LAS f16x8*)(VTl + (mbv * 32 + l31) * GST + 16 * s + 8 * hh), bb = *(const LAS f16x8*)(KT + (nbk * 32 + l31) * GST + 16 * s + 8 * hh);
        acc = __builtin_amdgcn_mfma_f32_32x32x16_f16(a, bb, acc, 0, 0, 0); }
    float* dst = (float*)(p.ws + WS_GLAS) + (size_t)item * 8192;
#pragma unroll
    for (int i = 0; i < 16; ++i) { const int dv = mbv * 32 + (i & 3) + 8 * (i >> 2) + 4 * hh; dst[dv * 64 + nbk * 32 + l31] = acc[i]; }
    __syncthreads();
}

__device__ __forceinline__ void phase_p4(const Params& p, LAS unsigned char* lds, int wave, int lane) {
    const float* dS = (const float*)(p.ws + WS_GLAS); const float* dec = (const float*)(p.ws + WS_GDEC); unsigned* S16 = (unsigned*)(p.ws + WS_S16);
    for (int ch = blockIdx.x * NT + threadIdx.x; ch < 32 * 4096; ch += gridDim.x * NT) {
        const int bh = ch >> 12, e2 = ch & 4095, dk = (e2 * 2) & 63;
        f32x2 run = {0.f, 0.f};
#pragma unroll 16
        for (int c = 0; c < NCH; ++c) { const size_t item = (size_t)bh * NCH + c;
            const f32x2 d = *(const f32x2*)(dS + item * 8192 + e2 * 2), a = *(const f32x2*)(dec + item * 64 + dk);
            S16[item * 4096 + e2] = pkh(run.x, run.y);
            run = a * run + d; }
    }
}

struct G3Ops { unsigned qw[4], kw[4], vw0[8], vw1[8]; u32x4 g0, g1; f16x8 sfr[4]; float bw[8]; };
#define GL_SYNC() do { asm volatile("s_waitcnt lgkmcnt(0)" ::: "memory"); __builtin_amdgcn_s_barrier(); asm volatile("" ::: "memory"); } while (0)
__device__ __forceinline__ void gla3_load(const Params& p, G3Ops& o, int item, int wave, int lane) {
    const int tid = threadIdx.x, c = item & (NCH - 1), h = (item >> 7) & 3, b = item >> 9;
    const int mb = wave >> 1, hh = lane >> 5, l31 = lane & 31;
    const u16* prow = (const u16*)(p.ws + WS_PROJ) + (size_t)(b * L + c * 64) * PJ;
#pragma unroll
    for (int i = 0; i < 4; ++i) { const int idx = tid + NT * i, dk = 2 * (idx & 31), t = idx >> 5;
        o.qw[i] = *(const unsigned*)(prow + (size_t)t * PJ + CGQ + h * 64 + dk); o.kw[i] = *(const unsigned*)(prow + (size_t)t * PJ + CGK + h * 64 + dk); }
#pragma unroll
    for (int i = 0; i < 8; ++i) { const int idx = tid + NT * i, dv = idx & 127, t = 2 * (idx >> 7);
        o.vw0[i] = prow[(size_t)t * PJ + CGV + h * 128 + dv]; o.vw1[i] = prow[(size_t)(t + 1) * PJ + CGV + h * 128 + dv]; }
    const u16* gorow = prow + (size_t)(tid >> 3) * PJ + CGO + h * 128 + (tid & 7) * 16;
    o.g0 = *(const u32x4*)gorow; o.g1 = *(const u32x4*)(gorow + 8);
    { const u16* srow = (const u16*)(p.ws + WS_S16) + (size_t)item * 8192 + (size_t)(mb * 32 + l31) * 64;
#pragma unroll
      for (int s = 0; s < 4; ++s) o.sfr[s] = *(const f16x8*)(srow + 16 * s + 8 * hh); }
#pragma unroll
    for (int i = 0; i < 8; ++i) { const int idx = tid + NT * i, t = idx >> 6, dk = idx & 63; o.bw[i] = ((const float*)(prow + (size_t)t * PJ + CK + h * 128))[dk]; }
}
__device__ __forceinline__ void gla3_item(const Params& p, LAS unsigned char* lds, const G3Ops& ops, int item, int wave, int lane) {
    const int tid = threadIdx.x, c = item & (NCH - 1), h = (item >> 7) & 3, b = item >> 9;
    const int mb = wave >> 1, nb = wave & 1, hh = lane >> 5, l31 = lane & 31;
    const unsigned (&qw)[4] = ops.qw; const unsigned (&kw)[4] = ops.kw; const unsigned (&vw0)[8] = ops.vw0; const unsigned (&vw1)[8] = ops.vw1; const u32x4 g0 = ops.g0, g1 = ops.g1; const f16x8 (&sfr)[4] = ops.sfr;
    LAS float* bc = (LAS float*)(lds + GL_BC);
#pragma unroll
    for (int i = 0; i < 8; ++i) { const int idx = tid + NT * i, t = idx >> 6, dk = idx & 63; bc[t * 65 + dk] = ops.bw[i]; }
    GL_SYNC();
    LAS u16* QD = (LAS u16*)(lds + GL_QD); LAS u16* KD = (LAS u16*)(lds + GL_KD); LAS u16* QP = (LAS u16*)(lds + GL_QP); LAS u16* VTl = (LAS u16*)(lds + GL_VT);
    LAS float* ssq = (LAS float*)(lds + GL_SSQ); LAS float* ost = (LAS float*)(lds + GL_OST);
#pragma unroll
    for (int i = 0; i < 4; ++i) { const int idx = tid + NT * i, dk = 2 * (idx & 31), t = idx >> 5;
        const float b0 = bc[t * 65 + dk], b1 = bc[t * 65 + dk + 1], r0 = bc[31 * 65 + dk], r1 = bc[31 * 65 + dk + 1];
        const float q0 = hlo(qw[i]) * 0.125f, q1 = hhi(qw[i]) * 0.125f;
        *(LAS unsigned*)(QD + t * GST + dk) = pkbf(q0 * __expf(b0 - r0), q1 * __expf(b1 - r1));
        *(LAS unsigned*)(KD + t * GST + dk) = pkbf(hlo(kw[i]) * __expf(r0 - b0), hhi(kw[i]) * __expf(r1 - b1));
        *(LAS unsigned*)(QP + t * GST + dk) = pkh(q0 * __expf(b0), q1 * __expf(b1)); }
#pragma unroll
    for (int i = 0; i < 8; ++i) { const int idx = tid + NT * i, dv = idx & 127, t = 2 * (idx >> 7);
        *(LAS unsigned*)(VTl + dv * GST + (t & ~15) + kperm16(t & 15)) = vw0[i] | (vw1[i] << 16); }
    GL_SYNC();
    f16x8 pf[4];
#pragma unroll
    for (int jb = 0; jb < 2; ++jb) {
        if (jb > nb) {
#pragma unroll
            for (int e = 0; e < 8; ++e) { pf[2 * jb][e] = (_Float16)0.f; pf[2 * jb + 1][e] = (_Float16)0.f; }
            continue; }
        f32x16 x;
#pragma unroll
        for (int i = 0; i < 16; ++i) x[i] = 0.f;
#pragma unroll
        for (int s = 0; s < 4; ++s) { const bf16x8 a = *(const LAS bf16x8*)(KD + (jb * 32 + l31) * GST + 16 * s + 8 * hh), bb = *(const LAS bf16x8*)(QD + (nb * 32 + l31) * GST + 16 * s + 8 * hh);
            x = __builtin_amdgcn_mfma_f32_32x32x16_bf16(a, bb, x, 0, 0, 0); }
#pragma unroll
        for (int i = 0; i < 16; ++i) { const int rowi = (i & 3) + 8 * (i >> 2) + 4 * hh; const bool keep = (jb < nb) || (rowi <= l31); const float v = keep ? x[i] : 0.f;
            pf[2 * jb + (i >> 3)][i & 7] = (_Float16)v; }
    }
    f32x16 o;
#pragma unroll
    for (int i = 0; i < 16; ++i) o[i] = 0.f;
#pragma unroll
    for (int kk = 0; kk < 4; ++kk) { if ((kk >> 1) > nb) continue;
        const f16x8 a = *(const LAS f16x8*)(VTl + (mb * 32 + l31) * GST + 16 * kk + 8 * hh);
        o = __builtin_amdgcn_mfma_f32_32x32x16_f16(a, pf[kk], o, 0, 0, 0); }
#pragma unroll
    for (int s = 0; s < 4; ++s) { const f16x8 bb = *(const LAS f16x8*)(QP + (nb * 32 + l31) * GST + 16 * s + 8 * hh);
        o = __builtin_amdgcn_mfma_f32_32x32x16_f16(sfr[s], bb, o, 0, 0, 0); }
    float part = 0.f;
#pragma unroll
    for (int i = 0; i < 16; ++i) { part += o[i] * o[i]; ost[(nb * 32 + l31) * 132 + mb * 32 + (i & 3) + 8 * (i >> 2) + 4 * hh] = o[i]; }
    part += __shfl_xor(part, 32);
    if (lane < 32) ssq[mb * 64 + nb * 32 + lane] = part;
    GL_SYNC();
    { const int t = tid >> 3, dv0 = (tid & 7) * 16;
      const float rstd = rsqrtf((ssq[t] + ssq[64 + t] + ssq[128 + t] + ssq[192 + t]) * (1.f / 128.f) + EPS);
      const unsigned gw[8] = {g0.x, g0.y, g0.z, g0.w, g1.x, g1.y, g1.z, g1.w};
      unsigned ow[8];
#pragma unroll
      for (int e = 0; e < 8; ++e) { const int dv = dv0 + 2 * e;
          const float a0 = ost[t * 132 + dv] * rstd * p.gla_g[dv] * silu_f(hlo(gw[e])), a1 = ost[t * 132 + dv + 1] * rstd * p.gla_g[dv + 1] * silu_f(hhi(gw[e]));
          ow[e] = pkh(a0, a1); }
      u16* crow = (u16*)(p.ws + WS_CAT) + (size_t)(b * L + c * 64 + t) * D + 512 + h * 128 + dv0;
      u32x4 o0, o1; o0.x = ow[0]; o0.y = ow[1]; o0.z = ow[2]; o0.w = ow[3]; o1.x = ow[4]; o1.y = ow[5]; o1.z = ow[6]; o1.w = ow[7];
      *(u32x4*)crow = o0; *(u32x4*)(crow + 8) = o1; }
    GL_SYNC();
}
}
namespace mk {
__device__ __forceinline__ int idx_row_slot(int r) { return 2 * ((r >> 2) & 1) + (r >> 4); }
__device__ __forceinline__ int idx_row_head(int r) { return (r & 3) + 4 * ((r >> 3) & 1); }
__device__ __forceinline__ float relu_f(float x) { const int i = __builtin_bit_cast(int, x); return __builtin_bit_cast(float, i > 0 ? i : 0); }
__device__ __forceinline__ float fmul_s(float a, float b) { float r; asm("v_mul_f32_e32 %0, %1, %2" : "=v"(r) : "v"(a), "v"(b)); return r; }
__device__ __forceinline__ float fma_s(float a, float b, float c) { asm("v_fmac_f32_e32 %0, %1, %2" : "+v"(c) : "v"(a), "v"(b)); return c; }
template <int BASE> __device__ __forceinline__ float idx_score(const f32x16& acc, const f32x4 wa, const f32x4 wb) {
    float s = fmul_s(wa[0], relu_f(acc[BASE + 0]));
    s = fma_s(wa[1], relu_f(acc[BASE + 1]), s);
    s = fma_s(wa[2], relu_f(acc[BASE + 2]), s); s = fma_s(wa[3], relu_f(acc[BASE + 3]), s);
    s = fma_s(wb[0], relu_f(acc[BASE + 4]), s); s = fma_s(wb[1], relu_f(acc[BASE + 5]), s);
    s = fma_s(wb[2], relu_f(acc[BASE + 6]), s); s = fma_s(wb[3], relu_f(acc[BASE + 7]), s);
    return s;
}
__device__ __forceinline__ unsigned fkey(float f) { f = f + 0.0f; const unsigned u = __builtin_bit_cast(unsigned, f); return u ^ ((unsigned)((int)u >> 31) | 0x80000000u); }
__device__ __forceinline__ int opq(int v) { asm volatile("" : "+v"(v)); return v; }
__device__ __forceinline__ unsigned lds_add(LAS unsigned* p, unsigned v) { return __hip_atomic_fetch_add(p, v, __ATOMIC_RELAXED, __HIP_MEMORY_SCOPE_WORKGROUP); }
__device__ __forceinline__ unsigned wave_prefix_incl(unsigned v) {
#define MK_DPPADD(ctrl, rm) v += (unsigned)__builtin_amdgcn_update_dpp(0, (int)v, ctrl, rm, 0xf, false)
    MK_DPPADD(0x111, 0xf); MK_DPPADD(0x112, 0xf); MK_DPPADD(0x114, 0xf); MK_DPPADD(0x118, 0xf); MK_DPPADD(0x142, 0xa); MK_DPPADD(0x143, 0xc);
#undef MK_DPPADD
    return v;
}
__device__ __forceinline__ unsigned wave_suffix_sum(unsigned x, int lane) {
    const unsigned pre = wave_prefix_incl(x), tot = (unsigned)__builtin_amdgcn_readlane((int)pre, 63);
    return tot - pre + x;
}

template <int NP, int NC>
__device__ __forceinline__ void wave_select(const LAS unsigned* const (&cq)[NC], const unsigned (&sc)[NC][4], const unsigned (&kk0)[NC], LAS unsigned* const (&hq)[NC], int lane, const int (&rp0)[NC], const unsigned (&pre)[NC], unsigned (&out)[NC]) {
    unsigned prefix[NC], mask[NC], kk[NC];
#pragma unroll
    for (int c = 0; c < NC; ++c) { prefix[c] = pre[c]; mask[c] = rp0[c] ? (0xffffffffu << (32 - 8 * rp0[c])) : 0u; kk[c] = kk0[c]; }
    int rpmin = NP;
#pragma unroll
    for (int c = 0; c < NC; ++c) rpmin = rp0[c] < rpmin ? rp0[c] : rpmin;
    for (int rp = rpmin; rp < NP; ++rp) { const int shift = 24 - 8 * rp;
#pragma unroll
        for (int c = 0; c < NC; ++c) { u32x4 z = {0u, 0u, 0u, 0u}; *(LAS u32x4*)(hq[c] + 4 * lane) = z; }
#pragma unroll
        for (int sl = 0; sl < 4; ++sl)
#pragma unroll
            for (int i = 0; i < 4; ++i)
#pragma unroll
                for (int c = 0; c < NC; ++c) { const unsigned idx = lane + 64 * i; if (rp >= rp0[c] && idx < sc[c][sl]) { const unsigned key = fkey(__builtin_bit_cast(float, cq[c][256 * sl + idx])); if ((key & mask[c]) == prefix[c]) lds_add(hq[c] + ((key >> shift) & 255u), 1u); } }
        LDS_WAIT();
        u32x4 cw[NC]; unsigned cs[NC], incl[NC];
#pragma unroll
        for (int c = 0; c < NC; ++c) { cw[c] = *(LAS u32x4*)(hq[c] + 4 * lane); cs[c] = cw[c].x + cw[c].y + cw[c].z + cw[c].w; incl[c] = cs[c]; }
#pragma unroll
        for (int c = 0; c < NC; ++c) incl[c] = wave_suffix_sum(cs[c], lane);
#pragma unroll
        for (int c = 0; c < NC; ++c) { const unsigned above = incl[c] - cs[c]; const bool found = above < kk[c] && kk[c] <= incl[c];
            unsigned dig = 0u, kk2 = 0u;
            if (found) { unsigned cum = above; const unsigned cv[4] = {cw[c].x, cw[c].y, cw[c].z, cw[c].w};
#pragma unroll
                for (int i = 3; i >= 0; --i) { if (kk2 == 0u) { if (cum + cv[i] >= kk[c]) { dig = (unsigned)(4 * lane + i); kk2 = kk[c] - cum; } else cum += cv[i]; } } }
            const unsigned long long bal = __ballot(found); const int src = bal ? (int)__builtin_ctzll(bal) : 0;
            dig = (unsigned)__builtin_amdgcn_readlane((int)dig, src); kk2 = (unsigned)__builtin_amdgcn_readlane((int)kk2, src);
            if (rp >= rp0[c]) { prefix[c] |= dig << shift; mask[c] |= 255u << shift; kk[c] = kk2 ? kk2 : 1u; } }
    }
#pragma unroll
    for (int c = 0; c < NC; ++c) out[c] = prefix[c];
}

constexpr int TH_HIST = 0, TH_CAND = 65536, TH_ST = 131072, TH_A = 133120;
constexpr int ST_LO = 0, ST_RMAX = 16, ST_SH = 32, ST_NEED = 48, ST_MODE = 64, ST_CCNT = 80, ST_HI = 96, ST_ABOVE = 112, ST_WL = 128, ST_SAMP = 256, ST_SCNT = 272, ST_THR = 336, ST_DIRTY = 352;
__device__ __forceinline__ void thr_loadB(f16x8 (&Bf)[4], const u16* KI, int kt) {
#pragma unroll
    for (int s = 0; s < 4; ++s) Bf[s] = *(const f16x8*)(KI + (size_t)(kt * 4 + s) * 512);
}
__device__ __forceinline__ void thr_scores(const f32x16& acc, const LAS float* wl, int mb, int hh, unsigned& k0, unsigned& k1) {
    const LAS float* w0 = wl + (4 * mb + 2 * hh) * 8;
    const f32x4 a0 = *(const LAS f32x4*)(w0), b0 = *(const LAS f32x4*)(w0 + 4), a1 = *(const LAS f32x4*)(w0 + 8), b1 = *(const LAS f32x4*)(w0 + 12);
    k0 = fkey(idx_score<0>(acc, a0, b0)); k1 = fkey(idx_score<8>(acc, a1, b1));
}
constexpr int TH_MASK = 0, TH_CIDX = 16384, TH_SCR = 49152;
__device__ __forceinline__ float key2f(unsigned k) { return __builtin_bit_cast(float, (k & 0x80000000u) ? (k ^ 0x80000000u) : ~k); }
template <int KIND>
__device__ __forceinline__ void thr_sweep(LAS unsigned char* lds, const f16x8 (&A)[2][4], const u16* KI, int t0, int ntiles, int wave, int lane) {
    LAS unsigned* hist = (LAS unsigned*)(lds + TH_HIST); LAS unsigned* cand = (LAS unsigned*)(lds + TH_CAND); LAS unsigned* st = (LAS unsigned*)(lds + TH_ST);
    LAS unsigned* maskb = (LAS unsigned*)(lds + TH_MASK); LAS u16* cidx = (LAS u16*)(lds + TH_CIDX);
    const int hh = lane >> 5, l31 = lane & 31, mbp = wave & 1, ph = wave >> 1;
    unsigned lo[2][2], rmax[2][2], sh[2][2], ccn[2][2]; float lof[2][2], upf[2][2];
#pragma unroll
    for (int mbl = 0; mbl < 2; ++mbl)
#pragma unroll
        for (int jj = 0; jj < 2; ++jj) { const int ql = 8 * mbp + 4 * mbl + 2 * hh + jj; const unsigned lk = st[ST_LO + ql], rm = st[ST_RMAX + ql], uk = lk + rm;
            lo[mbl][jj] = lk; rmax[mbl][jj] = rm; sh[mbl][jj] = st[ST_SH + ql]; ccn[mbl][jj] = 0u;
            lof[mbl][jj] = lk <= 0x007fffffu ? -__builtin_inff() : key2f(lk); upf[mbl][jj] = uk >= 0xff800000u ? (lk == 0xffffffffu ? -__builtin_inff() : __builtin_inff()) : key2f(uk); }
    f16x8 B0[4], B1[4];
    const unsigned cbase4 = (unsigned)(__UINTPTR_TYPE__)(lds + TH_CAND) + ((8 * mbp + 2 * hh) * 1024 + ph * 256) * 4, cbase2 = (unsigned)(__UINTPTR_TYPE__)(lds + TH_CIDX) + ((8 * mbp + 2 * hh) * 1024 + ph * 256) * 2;
    float lofv[2][2] = {{lof[0][0], lof[0][1]}, {lof[1][0], lof[1][1]}};
    float lofc[2][2];
#pragma unroll
    for (int mbl = 0; mbl < 2; ++mbl)
#pragma unroll
        for (int jj = 0; jj < 2; ++jj) lofc[mbl][jj] = ((ntiles - 1) * 32 + l31 <= t0 + 8 * mbp + 4 * mbl + 2 * hh + jj) ? lof[mbl][jj] : __builtin_inff();
    const LAS float* wlb = (const LAS float*)(st + ST_WL) + (8 * mbp + 2 * hh) * 8;
    asm volatile("" : "+v"(wlb));
    f32x4 wreg[2][2][2];
    if (KIND == 1) {
#pragma unroll
        for (int mbl = 0; mbl < 2; ++mbl)
#pragma unroll
            for (int jj = 0; jj < 2; ++jj) { wreg[mbl][jj][0] = *(const LAS f32x4*)(wlb + (4 * mbl + jj) * 8); wreg[mbl][jj][1] = *(const LAS f32x4*)(wlb + (4 * mbl + jj) * 8 + 4); } }
    auto tile = [&](const f16x8 (&BX)[4], int kt, const bool chk) __attribute__((always_inline)) {
        const int skey = kt * 32 + l31;
        f32x16 acc[2];
#pragma unroll
        for (int mbl = 0; mbl < 2; ++mbl) {
#pragma unroll
            for (int i = 0; i < 16; ++i) acc[mbl][i] = 0.f;
#pragma unroll
            for (int s = 0; s < 4; ++s) acc[mbl] = __builtin_amdgcn_mfma_f32_32x32x16_f16(A[mbl][s], BX[s], acc[mbl], 0, 0, 0); }
#pragma unroll
        for (int mbl = 0; mbl < 2; ++mbl)
#pragma unroll
            for (int jj = 0; jj < 2; ++jj) { const int ql = 8 * mbp + 4 * mbl + 2 * hh + jj;
                const f32x4 wa = KIND == 1 ? wreg[mbl][jj][0] : *(const LAS f32x4*)(wlb + (4 * mbl + jj) * 8), wb = KIND == 1 ? wreg[mbl][jj][1] : *(const LAS f32x4*)(wlb + (4 * mbl + jj) * 8 + 4);
                const float sc = jj == 0 ? idx_score<0>(acc[mbl], wa, wb) : idx_score<8>(acc[mbl], wa, wb);
                if (KIND == 0) { const bool caus = !chk || skey <= t0 + ql;
                    const unsigned key = fkey(sc), d = key - lo[mbl][jj]; if (caus && d <= rmax[mbl][jj]) { const unsigned bin = d >> sh[mbl][jj]; lds_add(hist + ql * 1024 + (bin >> 1), 1u << (16 * (bin & 1u))); } }
                else {
                    const unsigned long long bal = __ballot(sc >= lofv[mbl][jj]);
                    const unsigned blo = (unsigned)bal, bhi = (unsigned)(bal >> 32), nlo = (unsigned)__builtin_popcount(blo), nhi = (unsigned)__builtin_popcount(bhi);
                    const unsigned cpk = ccn[mbl][jj] - (nlo << 16);
                    const int base = __builtin_amdgcn_sbfe((int)cpk, 16 * hh, 16);
                    unsigned pos = __builtin_amdgcn_mbcnt_hi(bhi, __builtin_amdgcn_mbcnt_lo(blo, (unsigned)base)); pos = pos < 255u ? pos : 255u;
                    { const unsigned a4 = cbase4 + (4 * mbl + jj) * 4096 + pos * 4, a2 = cbase2 + (4 * mbl + jj) * 2048 + pos * 2; unsigned long long sv;
                      asm volatile("s_and_saveexec_b64 %0, %1\n\tds_write_b32 %2, %3\n\tds_write_b16 %4, %5\n\ts_mov_b64 exec, %0" : "=&s"(sv) : "s"(bal), "v"(a4), "v"(sc), "v"(a2), "v"(skey) : "memory"); }
                    ccn[mbl][jj] += nlo + (nhi << 16); } }
    };
    int kt = ph; const int last = ntiles - 1;
    if (KIND == 0) {
        for (; kt < ntiles; kt += 4) { thr_loadB(B0, KI, kt); tile(B0, kt, true); }
        return; }
    thr_loadB(B0, KI, kt);
#define TH_LASTTHR() do { if (kt == last) { asm volatile("" ::: "memory");   _Pragma("unroll") for (int a = 0; a < 2; ++a) { _Pragma("unroll") for (int c = 0; c < 2; ++c) lofv[a][c] = lofc[a][c]; } } } while (0)
    for (;;) {
        thr_loadB(B1, KI, kt + 4 < last ? kt + 4 : last); TH_LASTTHR(); tile(B0, kt, kt == last); kt += 4; if (kt >= ntiles) break;
        thr_loadB(B0, KI, kt + 4 < last ? kt + 4 : last); TH_LASTTHR(); tile(B1, kt, kt == last); kt += 4; if (kt >= ntiles) break;
    }
#undef TH_LASTTHR
    if (KIND == 1) {
#pragma unroll
        for (int mbl = 0; mbl < 2; ++mbl)
#pragma unroll
            for (int jj = 0; jj < 2; ++jj) {
                if (l31 == 0) st[ST_SCNT + (8 * mbp + 4 * mbl + 2 * hh + jj) * 4 + ph] = (ccn[mbl][jj] >> (16 * hh)) & 0xffffu; } }
}
__device__ __forceinline__ void thr_write_masks(const Params& p, LAS unsigned char* lds, int b, int t0, int ntw) {
    const int tidw = opq(threadIdx.x);
    const LAS unsigned* maskb = (const LAS unsigned*)(lds + TH_MASK); const int q = tidw & 15;
    unsigned* dst = (unsigned*)(p.ws + WS_SELM) + ((size_t)(b * 128 + (t0 >> 6)) * 256) * 64 + (t0 & 63) + q;
    for (int kt = tidw >> 4; kt < ntw; kt += 32) dst[(size_t)kt * 64] = maskb[q * 256 + kt];
}
struct ThrOps { f16x8 A[2][4]; float wl; };
__device__ __forceinline__ void thr_load(const Params& p, ThrOps& o, int b, int qb, int wave) {
    const int tid = opq(threadIdx.x), lane = tid & 63, hh = lane >> 5, l31 = lane & 31, t0 = qb * 16, mbp = wave & 1;
    const u16* P16 = (const u16*)(p.ws + WS_PROJ); const int slot = idx_row_slot(l31), head = idx_row_head(l31);
#pragma unroll
    for (int mbl = 0; mbl < 2; ++mbl) { const u16* qr = P16 + (size_t)(b * L + t0 + 8 * mbp + 4 * mbl + slot) * PJ + CQI + head * 64 + 8 * hh;
#pragma unroll
        for (int s = 0; s < 4; ++s) o.A[mbl][s] = *(const f16x8*)(qr + 16 * s); }
    o.wl = ((const float*)(p.ws + WS_WIDX))[(size_t)(b * L + t0) * 8 + (tid & 127)];
}
#define TH_SYNC() do { asm volatile("s_waitcnt lgkmcnt(0)" ::: "memory"); __builtin_amdgcn_s_barrier(); asm volatile("" ::: "memory"); } while (0)
__device__ __forceinline__ void thr_item(const Params& p, LAS unsigned char* lds, const ThrOps& ops, int b, int qb, int wave, int lane) {
    int tid = opq(threadIdx.x); lane = tid & 63; int hh = lane >> 5, l31 = lane & 31; const int t0 = qb * 16;
#define TH_FRESH() do { tid = opq(tid); lane = tid & 63; hh = lane >> 5; l31 = lane & 31; } while (0)
    LAS unsigned* hist = (LAS unsigned*)(lds + TH_HIST); LAS unsigned* cand = (LAS unsigned*)(lds + TH_CAND); LAS unsigned* st = (LAS unsigned*)(lds + TH_ST);
    LAS unsigned* maskb = (LAS unsigned*)(lds + TH_MASK);
    const int ntw = 2 * (qb >> 2) + 2;
    if (tid < 16) { const int n = t0 + tid + 1;
        if (n <= 256) { st[ST_MODE + tid] = 2u; st[ST_THR + tid] = 0u; }
        else { st[ST_MODE + tid] = 0u; st[ST_LO + tid] = 0u; st[ST_RMAX + tid] = 0xffffffffu; st[ST_SH + tid] = 21u; st[ST_NEED + tid] = 256u; }
        st[ST_SAMP + tid] = 0u; }
    if (tid == 0) st[ST_DIRTY] = 0u;
    if (tid < 128) ((LAS float*)(st + ST_WL))[tid] = ops.wl;
    TH_SYNC();
    if (t0 + 16 <= 256) {
        for (int i = tid; i < 16 * 256; i += NT) { const int q = i >> 8, kt = i & 255, d = t0 + q - kt * 32; maskb[i] = d < 0 ? 0u : (d >= 31 ? 0xffffffffu : (2u << d) - 1u); }
        TH_SYNC(); thr_write_masks(p, lds, b, t0, ntw); TH_SYNC(); return; }
    const u16* P16 = (const u16*)(p.ws + WS_PROJ); const u16* KI = (const u16*)(p.ws + WS_KIDX) + (size_t)b * L * 64 + lane * 8;
    const int mbp = wave & 1, ph = wave >> 1;
    const f16x8 (&A)[2][4] = ops.A;
    const int ntiles = (t0 + 15) / 32 + 1;
    const int sd = ntiles >= 64 ? 8 : (ntiles >= 32 ? 4 : (ntiles >= 16 ? 2 : 1)), soff = sd == 8 ? 3 : (sd == 4 ? 2 : 0), mg = sd == 8 ? 27 : (sd == 4 ? 35 : 41);
    const int ms = ntiles / sd;
    {
        { const LAS float* wlb = (const LAS float*)(st + ST_WL) + (8 * mbp + 2 * hh) * 8; asm volatile("" : "+v"(wlb));
          f16x8 Bs0[4], Bs1[4];
          auto stile = [&](const f16x8 (&Bs)[4], int j) __attribute__((always_inline)) { const int kt = sd * j + soff;
            f32x16 acc[2];
#pragma unroll
            for (int mbl = 0; mbl < 2; ++mbl) {
#pragma unroll
                for (int i = 0; i < 16; ++i) acc[mbl][i] = 0.f;
#pragma unroll
                for (int s = 0; s < 4; ++s) acc[mbl] = __builtin_amdgcn_mfma_f32_32x32x16_f16(A[mbl][s], Bs[s], acc[mbl], 0, 0, 0); }
#pragma unroll
            for (int mbl = 0; mbl < 2; ++mbl)
#pragma unroll
                for (int jj = 0; jj < 2; ++jj) { const int ql = 8 * mbp + 4 * mbl + 2 * hh + jj;
                    const f32x4 wa = *(const LAS f32x4*)(wlb + (4 * mbl + jj) * 8), wb = *(const LAS f32x4*)(wlb + (4 * mbl + jj) * 8 + 4);
                    const float sc = jj == 0 ? idx_score<0>(acc[mbl], wa, wb) : idx_score<8>(acc[mbl], wa, wb);
                    const bool caus = kt * 32 + l31 <= t0 + ql;
                    cand[ql * 1024 + j * 32 + l31] = caus ? __builtin_bit_cast(unsigned, sc) : 0xff800000u; }
          };
          if (ph < ms) { int j = ph; const int jl = ms - 1;
            thr_loadB(Bs0, KI, sd * j + soff);
            for (;;) {
                thr_loadB(Bs1, KI, sd * (j + 4 < jl ? j + 4 : jl) + soff); stile(Bs0, j); j += 4; if (j >= ms) break;
                thr_loadB(Bs0, KI, sd * (j + 4 < jl ? j + 4 : jl) + soff); stile(Bs1, j); j += 4; if (j >= ms) break;
            } } }
        TH_FRESH();
        if (sd == 1) { u32x4 z = {0u, 0u, 0u, 0u};
#pragma unroll
            for (int i = 0; i < 2; ++i) *(LAS u32x4*)(lds + TH_MASK + (tid + NT * i) * 16) = z; }
        TH_SYNC();
        const unsigned m = (unsigned)(ms * 32); const int qa = 2 * wave, qb2 = 2 * wave + 1;
        const unsigned s0 = m < 256u ? m : 256u, s1 = m < 256u ? 0u : (m < 512u ? m - 256u : 256u), s2 = m < 512u ? 0u : (m < 768u ? m - 512u : 256u), s3 = m < 768u ? 0u : m - 768u;
        if (sd == 1) {
            const LAS unsigned* const cq[2] = {cand + qa * 1024, cand + qb2 * 1024}; const unsigned sc[2][4] = {{s0, s1, s2, s3}, {s0, s1, s2, s3}}; const unsigned kk[2] = {256u, 256u};
            LAS unsigned* const hq[2] = {(LAS unsigned*)(lds + TH_SCR) + qa * 256, (LAS unsigned*)(lds + TH_SCR) + qb2 * 256}; const int rp0[2] = {0, 0}; const unsigned pre[2] = {0u, 0u}; unsigned res[2];
            wave_select<4, 2>(cq, sc, kk, hq, lane, rp0, pre, res);
#pragma unroll
            for (int c = 0; c < 2; ++c) { const int q = 2 * wave + c;
                for (int k2 = 0; 2 * k2 < ntiles; ++k2) { const int ki = k2 * 64 + lane; const bool sel = ki < (int)m && ki <= t0 + q && fkey(__builtin_bit_cast(float, cand[q * 1024 + ki])) >= res[c];
                    const unsigned long long bal = __ballot(sel); if (lane == 0) { maskb[q * 256 + 2 * k2] = (unsigned)bal; maskb[q * 256 + 2 * k2 + 1] = (unsigned)(bal >> 32); } }
                if (lane == 0) { st[ST_THR + q] = res[c]; st[ST_MODE + q] = 2u; } }
        } else {
          const float ra = 256.f * (float)m / (float)(t0 + qa + 1), rb = 256.f * (float)m / (float)(t0 + qb2 + 1);
          const int rloa = (int)ra + mg + 1, rlob = (int)rb + mg + 1;
          const LAS unsigned* const cq[2] = {cand + qa * 1024, cand + qb2 * 1024};
          const unsigned sc[2][4] = {{s0, s1, s2, s3}, {s0, s1, s2, s3}};
          const unsigned kk[2] = {(unsigned)(rloa <= (int)m ? rloa : (int)m), (unsigned)(rlob <= (int)m ? rlob : (int)m)};
          LAS unsigned* const hq[2] = {hist + (wave * 2 + 0) * 256, hist + (wave * 2 + 1) * 256};
          const int rp0[2] = {0, 0}; const unsigned pre[2] = {0u, 0u}; unsigned res[2];
          wave_select<2, 2>(cq, sc, kk, hq, lane, rp0, pre, res);
          if (lane == 0) {
              const unsigned loka = rloa <= (int)m ? res[0] : 0u, lokb = rlob <= (int)m ? res[1] : 0u;
              st[ST_MODE + qa] = 1u; st[ST_SAMP + qa] = 1u; st[ST_LO + qa] = loka; st[ST_RMAX + qa] = 0xffffffffu - loka;
              st[ST_MODE + qb2] = 1u; st[ST_SAMP + qb2] = 1u; st[ST_LO + qb2] = lokb; st[ST_RMAX + qb2] = 0xffffffffu - lokb; } }
        TH_SYNC();
    }
    bool clean = true, finalpass = false;
    for (int pass = 0; pass < 10 && sd != 1; ++pass) {
        TH_FRESH();
        { u32x4 z = {0u, 0u, 0u, 0u};
#pragma unroll
          for (int i = 0; i < 8; ++i) *(LAS u32x4*)(lds + TH_HIST + (tid + NT * i) * 16) = z;
          if (tid < 16) { st[ST_CCNT + tid] = 0u;
              if (finalpass) { const unsigned tk = st[ST_THR + tid]; st[ST_LO + tid] = tk; st[ST_RMAX + tid] = 0xffffffffu - tk; st[ST_MODE + tid] = 3u; } } }
        TH_SYNC();
        int kind; { const LAS u32x4* mv = (const LAS u32x4*)(st + ST_MODE); const u32x4 m0 = mv[0], m1 = mv[1], m2 = mv[2], m3 = mv[3];
            const unsigned w[16] = {m0.x, m0.y, m0.z, m0.w, m1.x, m1.y, m1.z, m1.w, m2.x, m2.y, m2.z, m2.w, m3.x, m3.y, m3.z, m3.w}; unsigned anyh = 0u;
#pragma unroll
            for (int q = 0; q < 16; ++q) anyh |= (w[q] == 0u) ? 1u : 0u;
            kind = __builtin_amdgcn_readfirstlane((int)anyh) ? 0 : 1; }
        const bool mpass = clean && pass == 0 && kind == 1;
        if (!mpass) clean = false;
        if (kind == 0) thr_sweep<0>(lds, A, KI, t0, ntiles, wave, lane); else thr_sweep<1>(lds, A, KI, t0, ntiles, wave, lane);
        TH_FRESH();
        TH_SYNC();
        if (finalpass) {
            for (int c = 0; c < 2; ++c) { const int q = 2 * wave + c; const LAS u16* ci = (const LAS u16*)(lds + TH_CIDX) + q * 1024;
#pragma unroll
                for (int sl = 0; sl < 4; ++sl) { const unsigned n = st[ST_SCNT + q * 4 + sl] < 256u ? st[ST_SCNT + q * 4 + sl] : 256u;
                    for (unsigned idx = lane; idx < n; idx += 64) { const unsigned ki = ci[256 * sl + idx];
                        __hip_atomic_fetch_or(maskb + q * 256 + (ki >> 5), 1u << (ki & 31u), __ATOMIC_RELAXED, __HIP_MEMORY_SCOPE_WORKGROUP); } } }
            break; }
        if (kind == 0) {
            for (int qq = 0; qq < 2; ++qq) { const int q = 2 * wave + qq;
                if (st[ST_MODE + q] != 0u) continue;
                const unsigned need = st[ST_NEED + q], shq = st[ST_SH + q], loq = st[ST_LO + q];
                LAS unsigned* hq = hist + q * 1024 + 16 * lane; unsigned c = 0u;
#pragma unroll
                for (int i = 0; i < 16; ++i) { const unsigned w = hq[i]; c += (w & 0xffffu) + (w >> 16); }
                const unsigned incl = wave_suffix_sum(c, lane), above = incl - c;
                if (above < need && need <= incl) {
                    unsigned cum = above, bsel = 0u, bcnt = 0u;
                    for (int i = 31; i >= 0; --i) { const unsigned w = hq[i >> 1], cnt = (i & 1) ? (w >> 16) : (w & 0xffffu); if (cum + cnt >= need) { bsel = (unsigned)(32 * lane + i); bcnt = cnt; break; } cum += cnt; }
                    const unsigned need2 = need - cum, newlo = loq + (bsel << shq);
                    if (bcnt == need2 || shq == 0u) { st[ST_THR + q] = newlo; st[ST_MODE + q] = 2u; st[ST_LO + q] = 0xffffffffu; st[ST_RMAX + q] = 0u; }
                    else { st[ST_LO + q] = newlo; st[ST_RMAX + q] = (1u << shq) - 1u; st[ST_NEED + q] = need2;
                        st[ST_SH + q] = shq > 11u ? shq - 11u : 0u; }
                } }
        } else {
            const LAS unsigned* cq[2]; unsigned sc[2][4], kk[2], pre[2], res[2]; LAS unsigned* hq[2]; int rp0[2]; bool act[2], good[2];
#pragma unroll
            for (int c = 0; c < 2; ++c) { const int q = 2 * wave + c; act[c] = st[ST_MODE + q] == 1u;
#pragma unroll
                for (int sl = 0; sl < 4; ++sl) sc[c][sl] = st[ST_SCNT + q * 4 + sl];
                const unsigned cnt = sc[c][0] + sc[c][1] + sc[c][2] + sc[c][3]; kk[c] = st[ST_NEED + q]; good[c] = sc[c][0] <= 256u && sc[c][1] <= 256u && sc[c][2] <= 256u && sc[c][3] <= 256u;
                good[c] = good[c] && kk[c] <= cnt;
                const unsigned loq = st[ST_LO + q], hiq = loq + st[ST_RMAX + q]; rp0[c] = (loq >> 24) != (hiq >> 24) ? 0 : ((loq >> 16) != (hiq >> 16) ? 1 : 2);
                pre[c] = rp0[c] == 0 ? 0u : (rp0[c] == 1 ? (loq & 0xff000000u) : (loq & 0xffff0000u));
                cq[c] = cand + q * 1024; hq[c] = (LAS unsigned*)(lds + TH_SCR) + q * 256;
                if (!(act[c] && good[c])) { sc[c][0] = 0u; sc[c][1] = 0u; sc[c][2] = 0u; sc[c][3] = 0u; kk[c] = 1u; rp0[c] = 4; } }
            wave_select<4, 2>(cq, sc, kk, hq, lane, rp0, pre, res);
#pragma unroll
            for (int c = 0; c < 2; ++c) { const int q = 2 * wave + c;
                if (!act[c]) continue;
                if (good[c]) { const unsigned key = res[c];
                    if (mpass) {
                        const LAS u16* ci = (const LAS u16*)(lds + TH_CIDX) + q * 1024;
#pragma unroll
                        for (int sl = 0; sl < 4; ++sl)
#pragma unroll
                            for (int i = 0; i < 4; ++i) { const unsigned idx = lane + 64 * i; if (idx < sc[c][sl] && fkey(__builtin_bit_cast(float, cand[q * 1024 + 256 * sl + idx])) >= key) { const unsigned ki = ci[256 * sl + idx];
                                __hip_atomic_fetch_or(maskb + q * 256 + (ki >> 5), 1u << (ki & 31u), __ATOMIC_RELAXED, __HIP_MEMORY_SCOPE_WORKGROUP); } } }
                    if (lane == 0) { st[ST_THR + q] = key; st[ST_MODE + q] = 2u; st[ST_LO + q] = 0xffffffffu; st[ST_RMAX + q] = 0u; } }
                else if (lane == 0) { st[ST_DIRTY] = 1u; st[ST_MODE + q] = 0u; st[ST_SAMP + q] = 0u; st[ST_LO + q] = 0u; st[ST_RMAX + q] = 0xffffffffu; st[ST_SH + q] = 21u; st[ST_NEED + q] = 256u; }
            }
        }
        TH_SYNC();
        bool alldone; { const LAS u32x4* mv = (const LAS u32x4*)(st + ST_MODE); const u32x4 m0 = mv[0], m1 = mv[1], m2 = mv[2], m3 = mv[3];
            const unsigned w[16] = {m0.x, m0.y, m0.z, m0.w, m1.x, m1.y, m1.z, m1.w, m2.x, m2.y, m2.z, m2.w, m3.x, m3.y, m3.z, m3.w}; unsigned nd = 0u;
#pragma unroll
            for (int q = 0; q < 16; ++q) nd |= (w[q] != 2u) ? 1u : 0u;
            alldone = __builtin_amdgcn_readfirstlane((int)nd) == 0; }
        if (alldone) { if (clean && st[ST_DIRTY] == 0u) break; finalpass = true; }
    }
    TH_SYNC();
    thr_write_masks(p, lds, b, t0, ntw);
    TH_SYNC();
#undef TH_FRESH
}
}
namespace mk {
constexpr int AT_MASKR = 0, AT_SSQ = 2560, AT_G = 8192, AT_KVB = 16384, AT_OST = 16384;
#define AT_DMA(gp, lp) __builtin_amdgcn_global_load_lds((const unsigned*)(gp), (LAS unsigned*)(lp), 16, 0, 0)
#define AT_DMAO(gp, lp, off) __builtin_amdgcn_global_load_lds((const unsigned*)(gp), (LAS unsigned*)(lp), 16, off, 0)
#define AT_DMA4(gp, lp) __builtin_amdgcn_global_load_lds((const unsigned*)(gp), (LAS unsigned*)(lp), 4, 0, 0)
__device__ __forceinline__ void att_item(const Params& p, LAS unsigned char* lds, int b, int qblk, int wave, int lane) {
    const int q0 = qblk * 128, g = wave >> 1, h2 = wave & 1, hh = lane >> 5, l31 = lane & 31;
    LAS unsigned* maskr = (LAS unsigned*)(lds + AT_MASKR); LAS float* ssq = (LAS float*)(lds + AT_SSQ);
    LAS float* atg = (LAS float*)(lds + AT_G); atg[threadIdx.x] = p.att_g[threadIdx.x];
    const u16* P16 = (const u16*)(p.ws + WS_PROJ);
    const unsigned* SM = (const unsigned*)(p.ws + WS_SELM) + (size_t)(b * 128 + 2 * qblk + (wave & 1)) * 256 * 64 + lane;
    const int ntiles = 4 * qblk + 4, glast = q0 + 32 * g + 31;
    const float csc = 0.08838834764831845f * 1.4426950408889634f;
    LAS unsigned char* ostw = lds + AT_OST + wave * 8704;
    u16* cbase = (u16*)(p.ws + WS_CAT) + (size_t)(b * L + q0 + 32 * g) * D;
    for (int sp = 0; sp < 2; ++sp) {
        const int h = 2 * sp + h2;
        const unsigned char* KF = (const unsigned char*)(p.ws + WS_KF) + (size_t)(b * 4 + 2 * sp + (wave & 1)) * 256 * 8192 + (size_t)(2 * (wave >> 1)) * 1024 + lane * 16;
        const unsigned char* VF = (const unsigned char*)(p.ws + WS_VT) + (size_t)(b * 4 + 2 * sp + (wave & 1)) * 256 * 8192 + (size_t)(2 * (wave >> 1)) * 1024 + lane * 16;
        const int dofs = (wave & 1) * 8192 + 2 * (wave >> 1) * 1024;
        if (wave < 2) { AT_DMA4(SM, lds + AT_MASKR + wave * 256); AT_DMA4(SM + 64, lds + AT_MASKR + 512 + wave * 256); }
#pragma unroll
        for (int i = 0; i < 2; ++i) { AT_DMA(KF + i * 1024, lds + AT_KVB + dofs + i * 1024); AT_DMA(VF + i * 1024, lds + AT_KVB + 16384 + dofs + i * 1024); }
        f16x8 Qf[8];
        { const u16* qa = P16 + (size_t)(b * L + q0 + 32 * g + l31) * PJ + CQ + h * 128 + 8 * hh;
#pragma unroll
          for (int s = 0; s < 8; ++s) Qf[s] = *(const f16x8*)(qa + 16 * s); }
#pragma unroll
        for (int s = 0; s < 8; ++s) Qf[s] = Qf[s] * (_Float16)csc;
        f32x16 O[4];
#pragma unroll
        for (int d = 0; d < 4; ++d)
#pragma unroll
            for (int i = 0; i < 16; ++i) O[d][i] = 0.f;
        const unsigned char* kfp = KF; const unsigned char* vfp = VF; const unsigned* smp = SM + 64;
        float mrun = 0.f, lsum = 0.f;
        f32x16 negm;
#pragma unroll
        for (int i = 0; i < 16; ++i) negm[i] = 0.f;
        for (int kt = 0; kt < ntiles; ++kt) {
            asm volatile("s_waitcnt vmcnt(0)" ::: "memory");
            __syncthreads();
            const bool act = kt * 32 <= glast;
            const LAS f16x8* kb = (const LAS f16x8*)(lds + AT_KVB + (kt & 1) * 32768 + h2 * 8192) + lane;
            f16x8 kf[8];
            if (act) {
#pragma unroll
                for (int s = 0; s < 8; ++s) kf[s] = kb[s * 64]; }
            kfp += 8192; vfp += 8192; smp += 64;
            asm volatile("" : "+v"(kfp), "+v"(vfp), "+v"(smp));
            if (kt + 1 < ntiles) { const int bo = AT_KVB + ((kt + 1) & 1) * 32768 + dofs;
                AT_DMAO(kfp, lds + bo, 0); AT_DMAO(kfp, lds + bo, 1024); AT_DMAO(vfp, lds + bo + 16384, 0); AT_DMAO(vfp, lds + bo + 16384, 1024); }
            if (kt + 2 < ntiles && wave < 2) AT_DMA4(smp, lds + AT_MASKR + ((kt + 2) & 3) * 512 + wave * 256);
            if (act) {
                f32x16 S = negm;
#pragma unroll
                for (int s = 0; s < 8; ++s) S = __builtin_amdgcn_mfma_f32_32x32x16_f16(kf[s], Qf[s], S, 0, 0, 0);

                const unsigned bits = maskr[(kt & 3) * 128 + 32 * g + l31] >> (4 * hh);
                f16x8 vf[8];
                const unsigned av = (unsigned)(__UINTPTR_TYPE__)(lds + AT_KVB + (kt & 1) * 32768 + 16384 + h2 * 8192) + lane * 16;
#define AT_RD(dst, off, dep) asm volatile("ds_read_b128 %0, %1 offset:" #off : "=v"(dst) : "v"(av), "v"(dep))
                AT_RD(vf[0], 0, bits); AT_RD(vf[2], 2048, bits); AT_RD(vf[4], 4096, bits); AT_RD(vf[6], 6144, bits);
                int mxi = 0;
#pragma unroll
                for (int i = 0; i < 16; ++i) { const unsigned mk = (unsigned)__builtin_amdgcn_sbfe((int)bits, (i & 3) + 8 * (i >> 2), 1); const float si = S[i];
                    S[i] = __builtin_bit_cast(float, (__builtin_bit_cast(unsigned, si) & mk) | (0xff61b1e6u & ~mk)); }
#pragma unroll
                for (int i = 0; i < 16; i += 2) { const float a = S[i], c = S[i + 1]; const int ai = __builtin_bit_cast(int, a), ci = __builtin_bit_cast(int, c); const int t = mxi > ai ? mxi : ai; mxi = t > ci ? t : ci; }
                { const auto r = __builtin_amdgcn_permlane32_swap((unsigned)mxi, (unsigned)mxi, false, false); const int r0 = (int)r[0], r1 = (int)r[1]; mxi = r0 > r1 ? r0 : r1; }
                const float mx = __builtin_bit_cast(float, mxi);
                if (__ballot(mx > 8.f)) { const float dlt = mx > 8.f ? mx : 0.f, alpha = __builtin_amdgcn_exp2f(-dlt);
                    mrun += dlt; lsum *= alpha;
#pragma unroll
                    for (int d = 0; d < 4; ++d)
#pragma unroll
                        for (int i = 0; i < 16; ++i) O[d][i] *= alpha;
#pragma unroll
                    for (int i = 0; i < 16; ++i) { S[i] -= dlt; negm[i] = -mrun; } }
                float ps = 0.f; f16x8 pf[2];
#pragma unroll
                for (int i = 0; i < 16; ++i) { const float pe = __builtin_amdgcn_exp2f(S[i]); ps += pe; pf[i >> 3][i & 7] = (_Float16)pe; }
                lsum += ps;
                asm volatile("s_waitcnt lgkmcnt(0)" : "+v"(vf[0]), "+v"(vf[2]), "+v"(vf[4]), "+v"(vf[6]));
                AT_RD(vf[1], 1024, vf[0]); AT_RD(vf[3], 3072, vf[0]); AT_RD(vf[5], 5120, vf[0]); AT_RD(vf[7], 7168, vf[0]);
#undef AT_RD
#pragma unroll
                for (int d = 0; d < 4; ++d) O[d] = __builtin_amdgcn_mfma_f32_32x32x16_f16(vf[d * 2], pf[0], O[d], 0, 0, 0);
                asm volatile("s_waitcnt lgkmcnt(0)" : "+v"(vf[1]), "+v"(vf[3]), "+v"(vf[5]), "+v"(vf[7]));
#pragma unroll
                for (int d = 0; d < 4; ++d) O[d] = __builtin_amdgcn_mfma_f32_32x32x16_f16(vf[d * 2 + 1], pf[1], O[d], 0, 0, 0);
            }
        }
        int lane2 = lane; asm volatile("" : "+v"(lane2)); const int l31b = lane2 & 31, hhb = lane2 >> 5;
        const float ltot = lsum + __shfl_xor(lsum, 32), inv = 1.f / ltot;
        float part = 0.f;
#pragma unroll
        for (int d = 0; d < 4; ++d)
#pragma unroll
            for (int i = 0; i < 16; ++i) { O[d][i] *= inv; part += O[d][i] * O[d][i]; }
        part += __shfl_xor(part, 32);
        if (lane2 < 32) ssq[h * 128 + 32 * g + lane2] = part;
        __syncthreads();
        const int qi = 32 * g + l31b;
        const float rstd = sp == 0 ? 1.f : rsqrtf((ssq[qi] + ssq[128 + qi] + ssq[256 + qi] + ssq[384 + qi]) * (1.f / 512.f) + EPS);
#pragma unroll
        for (int d = 0; d < 4; ++d)
#pragma unroll
            for (int ip = 0; ip < 8; ++ip) { const int i = 2 * ip, dv = d * 32 + (i & 3) + 8 * (i >> 2) + 4 * hhb;
                const f32x2 gp = *(const LAS f32x2*)(atg + h * 128 + dv); const float g0 = sp == 0 ? 1.f : gp.x, g1 = sp == 0 ? 1.f : gp.y;
                *(LAS unsigned*)(ostw + l31b * 272 + dv * 2) = pkh(O[d][i] * rstd * g0, O[d][i + 1] * rstd * g1); }
        LDS_WAIT(); asm volatile("" ::: "memory");
#pragma unroll
        for (int i = 0; i < 8; ++i) { const int idx = i * 64 + lane2, row = idx >> 4, ch = idx & 15;
            const u32x4 v = *(const LAS u32x4*)(ostw + row * 272 + ch * 16); *(u32x4*)(cbase + (size_t)row * D + h * 128 + ch * 8) = v; }
        if (sp == 0) __syncthreads();
    }
    {
            int lane2 = lane; asm volatile("" : "+v"(lane2));
            asm volatile("s_waitcnt vmcnt(0)" ::: "memory");
#pragma unroll
            for (int i = 0; i < 8; ++i) { const int idx = i * 64 + lane2, row = idx >> 4, ch = idx & 15;
                u16* ptr = cbase + (size_t)row * D + h2 * 128 + ch * 8; const u32x4 v = *(const u32x4*)ptr; const int qr = 32 * g + row;
                const float rs = rsqrtf((ssq[qr] + ssq[128 + qr] + ssq[256 + qr] + ssq[384 + qr]) * (1.f / 512.f) + EPS);
                const unsigned wv[4] = {v.x, v.y, v.z, v.w}; unsigned ov[4];
#pragma unroll
                for (int e = 0; e < 4; ++e) { const int dv = ch * 8 + 2 * e; const f32x2 gp = *(const LAS f32x2*)(atg + h2 * 128 + dv); ov[e] = pkh(hlo(wv[e]) * rs * gp.x, hhi(wv[e]) * rs * gp.y); }
                u32x4 o; o.x = ov[0]; o.y = ov[1]; o.z = ov[2]; o.w = ov[3]; *(u32x4*)ptr = o; } }
    __syncthreads();
}

__device__ __forceinline__ void phase_p3(const Params& p, LAS unsigned char* lds, int wave, int lane) {
    const int G = gridDim.x, bx = blockIdx.x;
    { LAS unsigned char* scr = lds + wave * 8704; const int gw = bx * NWAVES + wave, NGW = G * NWAVES;
      for (int it = gw; it < NB * 4 * (L / 32); it += NGW) vt_item(p, scr, it, lane); }
    __syncthreads();
    for (int it = bx; it < NB * 4 * NCH; it += G) gla1_item(p, lds, it, wave, lane);
    {
    if (G == 256) { const int bt = bx & 7, j = bx >> 3;
        ThrOps cur; thr_load(p, cur, bt, j, wave);
        for (int r = 0; r < 16; ++r) { const int qb = (r & 1) ? 511 - (32 * (r >> 1) + j) : 32 * (r >> 1) + j; const int rn = r < 15 ? r + 1 : r, qbn = (rn & 1) ? 511 - (32 * (rn >> 1) + j) : 32 * (rn >> 1) + j;
            ThrOps nxt; thr_load(p, nxt, bt, qbn, wave);
            thr_item(p, lds, cur, bt, qb, wave, lane); cur = nxt; } }
    else { for (int it = bx; it < NB * 512; it += G) { ThrOps cur; thr_load(p, cur, it >> 9, it & 511, wave); thr_item(p, lds, cur, it >> 9, it & 511, wave, lane); } } }
}
__device__ __forceinline__ void phase_p5(const Params& p, LAS unsigned char* lds, int wave, int lane) {
    const int G = gridDim.x, bx = blockIdx.x;
    if (G == 256) { const int bt = bx & 7, j = bx >> 3;
        for (int r = 0; r < 2; ++r) att_item(p, lds, bt, r == 0 ? 63 - j : j, wave, lane); }
    else { for (int it = bx; it < NB * 64; it += G) att_item(p, lds, it >> 6, it & 63, wave, lane); }
    { const int N = NB * 4 * NCH; G3Ops cur; if (bx < N) gla3_load(p, cur, bx, wave, lane);
      for (int it = bx; it < N; it += G) { G3Ops nxt; gla3_load(p, nxt, it + G < N ? it + G : it, wave, lane);
          gla3_item(p, lds, cur, it, wave, lane); cur = nxt; }
      __syncthreads(); }
}
}
namespace mk {
#define XB_TMO      128
#define XB_XCNT(j)  (256  + 64 * (j))
#define XB_XSUB(j)  (1280 + 64 * (j))
#define XB_XGEN(j)  (2304 + 64 * (j))
#define XB_TOP      3328
#define XB_TOPGEN   3392
#define XCD_BAR_WORDS 3456
#define XB_SPIN_CAP (1u << 18)

__device__ __forceinline__ unsigned xb_ld(unsigned* p)              { return __hip_atomic_load(p, __ATOMIC_RELAXED, __HIP_MEMORY_SCOPE_AGENT); }
__device__ __forceinline__ unsigned xb_add(unsigned* p, unsigned v) { return __hip_atomic_fetch_add(p, v, __ATOMIC_RELAXED, __HIP_MEMORY_SCOPE_AGENT); }
__device__ __forceinline__ unsigned xb_xcc_id() { return (unsigned)__builtin_amdgcn_s_getreg((3 << 11) | 20) & 0xFu; }
#define XB_SPIN(cond, bar) do { unsigned _sp = 0; while (cond) { __builtin_amdgcn_s_sleep(1); \
    if ((++_sp & 255u) == 0u) { if (xb_ld(&(bar)[XB_TMO])) break; if (_sp > XB_SPIN_CAP) { atomicAdd(&(bar)[XB_TMO], 1u); break; } } } } while (0)

struct XcdBarrier {
    unsigned* bar; unsigned x;
    volatile LAS unsigned* st;
};

__device__ __forceinline__ XcdBarrier xcd_barrier_post(unsigned* bar, volatile LAS unsigned* st) {
    XcdBarrier b; b.bar = bar; b.x = xb_xcc_id(); b.st = st;
    if (threadIdx.x == 0) (void)xb_add(&bar[XB_XCNT(b.x)], 1u);
    return b;
}
__device__ __forceinline__ void xcd_barrier_complete(unsigned* bar, unsigned x, unsigned& nloc, unsigned& nx) {
    const unsigned G = gridDim.x * gridDim.y * gridDim.z;
    unsigned sum, cnt, mine, sp = 0u;
    for (;;) {
        sum = 0u; cnt = 0u; mine = 0u;
#pragma unroll
        for (unsigned j = 0; j < 16; ++j) { const unsigned c = xb_ld(&bar[XB_XCNT(j)]); sum += c; cnt += (c > 0u) ? 1u : 0u; mine = (j == x) ? c : mine; }
        if (sum == G) break;
        __builtin_amdgcn_s_sleep(1);
        if ((++sp & 255u) == 0u) { if (xb_ld(&bar[XB_TMO])) break; if (sp > XB_SPIN_CAP) { atomicAdd(&bar[XB_TMO], 1u); break; } }
    }
    nloc = mine > 0u ? mine : 1u; nx = cnt > 0u ? cnt : 1u;
}

__device__ __forceinline__ void xcd_barrier(const XcdBarrier& b) {
    asm volatile("s_waitcnt vmcnt(0)" ::: "memory");
    __syncthreads();
    if (threadIdx.x == 0) {
        unsigned* bar = b.bar;
        __builtin_amdgcn_s_waitcnt(0);
        unsigned nloc = b.st[0], nx = b.st[1];
        if (nloc == 0u) { xcd_barrier_complete(bar, b.x, nloc, nx); b.st[0] = nloc; b.st[1] = nx; }
        const unsigned old = xb_add(&bar[XB_XSUB(b.x)], 1u);
        const unsigned gen = old / nloc;
        if (old + 1u == (gen + 1u) * nloc) {
            __builtin_amdgcn_fence(__ATOMIC_RELEASE, "agent");
            asm volatile("s_waitcnt vmcnt(0)" ::: "memory");
            const unsigned og = xb_add(&bar[XB_TOP], 1u);
            const unsigned tg = og / nx;
            if (og + 1u == (tg + 1u) * nx) xb_add(&bar[XB_TOPGEN], 1u);
            else XB_SPIN(xb_ld(&bar[XB_TOPGEN]) == tg, bar);
            __builtin_amdgcn_fence(__ATOMIC_ACQUIRE, "agent");
            xb_add(&bar[XB_XGEN(b.x)], 1u);
            asm volatile("s_waitcnt vmcnt(0)" ::: "memory");
        } else {
            XB_SPIN(xb_ld(&bar[XB_XGEN(b.x)]) == gen, bar);
            __builtin_amdgcn_fence(__ATOMIC_ACQUIRE, "agent");
            asm volatile("s_waitcnt vmcnt(0)" ::: "memory");
        }
    }
    __syncthreads();
}

}
namespace mk {
namespace cg = cooperative_groups;
constexpr int NPHASE = 11;
__global__ void __launch_bounds__(NT, 2) mk_fwd(Params p) {
    extern __shared__ __attribute__((aligned(16))) unsigned char lds_raw[];
    LAS unsigned char* lds = (LAS unsigned char*)lds_raw;
    cg::grid_group grid = cg::this_grid();
    const int tid = threadIdx.x, lane = tid & 63, wave = __builtin_amdgcn_readfirstlane(tid >> 6);
    unsigned char* ws = p.ws;
    float* mod = (float*)(ws + WS_MOD);
    volatile LAS unsigned* xst = (volatile LAS unsigned*)(lds + LDS_BYTES - 64);
    if (tid == 0) { xst[0] = 0u; xst[1] = 0u; }
    __syncthreads();
    const XcdBarrier xbar = xcd_barrier_post((unsigned*)(ws + WS_CTL), xst);
#define IN(k) (p.ph_lo <= (k) && (k) < p.ph_hi)
#define SEAM(k) do { if (IN(k) && IN((k) + 1)) { if ((k) == 0) grid.sync(); else xcd_barrier(xbar); } } while (0)
    if (IN(0)) { phase_p0a(p, lds, wave, lane); __syncthreads(); }
    SEAM(0);
    if (IN(1)) { row_phase<0>(p.x, p.norm1_g, mod, 0, D, nullptr, ws + WS_H, wave, lane); phase_p0b(p, lds, wave, lane); }
    SEAM(1);
    if (IN(2)) {
        pg8::Gemm g{(const pg8::bf16_t*)(ws + WS_H), (const pg8::bf16_t*)(ws + WS_WIN), T, 3840, D}; pg8::StaticOrder S; S.init(T, 3840, gridDim.x, blockIdx.x);
        EpiProj E{(u16*)(ws + WS_PROJ), (u16*)(ws + WS_KIDX), (float*)(ws + WS_WIDX), (float*)(ws + WS_GLR), (u16*)(ws + WS_KF)};
        pg8::gemm_phase<EpiProj, pg8::StaticOrder>(lds, g, S, E);
    }
    SEAM(2);
    if (IN(3)) phase_p3(p, lds, wave, lane);
    SEAM(3);
    if (IN(4)) phase_p4(p, lds, wave, lane);
    SEAM(4);
    if (IN(5)) phase_p5(p, lds, wave, lane);
    SEAM(5);
    if (IN(6)) {
        pg8::Gemm g{(const pg8::bf16_t*)(ws + WS_CAT), (const pg8::bf16_t*)(ws + WS_WOUT), T, D, D}; pg8::StaticOrder S; S.init(T, D, gridDim.x, blockIdx.x);
        EpiRes<false> E{p.x, (u16*)(ws + WS_X16), mod, (float*)(ws + WS_SS1), 2 * D, 0};
        pg8::gemm_phase<EpiRes<false>, pg8::StaticOrder>(lds, g, S, E);
    }
    SEAM(6);
    if (IN(7)) row_phase<1>(ws + WS_X16, p.norm2_g, mod, 3 * D, 4 * D, (const float*)(ws + WS_SS1), ws + WS_H, wave, lane);
    SEAM(7);
    if (IN(8)) {
        pg8::Gemm g{(const pg8::bf16_t*)(ws + WS_H), (const pg8::bf16_t*)(ws + WS_WGU), T, 2 * DFF, D}; pg8::StaticOrder S; S.init(T, 2 * DFF, gridDim.x, blockIdx.x);
        EpiSwiGLU E{(u16*)(ws + WS_ACT)};
        pg8::gemm_phase<EpiSwiGLU, pg8::StaticOrder>(lds, g, S, E);
    }
    SEAM(8);
    if (IN(9)) {
        pg8::Gemm g{(const pg8::bf16_t*)(ws + WS_ACT), (const pg8::bf16_t*)(ws + WS_WDN), T, D, DFF}; pg8::StaticOrder S; S.init(T, D, gridDim.x, blockIdx.x);
        EpiRes<true> E{ws + WS_X16, (u16*)(ws + WS_X16), mod, (float*)(ws + WS_SS2), 5 * D, 0};
        pg8::gemm_phase<EpiRes<true>, pg8::StaticOrder>(lds, g, S, E);
    }
    SEAM(9);
    if (IN(10)) row_phase<2>(ws + WS_X16, p.final_g, nullptr, 0, 0, (const float*)(ws + WS_SS2), p.out, wave, lane);
#undef IN
#undef SEAM
}

static int g_grid = 0;
static Params make_params(void* const* d_in, void* d_out, void* d_ws) {
    Params p{};
    p.x = (const float*)d_in[0]; p.c = (const float*)d_in[1]; p.w_mod = (const float*)d_in[2]; p.b_mod = (const float*)d_in[3]; p.norm1_g = (const float*)d_in[4];
    p.w_in = (const float*)d_in[5]; p.w_gate2 = (const float*)d_in[6]; p.b_gate2 = (const float*)d_in[7]; p.att_g = (const float*)d_in[8]; p.gla_g = (const float*)d_in[9];
    p.w_out = (const float*)d_in[10]; p.norm2_g = (const float*)d_in[11]; p.w_gu = (const float*)d_in[12]; p.w_down = (const float*)d_in[13]; p.final_g = (const float*)d_in[14];
    p.out = (float*)d_out; p.ws = (unsigned char*)d_ws; p.ph_lo = 0; p.ph_hi = NPHASE;
    return p;
}
static bool init_grid(size_t ws_size) {
    if (g_grid) return g_grid > 0;
    int dev = 0, cus = 0, per_cu = 0;
    if (hipGetDevice(&dev) != hipSuccess || hipDeviceGetAttribute(&cus, hipDeviceAttributeMultiprocessorCount, dev) != hipSuccess) { g_grid = -1; return false; }
    if (hipFuncSetAttribute((const void*)mk_fwd, hipFuncAttributeMaxDynamicSharedMemorySize, LDS_BYTES) != hipSuccess) { fprintf(stderr, "hipFuncSetAttribute failed\n"); g_grid = -1; return false; }
    if (hipOccupancyMaxActiveBlocksPerMultiprocessor(&per_cu, (const void*)mk_fwd, NT, LDS_BYTES) != hipSuccess || per_cu < 1) { fprintf(stderr, "occupancy query: %d blocks/CU\n", per_cu); g_grid = -1; return false; }
    if (ws_size < WS_END) { fprintf(stderr, "workspace too small: %zu < %zu\n", ws_size, (size_t)WS_END); g_grid = -1; return false; }
    g_grid = cus;
    fprintf(stderr, "mk: grid %d, per_cu %d, ws %zu\n", g_grid, per_cu, ws_size);
    return true;
}
static void launch(Params p, int lo, int hi, hipStream_t stream) {
    p.ph_lo = lo; p.ph_hi = hi;
    if (hipMemsetAsync(p.ws + WS_CTL, 0, 16384, stream) != hipSuccess) { fprintf(stderr, "hipMemsetAsync of the barrier words failed\n"); return; }
    void* args[] = {&p};
    const hipError_t e = hipLaunchCooperativeKernel((const void*)mk_fwd, dim3(g_grid), dim3(NT), args, LDS_BYTES, stream);
    if (e != hipSuccess) fprintf(stderr, "cooperative launch failed: %s (grid %d)\n", hipGetErrorString(e), g_grid);
}
}

extern "C" void kernel_launch(void* const* d_in, const int* in_sizes, int n_in, void* d_out, int out_size, void* d_ws, size_t ws_size, hipStream_t stream) {
    using namespace mk;
    if (n_in != 15 || out_size != T * D) { fprintf(stderr, "kernel_launch: unexpected problem shape\n"); return; }
    if (!init_grid(ws_size)) return;
    Params p = make_params(d_in, d_out, d_ws);
    launch(p, 0, NPHASE, stream);
}
```

```cpp
#include <hip/hip_runtime.h>
#include <hip/hip_cooperative_groups.h>
#include <cstdio>
#include <cstdint>
#include <cmath>
namespace pg8 {
#define PG8_LAS __attribute__((address_space(3)))
typedef unsigned short bf16_t;
typedef _Float16 bf16x8 __attribute__((ext_vector_type(8)));
typedef float f32x4 __attribute__((ext_vector_type(4)));
typedef unsigned u32x4 __attribute__((ext_vector_type(4)));
constexpr int BM = 256, BK = 64, HALF = 128, HTB = HALF * BK * 2  , STAGE_BYTES = 8 * HTB, NXCD = 8, WGM = 8;

__host__ __device__ __forceinline__ int lds_byte(int r, int c) { const int st = (r >> 4) * 2 + (c >> 5), rr = r & 15, cc = c & 31, ob = rr * 64 + cc * 2; return st * 1024 + (ob ^ (((ob >> 9) & 1) << 5)); }
__host__ __device__ __forceinline__ void stage_rc(int b, int& R, int& C) { const int st = b / 1024, sb = b % 1024, swz = sb ^ (((sb >> 9) & 1) << 5); R = (st >> 1) * 16 + swz / 64; C = (st & 1) * 32 + (swz % 64) / 2; }
__host__ __device__ __forceinline__ int perm32(int rho) { const int n = rho >> 4, i = rho & 15; return 8 * (i >> 2) + 4 * n + (i & 3); }

struct Unit { int pm, pn; };
struct Gemm { const bf16_t* A; const bf16_t* Bt; int M, N, K; };

struct StaticOrder {
    int nM, nN, nwg, G, c, wgm;
    __host__ __device__ void init(int M, int N, int G_, int c_, int wgm_ = WGM) { nM = M / BM; nN = N / BM; nwg = nM * nN; G = G_; c = c_; wgm = wgm_; }
    __host__ __device__ bool next(int i, Unit& u) const {
        const long L = (long)i * G + c; if (L >= nwg) return false;
        int wgid = (int)L; { const int q = nwg / NXCD, r = nwg % NXCD, xcd = wgid % NXCD, off = wgid / NXCD; wgid = (xcd < r ? xcd * (q + 1) : r * (q + 1) + (xcd - r) * q) + off; }
        const int nig = wgm * nN, gid = wgid / nig, fm = gid * wgm, gsz = (nM - fm) < wgm ? (nM - fm) : wgm;
        u.pm = fm + ((wgid % nig) % gsz); u.pn = (wgid % nig) / gsz; return true;
    }
    __device__ __forceinline__ void a_ready(const Unit&) const {}
    __device__ __forceinline__ void done(const Unit&) const {}
};
template <class Epi, class Sched>
__device__ __forceinline__ void gemm_phase(PG8_LAS unsigned char* lds, const Gemm g, const Sched& S, const Epi& E) {
    const int tid = threadIdx.x, wid = __builtin_amdgcn_readfirstlane(tid >> 6), lane = tid & 63, wr = wid >> 2, wc = wid & 3, fr = lane & 15, fq = lane >> 4;
    const int K = g.K, nt = K / BK;
    unsigned voffA[2], voffB[2];
#pragma unroll
    for (int i = 0; i < 2; ++i) { int R, C; stage_rc(tid * 16 + i * 8192, R, C); const int Rb = Epi::PERM ? ((R & ~31) + perm32(R & 31)) : R;
        voffA[i] = (unsigned)(R * K + C) * 2u; voffB[i] = (unsigned)(Rb * K + C) * 2u; }
    const size_t kstep = (size_t)(BK * 2);
    const size_t hstep = (size_t)HALF * K * 2;
    const size_t tstep = 2 * hstep;
    const unsigned ldsw = (unsigned)wid * 1024u;
    const int aoff = lds_byte(wr * 64 + fr, fq * 8), boff = lds_byte(wc * 32 + fr, fq * 8);
#define PG8_SA(b, h) (((b) * 2 + (h)) * HTB)
#define PG8_SB(b, h) ((4 + (b) * 2 + (h)) * HTB)
#define PG8_STAGE(bufoff, gbase, voff) do { _Pragma("unroll") for (int _i = 0; _i < 2; ++_i) \
        __builtin_amdgcn_global_load_lds((const unsigned*)((const char*)(gbase) + (voff)[_i]), (PG8_LAS unsigned*)(lds + (bufoff) + ldsw + _i * 8192), 16, 0, 0); } while (0)
#define PG8_LDA(dst, b, h) do { _Pragma("unroll") for (int m = 0; m < 4; ++m) _Pragma("unroll") for (int k = 0; k < 2; ++k) dst[m][k] = *(const PG8_LAS bf16x8*)(lds + PG8_SA(b, h) + aoff + m * 2048 + k * 1024); } while (0)
#define PG8_LDB(dst, b, h) do { _Pragma("unroll") for (int n = 0; n < 2; ++n) _Pragma("unroll") for (int k = 0; k < 2; ++k) dst[n][k] = *(const PG8_LAS bf16x8*)(lds + PG8_SB(b, h) + boff + n * 2048 + k * 1024); } while (0)
#define PG8_MMA(ai, bj, At, Bt) do { __builtin_amdgcn_s_setprio(1); _Pragma("unroll") for (int m = 0; m < 4; ++m) _Pragma("unroll") for (int n = 0; n < 2; ++n) _Pragma("unroll") for (int k = 0; k < 2; ++k) \
        acc[ai][bj][m][n] = __builtin_amdgcn_mfma_f32_16x16x32_f16(Bt[n][k], At[m][k], acc[ai][bj][m][n], 0, 0, 0); __builtin_amdgcn_s_setprio(0); } while (0)
#define PG8_WAIT_V(n) asm volatile("s_waitcnt vmcnt(" #n ")" ::: "memory")
#define PG8_WAIT_L(n) asm volatile("s_waitcnt lgkmcnt(" #n ")" ::: "memory")
#define PG8_BAR __builtin_amdgcn_s_barrier()
#define PG8_SCHED __builtin_amdgcn_sched_barrier(0)
    Unit cur, nxt; int ui = 0;
    if (!S.next(0, cur)) return;
    f32x4 acc[2][2][4][2];
#pragma unroll
    for (int a = 0; a < 2; ++a)
#pragma unroll
        for (int b = 0; b < 2; ++b)
#pragma unroll
            for (int m = 0; m < 4; ++m)
#pragma unroll
                for (int n = 0; n < 2; ++n) acc[a][b][m][n] = (f32x4){0.f, 0.f, 0.f, 0.f};
    bf16x8 At[4][2], B0[2][2], B1[2][2];
    const char* cA = (const char*)g.A + (size_t)cur.pm * tstep; const char* cB = (const char*)g.Bt + (size_t)cur.pn * tstep;
    S.a_ready(cur);
    PG8_STAGE(PG8_SB(0, 0), cB, voffB); PG8_STAGE(PG8_SA(0, 0), cA, voffA); PG8_STAGE(PG8_SB(0, 1), cB + hstep, voffB); PG8_STAGE(PG8_SA(0, 1), cA + hstep, voffA);
    if (wr == 1) PG8_BAR;
    PG8_WAIT_V(4); PG8_BAR;
    PG8_STAGE(PG8_SB(1, 0), cB + kstep, voffB); PG8_STAGE(PG8_SA(1, 0), cA + kstep, voffA); PG8_STAGE(PG8_SB(1, 1), cB + hstep + kstep, voffB);
    PG8_WAIT_V(6); PG8_BAR;
    for (;;) {
        const bool has_next = S.next(ui + 1, nxt);
        const char* nA = has_next ? (const char*)g.A + (size_t)nxt.pm * tstep : cA; const char* nB = has_next ? (const char*)g.Bt + (size_t)nxt.pn * tstep : cB;
        for (int t = 0; t < nt; t += 2) {
            const bool last = (t == nt - 2);
            const char* a1 = cA + (size_t)(t + 1) * kstep;
            const char* a2 = last ? nA : cA + (size_t)(t + 2) * kstep; const char* b2 = last ? nB : cB + (size_t)(t + 2) * kstep;
            const char* a3 = a2 + kstep; const char* b3 = b2 + kstep;
            if (last && has_next) S.a_ready(nxt);
            PG8_LDB(B0, 0, 0); PG8_SCHED; PG8_LDA(At, 0, 0); PG8_STAGE(PG8_SA(1, 1), a1 + hstep, voffA);
            PG8_WAIT_L(8); PG8_BAR; PG8_WAIT_L(0); PG8_MMA(0, 0, At, B0); PG8_BAR; PG8_SCHED;
            PG8_LDB(B1, 0, 1); PG8_STAGE(PG8_SB(0, 0), b2, voffB);
            PG8_BAR; PG8_WAIT_L(0); PG8_MMA(0, 1, At, B1); PG8_BAR;
            PG8_LDA(At, 0, 1); PG8_STAGE(PG8_SA(0, 0), a2, voffA);
            PG8_BAR; PG8_WAIT_L(0); PG8_MMA(1, 0, At, B0); PG8_BAR; PG8_SCHED;
            PG8_STAGE(PG8_SB(0, 1), b2 + hstep, voffB);
            PG8_WAIT_V(6); PG8_BAR; PG8_MMA(1, 1, At, B1); PG8_BAR;
            PG8_LDB(B0, 1, 0); PG8_SCHED; PG8_LDA(At, 1, 0); PG8_STAGE(PG8_SA(0, 1), a2 + hstep, voffA);
            PG8_WAIT_L(8); PG8_BAR; PG8_WAIT_L(0); PG8_MMA(0, 0, At, B0); PG8_BAR; PG8_SCHED;
            PG8_LDB(B1, 1, 1); PG8_STAGE(PG8_SB(1, 0), b3, voffB);
            PG8_BAR; PG8_WAIT_L(0); PG8_MMA(0, 1, At, B1); PG8_BAR;
            PG8_LDA(At, 1, 1); PG8_STAGE(PG8_SA(1, 0), a3, voffA);
            PG8_BAR; PG8_WAIT_L(0); PG8_MMA(1, 0, At, B0); PG8_BAR; PG8_SCHED;
            PG8_STAGE(PG8_SB(1, 1), b3 + hstep, voffB);
            PG8_WAIT_V(6); PG8_BAR; PG8_MMA(1, 1, At, B1); PG8_BAR;
        }
        if constexpr (!Epi::AFTER_DRAIN) { E(acc, cur, wr, wc, fr, fq); S.done(cur); }
        if (!has_next) break;
#pragma unroll
        for (int a = 0; a < 2; ++a)
#pragma unroll
            for (int b = 0; b < 2; ++b)
#pragma unroll
                for (int m = 0; m < 4; ++m)
#pragma unroll
                    for (int n = 0; n < 2; ++n) acc[a][b][m][n] = (f32x4){0.f, 0.f, 0.f, 0.f};
        cur = nxt; cA = nA; cB = nB; ++ui;
    }
    PG8_WAIT_V(0);
    if (wr == 0) PG8_BAR;
    PG8_BAR;
    if constexpr (Epi::AFTER_DRAIN) { E.fused(acc, cur, wr, wc, fr, fq, lds, wid, lane); S.done(cur); }
#undef PG8_SA
#undef PG8_SB
#undef PG8_STAGE
#undef PG8_LDA
#undef PG8_LDB
#undef PG8_MMA
#undef PG8_WAIT_V
#undef PG8_WAIT_L
#undef PG8_BAR
#undef PG8_SCHED
}
}
namespace mk {
#define LAS __attribute__((address_space(3)))
using pg8::f32x4; using pg8::u32x4; using pg8::Unit;
typedef float f32x2 __attribute__((ext_vector_type(2)));
typedef float f32x16 __attribute__((ext_vector_type(16)));
typedef _Float16 h2v __attribute__((ext_vector_type(2)));
typedef _Float16 f16x8 __attribute__((ext_vector_type(8)));
typedef _Float16 f16x4 __attribute__((ext_vector_type(4)));
typedef short bf16x8 __attribute__((ext_vector_type(8)));
typedef unsigned u32x2 __attribute__((ext_vector_type(2)));
typedef unsigned short u16;

constexpr int NWAVES = 8, NT = 512;
constexpr int D = 1024, NB = 8, L = 8192, T = NB * L, DIN = 3672, DFF = 2816;
constexpr int PJ = 3584;
constexpr int CQ = 0, CK = 512, CV = 1024, CQI = 1536, CGQ = 2048, CGK = 2304, CGV = 2560, CGO = 3072;
constexpr float EPS = 1e-6f;
constexpr float IDX_SCALE = 0.35355339059327373f * 0.125f;
constexpr size_t MiB = 1u << 20;
constexpr size_t WS_CTL = 0, WS_MOD = 1 * MiB, WS_WIN = 2 * MiB, WS_WOUT = 10 * MiB, WS_WGU = 12 * MiB, WS_WDN = 23 * MiB;
constexpr size_t WS_SS1 = 29 * MiB, WS_SS2 = 33 * MiB, WS_KIDX = 37 * MiB, WS_WIDX = 45 * MiB, WS_GLR = 47 * MiB, WS_THR = 51 * MiB;
constexpr size_t WS_H = 64 * MiB, WS_CAT = 192 * MiB, WS_PROJ = 320 * MiB, WS_ACT = 320 * MiB, WS_GLAS = 768 * MiB, WS_VT = 896 * MiB, WS_KF = 960 * MiB, WS_END = 1024 * MiB;
constexpr int LDS_BYTES = 163840;

struct Params {
    const float *x, *c, *w_mod, *b_mod, *norm1_g, *w_in, *w_gate2, *b_gate2, *att_g, *gla_g, *w_out, *norm2_g, *w_gu, *w_down, *final_g;
    float* out; unsigned char* ws; int ph_lo, ph_hi;
};

__device__ __forceinline__ unsigned pkh(float a, float b) { const h2v h = __builtin_convertvector((f32x2){a, b}, h2v); return __builtin_bit_cast(unsigned, h); }
__device__ __forceinline__ float silu_f(float v) { return v * __builtin_amdgcn_rcpf(1.f + __expf(-v)); }
__device__ __forceinline__ float wave_sum(float v) {
#pragma unroll
    for (int o = 1; o < 64; o <<= 1) v += __shfl_xor(v, o);
    return v;
}
__device__ __forceinline__ float rows_sum(float s) {
    { const unsigned u = __builtin_bit_cast(unsigned, s); const auto r = __builtin_amdgcn_permlane16_swap(u, u, false, false); const unsigned a = r[0], b = r[1]; s = __builtin_bit_cast(float, a) + __builtin_bit_cast(float, b); }
    { const unsigned u = __builtin_bit_cast(unsigned, s); const auto r = __builtin_amdgcn_permlane32_swap(u, u, false, false); const unsigned a = r[0], b = r[1]; s = __builtin_bit_cast(float, a) + __builtin_bit_cast(float, b); }
    return s;
}
#define LDS_WAIT() asm volatile("s_waitcnt lgkmcnt(0)" ::: "memory")

struct MapIn { __device__ __forceinline__ int operator()(int n) const {
    if (n < 2048) return n; if (n < 3584) return n + 72; if (n < 3648) return 2048 + (n - 3584); if (n < 3656) return 2112 + (n - 3648); if (n < 3672) return n; return -1; } };
struct MapGU { __device__ __forceinline__ int operator()(int n) const { const int pn = n >> 8, r = n & 255; return r < 128 ? 128 * pn + r : DFF + 128 * pn + (r - 128); } };
struct MapId { __device__ __forceinline__ int operator()(int n) const { return n; } };

template <class Map>
__device__ __forceinline__ void transpose_item(const float* __restrict__ W, int K, int Nsrc, u16* __restrict__ WT, int nblk, LAS float* scr, int item, int lane, Map map) {
    const int kb = item / nblk, nb = item % nblk, k0 = 64 * kb, n0 = 32 * nb;
    const int sc = map(n0 + (lane & 31));
#pragma unroll 8
    for (int i = 0; i < 32; ++i) { const int kk = 2 * i + (lane >> 5); const float v = W[(size_t)(k0 + kk) * Nsrc + (sc >= 0 ? sc : 0)]; scr[kk * 33 + (lane & 31)] = sc >= 0 ? v : 0.f; }
    LDS_WAIT(); asm volatile("" ::: "memory");
    const int c = lane & 7;
#pragma unroll
    for (int j = 0; j < 4; ++j) { const int n = (lane >> 3) + 8 * j; const LAS float* s = scr + (8 * c) * 33 + n;
        u32x4 o; o.x = pkh(s[0 * 33], s[1 * 33]); o.y = pkh(s[2 * 33], s[3 * 33]); o.z = pkh(s[4 * 33], s[5 * 33]); o.w = pkh(s[6 * 33], s[7 * 33]);
        *(u32x4*)(WT + (size_t)(n0 + n) * K + k0 + 8 * c) = o; }
    LDS_WAIT(); asm volatile("" ::: "memory");
}

__device__ __forceinline__ void phase_p0a(const Params& p, LAS unsigned char* lds, int wave, int lane) {
    LAS float* sct = (LAS float*)(lds + 98304);
    for (int i = threadIdx.x; i < NB * D; i += NT) { const float cv = p.c[i]; sct[i] = cv / (1.f + expf(-cv)); }
    __syncthreads();
    const int gw = blockIdx.x * NWAVES + wave, NGW = gridDim.x * NWAVES;
    float* mod = (float*)(p.ws + WS_MOD);
    for (int it = gw; it < 6 * D / 16; it += NGW) {
        const int j = it * 16 + (lane & 15), kq = lane >> 4;
        float acc[NB];
#pragma unroll
        for (int b = 0; b < NB; ++b) acc[b] = 0.f;
#pragma unroll 16
        for (int k4 = 0; k4 < D / 4; ++k4) { const int k = 4 * k4 + kq; const float w = p.w_mod[(size_t)k * (6 * D) + j];
#pragma unroll
            for (int b = 0; b < NB; ++b) acc[b] += sct[b * D + k] * w; }
#pragma unroll
        for (int b = 0; b < NB; ++b) acc[b] = rows_sum(acc[b]);
        if (lane < 16) { const float bm = p.b_mod[j];
#pragma unroll
            for (int b = 0; b < NB; ++b) mod[b * 6 * D + j] = acc[b] + bm; }
    }
}
__device__ __forceinline__ void phase_p0b(const Params& p, LAS unsigned char* lds, int wave, int lane) {
    const int gw = blockIdx.x * NWAVES + wave, NGW = gridDim.x * NWAVES;
    LAS float* scr = (LAS float*)(lds + wave * 8704);
    constexpr int I_IN = (D / 64) * (3840 / 32), I_OUT = (D / 64) * (D / 32), I_GU = (D / 64) * (2 * DFF / 32), I_DN = (DFF / 64) * (D / 32);
    constexpr int NITEMS = I_IN + I_OUT + I_GU + I_DN;
    for (int it = gw; it < NITEMS; it += NGW) {
        int r = it;
        if (r < I_IN) { transpose_item(p.w_in, D, DIN, (u16*)(p.ws + WS_WIN), 3840 / 32, scr, r, lane, MapIn()); continue; } r -= I_IN;
        if (r < I_OUT) { transpose_item(p.w_out, D, D, (u16*)(p.ws + WS_WOUT), D / 32, scr, r, lane, MapId()); continue; } r -= I_OUT;
        if (r < I_GU) { transpose_item(p.w_gu, D, 2 * DFF, (u16*)(p.ws + WS_WGU), 2 * DFF / 32, scr, r, lane, MapGU()); continue; } r -= I_GU;
        transpose_item(p.w_down, DFF, D, (u16*)(p.ws + WS_WDN), D / 32, scr, r, lane, MapId());
    }
}

template <int MODE>
__device__ __forceinline__ void row_phase(const void* xin, const float* __restrict__ g, const float* __restrict__ mod, int sh_off, int sc_off, const float* __restrict__ ss, void* outp, int wave, int lane) {
    const int gw = blockIdx.x * NWAVES + wave, NGW = gridDim.x * NWAVES;
    f32x4 gv[4];
#pragma unroll
    for (int j = 0; j < 4; ++j) gv[j] = ((const f32x4*)g)[lane + 64 * j];
    auto load = [&](f32x4 (&v)[4], int m) __attribute__((always_inline)) {
        if (MODE == 0) { const f32x4* xr = (const f32x4*)((const float*)xin + (size_t)m * D) + lane;
#pragma unroll
            for (int j = 0; j < 4; ++j) v[j] = __builtin_nontemporal_load(xr + 64 * j); }
        else { const u32x2* xr = (const u32x2*)((const u16*)xin + (size_t)m * D) + lane;
#pragma unroll
            for (int j = 0; j < 4; ++j) { const u32x2 w = xr[64 * j]; const unsigned wx = w.x, wy = w.y; const h2v a = __builtin_bit_cast(h2v, wx), b = __builtin_bit_cast(h2v, wy); v[j] = (f32x4){(float)a[0], (float)a[1], (float)b[0], (float)b[1]}; } }
    };
    auto finish = [&](f32x4 (&v)[4], int m) __attribute__((always_inline)) {
        float tot;
        if (MODE == 0) { float s = 0.f;
#pragma unroll
            for (int j = 0; j < 4; ++j) s += (v[j].x * v[j].x + v[j].y * v[j].y) + (v[j].z * v[j].z + v[j].w * v[j].w);
            tot = wave_sum(s); }
        else { const f32x4* sp = (const f32x4*)(ss + (size_t)m * 16); const f32x4 a = sp[0], b = sp[1], c = sp[2], d = sp[3];
            tot = ((a.x + a.y) + (a.z + a.w)) + ((b.x + b.y) + (b.z + b.w)) + ((c.x + c.y) + (c.z + c.w)) + ((d.x + d.y) + (d.z + d.w)); }
        const float rstd = rsqrtf(tot * (1.f / D) + EPS);
        if (MODE == 2) { f32x4* o = (f32x4*)((float*)outp + (size_t)m * D) + lane;
#pragma unroll
            for (int j = 0; j < 4; ++j) __builtin_nontemporal_store(v[j] * rstd * gv[j], o + 64 * j); }
        else { const float* mb = mod + (m >> 13) * (6 * D);
            u32x2* o = (u32x2*)((u16*)outp + (size_t)m * D) + lane;
#pragma unroll
            for (int j = 0; j < 4; ++j) { const f32x4 sc = ((const f32x4*)(mb + sc_off))[lane + 64 * j], sh = ((const f32x4*)(mb + sh_off))[lane + 64 * j];
                const f32x4 r = v[j] * rstd * gv[j] * (sc + 1.f) + sh; u32x2 w; w.x = pkh(r.x, r.y); w.y = pkh(r.z, r.w); o[64 * j] = w; } }
    };
    for (int m = gw; m < T; m += 2 * NGW) {
        f32x4 va[4], vb[4];
        load(va, m); const bool two = m + NGW < T; if (two) load(vb, m + NGW);
        finish(va, m); if (two) finish(vb, m + NGW);
    }
}

struct EpiProj {
    static constexpr bool PERM = true, AFTER_DRAIN = false;
    u16* P; u16* kidx; float* widx; float* glr; u16* kf;
    __device__ __forceinline__ void operator()(const f32x4 (&acc)[2][2][4][2], const Unit& u, int wr, int wc, int fr, int fq) const {
        const int row0 = u.pm * 256 + wr * 64 + fr;
        if (u.pn < 14) {
            const int col0 = u.pn * 256 + wc * 32 + 8 * fq;
#pragma unroll
            for (int ai = 0; ai < 2; ++ai)
#pragma unroll
                for (int m = 0; m < 4; ++m) { u16* rowp = P + (size_t)(row0 + ai * 128 + m * 16) * PJ + col0;
#pragma unroll
                    for (int bj = 0; bj < 2; ++bj) { const f32x4 v0 = acc[ai][bj][m][0], v1 = acc[ai][bj][m][1];
                        u32x4 w; w.x = pkh(v0[0], v0[1]); w.y = pkh(v0[2], v0[3]); w.z = pkh(v1[0], v1[1]); w.w = pkh(v1[2], v1[3]);
                        if (u.pn == 2 || u.pn == 3) {
                            const int row = row0 + ai * 128 + m * 16, hd = 2 * (u.pn - 2) + bj, bb = row >> 13, kt = (row & 8191) >> 5;
                            __builtin_nontemporal_store(w, (u32x4*)(kf + ((((size_t)(bb * 4 + hd) * 256 + kt) * 8 + 2 * wc + (fq >> 1)) * 64 + (fq & 1) * 32 + (row & 31)) * 8)); }
                        else __builtin_nontemporal_store(w, (u32x4*)(rowp + bj * 128)); } }
        } else {
#pragma unroll
            for (int ai = 0; ai < 2; ++ai)
#pragma unroll
                for (int m = 0; m < 4; ++m) { const size_t row = (size_t)(row0 + ai * 128 + m * 16); const f32x4 v0 = acc[ai][0][m][0], v1 = acc[ai][0][m][1];
                    if (wc < 2) { u32x4 w; w.x = pkh(v0[0], v0[1]); w.y = pkh(v0[2], v0[3]); w.z = pkh(v1[0], v1[1]); w.w = pkh(v1[2], v1[3]);
                        *(u32x4*)(kidx + (((row >> 5) * 4 + 2 * wc + (fq >> 1)) * 64 + (fq & 1) * 32 + (row & 31)) * 8) = w; }
                    else if (wc == 2) {
                        if (fq == 0) { *(f32x4*)(widx + row * 8) = v0 * IDX_SCALE; *(f32x4*)(widx + row * 8 + 4) = v1 * IDX_SCALE; }
                        else if (fq < 3) { *(f32x4*)(glr + row * 16 + (fq - 1) * 8) = v0; *(f32x4*)(glr + row * 16 + (fq - 1) * 8 + 4) = v1; } } }
        }
    }
};
template <bool BASE_HALF>
struct EpiRes {
    static constexpr bool PERM = false, AFTER_DRAIN = false;
    const void* base; u16* out; const float* mod; float* ss; int gate_off; int pad;
    __device__ __forceinline__ void operator()(const f32x4 (&acc)[2][2][4][2], const Unit& u, int wr, int wc, int fr, int fq) const {
        const int row0 = u.pm * 256 + wr * 64 + fr, col0 = u.pn * 256 + wc * 32 + 4 * fq;
        const float* g = mod + (u.pm >> 5) * (6 * D) + gate_off;
        f32x4 gv[2][2];
#pragma unroll
        for (int bj = 0; bj < 2; ++bj)
#pragma unroll
            for (int n = 0; n < 2; ++n) gv[bj][n] = *(const f32x4*)(g + col0 + bj * 128 + n * 16);
#pragma unroll
        for (int ai = 0; ai < 2; ++ai) {
            f32x4 bsf[4][2][2]; u32x2 bsh[4][2][2];
#pragma unroll
            for (int m = 0; m < 4; ++m)
#pragma unroll
                for (int bj = 0; bj < 2; ++bj)
#pragma unroll
                    for (int n = 0; n < 2; ++n) { const size_t off = (size_t)(row0 + ai * 128 + m * 16) * D + col0 + bj * 128 + n * 16;
                        if (BASE_HALF) bsh[m][bj][n] = *(const u32x2*)((const u16*)base + off);
                        else bsf[m][bj][n] = __builtin_nontemporal_load((const f32x4*)((const float*)base + off)); }
#pragma unroll
            for (int m = 0; m < 4; ++m) { const size_t row = (size_t)(row0 + ai * 128 + m * 16); float s = 0.f;
#pragma unroll
                for (int bj = 0; bj < 2; ++bj)
#pragma unroll
                    for (int n = 0; n < 2; ++n) { const size_t off = row * D + col0 + bj * 128 + n * 16; f32x4 bs;
                        if (BASE_HALF) { const u32x2 wi = bsh[m][bj][n]; const unsigned wx = wi.x, wy = wi.y;        const h2v a = __builtin_bit_cast(h2v, wx), b = __builtin_bit_cast(h2v, wy); bs = (f32x4){(float)a[0], (float)a[1], (float)b[0], (float)b[1]}; }
                        else bs = bsf[m][bj][n];
                        const f32x4 o = bs + gv[bj][n] * acc[ai][bj][m][n]; u32x2 w; w.x = pkh(o[0], o[1]); w.y = pkh(o[2], o[3]); *(u32x2*)(out + off) = w;
                        s += (o[0] * o[0] + o[1] * o[1]) + (o[2] * o[2] + o[3] * o[3]); }
                s = rows_sum(s);
                if (fq == 0) ss[row * 16 + u.pn * 4 + wc] = s; } }
    }
};
struct EpiSwiGLU {
    static constexpr bool PERM = true, AFTER_DRAIN = false;
    u16* act;
    __device__ __forceinline__ void operator()(const f32x4 (&acc)[2][2][4][2], const Unit& u, int wr, int wc, int fr, int fq) const {
        const int row0 = u.pm * 256 + wr * 64 + fr, col0 = u.pn * 128 + wc * 32 + 8 * fq;
#pragma unroll
        for (int ai = 0; ai < 2; ++ai)
#pragma unroll
            for (int m = 0; m < 4; ++m) { const f32x4 g0 = acc[ai][0][m][0], g1 = acc[ai][0][m][1], u0 = acc[ai][1][m][0], u1 = acc[ai][1][m][1];
                float a[8];
#pragma unroll
                for (int j = 0; j < 4; ++j) { a[j] = silu_f(g0[j]) * u0[j]; a[4 + j] = silu_f(g1[j]) * u1[j]; }
                u32x4 w; w.x = pkh(a[0], a[1]); w.y = pkh(a[2], a[3]); w.z = pkh(a[4], a[5]); w.w = pkh(a[6], a[7]);
                __builtin_nontemporal_store(w, (u32x4*)(act + (size_t)(row0 + ai * 128 + m * 16) * DFF + col0)); }
    }
};
}
#define MK_HAVE_MIX 1
namespace mk {
constexpr size_t WS_GDEC = 52 * MiB;
constexpr size_t WS_SELM = WS_H + 64 * MiB;
constexpr size_t WS_X16 = WS_GLAS;
constexpr size_t WS_S16 = WS_H;
constexpr int NCH = L / 64;

__device__ __forceinline__ unsigned f2bf(float f) { unsigned u = __builtin_bit_cast(unsigned, f); return (u + 0x7fffu + ((u >> 16) & 1u)) >> 16; }
__device__ __forceinline__ unsigned pkbf(float lo, float hi) { return f2bf(lo) | (f2bf(hi) << 16); }
__device__ __forceinline__ float h2f(u16 h) { return (float)__builtin_bit_cast(_Float16, h); }
__device__ __forceinline__ float hlo(unsigned w) { return h2f((u16)(w & 0xffffu)); }
__device__ __forceinline__ float hhi(unsigned w) { return h2f((u16)(w >> 16)); }
__device__ __forceinline__ int kperm16(int o) { return 8 * ((o >> 2) & 1) + 4 * (o >> 3) + (o & 3); }

__device__ __forceinline__ void vt_item(const Params& p, LAS unsigned char* scr  , int item, int lane) {
    const int tb = item & 255, h = (item >> 8) & 3, b = item >> 10, t0 = tb * 32;
    const u16* src = (const u16*)(p.ws + WS_PROJ) + (size_t)(b * L + t0) * PJ + CV + h * 128;
#pragma unroll
    for (int i = 0; i < 8; ++i) { const int r = 4 * i + (lane >> 4), ch = lane & 15; const u32x4 v = *(const u32x4*)(src + (size_t)r * PJ + ch * 8);
        LAS unsigned* d = (LAS unsigned*)(scr + r * 264 + ch * 16); d[0] = v.x; d[1] = v.y; d[2] = v.z; d[3] = v.w; }
    LDS_WAIT(); asm volatile("" ::: "memory");
    u16* dst = (u16*)(p.ws + WS_VT) + ((size_t)(b * 4 + h) * 256 + tb) * 4096;
#pragma unroll
    for (int i = 0; i < 8; ++i) { const int c = i * 64 + lane, dv = c & 127, tg = c >> 7;
        unsigned w[4];
#pragma unroll
        for (int jp = 0; jp < 4; ++jp) { const int j = 2 * jp, tok = 16 * (tg >> 1) + 8 * (j >> 2) + 4 * (tg & 1) + (j & 3);
            const unsigned lo = *(LAS u16*)(scr + tok * 264 + dv * 2), hi = *(LAS u16*)(scr + (tok + 1) * 264 + dv * 2); w[jp] = lo | (hi << 16); }
        u32x4 o; o.x = w[0]; o.y = w[1]; o.z = w[2]; o.w = w[3];
        *(u32x4*)(dst + ((((dv >> 5) * 2 + (tg >> 1)) * 2 + (tg & 1)) * 32 + (dv & 31)) * 8) = o; }
    LDS_WAIT(); asm volatile("" ::: "memory");
}

constexpr int GL_SEG = 106496;
constexpr int GL_GLR = 0, GL_WG = 4096, GL_BG = 8192, GL_BC = 8448, GL_QD = 25088, GL_KD = 34304, GL_QP = 43520, GL_VT = 52736, GL_SSQ = 71168, GL_OST = 72192, GL_END = 105984;
constexpr int GST = 72;
__device__ __forceinline__ void gla_bcum(const Params& p, LAS unsigned char* lds, int b, int h, int c) {
    const int tid = threadIdx.x;
    LAS float* glr = (LAS float*)(lds + GL_GLR); LAS float* wg = (LAS float*)(lds + GL_WG); LAS float* bg = (LAS float*)(lds + GL_BG); LAS float* bc = (LAS float*)(lds + GL_BC);
    const float* gsrc = (const float*)(p.ws + WS_GLR) + (size_t)(b * L + c * 64) * 16;
    for (int i = tid; i < 1024; i += NT) { glr[i] = gsrc[i]; wg[i] = p.w_gate2[(i >> 6) * 256 + h * 64 + (i & 63)]; }
    if (tid < 64) bg[tid] = p.b_gate2[h * 64 + tid];
    __syncthreads();
    { const int dk = tid & 63; float wr[16];
#pragma unroll
      for (int r = 0; r < 16; ++r) wr[r] = wg[r * 64 + dk];
      const float bias = bg[dk];
#pragma unroll
      for (int i = 0; i < 8; ++i) { const int t = (tid >> 6) + 8 * i; float z = bias;
#pragma unroll
          for (int r4 = 0; r4 < 4; ++r4) { const f32x4 gq = *(const LAS f32x4*)(glr + t * 16 + 4 * r4); z += gq[0] * wr[4 * r4] + gq[1] * wr[4 * r4 + 1] + gq[2] * wr[4 * r4 + 2] + gq[3] * wr[4 * r4 + 3]; }
          bc[t * 65 + dk] = (fminf(z, 0.f) - __logf(1.f + __expf(-fabsf(z)))) * (1.f / 16.f); } }
    __syncthreads();
    { const int dk = tid & 63, sg = tid >> 6; LAS float* segt = (LAS float*)(lds + GL_SEG);
      float v[8], run = 0.f;
#pragma unroll
      for (int i = 0; i < 8; ++i) { run += bc[(sg * 8 + i) * 65 + dk]; v[i] = run; }
      segt[sg * 64 + dk] = run;
      __syncthreads();
      float off = 0.f;
#pragma unroll
      for (int j = 0; j < 7; ++j) off += (j < sg) ? segt[j * 64 + dk] : 0.f;
#pragma unroll
      for (int i = 0; i < 8; ++i) bc[(sg * 8 + i) * 65 + dk] = v[i] + off; }
    __syncthreads();
}

__device__ __forceinline__ void gla1_item(const Params& p, LAS unsigned char* lds, int item, int wave, int lane) {
    const int tid = threadIdx.x, c = item & (NCH - 1), h = (item >> 7) & 3, b = item >> 9;
    const u16* prow = (const u16*)(p.ws + WS_PROJ) + (size_t)(b * L + c * 64) * PJ;
    unsigned kw0[4], kw1[4], vw0[8], vw1[8];
#pragma unroll
    for (int i = 0; i < 4; ++i) { const int idx = tid + NT * i, dk = idx & 63, t = 2 * (idx >> 6);
        kw0[i] = prow[(size_t)t * PJ + CGK + h * 64 + dk]; kw1[i] = prow[(size_t)(t + 1) * PJ + CGK + h * 64 + dk]; }
#pragma unroll
    for (int i = 0; i < 8; ++i) { const int idx = tid + NT * i, dv = idx & 127, t = 2 * (idx >> 7);
        vw0[i] = prow[(size_t)t * PJ + CGV + h * 128 + dv]; vw1[i] = prow[(size_t)(t + 1) * PJ + CGV + h * 128 + dv]; }
    gla_bcum(p, lds, b, h, c);
    LAS float* bc = (LAS float*)(lds + GL_BC); LAS u16* KT = (LAS u16*)(lds + GL_KD); LAS u16* VTl = (LAS u16*)(lds + GL_VT);
#pragma unroll
    for (int i = 0; i < 4; ++i) { const int idx = tid + NT * i, dk = idx & 63, t = 2 * (idx >> 6); const float bl = bc[63 * 65 + dk];
        const float k0 = h2f((u16)kw0[i]) * __expf(bl - bc[t * 65 + dk]), k1 = h2f((u16)kw1[i]) * __expf(bl - bc[(t + 1) * 65 + dk]);
        *(LAS unsigned*)(KT + dk * GST + t) = pkh(k0, k1); }
#pragma unroll
    for (int i = 0; i < 8; ++i) { const int idx = tid + NT * i, dv = idx & 127, t = 2 * (idx >> 7);
        *(LAS unsigned*)(VTl + dv * GST + t) = vw0[i] | (vw1[i] << 16); }
    if (tid < 64) ((float*)(p.ws + WS_GDEC))[(size_t)item * 64 + tid] = __expf(bc[63 * 65 + tid]);
#pragma unroll
    for (int i = 0; i < 8; ++i) { const int idx = tid + NT * i, t = idx >> 6, dk = idx & 63;
        ((float*)((u16*)(p.ws + WS_PROJ) + (size_t)(b * L + c * 64 + t) * PJ + CK + h * 128))[dk] = bc[t * 65 + dk]; }
    __syncthreads();
    const int mbv = wave >> 1, nbk = wave & 1, hh = lane >> 5, l31 = lane & 31;
    f32x16 acc;
#pragma unroll
    for (int i = 0; i < 16; ++i) acc[i] = 0.f;
#pragma unroll
    for (int s = 0; s < 4; ++s) { const f16x8 a = *(const LAS f16x8*)(VTl + (mbv * 32 + l31) * GST + 16 * s + 8 * hh), bb = *(const LAS f16x8*)(KT + (nbk * 32 + l31) * GST + 16 * s + 8 * hh);
        acc = __builtin_amdgcn_mfma_f32_32x32x16_f16(a, bb, acc, 0, 0, 0); }
    float* dst = (float*)(p.ws + WS_GLAS) + (size_t)item * 8192;
#pragma unroll
    for (int i = 0; i < 16; ++i) { const int dv = mbv * 32 + (i & 3) + 8 * (i >> 2) + 4 * hh; dst[dv * 64 + nbk * 32 + l31] = acc[i]; }
    __syncthreads();
}

__device__ __forceinline__ void phase_p4(const Params& p, LAS unsigned char* lds, int wave, int lane) {
    const float* dS = (const float*)(p.ws + WS_GLAS); const float* dec = (const float*)(p.ws + WS_GDEC); unsigned* S16 = (unsigned*)(p.ws + WS_S16);
    for (int ch = blockIdx.x * NT + threadIdx.x; ch < 32 * 4096; ch += gridDim.x * NT) {
        const int bh = ch >> 12, e2 = ch & 4095, dk = (e2 * 2) & 63;
        f32x2 run = {0.f, 0.f};
        for (int c0 = 0; c0 < NCH; c0 += 16) {
            f32x2 dv[16], av[16];
#pragma unroll
            for (int i = 0; i < 16; ++i) { const size_t item = (size_t)bh * NCH + c0 + i; dv[i] = *(const f32x2*)(dS + item * 8192 + e2 * 2); av[i] = *(const f32x2*)(dec + item * 64 + dk); }
#pragma unroll
            for (int i = 0; i < 16; ++i) { const size_t item = (size_t)bh * NCH + c0 + i; S16[item * 4096 + e2] = pkh(run.x, run.y); run = av[i] * run + dv[i]; } }
    }
}

struct G3Ops { unsigned qw[4], kw[4], vw0[8], vw1[8]; u32x4 g0, g1; f16x8 sfr[4]; float bw[8]; };
#define GL_SYNC() do { asm volatile("s_waitcnt lgkmcnt(0)" ::: "memory"); __builtin_amdgcn_s_barrier(); asm volatile("" ::: "memory"); } while (0)
__device__ __forceinline__ void gla3_load(const Params& p, G3Ops& o, int item, int wave, int lane) {
    const int tid = threadIdx.x, c = item & (NCH - 1), h = (item >> 7) & 3, b = item >> 9;
    const int mb = wave >> 1, hh = lane >> 5, l31 = lane & 31;
    const u16* prow = (const u16*)(p.ws + WS_PROJ) + (size_t)(b * L + c * 64) * PJ;
#pragma unroll
    for (int i = 0; i < 4; ++i) { const int idx = tid + NT * i, dk = 2 * (idx & 31), t = idx >> 5;
        o.qw[i] = *(const unsigned*)(prow + (size_t)t * PJ + CGQ + h * 64 + dk); o.kw[i] = *(const unsigned*)(prow + (size_t)t * PJ + CGK + h * 64 + dk); }
#pragma unroll
    for (int i = 0; i < 8; ++i) { const int idx = tid + NT * i, dv = idx & 127, t = 2 * (idx >> 7);
        o.vw0[i] = prow[(size_t)t * PJ + CGV + h * 128 + dv]; o.vw1[i] = prow[(size_t)(t + 1) * PJ + CGV + h * 128 + dv]; }
    const u16* gorow = prow + (size_t)(tid >> 3) * PJ + CGO + h * 128 + (tid & 7) * 16;
    o.g0 = *(const u32x4*)gorow; o.g1 = *(const u32x4*)(gorow + 8);
    { const u16* srow = (const u16*)(p.ws + WS_S16) + (size_t)item * 8192 + (size_t)(mb * 32 + l31) * 64;
#pragma unroll
      for (int s = 0; s < 4; ++s) o.sfr[s] = *(const f16x8*)(srow + 16 * s + 8 * hh); }
#pragma unroll
    for (int i = 0; i < 8; ++i) { const int idx = tid + NT * i, t = idx >> 6, dk = idx & 63; o.bw[i] = ((const float*)(prow + (size_t)t * PJ + CK + h * 128))[dk]; }
}
__device__ __forceinline__ void gla3_item(const Params& p, LAS unsigned char* lds, const G3Ops& ops, int item, int wave, int lane) {
    const int tid = threadIdx.x, c = item & (NCH - 1), h = (item >> 7) & 3, b = item >> 9;
    const int mb = wave >> 1, nb = wave & 1, hh = lane >> 5, l31 = lane & 31;
    const unsigned (&qw)[4] = ops.qw; const unsigned (&kw)[4] = ops.kw; const unsigned (&vw0)[8] = ops.vw0; const unsigned (&vw1)[8] = ops.vw1; const u32x4 g0 = ops.g0, g1 = ops.g1; const f16x8 (&sfr)[4] = ops.sfr;
    LAS float* bc = (LAS float*)(lds + GL_BC);
#pragma unroll
    for (int i = 0; i < 8; ++i) { const int idx = tid + NT * i, t = idx >> 6, dk = idx & 63; bc[t * 65 + dk] = ops.bw[i]; }
    GL_SYNC();
    LAS u16* QD = (LAS u16*)(lds + GL_QD); LAS u16* KD = (LAS u16*)(lds + GL_KD); LAS u16* QP = (LAS u16*)(lds + GL_QP); LAS u16* VTl = (LAS u16*)(lds + GL_VT);
    LAS float* ssq = (LAS float*)(lds + GL_SSQ); LAS float* ost = (LAS float*)(lds + GL_OST);
#pragma unroll
    for (int i = 0; i < 4; ++i) { const int idx = tid + NT * i, dk = 2 * (idx & 31), t = idx >> 5;
        const float b0 = bc[t * 65 + dk], b1 = bc[t * 65 + dk + 1], r0 = bc[31 * 65 + dk], r1 = bc[31 * 65 + dk + 1];
        const float q0 = hlo(qw[i]) * 0.125f, q1 = hhi(qw[i]) * 0.125f;
        *(LAS unsigned*)(QD + t * GST + dk) = pkbf(q0 * __expf(b0 - r0), q1 * __expf(b1 - r1));
        *(LAS unsigned*)(KD + t * GST + dk) = pkbf(hlo(kw[i]) * __expf(r0 - b0), hhi(kw[i]) * __expf(r1 - b1));
        *(LAS unsigned*)(QP + t * GST + dk) = pkh(q0 * __expf(b0), q1 * __expf(b1)); }
#pragma unroll
    for (int i = 0; i < 8; ++i) { const int idx = tid + NT * i, dv = idx & 127, t = 2 * (idx >> 7);
        *(LAS unsigned*)(VTl + dv * GST + (t & ~15) + kperm16(t & 15)) = vw0[i] | (vw1[i] << 16); }
    GL_SYNC();
    f16x8 pf[4];
#pragma unroll
    for (int jb = 0; jb < 2; ++jb) {
        if (jb > nb) {
#pragma unroll
            for (int e = 0; e < 8; ++e) { pf[2 * jb][e] = (_Float16)0.f; pf[2 * jb + 1][e] = (_Float16)0.f; }
            continue; }
        f32x16 x;
#pragma unroll
        for (int i = 0; i < 16; ++i) x[i] = 0.f;
#pragma unroll
        for (int s = 0; s < 4; ++s) { const bf16x8 a = *(const LAS bf16x8*)(KD + (jb * 32 + l31) * GST + 16 * s + 8 * hh), bb = *(const LAS bf16x8*)(QD + (nb * 32 + l31) * GST + 16 * s + 8 * hh);
            x = __builtin_amdgcn_mfma_f32_32x32x16_bf16(a, bb, x, 0, 0, 0); }
#pragma unroll
        for (int i = 0; i < 16; ++i) { const int rowi = (i & 3) + 8 * (i >> 2) + 4 * hh; const bool keep = (jb < nb) || (rowi <= l31); const float v = keep ? x[i] : 0.f;
            pf[2 * jb + (i >> 3)][i & 7] = (_Float16)v; }
    }
    f32x16 o;
#pragma unroll
    for (int i = 0; i < 16; ++i) o[i] = 0.f;
#pragma unroll
    for (int kk = 0; kk < 4; ++kk) { if ((kk >> 1) > nb) continue;
        const f16x8 a = *(const LAS f16x8*)(VTl + (mb * 32 + l31) * GST + 16 * kk + 8 * hh);
        o = __builtin_amdgcn_mfma_f32_32x32x16_f16(a, pf[kk], o, 0, 0, 0); }
#pragma unroll
    for (int s = 0; s < 4; ++s) { const f16x8 bb = *(const LAS f16x8*)(QP + (nb * 32 + l31) * GST + 16 * s + 8 * hh);
        o = __builtin_amdgcn_mfma_f32_32x32x16_f16(sfr[s], bb, o, 0, 0, 0); }
    float part = 0.f;
#pragma unroll
    for (int i = 0; i < 16; ++i) { part += o[i] * o[i]; ost[(nb * 32 + l31) * 132 + mb * 32 + (i & 3) + 8 * (i >> 2) + 4 * hh] = o[i]; }
    part += __shfl_xor(part, 32);
    if (lane < 32) ssq[mb * 64 + nb * 32 + lane] = part;
    GL_SYNC();
    { const int t = tid >> 3, dv0 = (tid & 7) * 16;
      const float rstd = rsqrtf((ssq[t] + ssq[64 + t] + ssq[128 + t] + ssq[192 + t]) * (1.f / 128.f) + EPS);
      const unsigned gw[8] = {g0.x, g0.y, g0.z, g0.w, g1.x, g1.y, g1.z, g1.w};
      unsigned ow[8];
#pragma unroll
      for (int e = 0; e < 8; ++e) { const int dv = dv0 + 2 * e;
          const float a0 = ost[t * 132 + dv] * rstd * p.gla_g[dv] * silu_f(hlo(gw[e])), a1 = ost[t * 132 + dv + 1] * rstd * p.gla_g[dv + 1] * silu_f(hhi(gw[e]));
          ow[e] = pkh(a0, a1); }
      u16* crow = (u16*)(p.ws + WS_CAT) + (size_t)(b * L + c * 64 + t) * D + 512 + h * 128 + dv0;
      u32x4 o0, o1; o0.x = ow[0]; o0.y = ow[1]; o0.z = ow[2]; o0.w = ow[3]; o1.x = ow[4]; o1.y = ow[5]; o1.z = ow[6]; o1.w = ow[7];
      *(u32x4*)crow = o0; *(u32x4*)(crow + 8) = o1; }
    GL_SYNC();
}
}
namespace mk {
__device__ __forceinline__ int idx_row_slot(int r) { return 2 * ((r >> 2) & 1) + (r >> 4); }
__device__ __forceinline__ int idx_row_head(int r) { return (r & 3) + 4 * ((r >> 3) & 1); }
__device__ __forceinline__ float relu_f(float x) { const int i = __builtin_bit_cast(int, x); return __builtin_bit_cast(float, i > 0 ? i : 0); }
__device__ __forceinline__ float fmul_s(float a, float b) { float r; asm("v_mul_f32_e32 %0, %1, %2" : "=v"(r) : "v"(a), "v"(b)); return r; }
__device__ __forceinline__ float fma_s(float a, float b, float c) { asm("v_fmac_f32_e32 %0, %1, %2" : "+v"(c) : "v"(a), "v"(b)); return c; }
template <int BASE> __device__ __forceinline__ float idx_score(const f32x16& acc, const f32x4 wa, const f32x4 wb) {
    float s = fmul_s(wa[0], relu_f(acc[BASE + 0]));
    s = fma_s(wa[1], relu_f(acc[BASE + 1]), s);
    s = fma_s(wa[2], relu_f(acc[BASE + 2]), s); s = fma_s(wa[3], relu_f(acc[BASE + 3]), s);
    s = fma_s(wb[0], relu_f(acc[BASE + 4]), s); s = fma_s(wb[1], relu_f(acc[BASE + 5]), s);
    s = fma_s(wb[2], relu_f(acc[BASE + 6]), s); s = fma_s(wb[3], relu_f(acc[BASE + 7]), s);
    return s;
}
__device__ __forceinline__ unsigned fkey(float f) { f = f + 0.0f; const unsigned u = __builtin_bit_cast(unsigned, f); return u ^ ((unsigned)((int)u >> 31) | 0x80000000u); }
__device__ __forceinline__ int opq(int v) { asm volatile("" : "+v"(v)); return v; }
__device__ __forceinline__ unsigned lds_add(LAS unsigned* p, unsigned v) { return __hip_atomic_fetch_add(p, v, __ATOMIC_RELAXED, __HIP_MEMORY_SCOPE_WORKGROUP); }
__device__ __forceinline__ unsigned wave_prefix_incl(unsigned v) {
#define MK_DPPADD(ctrl, rm) v += (unsigned)__builtin_amdgcn_update_dpp(0, (int)v, ctrl, rm, 0xf, false)
    MK_DPPADD(0x111, 0xf); MK_DPPADD(0x112, 0xf); MK_DPPADD(0x114, 0xf); MK_DPPADD(0x118, 0xf); MK_DPPADD(0x142, 0xa); MK_DPPADD(0x143, 0xc);
#undef MK_DPPADD
    return v;
}
__device__ __forceinline__ unsigned wave_suffix_sum(unsigned x, int lane) {
    const unsigned pre = wave_prefix_incl(x), tot = (unsigned)__builtin_amdgcn_readlane((int)pre, 63);
    return tot - pre + x;
}

template <int NP, int NC>
__device__ __forceinline__ void wave_select(const LAS unsigned* const (&cq)[NC], const unsigned (&sc)[NC][4], const unsigned (&kk0)[NC], LAS unsigned* const (&hq)[NC], int lane, const int (&rp0)[NC], const unsigned (&pre)[NC], unsigned (&out)[NC]) {
    unsigned prefix[NC], mask[NC], kk[NC];
#pragma unroll
    for (int c = 0; c < NC; ++c) { prefix[c] = pre[c]; mask[c] = rp0[c] ? (0xffffffffu << (32 - 8 * rp0[c])) : 0u; kk[c] = kk0[c]; }
    int rpmin = NP;
#pragma unroll
    for (int c = 0; c < NC; ++c) rpmin = rp0[c] < rpmin ? rp0[c] : rpmin;
    for (int rp = rpmin; rp < NP; ++rp) { const int shift = 24 - 8 * rp;
#pragma unroll
        for (int c = 0; c < NC; ++c) { u32x4 z = {0u, 0u, 0u, 0u}; *(LAS u32x4*)(hq[c] + 4 * lane) = z; }
#pragma unroll
        for (int sl = 0; sl < 4; ++sl)
#pragma unroll
            for (int i = 0; i < 4; ++i)
#pragma unroll
                for (int c = 0; c < NC; ++c) { const unsigned idx = lane + 64 * i; if (rp >= rp0[c] && idx < sc[c][sl]) { const unsigned key = fkey(__builtin_bit_cast(float, cq[c][256 * sl + idx])); if ((key & mask[c]) == prefix[c]) lds_add(hq[c] + ((key >> shift) & 255u), 1u); } }
        LDS_WAIT();
        u32x4 cw[NC]; unsigned cs[NC], incl[NC];
#pragma unroll
        for (int c = 0; c < NC; ++c) { cw[c] = *(LAS u32x4*)(hq[c] + 4 * lane); cs[c] = cw[c].x + cw[c].y + cw[c].z + cw[c].w; incl[c] = cs[c]; }
#pragma unroll
        for (int c = 0; c < NC; ++c) incl[c] = wave_suffix_sum(cs[c], lane);
#pragma unroll
        for (int c = 0; c < NC; ++c) { const unsigned above = incl[c] - cs[c]; const bool found = above < kk[c] && kk[c] <= incl[c];
            unsigned dig = 0u, kk2 = 0u;
            if (found) { unsigned cum = above; const unsigned cv[4] = {cw[c].x, cw[c].y, cw[c].z, cw[c].w};
#pragma unroll
                for (int i = 3; i >= 0; --i) { if (kk2 == 0u) { if (cum + cv[i] >= kk[c]) { dig = (unsigned)(4 * lane + i); kk2 = kk[c] - cum; } else cum += cv[i]; } } }
            const unsigned long long bal = __ballot(found); const int src = bal ? (int)__builtin_ctzll(bal) : 0;
            dig = (unsigned)__builtin_amdgcn_readlane((int)dig, src); kk2 = (unsigned)__builtin_amdgcn_readlane((int)kk2, src);
            if (rp >= rp0[c]) { prefix[c] |= dig << shift; mask[c] |= 255u << shift; kk[c] = kk2 ? kk2 : 1u; } }
    }
#pragma unroll
    for (int c = 0; c < NC; ++c) out[c] = prefix[c];
}

constexpr int TH_HIST = 0, TH_CAND = 65536, TH_ST = 131072, TH_A = 133120;
constexpr int ST_LO = 0, ST_RMAX = 16, ST_SH = 32, ST_NEED = 48, ST_MODE = 64, ST_CCNT = 80, ST_HI = 96, ST_ABOVE = 112, ST_WL = 128, ST_SAMP = 256, ST_SCNT = 272, ST_THR = 336, ST_DIRTY = 352;
__device__ __forceinline__ void thr_loadB(f16x8 (&Bf)[4], const u16* KI, int kt) {
#pragma unroll
    for (int s = 0; s < 4; ++s) Bf[s] = *(const f16x8*)(KI + (size_t)(kt * 4 + s) * 512);
}
__device__ __forceinline__ void thr_scores(const f32x16& acc, const LAS float* wl, int mb, int hh, unsigned& k0, unsigned& k1) {
    const LAS float* w0 = wl + (4 * mb + 2 * hh) * 8;
    const f32x4 a0 = *(const LAS f32x4*)(w0), b0 = *(const LAS f32x4*)(w0 + 4), a1 = *(const LAS f32x4*)(w0 + 8), b1 = *(const LAS f32x4*)(w0 + 12);
    k0 = fkey(idx_score<0>(acc, a0, b0)); k1 = fkey(idx_score<8>(acc, a1, b1));
}
constexpr int TH_MASK = 0, TH_CIDX = 16384, TH_SCR = 49152;
__device__ __forceinline__ float key2f(unsigned k) { return __builtin_bit_cast(float, (k & 0x80000000u) ? (k ^ 0x80000000u) : ~k); }
template <int KIND>
__device__ __forceinline__ void thr_sweep(LAS unsigned char* lds, const f16x8 (&A)[2][4], const u16* KI, int t0, int ntiles, int wave, int lane) {
    LAS unsigned* hist = (LAS unsigned*)(lds + TH_HIST); LAS unsigned* cand = (LAS unsigned*)(lds + TH_CAND); LAS unsigned* st = (LAS unsigned*)(lds + TH_ST);
    LAS unsigned* maskb = (LAS unsigned*)(lds + TH_MASK); LAS u16* cidx = (LAS u16*)(lds + TH_CIDX);
    const int hh = lane >> 5, l31 = lane & 31, mbp = wave & 1, ph = wave >> 1;
    unsigned lo[2][2], rmax[2][2], sh[2][2], ccn[2][2]; float lof[2][2], upf[2][2];
#pragma unroll
    for (int mbl = 0; mbl < 2; ++mbl)
#pragma unroll
        for (int jj = 0; jj < 2; ++jj) { const int ql = 8 * mbp + 4 * mbl + 2 * hh + jj; const unsigned lk = st[ST_LO + ql], rm = st[ST_RMAX + ql], uk = lk + rm;
            lo[mbl][jj] = lk; rmax[mbl][jj] = rm; sh[mbl][jj] = st[ST_SH + ql]; ccn[mbl][jj] = 0u;
            lof[mbl][jj] = lk <= 0x007fffffu ? -__builtin_inff() : key2f(lk); upf[mbl][jj] = uk >= 0xff800000u ? (lk == 0xffffffffu ? -__builtin_inff() : __builtin_inff()) : key2f(uk); }
    f16x8 B0[4], B1[4];
    const unsigned cbase4 = (unsigned)(__UINTPTR_TYPE__)(lds + TH_CAND) + ((8 * mbp + 2 * hh) * 1024 + ph * 256) * 4, cbase2 = (unsigned)(__UINTPTR_TYPE__)(lds + TH_CIDX) + ((8 * mbp + 2 * hh) * 1024 + ph * 256) * 2;
    float lofv[2][2] = {{lof[0][0], lof[0][1]}, {lof[1][0], lof[1][1]}};
    float lofc[2][2];
#pragma unroll
    for (int mbl = 0; mbl < 2; ++mbl)
#pragma unroll
        for (int jj = 0; jj < 2; ++jj) lofc[mbl][jj] = ((ntiles - 1) * 32 + l31 <= t0 + 8 * mbp + 4 * mbl + 2 * hh + jj) ? lof[mbl][jj] : __builtin_inff();
    const LAS float* wlb = (const LAS float*)(st + ST_WL) + (8 * mbp + 2 * hh) * 8;
    asm volatile("" : "+v"(wlb));
    f32x4 wreg[2][2][2];
    if (KIND == 1) {
#pragma unroll
        for (int mbl = 0; mbl < 2; ++mbl)
#pragma unroll
            for (int jj = 0; jj < 2; ++jj) { wreg[mbl][jj][0] = *(const LAS f32x4*)(wlb + (4 * mbl + jj) * 8); wreg[mbl][jj][1] = *(const LAS f32x4*)(wlb + (4 * mbl + jj) * 8 + 4); } }
    auto tile = [&](const f16x8 (&BX)[4], int kt, const bool chk) __attribute__((always_inline)) {
        const int skey = kt * 32 + l31;
        f32x16 acc[2];
#pragma unroll
        for (int mbl = 0; mbl < 2; ++mbl) {
#pragma unroll
            for (int i = 0; i < 16; ++i) acc[mbl][i] = 0.f;
#pragma unroll
            for (int s = 0; s < 4; ++s) acc[mbl] = __builtin_amdgcn_mfma_f32_32x32x16_f16(A[mbl][s], BX[s], acc[mbl], 0, 0, 0); }
#pragma unroll
        for (int mbl = 0; mbl < 2; ++mbl)
#pragma unroll
            for (int jj = 0; jj < 2; ++jj) { const int ql = 8 * mbp + 4 * mbl + 2 * hh + jj;
                const f32x4 wa = KIND == 1 ? wreg[mbl][jj][0] : *(const LAS f32x4*)(wlb + (4 * mbl + jj) * 8), wb = KIND == 1 ? wreg[mbl][jj][1] : *(const LAS f32x4*)(wlb + (4 * mbl + jj) * 8 + 4);
                const float sc = jj == 0 ? idx_score<0>(acc[mbl], wa, wb) : idx_score<8>(acc[mbl], wa, wb);
                if (KIND == 0) { const bool caus = !chk || skey <= t0 + ql;
                    const unsigned key = fkey(sc), d = key - lo[mbl][jj]; if (caus && d <= rmax[mbl][jj]) { const unsigned bin = d >> sh[mbl][jj]; lds_add(hist + ql * 1024 + (bin >> 1), 1u << (16 * (bin & 1u))); } }
                else {
                    const unsigned long long bal = __ballot(sc >= lofv[mbl][jj]);
                    const unsigned blo = (unsigned)bal, bhi = (unsigned)(bal >> 32), nlo = (unsigned)__builtin_popcount(blo), nhi = (unsigned)__builtin_popcount(bhi);
                    const unsigned cpk = ccn[mbl][jj] - (nlo << 16);
                    const int base = __builtin_amdgcn_sbfe((int)cpk, 16 * hh, 16);
                    unsigned pos = __builtin_amdgcn_mbcnt_hi(bhi, __builtin_amdgcn_mbcnt_lo(blo, (unsigned)base)); pos = pos < 255u ? pos : 255u;
                    { const unsigned a4 = cbase4 + (4 * mbl + jj) * 4096 + pos * 4, a2 = cbase2 + (4 * mbl + jj) * 2048 + pos * 2; unsigned long long sv;
                      asm volatile("s_and_saveexec_b64 %0, %1\n\tds_write_b32 %2, %3\n\tds_write_b16 %4, %5\n\ts_mov_b64 exec, %0" : "=&s"(sv) : "s"(bal), "v"(a4), "v"(sc), "v"(a2), "v"(skey) : "memory"); }
                    ccn[mbl][jj] += nlo + (nhi << 16); } }
    };
    int kt = ph; const int last = ntiles - 1;
    if (KIND == 0) {
        for (; kt < ntiles; kt += 4) { thr_loadB(B0, KI, kt); tile(B0, kt, true); }
        return; }
    thr_loadB(B0, KI, kt);
#define TH_LASTTHR() do { if (kt == last) { asm volatile("" ::: "memory");   _Pragma("unroll") for (int a = 0; a < 2; ++a) { _Pragma("unroll") for (int c = 0; c < 2; ++c) lofv[a][c] = lofc[a][c]; } } } while (0)
    for (;;) {
        thr_loadB(B1, KI, kt + 4 < last ? kt + 4 : last); TH_LASTTHR(); tile(B0, kt, kt == last); kt += 4; if (kt >= ntiles) break;
        thr_loadB(B0, KI, kt + 4 < last ? kt + 4 : last); TH_LASTTHR(); tile(B1, kt, kt == last); kt += 4; if (kt >= ntiles) break;
    }
#undef TH_LASTTHR
    if (KIND == 1) {
#pragma unroll
        for (int mbl = 0; mbl < 2; ++mbl)
#pragma unroll
            for (int jj = 0; jj < 2; ++jj) {
                if (l31 == 0) st[ST_SCNT + (8 * mbp + 4 * mbl + 2 * hh + jj) * 4 + ph] = (ccn[mbl][jj] >> (16 * hh)) & 0xffffu; } }
}
__device__ __forceinline__ void thr_write_masks(const Params& p, LAS unsigned char* lds, int b, int t0, int ntw) {
    const int tidw = opq(threadIdx.x);
    const LAS unsigned* maskb = (const LAS unsigned*)(lds + TH_MASK); const int q = tidw & 15;
    unsigned* dst = (unsigned*)(p.ws + WS_SELM) + ((size_t)(b * 128 + (t0 >> 6)) * 256) * 64 + (t0 & 63) + q;
    for (int kt = tidw >> 4; kt < ntw; kt += 32) dst[(size_t)kt * 64] = maskb[q * 256 + kt];
}
struct ThrOps { f16x8 A[2][4]; float wl; };
__device__ __forceinline__ void thr_load(const Params& p, ThrOps& o, int b, int qb, int wave) {
    const int tid = opq(threadIdx.x), lane = tid & 63, hh = lane >> 5, l31 = lane & 31, t0 = qb * 16, mbp = wave & 1;
    const u16* P16 = (const u16*)(p.ws + WS_PROJ); const int slot = idx_row_slot(l31), head = idx_row_head(l31);
#pragma unroll
    for (int mbl = 0; mbl < 2; ++mbl) { const u16* qr = P16 + (size_t)(b * L + t0 + 8 * mbp + 4 * mbl + slot) * PJ + CQI + head * 64 + 8 * hh;
#pragma unroll
        for (int s = 0; s < 4; ++s) o.A[mbl][s] = *(const f16x8*)(qr + 16 * s); }
    o.wl = ((const float*)(p.ws + WS_WIDX))[(size_t)(b * L + t0) * 8 + (tid & 127)];
}
#define TH_SYNC() do { asm volatile("s_waitcnt lgkmcnt(0)" ::: "memory"); __builtin_amdgcn_s_barrier(); asm volatile("" ::: "memory"); } while (0)
__device__ __forceinline__ void thr_item(const Params& p, LAS unsigned char* lds, const ThrOps& ops, int b, int qb, int wave, int lane) {
    int tid = opq(threadIdx.x); lane = tid & 63; int hh = lane >> 5, l31 = lane & 31; const int t0 = qb * 16;
#define TH_FRESH() do { tid = opq(tid); lane = tid & 63; hh = lane >> 5; l31 = lane & 31; } while (0)
    LAS unsigned* hist = (LAS unsigned*)(lds + TH_HIST); LAS unsigned* cand = (LAS unsigned*)(lds + TH_CAND); LAS unsigned* st = (LAS unsigned*)(lds + TH_ST);
    LAS unsigned* maskb = (LAS unsigned*)(lds + TH_MASK);
    const int ntw = 2 * (qb >> 2) + 2;
    if (tid < 16) { const int n = t0 + tid + 1;
        if (n <= 256) { st[ST_MODE + tid] = 2u; st[ST_THR + tid] = 0u; }
        else { st[ST_MODE + tid] = 0u; st[ST_LO + tid] = 0u; st[ST_RMAX + tid] = 0xffffffffu; st[ST_SH + tid] = 21u; st[ST_NEED + tid] = 256u; }
        st[ST_SAMP + tid] = 0u; }
    if (tid == 0) st[ST_DIRTY] = 0u;
    if (tid < 128) ((LAS float*)(st + ST_WL))[tid] = ops.wl;
    TH_SYNC();
    if (t0 + 16 <= 256) {
        for (int i = tid; i < 16 * 256; i += NT) { const int q = i >> 8, kt = i & 255, d = t0 + q - kt * 32; maskb[i] = d < 0 ? 0u : (d >= 31 ? 0xffffffffu : (2u << d) - 1u); }
        TH_SYNC(); thr_write_masks(p, lds, b, t0, ntw); TH_SYNC(); return; }
    const u16* P16 = (const u16*)(p.ws + WS_PROJ); const u16* KI = (const u16*)(p.ws + WS_KIDX) + (size_t)b * L * 64 + lane * 8;
    const int mbp = wave & 1, ph = wave >> 1;
    const f16x8 (&A)[2][4] = ops.A;
    const int ntiles = (t0 + 15) / 32 + 1;
    const int sd = ntiles >= 64 ? 8 : (ntiles >= 32 ? 4 : (ntiles >= 16 ? 2 : 1)), soff = sd == 8 ? 3 : (sd == 4 ? 2 : 0), mg = sd == 8 ? 27 : (sd == 4 ? 35 : 41);
    const int ms = ntiles / sd;
    {
        { const LAS float* wlb = (const LAS float*)(st + ST_WL) + (8 * mbp + 2 * hh) * 8; asm volatile("" : "+v"(wlb));
          f16x8 Bs0[4], Bs1[4];
          auto stile = [&](const f16x8 (&Bs)[4], int j) __attribute__((always_inline)) { const int kt = sd * j + soff;
            f32x16 acc[2];
#pragma unroll
            for (int mbl = 0; mbl < 2; ++mbl) {
#pragma unroll
                for (int i = 0; i < 16; ++i) acc[mbl][i] = 0.f;
#pragma unroll
                for (int s = 0; s < 4; ++s) acc[mbl] = __builtin_amdgcn_mfma_f32_32x32x16_f16(A[mbl][s], Bs[s], acc[mbl], 0, 0, 0); }
#pragma unroll
            for (int mbl = 0; mbl < 2; ++mbl)
#pragma unroll
                for (int jj = 0; jj < 2; ++jj) { const int ql = 8 * mbp + 4 * mbl + 2 * hh + jj;
                    const f32x4 wa = *(const LAS f32x4*)(wlb + (4 * mbl + jj) * 8), wb = *(const LAS f32x4*)(wlb + (4 * mbl + jj) * 8 + 4);
                    const float sc = jj == 0 ? idx_score<0>(acc[mbl], wa, wb) : idx_score<8>(acc[mbl], wa, wb);
                    const bool caus = kt * 32 + l31 <= t0 + ql;
                    cand[ql * 1024 + j * 32 + l31] = caus ? __builtin_bit_cast(unsigned, sc) : 0xff800000u; }
          };
          if (ph < ms) { int j = ph; const int jl = ms - 1;
            thr_loadB(Bs0, KI, sd * j + soff);
            for (;;) {
                thr_loadB(Bs1, KI, sd * (j + 4 < jl ? j + 4 : jl) + soff); stile(Bs0, j); j += 4; if (j >= ms) break;
                thr_loadB(Bs0, KI, sd * (j + 4 < jl ? j + 4 : jl) + soff); stile(Bs1, j); j += 4; if (j >= ms) break;
            } } }
        TH_FRESH();
        if (sd == 1) { u32x4 z = {0u, 0u, 0u, 0u};
#pragma unroll
            for (int i = 0; i < 2; ++i) *(LAS u32x4*)(lds + TH_MASK + (tid + NT * i) * 16) = z; }
        TH_SYNC();
        const unsigned m = (unsigned)(ms * 32); const int qa = 2 * wave, qb2 = 2 * wave + 1;
        const unsigned s0 = m < 256u ? m : 256u, s1 = m < 256u ? 0u : (m < 512u ? m - 256u : 256u), s2 = m < 512u ? 0u : (m < 768u ? m - 512u : 256u), s3 = m < 768u ? 0u : m - 768u;
        if (sd == 1) {
            const LAS unsigned* const cq[2] = {cand + qa * 1024, cand + qb2 * 1024}; const unsigned sc[2][4] = {{s0, s1, s2, s3}, {s0, s1, s2, s3}}; const unsigned kk[2] = {256u, 256u};
            LAS unsigned* const hq[2] = {(LAS unsigned*)(lds + TH_SCR) + qa * 256, (LAS unsigned*)(lds + TH_SCR) + qb2 * 256}; const int rp0[2] = {0, 0}; const unsigned pre[2] = {0u, 0u}; unsigned res[2];
            wave_select<4, 2>(cq, sc, kk, hq, lane, rp0, pre, res);
#pragma unroll
            for (int c = 0; c < 2; ++c) { const int q = 2 * wave + c;
                for (int k2 = 0; 2 * k2 < ntiles; ++k2) { const int ki = k2 * 64 + lane; const bool sel = ki < (int)m && ki <= t0 + q && fkey(__builtin_bit_cast(float, cand[q * 1024 + ki])) >= res[c];
                    const unsigned long long bal = __ballot(sel); if (lane == 0) { maskb[q * 256 + 2 * k2] = (unsigned)bal; maskb[q * 256 + 2 * k2 + 1] = (unsigned)(bal >> 32); } }
                if (lane == 0) { st[ST_THR + q] = res[c]; st[ST_MODE + q] = 2u; } }
        } else {
          const float ra = 256.f * (float)m / (float)(t0 + qa + 1), rb = 256.f * (float)m / (float)(t0 + qb2 + 1);
          const int rloa = (int)ra + mg + 1, rlob = (int)rb + mg + 1;
          const LAS unsigned* const cq[2] = {cand + qa * 1024, cand + qb2 * 1024};
          const unsigned sc[2][4] = {{s0, s1, s2, s3}, {s0, s1, s2, s3}};
          const unsigned kk[2] = {(unsigned)(rloa <= (int)m ? rloa : (int)m), (unsigned)(rlob <= (int)m ? rlob : (int)m)};
          LAS unsigned* const hq[2] = {hist + (wave * 2 + 0) * 256, hist + (wave * 2 + 1) * 256};
          const int rp0[2] = {0, 0}; const unsigned pre[2] = {0u, 0u}; unsigned res[2];
          wave_select<2, 2>(cq, sc, kk, hq, lane, rp0, pre, res);
          if (lane == 0) {
              const unsigned loka = rloa <= (int)m ? res[0] : 0u, lokb = rlob <= (int)m ? res[1] : 0u;
              st[ST_MODE + qa] = 1u; st[ST_SAMP + qa] = 1u; st[ST_LO + qa] = loka; st[ST_RMAX + qa] = 0xffffffffu - loka;
              st[ST_MODE + qb2] = 1u; st[ST_SAMP + qb2] = 1u; st[ST_LO + qb2] = lokb; st[ST_RMAX + qb2] = 0xffffffffu - lokb; } }
        TH_SYNC();
    }
    bool clean = true, finalpass = false;
    for (int pass = 0; pass < 10 && sd != 1; ++pass) {
        TH_FRESH();
        { u32x4 z = {0u, 0u, 0u, 0u};
#pragma unroll
          for (int i = 0; i < 8; ++i) *(LAS u32x4*)(lds + TH_HIST + (tid + NT * i) * 16) = z;
          if (tid < 16) { st[ST_CCNT + tid] = 0u;
              if (finalpass) { const unsigned tk = st[ST_THR + tid]; st[ST_LO + tid] = tk; st[ST_RMAX + tid] = 0xffffffffu - tk; st[ST_MODE + tid] = 3u; } } }
        TH_SYNC();
        int kind; { const LAS u32x4* mv = (const LAS u32x4*)(st + ST_MODE); const u32x4 m0 = mv[0], m1 = mv[1], m2 = mv[2], m3 = mv[3];
            const unsigned w[16] = {m0.x, m0.y, m0.z, m0.w, m1.x, m1.y, m1.z, m1.w, m2.x, m2.y, m2.z, m2.w, m3.x, m3.y, m3.z, m3.w}; unsigned anyh = 0u;
#pragma unroll
            for (int q = 0; q < 16; ++q) anyh |= (w[q] == 0u) ? 1u : 0u;
            kind = __builtin_amdgcn_readfirstlane((int)anyh) ? 0 : 1; }
        const bool mpass = clean && pass == 0 && kind == 1;
        if (!mpass) clean = false;
        if (kind == 0) thr_sweep<0>(lds, A, KI, t0, ntiles, wave, lane); else thr_sweep<1>(lds, A, KI, t0, ntiles, wave, lane);
        TH_FRESH();
        TH_SYNC();
        if (finalpass) {
            for (int c = 0; c < 2; ++c) { const int q = 2 * wave + c; const LAS u16* ci = (const LAS u16*)(lds + TH_CIDX) + q * 1024;
#pragma unroll
                for (int sl = 0; sl < 4; ++sl) { const unsigned n = st[ST_SCNT + q * 4 + sl] < 256u ? st[ST_SCNT + q * 4 + sl] : 256u;
                    for (unsigned idx = lane; idx < n; idx += 64) { const unsigned ki = ci[256 * sl + idx];
                        __hip_atomic_fetch_or(maskb + q * 256 + (ki >> 5), 1u << (ki & 31u), __ATOMIC_RELAXED, __HIP_MEMORY_SCOPE_WORKGROUP); } } }
            break; }
        if (kind == 0) {
            for (int qq = 0; qq < 2; ++qq) { const int q = 2 * wave + qq;
                if (st[ST_MODE + q] != 0u) continue;
                const unsigned need = st[ST_NEED + q], shq = st[ST_SH + q], loq = st[ST_LO + q];
                LAS unsigned* hq = hist + q * 1024 + 16 * lane; unsigned c = 0u;
#pragma unroll
                for (int i = 0; i < 16; ++i) { const unsigned w = hq[i]; c += (w & 0xffffu) + (w >> 16); }
                const unsigned incl = wave_suffix_sum(c, lane), above = incl - c;
                if (above < need && need <= incl) {
                    unsigned cum = above, bsel = 0u, bcnt = 0u;
                    for (int i = 31; i >= 0; --i) { const unsigned w = hq[i >> 1], cnt = (i & 1) ? (w >> 16) : (w & 0xffffu); if (cum + cnt >= need) { bsel = (unsigned)(32 * lane + i); bcnt = cnt; break; } cum += cnt; }
                    const unsigned need2 = need - cum, newlo = loq + (bsel << shq);
                    if (bcnt == need2 || shq == 0u) { st[ST_THR + q] = newlo; st[ST_MODE + q] = 2u; st[ST_LO + q] = 0xffffffffu; st[ST_RMAX + q] = 0u; }
                    else { st[ST_LO + q] = newlo; st[ST_RMAX + q] = (1u << shq) - 1u; st[ST_NEED + q] = need2;
                        st[ST_SH + q] = shq > 11u ? shq - 11u : 0u; }
                } }
        } else {
            const LAS unsigned* cq[2]; unsigned sc[2][4], kk[2], pre[2], res[2]; LAS unsigned* hq[2]; int rp0[2]; bool act[2], good[2];
#pragma unroll
            for (int c = 0; c < 2; ++c) { const int q = 2 * wave + c; act[c] = st[ST_MODE + q] == 1u;
#pragma unroll
                for (int sl = 0; sl < 4; ++sl) sc[c][sl] = st[ST_SCNT + q * 4 + sl];
                const unsigned cnt = sc[c][0] + sc[c][1] + sc[c][2] + sc[c][3]; kk[c] = st[ST_NEED + q]; good[c] = sc[c][0] <= 256u && sc[c][1] <= 256u && sc[c][2] <= 256u && sc[c][3] <= 256u;
                good[c] = good[c] && kk[c] <= cnt;
                const unsigned loq = st[ST_LO + q], hiq = loq + st[ST_RMAX + q]; rp0[c] = (loq >> 24) != (hiq >> 24) ? 0 : ((loq >> 16) != (hiq >> 16) ? 1 : 2);
                pre[c] = rp0[c] == 0 ? 0u : (rp0[c] == 1 ? (loq & 0xff000000u) : (loq & 0xffff0000u));
                cq[c] = cand + q * 1024; hq[c] = (LAS unsigned*)(lds + TH_SCR) + q * 256;
                if (!(act[c] && good[c])) { sc[c][0] = 0u; sc[c][1] = 0u; sc[c][2] = 0u; sc[c][3] = 0u; kk[c] = 1u; rp0[c] = 4; } }
            wave_select<4, 2>(cq, sc, kk, hq, lane, rp0, pre, res);
#pragma unroll
            for (int c = 0; c < 2; ++c) { const int q = 2 * wave + c;
                if (!act[c]) continue;
                if (good[c]) { const unsigned key = res[c];
                    if (mpass) {
                        const LAS u16* ci = (const LAS u16*)(lds + TH_CIDX) + q * 1024;
#pragma unroll
                        for (int sl = 0; sl < 4; ++sl)
#pragma unroll
                            for (int i = 0; i < 4; ++i) { const unsigned idx = lane + 64 * i; if (idx < sc[c][sl] && fkey(__builtin_bit_cast(float, cand[q * 1024 + 256 * sl + idx])) >= key) { const unsigned ki = ci[256 * sl + idx];
                                __hip_atomic_fetch_or(maskb + q * 256 + (ki >> 5), 1u << (ki & 31u), __ATOMIC_RELAXED, __HIP_MEMORY_SCOPE_WORKGROUP); } } }
                    if (lane == 0) { st[ST_THR + q] = key; st[ST_MODE + q] = 2u; st[ST_LO + q] = 0xffffffffu; st[ST_RMAX + q] = 0u; } }
                else if (lane == 0) { st[ST_DIRTY] = 1u; st[ST_MODE + q] = 0u; st[ST_SAMP + q] = 0u; st[ST_LO + q] = 0u; st[ST_RMAX + q] = 0xffffffffu; st[ST_SH + q] = 21u; st[ST_NEED + q] = 256u; }
            }
        }
        TH_SYNC();
        bool alldone; { const LAS u32x4* mv = (const LAS u32x4*)(st + ST_MODE); const u32x4 m0 = mv[0], m1 = mv[1], m2 = mv[2], m3 = mv[3];
            const unsigned w[16] = {m0.x, m0.y, m0.z, m0.w, m1.x, m1.y, m1.z, m1.w, m2.x, m2.y, m2.z, m2.w, m3.x, m3.y, m3.z, m3.w}; unsigned nd = 0u;
#pragma unroll
            for (int q = 0; q < 16; ++q) nd |= (w[q] != 2u) ? 1u : 0u;
            alldone = __builtin_amdgcn_readfirstlane((int)nd) == 0; }
        if (alldone) { if (clean && st[ST_DIRTY] == 0u) break; finalpass = true; }
    }
    TH_SYNC();
    thr_write_masks(p, lds, b, t0, ntw);
    TH_SYNC();
#undef TH_FRESH
}
}
namespace mk {
constexpr int AT_MASKR = 0, AT_SSQ = 2560, AT_G = 8192, AT_KVB = 16384, AT_OST = 16384;
#define AT_DMA(gp, lp) __builtin_amdgcn_global_load_lds((const unsigned*)(gp), (LAS unsigned*)(lp), 16, 0, 0)
#define AT_DMAO(gp, lp, off) __builtin_amdgcn_global_load_lds((const unsigned*)(gp), (LAS unsigned*)(lp), 16, off, 0)
#define AT_DMA4(gp, lp) __builtin_amdgcn_global_load_lds((const unsigned*)(gp), (LAS unsigned*)(lp), 4, 0, 0)
__device__ __forceinline__ void att_item(const Params& p, LAS unsigned char* lds, int b, int qblk, int wave, int lane) {
    const int q0 = qblk * 128, g = wave >> 1, h2 = wave & 1, hh = lane >> 5, l31 = lane & 31;
    LAS unsigned* maskr = (LAS unsigned*)(lds + AT_MASKR); LAS float* ssq = (LAS float*)(lds + AT_SSQ);
    LAS float* atg = (LAS float*)(lds + AT_G); atg[threadIdx.x] = p.att_g[threadIdx.x];
    const u16* P16 = (const u16*)(p.ws + WS_PROJ);
    const unsigned* SM = (const unsigned*)(p.ws + WS_SELM) + (size_t)(b * 128 + 2 * qblk + (wave & 1)) * 256 * 64 + lane;
    const int ntiles = 4 * qblk + 4, glast = q0 + 32 * g + 31;
    const float csc = 0.08838834764831845f * 1.4426950408889634f;
    LAS unsigned char* ostw = lds + AT_OST + wave * 8704;
    u16* cbase = (u16*)(p.ws + WS_CAT) + (size_t)(b * L + q0 + 32 * g) * D;
    for (int sp = 0; sp < 2; ++sp) {
        const int h = 2 * sp + h2;
        const unsigned char* KF = (const unsigned char*)(p.ws + WS_KF) + (size_t)(b * 4 + 2 * sp + (wave & 1)) * 256 * 8192 + (size_t)(2 * (wave >> 1)) * 1024 + lane * 16;
        const unsigned char* VF = (const unsigned char*)(p.ws + WS_VT) + (size_t)(b * 4 + 2 * sp + (wave & 1)) * 256 * 8192 + (size_t)(2 * (wave >> 1)) * 1024 + lane * 16;
        const int dofs = (wave & 1) * 8192 + 2 * (wave >> 1) * 1024;
        if (wave < 2) { AT_DMA4(SM, lds + AT_MASKR + wave * 256); AT_DMA4(SM + 64, lds + AT_MASKR + 512 + wave * 256); }
#pragma unroll
        for (int i = 0; i < 2; ++i) { AT_DMA(KF + i * 1024, lds + AT_KVB + dofs + i * 1024); AT_DMA(VF + i * 1024, lds + AT_KVB + 16384 + dofs + i * 1024); }
        f16x8 Qf[8];
        { const u16* qa = P16 + (size_t)(b * L + q0 + 32 * g + l31) * PJ + CQ + h * 128 + 8 * hh;
#pragma unroll
          for (int s = 0; s < 8; ++s) Qf[s] = *(const f16x8*)(qa + 16 * s); }
#pragma unroll
        for (int s = 0; s < 8; ++s) Qf[s] = Qf[s] * (_Float16)csc;
        f32x16 O[4];
#pragma unroll
        for (int d = 0; d < 4; ++d)
#pragma unroll
            for (int i = 0; i < 16; ++i) O[d][i] = 0.f;
        const unsigned char* kfp = KF; const unsigned char* vfp = VF; const unsigned* smp = SM + 64;
        float mrun = 0.f, lsum = 0.f;
        f32x16 negm;
#pragma unroll
        for (int i = 0; i < 16; ++i) negm[i] = 0.f;
        for (int kt = 0; kt < ntiles; ++kt) {
            asm volatile("s_waitcnt vmcnt(0)" ::: "memory");
            __syncthreads();
            const bool act = kt * 32 <= glast;
            const LAS f16x8* kb = (const LAS f16x8*)(lds + AT_KVB + (kt & 1) * 32768 + h2 * 8192) + lane;
            f16x8 kf[8];
            if (act) {
#pragma unroll
                for (int s = 0; s < 8; ++s) kf[s] = kb[s * 64]; }
            kfp += 8192; vfp += 8192; smp += 64;
            asm volatile("" : "+v"(kfp), "+v"(vfp), "+v"(smp));
            if (kt + 1 < ntiles) { const int bo = AT_KVB + ((kt + 1) & 1) * 32768 + dofs;
                AT_DMAO(kfp, lds + bo, 0); AT_DMAO(kfp, lds + bo, 1024); AT_DMAO(vfp, lds + bo + 16384, 0); AT_DMAO(vfp, lds + bo + 16384, 1024); }
            if (kt + 2 < ntiles && wave < 2) AT_DMA4(smp, lds + AT_MASKR + ((kt + 2) & 3) * 512 + wave * 256);
            if (act) {
                f32x16 S = negm;
#pragma unroll
                for (int s = 0; s < 8; ++s) S = __builtin_amdgcn_mfma_f32_32x32x16_f16(kf[s], Qf[s], S, 0, 0, 0);

                const unsigned bits = maskr[(kt & 3) * 128 + 32 * g + l31] >> (4 * hh);
                f16x8 vf[8];
                const unsigned av = (unsigned)(__UINTPTR_TYPE__)(lds + AT_KVB + (kt & 1) * 32768 + 16384 + h2 * 8192) + lane * 16;
#define AT_RD(dst, off, dep) asm volatile("ds_read_b128 %0, %1 offset:" #off : "=v"(dst) : "v"(av), "v"(dep))
                AT_RD(vf[0], 0, bits); AT_RD(vf[2], 2048, bits); AT_RD(vf[4], 4096, bits); AT_RD(vf[6], 6144, bits);
                int mxi = 0;
#pragma unroll
                for (int i = 0; i < 16; ++i) { const unsigned mk = (unsigned)__builtin_amdgcn_sbfe((int)bits, (i & 3) + 8 * (i >> 2), 1); const float si = S[i];
                    S[i] = __builtin_bit_cast(float, (__builtin_bit_cast(unsigned, si) & mk) | (0xff61b1e6u & ~mk)); }
#pragma unroll
                for (int i = 0; i < 16; i += 2) { const float a = S[i], c = S[i + 1]; const int ai = __builtin_bit_cast(int, a), ci = __builtin_bit_cast(int, c); const int t = mxi > ai ? mxi : ai; mxi = t > ci ? t : ci; }
                { const auto r = __builtin_amdgcn_permlane32_swap((unsigned)mxi, (unsigned)mxi, false, false); const int r0 = (int)r[0], r1 = (int)r[1]; mxi = r0 > r1 ? r0 : r1; }
                const float mx = __builtin_bit_cast(float, mxi);
                if (__ballot(mx > 8.f)) { const float dlt = mx > 8.f ? mx : 0.f, alpha = __builtin_amdgcn_exp2f(-dlt);
                    mrun += dlt; lsum *= alpha;
#pragma unroll
                    for (int d = 0; d < 4; ++d)
#pragma unroll
                        for (int i = 0; i < 16; ++i) O[d][i] *= alpha;
#pragma unroll
                    for (int i = 0; i < 16; ++i) { S[i] -= dlt; negm[i] = -mrun; } }
                float ps = 0.f; f16x8 pf[2];
#pragma unroll
                for (int i = 0; i < 16; ++i) { const float pe = __builtin_amdgcn_exp2f(S[i]); ps += pe; pf[i >> 3][i & 7] = (_Float16)pe; }
                lsum += ps;
                asm volatile("s_waitcnt lgkmcnt(0)" : "+v"(vf[0]), "+v"(vf[2]), "+v"(vf[4]), "+v"(vf[6]));
                AT_RD(vf[1], 1024, vf[0]); AT_RD(vf[3], 3072, vf[0]); AT_RD(vf[5], 5120, vf[0]); AT_RD(vf[7], 7168, vf[0]);
#undef AT_RD
#pragma unroll
                for (int d = 0; d < 4; ++d) O[d] = __builtin_amdgcn_mfma_f32_32x32x16_f16(vf[d * 2], pf[0], O[d], 0, 0, 0);
                asm volatile("s_waitcnt lgkmcnt(0)" : "+v"(vf[1]), "+v"(vf[3]), "+v"(vf[5]), "+v"(vf[7]));
#pragma unroll
                for (int d = 0; d < 4; ++d) O[d] = __builtin_amdgcn_mfma_f32_32x32x16_f16(vf[d * 2 + 1], pf[1], O[d], 0, 0, 0);
            }
        }
        int lane2 = lane; asm volatile("" : "+v"(lane2)); const int l31b = lane2 & 31, hhb = lane2 >> 5;
        const float ltot = lsum + __shfl_xor(lsum, 32), inv = 1.f / ltot;
        float part = 0.f;
#pragma unroll
        for (int d = 0; d < 4; ++d)
#pragma unroll
            for (int i = 0; i < 16; ++i) { O[d][i] *= inv; part += O[d][i] * O[d][i]; }
        part += __shfl_xor(part, 32);
        if (lane2 < 32) ssq[h * 128 + 32 * g + lane2] = part;
        __syncthreads();
        const int qi = 32 * g + l31b;
        const float rstd = sp == 0 ? 1.f : rsqrtf((ssq[qi] + ssq[128 + qi] + ssq[256 + qi] + ssq[384 + qi]) * (1.f / 512.f) + EPS);
#pragma unroll
        for (int d = 0; d < 4; ++d)
#pragma unroll
            for (int ip = 0; ip < 8; ++ip) { const int i = 2 * ip, dv = d * 32 + (i & 3) + 8 * (i >> 2) + 4 * hhb;
                const f32x2 gp = *(const LAS f32x2*)(atg + h * 128 + dv); const float g0 = sp == 0 ? 1.f : gp.x, g1 = sp == 0 ? 1.f : gp.y;
                *(LAS unsigned*)(ostw + l31b * 272 + dv * 2) = pkh(O[d][i] * rstd * g0, O[d][i + 1] * rstd * g1); }
        LDS_WAIT(); asm volatile("" ::: "memory");
#pragma unroll
        for (int i = 0; i < 8; ++i) { const int idx = i * 64 + lane2, row = idx >> 4, ch = idx & 15;
            const u32x4 v = *(const LAS u32x4*)(ostw + row * 272 + ch * 16); *(u32x4*)(cbase + (size_t)row * D + h * 128 + ch * 8) = v; }
        if (sp == 0) __syncthreads();
    }
    {
            int lane2 = lane; asm volatile("" : "+v"(lane2));
            asm volatile("s_waitcnt vmcnt(0)" ::: "memory");
#pragma unroll
            for (int i = 0; i < 8; ++i) { const int idx = i * 64 + lane2, row = idx >> 4, ch = idx & 15;
                u16* ptr = cbase + (size_t)row * D + h2 * 128 + ch * 8; const u32x4 v = *(const u32x4*)ptr; const int qr = 32 * g + row;
                const float rs = rsqrtf((ssq[qr] + ssq[128 + qr] + ssq[256 + qr] + ssq[384 + qr]) * (1.f / 512.f) + EPS);
                const unsigned wv[4] = {v.x, v.y, v.z, v.w}; unsigned ov[4];
#pragma unroll
                for (int e = 0; e < 4; ++e) { const int dv = ch * 8 + 2 * e; const f32x2 gp = *(const LAS f32x2*)(atg + h2 * 128 + dv); ov[e] = pkh(hlo(wv[e]) * rs * gp.x, hhi(wv[e]) * rs * gp.y); }
                u32x4 o; o.x = ov[0]; o.y = ov[1]; o.z = ov[2]; o.w = ov[3]; *(u32x4*)ptr = o; } }
    __syncthreads();
}

__device__ __forceinline__ void phase_p3(const Params& p, LAS unsigned char* lds, int wave, int lane) {
    const int G = gridDim.x, bx = blockIdx.x;
    { LAS unsigned char* scr = lds + wave * 8704; const int gw = bx * NWAVES + wave, NGW = G * NWAVES;
      for (int it = gw; it < NB * 4 * (L / 32); it += NGW) vt_item(p, scr, it, lane); }
    __syncthreads();
    for (int it = bx; it < NB * 4 * NCH; it += G) gla1_item(p, lds, it, wave, lane);
    {
    if (G == 256) { const int bt = bx & 7, j = bx >> 3;
        ThrOps cur; thr_load(p, cur, bt, j, wave);
        for (int r = 0; r < 16; ++r) { const int qb = (r & 1) ? 511 - (32 * (r >> 1) + j) : 32 * (r >> 1) + j; const int rn = r < 15 ? r + 1 : r, qbn = (rn & 1) ? 511 - (32 * (rn >> 1) + j) : 32 * (rn >> 1) + j;
            ThrOps nxt; thr_load(p, nxt, bt, qbn, wave);
            thr_item(p, lds, cur, bt, qb, wave, lane); cur = nxt; } }
    else { for (int it = bx; it < NB * 512; it += G) { ThrOps cur; thr_load(p, cur, it >> 9, it & 511, wave); thr_item(p, lds, cur, it >> 9, it & 511, wave, lane); } } }
}
__device__ __forceinline__ void phase_p5(const Params& p, LAS unsigned char* lds, int wave, int lane) {
    const int G = gridDim.x, bx = blockIdx.x;
    if (G == 256) { const int bt = bx & 7, j = bx >> 3;
        for (int r = 0; r < 2; ++r) att_item(p, lds, bt, r == 0 ? 63 - j : j, wave, lane); }
    else { for (int it = bx; it < NB * 64; it += G) att_item(p, lds, it >> 6, it & 63, wave, lane); }
    { const int N = NB * 4 * NCH; G3Ops cur; if (bx < N) gla3_load(p, cur, bx, wave, lane);
      for (int it = bx; it < N; it += G) { G3Ops nxt; gla3_load(p, nxt, it + G < N ? it + G : it, wave, lane);
          gla3_item(p, lds, cur, it, wave, lane); cur = nxt; }
      __syncthreads(); }
}
}
namespace mk {
#define XB_TMO      128
#define XB_XCNT(j)  (256  + 64 * (j))
#define XB_XSUB(j)  (1280 + 64 * (j))
#define XB_XGEN(j)  (2304 + 64 * (j))
#define XB_TOP      3328
#define XB_TOPGEN   3392
#define XCD_BAR_WORDS 3456
#define XB_SPIN_CAP (1u << 18)

__device__ __forceinline__ unsigned xb_ld(unsigned* p)              { return __hip_atomic_load(p, __ATOMIC_RELAXED, __HIP_MEMORY_SCOPE_AGENT); }
__device__ __forceinline__ unsigned xb_add(unsigned* p, unsigned v) { return __hip_atomic_fetch_add(p, v, __ATOMIC_RELAXED, __HIP_MEMORY_SCOPE_AGENT); }
__device__ __forceinline__ unsigned xb_xcc_id() { return (unsigned)__builtin_amdgcn_s_getreg((3 << 11) | 20) & 0xFu; }
#define XB_SPIN(cond, bar) do { unsigned _sp = 0; while (cond) { __builtin_amdgcn_s_sleep(1); \
    if ((++_sp & 255u) == 0u) { if (xb_ld(&(bar)[XB_TMO])) break; if (_sp > XB_SPIN_CAP) { atomicAdd(&(bar)[XB_TMO], 1u); break; } } } } while (0)

struct XcdBarrier {
    unsigned* bar; unsigned x;
    volatile LAS unsigned* st;
};

__device__ __forceinline__ XcdBarrier xcd_barrier_post(unsigned* bar, volatile LAS unsigned* st) {
    XcdBarrier b; b.bar = bar; b.x = xb_xcc_id(); b.st = st;
    if (threadIdx.x == 0) (void)xb_add(&bar[XB_XCNT(b.x)], 1u);
    return b;
}
__device__ __forceinline__ void xcd_barrier_complete(unsigned* bar, unsigned x, unsigned& nloc, unsigned& nx) {
    const unsigned G = gridDim.x * gridDim.y * gridDim.z;
    unsigned sum, cnt, mine, sp = 0u;
    for (;;) {
        sum = 0u; cnt = 0u; mine = 0u;
#pragma unroll
        for (unsigned j = 0; j < 16; ++j) { const unsigned c = xb_ld(&bar[XB_XCNT(j)]); sum += c; cnt += (c > 0u) ? 1u : 0u; mine = (j == x) ? c : mine; }
        if (sum == G) break;
        __builtin_amdgcn_s_sleep(1);
        if ((++sp & 255u) == 0u) { if (xb_ld(&bar[XB_TMO])) break; if (sp > XB_SPIN_CAP) { atomicAdd(&bar[XB_TMO], 1u); break; } }
    }
    nloc = mine > 0u ? mine : 1u; nx = cnt > 0u ? cnt : 1u;
}

__device__ __forceinline__ void xcd_barrier(const XcdBarrier& b) {
    asm volatile("s_waitcnt vmcnt(0)" ::: "memory");
    __syncthreads();
    if (threadIdx.x == 0) {
        unsigned* bar = b.bar;
        __builtin_amdgcn_s_waitcnt(0);
        unsigned nloc = b.st[0], nx = b.st[1];
        if (nloc == 0u) { xcd_barrier_complete(bar, b.x, nloc, nx); b.st[0] = nloc; b.st[1] = nx; }
        const unsigned old = xb_add(&bar[XB_XSUB(b.x)], 1u);
        const unsigned gen = old / nloc;
        if (old + 1u == (gen + 1u) * nloc) {
            __builtin_amdgcn_fence(__ATOMIC_RELEASE, "agent");
            asm volatile("s_waitcnt vmcnt(0)" ::: "memory");
            const unsigned og = xb_add(&bar[XB_TOP], 1u);
            const unsigned tg = og / nx;
            if (og + 1u == (tg + 1u) * nx) xb_add(&bar[XB_TOPGEN], 1u);
            else XB_SPIN(xb_ld(&bar[XB_TOPGEN]) == tg, bar);
            __builtin_amdgcn_fence(__ATOMIC_ACQUIRE, "agent");
            xb_add(&bar[XB_XGEN(b.x)], 1u);
            asm volatile("s_waitcnt vmcnt(0)" ::: "memory");
        } else {
            XB_SPIN(xb_ld(&bar[XB_XGEN(b.x)]) == gen, bar);
            __builtin_amdgcn_fence(__ATOMIC_ACQUIRE, "agent");
            asm volatile("s_waitcnt vmcnt(0)" ::: "memory");
        }
    }
    __syncthreads();
}

}
namespace mk {
namespace cg = cooperative_groups;
constexpr int NPHASE = 11;
__global__ void __launch_bounds__(NT, 2) mk_fwd(Params p) {
    extern __shared__ __attribute__((aligned(16))) unsigned char lds_raw[];
    LAS unsigned char* lds = (LAS unsigned char*)lds_raw;
    cg::grid_group grid = cg::this_grid();
    const int tid = threadIdx.x, lane = tid & 63, wave = __builtin_amdgcn_readfirstlane(tid >> 6);
    unsigned char* ws = p.ws;
    float* mod = (float*)(ws + WS_MOD);
    volatile LAS unsigned* xst = (volatile LAS unsigned*)(lds + LDS_BYTES - 64);
    if (tid == 0) { xst[0] = 0u; xst[1] = 0u; }
    __syncthreads();
    const XcdBarrier xbar = xcd_barrier_post((unsigned*)(ws + WS_CTL), xst);
#define IN(k) (p.ph_lo <= (k) && (k) < p.ph_hi)
#define SEAM(k) do { if (IN(k) && IN((k) + 1)) { if ((k) == 0) grid.sync(); else xcd_barrier(xbar); } } while (0)
    if (IN(0)) { phase_p0a(p, lds, wave, lane); __syncthreads(); }
    SEAM(0);
    if (IN(1)) { row_phase<0>(p.x, p.norm1_g, mod, 0, D, nullptr, ws + WS_H, wave, lane); phase_p0b(p, lds, wave, lane); }
    SEAM(1);
    if (IN(2)) {
        pg8::Gemm g{(const pg8::bf16_t*)(ws + WS_H), (const pg8::bf16_t*)(ws + WS_WIN), T, 3840, D}; pg8::StaticOrder S; S.init(T, 3840, gridDim.x, blockIdx.x);
        EpiProj E{(u16*)(ws + WS_PROJ), (u16*)(ws + WS_KIDX), (float*)(ws + WS_WIDX), (float*)(ws + WS_GLR), (u16*)(ws + WS_KF)};
        pg8::gemm_phase<EpiProj, pg8::StaticOrder>(lds, g, S, E);
    }
    SEAM(2);
    if (IN(3)) phase_p3(p, lds, wave, lane);
    SEAM(3);
    if (IN(4)) phase_p4(p, lds, wave, lane);
    SEAM(4);
    if (IN(5)) phase_p5(p, lds, wave, lane);
    SEAM(5);
    if (IN(6)) {
        pg8::Gemm g{(const pg8::bf16_t*)(ws + WS_CAT), (const pg8::bf16_t*)(ws + WS_WOUT), T, D, D}; pg8::StaticOrder S; S.init(T, D, gridDim.x, blockIdx.x);
        EpiRes<false> E{p.x, (u16*)(ws + WS_X16), mod, (float*)(ws + WS_SS1), 2 * D, 0};
        pg8::gemm_phase<EpiRes<false>, pg8::StaticOrder>(lds, g, S, E);
    }
    SEAM(6);
    if (IN(7)) row_phase<1>(ws + WS_X16, p.norm2_g, mod, 3 * D, 4 * D, (const float*)(ws + WS_SS1), ws + WS_H, wave, lane);
    SEAM(7);
    if (IN(8)) {
        pg8::Gemm g{(const pg8::bf16_t*)(ws + WS_H), (const pg8::bf16_t*)(ws + WS_WGU), T, 2 * DFF, D}; pg8::StaticOrder S; S.init(T, 2 * DFF, gridDim.x, blockIdx.x);
        EpiSwiGLU E{(u16*)(ws + WS_ACT)};
        pg8::gemm_phase<EpiSwiGLU, pg8::StaticOrder>(lds, g, S, E);
    }
    SEAM(8);
    if (IN(9)) {
        pg8::Gemm g{(const pg8::bf16_t*)(ws + WS_ACT), (const pg8::bf16_t*)(ws + WS_WDN), T, D, DFF}; pg8::StaticOrder S; S.init(T, D, gridDim.x, blockIdx.x);
        EpiRes<true> E{ws + WS_X16, (u16*)(ws + WS_X16), mod, (float*)(ws + WS_SS2), 5 * D, 0};
        pg8::gemm_phase<EpiRes<true>, pg8::StaticOrder>(lds, g, S, E);
    }
    SEAM(9);
    if (IN(10)) row_phase<2>(ws + WS_X16, p.final_g, nullptr, 0, 0, (const float*)(ws + WS_SS2), p.out, wave, lane);
#undef IN
#undef SEAM
}

static int g_grid = 0;
static Params make_params(void* const* d_in, void* d_out, void* d_ws) {
    Params p{};
    p.x = (const float*)d_in[0]; p.c = (const float*)d_in[1]; p.w_mod = (const float*)d_in[2]; p.b_mod = (const float*)d_in[3]; p.norm1_g = (const float*)d_in[4];
    p.w_in = (const float*)d_in[5]; p.w_gate2 = (const float*)d_in[6]; p.b_gate2 = (const float*)d_in[7]; p.att_g = (const float*)d_in[8]; p.gla_g = (const float*)d_in[9];
    p.w_out = (const float*)d_in[10]; p.norm2_g = (const float*)d_in[11]; p.w_gu = (const float*)d_in[12]; p.w_down = (const float*)d_in[13]; p.final_g = (const float*)d_in[14];
    p.out = (float*)d_out; p.ws = (unsigned char*)d_ws; p.ph_lo = 0; p.ph_hi = NPHASE;
    return p;
}
static bool init_grid(size_t ws_size) {
    if (g_grid) return g_grid > 0;
    int dev = 0, cus = 0, per_cu = 0;
    if (hipGetDevice(&dev) != hipSuccess || hipDeviceGetAttribute(&cus, hipDeviceAttributeMultiprocessorCount, dev) != hipSuccess) { g_grid = -1; return false; }
    if (hipFuncSetAttribute((const void*)mk_fwd, hipFuncAttributeMaxDynamicSharedMemorySize, LDS_BYTES) != hipSuccess) { fprintf(stderr, "hipFuncSetAttribute failed\n"); g_grid = -1; return false; }
    if (hipOccupancyMaxActiveBlocksPerMultiprocessor(&per_cu, (const void*)mk_fwd, NT, LDS_BYTES) != hipSuccess || per_cu < 1) { fprintf(stderr, "occupancy query: %d blocks/CU\n", per_cu); g_grid = -1; return false; }
    if (ws_size < WS_END) { fprintf(stderr, "workspace too small: %zu < %zu\n", ws_size, (size_t)WS_END); g_grid = -1; return false; }
    g_grid = cus;
    fprintf(stderr, "mk: grid %d, per_cu %d, ws %zu\n", g_grid, per_cu, ws_size);
    return true;
}
static void launch(Params p, int lo, int hi, hipStream_t stream) {
    p.ph_lo = lo; p.ph_hi = hi;
    if (hipMemsetAsync(p.ws + WS_CTL, 0, 16384, stream) != hipSuccess) { fprintf(stderr, "hipMemsetAsync of the barrier words failed\n"); return; }
    void* args[] = {&p};
    const hipError_t e = hipLaunchCooperativeKernel((const void*)mk_fwd, dim3(g_grid), dim3(NT), args, LDS_BYTES, stream);
    if (e != hipSuccess) fprintf(stderr, "cooperative launch failed: %s (grid %d)\n", hipGetErrorString(e), g_grid);
}
}

extern "C" void kernel_launch(void* const* d_in, const int* in_sizes, int n_in, void* d_out, int out_size, void* d_ws, size_t ws_size, hipStream_t stream) {
    using namespace mk;
    if (n_in != 15 || out_size != T * D) { fprintf(stderr, "kernel_launch: unexpected problem shape\n"); return; }
    if (!init_grid(ws_size)) return;
    Params p = make_params(d_in, d_out, d_ws);
    launch(p, 0, NPHASE, stream);
}
```
